# Optimizing an MI355X kernel written in HIP

```python
import jax, jax.numpy as jnp
from jax import lax
import numpy as np

D_MODEL = 1024
BATCH = 4
SEQ = 4096
DEPTH = 4

N_MIXERS = 4
N_HEADS = 16
HEAD_DIM = D_MODEL // N_HEADS
BLOCK_Q = 128
CHUNK = 128
GMLP_GROUPS = 8
GMLP_DIM = D_MODEL
LORA_W = 64
LORA_A = 64
LORA_G = 128
N_EXPERTS = 16
N_GROUPS = 4
EXPERTS_PER_GROUP = N_EXPERTS // N_GROUPS
TOP_K = 2
D_EXPERT = 512
ALPHA = (2 * DEPTH) ** 0.25
BETA = (8 * DEPTH) ** -0.25
LN_EPS = 1e-5
GN_EPS = 64e-5

kernel_name = "hybrid_fox_gmlp_stickbreak_rwkv7_grouped_moe"


def _layer_norm(x, g, b, eps=LN_EPS):
    xf = x.astype(jnp.float32)
    mu = jnp.mean(xf, axis=-1, keepdims=True)
    var = jnp.mean(jnp.square(xf - mu), axis=-1, keepdims=True)
    return ((xf - mu) * lax.rsqrt(var + eps)).astype(x.dtype) * g + b


def _split_heads(t):
    B, S, _ = t.shape
    return t.reshape(B, S, N_HEADS, HEAD_DIM)


def _query_blocks(t):
    B, S, H, Dh = t.shape
    return t.reshape(B, S // BLOCK_Q, BLOCK_Q, H, Dh).transpose(1, 0, 2, 3, 4)


def _merge_blocks(o):
    nb, B, BQ, H, Dh = o.shape
    return o.transpose(1, 0, 2, 3, 4).reshape(B, nb * BQ, H * Dh)


def forgetting_attention(h, w_in, b_f, w_out):
    B, S, _ = h.shape
    proj = h @ w_in
    q, k, v, f_logit, o_logit = jnp.split(
        proj, [D_MODEL, 2 * D_MODEL, 3 * D_MODEL, 3 * D_MODEL + N_HEADS], axis=-1)
    q, k, v = _split_heads(q), _split_heads(k), _split_heads(v)
    log_f = jax.nn.log_sigmoid((f_logit + b_f).astype(jnp.float32))
    c = jnp.cumsum(log_f, axis=1).transpose(0, 2, 1)
    c_blocks = c.reshape(B, N_HEADS, S // BLOCK_Q, BLOCK_Q).transpose(2, 0, 1, 3)
    key_pos = jnp.arange(S)
    scale = HEAD_DIM ** -0.5

    def block(args):
        i, q_i, c_i = args
        q_pos = i * BLOCK_Q + jnp.arange(BLOCK_Q)
        logits = (jnp.einsum('bqhd,bkhd->bhqk', q_i, k).astype(jnp.float32) * scale
                  + c_i[..., :, None] - c[:, :, None, :])
        logits = jnp.where(key_pos[None, :] <= q_pos[:, None], logits, -jnp.inf)
        p = jax.nn.softmax(logits, axis=-1).astype(v.dtype)
        return jnp.einsum('bhqk,bkhd->bqhd', p, v)

    o = lax.map(block, (jnp.arange(S // BLOCK_Q), _query_blocks(q), c_blocks))
    o = _merge_blocks(o) * jax.nn.sigmoid(o_logit)
    return o @ w_out


def chunked_spatial_gating(h, w_in, b_in, ln_g, ln_b, w_s, b_s, w_out):
    B, S, _ = h.shape
    z = jax.nn.gelu(h @ w_in + b_in)
    u, v = jnp.split(z, 2, axis=-1)
    v = _layer_norm(v, ln_g, ln_b)
    v = v.reshape(B, S // CHUNK, CHUNK, GMLP_GROUPS, GMLP_DIM // GMLP_GROUPS)
    causal = jnp.tril(jnp.ones((CHUNK, CHUNK), dtype=bool))
    w_causal = jnp.where(causal, w_s, 0.0).astype(v.dtype)
    sv = jnp.einsum('gts,bnsgc->bntgc', w_causal, v) + b_s.T[:, :, None]
    y = u * sv.reshape(B, S, GMLP_DIM)
    return y @ w_out


def stick_breaking_attention(h, w_in, w_out):
    B, S, _ = h.shape
    q, k, v = jnp.split(h @ w_in, 3, axis=-1)
    q, k, v = _split_heads(q), _split_heads(k), _split_heads(v)
    key_pos = jnp.arange(S)
    scale = HEAD_DIM ** -0.5

    def block(args):
        i, q_i = args
        q_pos = i * BLOCK_Q + jnp.arange(BLOCK_Q)
        z = jnp.einsum('bqhd,bkhd->bhqk', q_i, k).astype(jnp.float32) * scale
        strict = key_pos[None, :] < q_pos[:, None]
        log_not = jnp.where(strict, jax.nn.log_sigmoid(-z), 0.0)
        log_rest = lax.cumsum(log_not, axis=3, reverse=True) - log_not
        a = jnp.where(strict, jnp.exp(jax.nn.log_sigmoid(z) + log_rest), 0.0).astype(v.dtype)
        return jnp.einsum('bhqk,bkhd->bqhd', a, v)

    o = lax.map(block, (jnp.arange(S // BLOCK_Q), _query_blocks(q)))
    return _merge_blocks(o) @ w_out


def rwkv7_time_mix(h, mu, w_rkv, w0, w1, w2, a0, a1, a2, g1, g2, k_k, k_a, r_k, gn_g, gn_b, w_out):
    B, S, _ = h.shape
    f32 = jnp.float32
    h_prev = jnp.pad(h, ((0, 0), (1, 0), (0, 0)))[:, :-1]
    hm = h[None] + (h_prev - h)[None] * mu[:, None, None, :]
    r, k, v = jnp.einsum('cbsd,cde->cbse', hm[:3], w_rkv)
    x_w, x_a, x_g = hm[3], hm[4], hm[5]
    d = (w0 + jnp.tanh(x_w @ w1) @ w2).astype(f32)
    log_w = -jnp.exp(-jax.nn.softplus(-d) - 0.5)
    a = jax.nn.sigmoid(a0 + (x_a @ a1) @ a2)
    g = jax.nn.sigmoid(x_g @ g1) @ g2
    kk = _split_heads(k * k_k).astype(f32)
    kk = kk / jnp.maximum(jnp.linalg.norm(kk, axis=-1, keepdims=True), 1e-12)
    k = k * (1 + (a - 1) * k_a)

    def heads_t(t):
        return _split_heads(t).astype(f32).transpose(1, 0, 2, 3)

    def step(state, inp):
        r_t, w_t, k_t, v_t, kk_t, a_t = inp
        sa = jnp.einsum('bhij,bhj->bhi', state, -kk_t)
        state = (state * w_t[:, :, None, :]
                 + sa[..., None] * (kk_t * a_t)[:, :, None, :]
                 + v_t[..., None] * k_t[:, :, None, :])
        return state, jnp.einsum('bhij,bhj->bhi', state, r_t)

    state0 = jnp.zeros((B, N_HEADS, HEAD_DIM, HEAD_DIM), f32)
    xs = (heads_t(r), heads_t(jnp.exp(log_w)), heads_t(k), heads_t(v),
          kk.transpose(1, 0, 2, 3), heads_t(a))
    _, y = lax.scan(step, state0, xs)
    y = y.transpose(1, 0, 2, 3)
    mean = jnp.mean(y, axis=-1, keepdims=True)
    var = jnp.mean(jnp.square(y - mean), axis=-1, keepdims=True)
    y = ((y - mean) * lax.rsqrt(var + GN_EPS)).reshape(B, S, D_MODEL) * gn_g + gn_b
    r_h, k_h, v_h = (_split_heads(t).astype(f32) for t in (r, k, v))
    bonus = jnp.sum(r_h * k_h * r_k, axis=-1, keepdims=True) * v_h
    y = (y + bonus.reshape(B, S, D_MODEL)).astype(h.dtype)
    return (y * g) @ w_out


def grouped_moe(h, router_w, router_b, w_gate, w_up, w_down):
    B, S, D = h.shape
    T = B * S
    hf = h.reshape(T, D)
    scores = jax.nn.sigmoid((hf @ router_w).astype(jnp.float32))
    sel = (scores + router_b.astype(jnp.float32)).reshape(T, N_GROUPS, EXPERTS_PER_GROUP)
    group_score = jnp.sum(lax.top_k(sel, TOP_K)[0], axis=-1)
    g_idx = jnp.argmax(group_score, axis=-1)
    in_group = jnp.take_along_axis(sel, g_idx[:, None, None], axis=1)[:, 0]
    _, local = lax.top_k(in_group, TOP_K)
    e_idx = g_idx[:, None] * EXPERTS_PER_GROUP + local
    gate = jnp.take_along_axis(scores, e_idx, axis=-1)
    gate = gate / jnp.sum(gate, axis=-1, keepdims=True)
    combine = jnp.sum(jax.nn.one_hot(e_idx, N_EXPERTS, dtype=jnp.float32) * gate[..., None], axis=1)
    combine = combine.astype(h.dtype)
    y = jnp.zeros_like(hf)
    for e in range(N_EXPERTS):
        he = jax.nn.silu(hf @ w_gate[e]) * (hf @ w_up[e])
        y = y + combine[:, e:e + 1] * (he @ w_down[e])
    return y.reshape(B, S, D)


def setup_inputs(seed: int = 0) -> dict:
    key = jax.random.key(seed)
    keys = iter(jax.random.split(key, 64))

    def normal(shape, scale):
        return scale * jax.random.normal(next(keys), shape, jnp.float32)

    D, H, N = D_MODEL, N_HEADS, HEAD_DIM
    n_fox, n_gm, n_sb, n_rw = [len(range(m, DEPTH, N_MIXERS)) for m in range(N_MIXERS)]
    s_in = D ** -0.5
    inp = {}
    inp["x"] = normal((BATCH, SEQ, D), 1.0)
    inp["ln1_g"] = 1.0 + normal((DEPTH, D), 0.02)
    inp["ln1_b"] = normal((DEPTH, D), 0.02)
    inp["ln2_g"] = 1.0 + normal((DEPTH, D), 0.02)
    inp["ln2_b"] = normal((DEPTH, D), 0.02)
    inp["fox_w_in"] = jnp.concatenate([
        normal((n_fox, D, 2 * D), s_in), normal((n_fox, D, D), s_in * BETA),
        normal((n_fox, D, H), s_in), normal((n_fox, D, D), s_in)], axis=-1)
    inp["fox_b_f"] = 3.0 + normal((n_fox, H), 0.1)
    inp["fox_w_out"] = normal((n_fox, D, D), s_in * BETA)
    inp["gm_w_in"] = normal((n_gm, D, 2 * GMLP_DIM), s_in)
    inp["gm_b_in"] = normal((n_gm, 2 * GMLP_DIM), 0.02)
    inp["gm_ln_g"] = 1.0 + normal((n_gm, GMLP_DIM), 0.02)
    inp["gm_ln_b"] = normal((n_gm, GMLP_DIM), 0.02)
    inp["gm_w_s"] = normal((n_gm, GMLP_GROUPS, CHUNK, CHUNK), CHUNK ** -0.5)
    inp["gm_b_s"] = 1.0 + normal((n_gm, GMLP_GROUPS, CHUNK), 0.02)
    inp["gm_w_out"] = normal((n_gm, GMLP_DIM, D), GMLP_DIM ** -0.5 * BETA)
    inp["sb_w_in"] = jnp.concatenate([
        normal((n_sb, D, 2 * D), s_in), normal((n_sb, D, D), s_in * BETA)], axis=-1)
    inp["sb_w_out"] = normal((n_sb, D, D), s_in * BETA)
    inp["rw_mu"] = jax.random.uniform(next(keys), (n_rw, 6, D), jnp.float32)
    inp["rw_w_rkv"] = jnp.concatenate([
        normal((n_rw, 2, D, D), s_in), normal((n_rw, 1, D, D), s_in * BETA)], axis=1)
    inp["rw_w0"] = normal((n_rw, D), 0.5)
    inp["rw_w1"] = normal((n_rw, D, LORA_W), s_in)
    inp["rw_w2"] = normal((n_rw, LORA_W, D), LORA_W ** -0.5)
    inp["rw_a0"] = normal((n_rw, D), 0.1)
    inp["rw_a1"] = normal((n_rw, D, LORA_A), s_in)
    inp["rw_a2"] = normal((n_rw, LORA_A, D), LORA_A ** -0.5)
    inp["rw_g1"] = normal((n_rw, D, LORA_G), s_in)
    inp["rw_g2"] = normal((n_rw, LORA_G, D), LORA_G ** -0.5)
    inp["rw_k_k"] = 0.85 + normal((n_rw, D), 0.1)
    inp["rw_k_a"] = 1.0 + normal((n_rw, D), 0.1)
    inp["rw_r_k"] = normal((n_rw, H, N), 0.1)
    inp["rw_gn_g"] = 1.0 + normal((n_rw, D), 0.02)
    inp["rw_gn_b"] = normal((n_rw, D), 0.02)
    inp["rw_w_out"] = normal((n_rw, D, D), s_in * BETA)
    inp["router_w"] = normal((D, N_EXPERTS), s_in)
    inp["router_b"] = normal((N_EXPERTS,), 0.01)
    inp["moe_w_gate"] = normal((DEPTH, N_EXPERTS, D, D_EXPERT), s_in)
    inp["moe_w_up"] = normal((DEPTH, N_EXPERTS, D, D_EXPERT), s_in)
    inp["moe_w_down"] = normal((DEPTH, N_EXPERTS, D_EXPERT, D), D_EXPERT ** -0.5 * BETA)
    return inp


def reference(x, ln1_g, ln1_b, ln2_g, ln2_b,
              fox_w_in, fox_b_f, fox_w_out,
              gm_w_in, gm_b_in, gm_ln_g, gm_ln_b, gm_w_s, gm_b_s, gm_w_out,
              sb_w_in, sb_w_out,
              rw_mu, rw_w_rkv, rw_w0, rw_w1, rw_w2, rw_a0, rw_a1, rw_a2, rw_g1, rw_g2,
              rw_k_k, rw_k_a, rw_r_k, rw_gn_g, rw_gn_b, rw_w_out,
              router_w, router_b, moe_w_gate, moe_w_up, moe_w_down):
    h = x
    for i in range(DEPTH):
        kind, j = i % N_MIXERS, i // N_MIXERS
        if kind == 0:
            mix = forgetting_attention(h, fox_w_in[j], fox_b_f[j], fox_w_out[j])
        elif kind == 1:
            mix = chunked_spatial_gating(h, gm_w_in[j], gm_b_in[j], gm_ln_g[j], gm_ln_b[j],
                                         gm_w_s[j], gm_b_s[j], gm_w_out[j])
        elif kind == 2:
            mix = stick_breaking_attention(h, sb_w_in[j], sb_w_out[j])
        else:
            mix = rwkv7_time_mix(h, rw_mu[j], rw_w_rkv[j], rw_w0[j], rw_w1[j], rw_w2[j],
                                 rw_a0[j], rw_a1[j], rw_a2[j], rw_g1[j], rw_g2[j],
                                 rw_k_k[j], rw_k_a[j], rw_r_k[j], rw_gn_g[j], rw_gn_b[j],
                                 rw_w_out[j])
        h = _layer_norm(ALPHA * h + mix, ln1_g[i], ln1_b[i])
        ffn = grouped_moe(h, router_w, router_b, moe_w_gate[i], moe_w_up[i], moe_w_down[i])
        h = _layer_norm(ALPHA * h + ffn, ln2_g[i], ln2_b[i])
    return h
```

```cpp
#include <hip/hip_runtime.h>
#include <cstdio>
#include <cstdint>
#include <hip/hip_bf16.h>
#include <cmath>

#define LAS __attribute__((address_space(3)))
typedef unsigned short bf16;
typedef unsigned u32x4 __attribute__((ext_vector_type(4)));
typedef float f32x4 __attribute__((ext_vector_type(4)));

constexpr int D = 1024, BATCH = 4, SEQ = 4096, T = BATCH * SEQ, NH = 16, HD = 64;
constexpr int NEXP = 16, DEXP = 512;
constexpr float ALPHA = 1.6817928305074290f;
constexpr float LN_EPS = 1e-5f, GN_EPS = 64e-5f;
constexpr float LOG2E = 1.4426950408889634f;
constexpr float C2 = 0.125f * LOG2E;
constexpr int NW = 8, NTHR = 512;
constexpr int MPAD_MAX = 36864;

constexpr size_t MiB = 1u << 20;
constexpr size_t WS_CTL = 0, CTL_BYTES = 1 * MiB;
constexpr size_t WS_FOX_IN = 2 * MiB, WS_FOX_OUT = 10 * MiB, WS_GM_IN = 12 * MiB, WS_GM_OUT = 16 * MiB, WS_GM_WS = 18 * MiB;
constexpr size_t WS_SB_IN = 19 * MiB, WS_SB_OUT = 25 * MiB, WS_RKV = 27 * MiB, WS_LORA1 = 33 * MiB, WS_LORA2 = 35 * MiB, WS_RW_OUT = 134 * MiB;
constexpr size_t WS_GU = 38 * MiB, WS_DOWN = 70 * MiB, WS_MOE_ALT = 48 * MiB;
constexpr size_t WS_HF = 86 * MiB, WS_HB = 150 * MiB;
constexpr size_t WS_TOKE = 182 * MiB, WS_TOKG = WS_TOKE + 128 * 1024, WS_TOKP = WS_TOKG + 128 * 1024, WS_ROWG = WS_TOKP + 128 * 1024, WS_TILEE = WS_ROWG + 256 * 1024, WS_BLKB = WS_TILEE + 4096, WS_TOKQ = WS_BLKB + 32768, WS_P2T = WS_TOKQ + 128 * 1024;
constexpr size_t WS_FL = 184 * MiB, WS_CB = 185 * MiB;
constexpr int ECAP = 16384;
constexpr size_t WS_P2TE = 140 * MiB, WS_ROWGE = 141 * MiB;
constexpr size_t WS_ACT = 186 * MiB;
constexpr size_t WS_Q = WS_ACT, WS_K = WS_ACT + 32 * MiB, WS_V = WS_ACT + 64 * MiB, WS_OG = WS_ACT + 96 * MiB, WS_O = WS_ACT + 128 * MiB;
constexpr size_t WS_Z = WS_ACT, WS_YG = WS_ACT + 64 * MiB;
constexpr size_t WS_HM = WS_ACT, WS_RR = WS_ACT + 192 * MiB, WS_RK = WS_RR + 32 * MiB, WS_RV = WS_RK + 32 * MiB, WS_L1 = WS_RV + 32 * MiB;
constexpr size_t WS_WDEC = WS_ACT, WS_RA = WS_ACT + 64 * MiB, WS_RG = WS_ACT + 96 * MiB, WS_YSC = WS_ACT + 128 * MiB  , WS_RYG = WS_ACT  ;
constexpr size_t WS_XS = WS_ACT, WS_H1 = WS_ACT + 72 * MiB, WS_YD = WS_ACT + 108 * MiB;
constexpr size_t WS_CD0 = 2 * MiB, WS_CD1 = WS_ACT + 128 * MiB;
constexpr size_t WS_WLG = 136 * MiB;
constexpr size_t WS_SIG = 138 * MiB;
constexpr size_t WS_Y2 = WS_L1;
constexpr size_t WS_END = WS_Y2 + 32 * MiB;
constexpr int CW_BAR = 4096;
constexpr int CW_CNT = 200000;

constexpr int LDS_BYTES = 147456;
constexpr int MISC_OFF = LDS_BYTES - 256;

__device__ __forceinline__ float bf2f(unsigned b) { return __uint_as_float(b << 16); }
__device__ __forceinline__ unsigned f2bf(float f) { unsigned u = __float_as_uint(f); return (u + 0x7fffu + ((u >> 16) & 1u)) >> 16; }
typedef float f32x2_hw __attribute__((ext_vector_type(2))); typedef __bf16 bf16x2_hw __attribute__((ext_vector_type(2)));
__device__ __forceinline__ unsigned pk2(float lo, float hi) { f32x2_hw v = {lo, hi}; bf16x2_hw b = __builtin_convertvector(v, bf16x2_hw); return __builtin_bit_cast(unsigned, b); }
template <int CTRL> __device__ __forceinline__ float dppf(float v) { return __int_as_float(__builtin_amdgcn_update_dpp(0, __float_as_int(v), CTRL, 0xf, 0xf, true)); }
__device__ __forceinline__ float red16(float x) { x += dppf<0xB1>(x); x += dppf<0x4E>(x); x += dppf<0x141>(x); x += dppf<0x140>(x); return x; }
__device__ __forceinline__ float wave_sum(float v) {
    v = red16(v);
    return (__uint_as_float(__builtin_amdgcn_readlane(__float_as_uint(v), 0)) + __uint_as_float(__builtin_amdgcn_readlane(__float_as_uint(v), 16)))
         + (__uint_as_float(__builtin_amdgcn_readlane(__float_as_uint(v), 32)) + __uint_as_float(__builtin_amdgcn_readlane(__float_as_uint(v), 48)));
}
__device__ __forceinline__ float wave_max(float v) {
#pragma unroll
    for (int o = 1; o < 64; o <<= 1) v = fmaxf(v, __shfl_xor(v, o));
    return v;
}
__device__ __forceinline__ float wave_incl_scan(float v, int lane) {
#pragma unroll
    for (int o = 1; o < 64; o <<= 1) { float t = __shfl_up(v, o); if (lane >= o) v += t; }
    return v;
}
__device__ __forceinline__ float rdlane(float v, int l) { return __uint_as_float(__builtin_amdgcn_readlane(__float_as_uint(v), l)); }
__device__ __forceinline__ float sigmoidf_(float x) { return 1.0f / (1.0f + expf(-x)); }
__device__ __forceinline__ float softplusf_(float x) { return fmaxf(x, 0.f) + log1pf(expf(-fabsf(x))); }
#define LDS_WAIT() asm volatile("s_waitcnt lgkmcnt(0)" ::: "memory")

#define XB_TMO      128
#define XB_XCNT(j)  (256  + 64 * (j))
#define XB_XSUB(j)  (1280 + 64 * (j))
#define XB_XGEN(j)  (2304 + 64 * (j))
#define XB_TOP      3328
#define XB_TOPGEN   3392
#define XCD_BAR_WORDS 3456
#define XB_SPIN_CAP (1u << 24)
__device__ __forceinline__ unsigned xb_ld(unsigned* p)              { return __hip_atomic_load(p, __ATOMIC_RELAXED, __HIP_MEMORY_SCOPE_AGENT); }
__device__ __forceinline__ unsigned xb_add(unsigned* p, unsigned v) { return __hip_atomic_fetch_add(p, v, __ATOMIC_RELAXED, __HIP_MEMORY_SCOPE_AGENT); }
__device__ __forceinline__ unsigned xb_xcc_id() { return (unsigned)__builtin_amdgcn_s_getreg((3 << 11) | 20) & 0xFu; }
#define XB_SPIN(cond, bar) do { unsigned _sp = 0; while (cond) { __builtin_amdgcn_s_sleep(1); \
    if ((++_sp & 255u) == 0u) { if (xb_ld(&(bar)[XB_TMO])) break; if (_sp > XB_SPIN_CAP) { atomicAdd(&(bar)[XB_TMO], 1u); break; } } } } while (0)
struct XcdBarrier { unsigned* bar; unsigned x; volatile LAS unsigned* st; };
__device__ __forceinline__ XcdBarrier xcd_barrier_post(unsigned* bar, volatile LAS unsigned* st) {
    XcdBarrier b; b.bar = bar; b.x = xb_xcc_id(); b.st = st;
    if (threadIdx.x == 0) (void)xb_add(&bar[XB_XCNT(b.x)], 1u);
    return b;
}
__device__ __forceinline__ void xcd_barrier_complete(unsigned* bar, unsigned x, unsigned& nloc, unsigned& nx) {
    const unsigned G = gridDim.x * gridDim.y * gridDim.z;
    unsigned sum, cnt, mine, sp = 0u;
    for (;;) {
        sum = 0u; cnt = 0u; mine = 0u;
#pragma unroll
        for (unsigned j = 0; j < 16; ++j) { const unsigned c = xb_ld(&bar[XB_XCNT(j)]); sum += c; cnt += (c > 0u) ? 1u : 0u; mine = (j == x) ? c : mine; }
        if (sum == G) break;
        __builtin_amdgcn_s_sleep(1);
        if ((++sp & 255u) == 0u) { if (xb_ld(&bar[XB_TMO])) break; if (sp > XB_SPIN_CAP) { atomicAdd(&bar[XB_TMO], 1u); break; } }
    }
    nloc = mine > 0u ? mine : 1u; nx = cnt > 0u ? cnt : 1u;
}
__device__ __forceinline__ void xcd_barrier(const XcdBarrier& b) {
    asm volatile("s_waitcnt vmcnt(0)" ::: "memory");
    __syncthreads();
    if (threadIdx.x == 0) {
        unsigned* bar = b.bar;
        __builtin_amdgcn_s_waitcnt(0);
        unsigned nloc = b.st[0], nx = b.st[1];
        if (nloc == 0u) { xcd_barrier_complete(bar, b.x, nloc, nx); b.st[0] = nloc; b.st[1] = nx; }
        const unsigned old = xb_add(&bar[XB_XSUB(b.x)], 1u);
        const unsigned gen = old / nloc;
        if (old + 1u == (gen + 1u) * nloc) {
            __builtin_amdgcn_fence(__ATOMIC_RELEASE, "agent");
            asm volatile("s_waitcnt vmcnt(0)" ::: "memory");
            const unsigned og = xb_add(&bar[XB_TOP], 1u);
            const unsigned tg = og / nx;
            if (og + 1u == (tg + 1u) * nx) xb_add(&bar[XB_TOPGEN], 1u);
            else XB_SPIN(xb_ld(&bar[XB_TOPGEN]) == tg, bar);
            __builtin_amdgcn_fence(__ATOMIC_ACQUIRE, "agent");
            xb_add(&bar[XB_XGEN(b.x)], 1u);
            asm volatile("s_waitcnt vmcnt(0)" ::: "memory");
        } else {
            XB_SPIN(xb_ld(&bar[XB_XGEN(b.x)]) == gen, bar);
            __builtin_amdgcn_fence(__ATOMIC_ACQUIRE, "agent");
            asm volatile("s_waitcnt vmcnt(0)" ::: "memory");
        }
    }
    __syncthreads();
}

namespace pg8 {
#define PG8_LAS __attribute__((address_space(3)))
typedef unsigned short bf16_t;
typedef short bf16x8 __attribute__((ext_vector_type(8)));
typedef float f32x4 __attribute__((ext_vector_type(4)));
typedef unsigned u32x4 __attribute__((ext_vector_type(4)));
constexpr int BM = 256, BK = 64, HALF = 128, HTB = HALF * BK * 2  , STAGE_BYTES = 8 * HTB, NXCD = 8, WGM = 8;

__host__ __device__ __forceinline__ int lds_byte(int r, int c) { const int st = (r >> 4) * 2 + (c >> 5), rr = r & 15, cc = c & 31, ob = rr * 64 + cc * 2; return st * 1024 + (ob ^ (((ob >> 9) & 1) << 5)); }
__host__ __device__ __forceinline__ void stage_rc(int b, int& R, int& C) { const int st = b / 1024, sb = b % 1024, swz = sb ^ (((sb >> 9) & 1) << 5); R = (st >> 1) * 16 + swz / 64; C = (st & 1) * 32 + (swz % 64) / 2; }
__host__ __device__ __forceinline__ int perm32(int rho) { const int n = rho >> 4, i = rho & 15; return 8 * (i >> 2) + 4 * n + (i & 3); }

struct Unit { int pm, pn, rt, nv; };
struct Gemm { const bf16_t* A; const bf16_t* Bt; int M, N, K; const int* rowtok; };

struct StaticOrder {
    static constexpr bool HALF_SKIP = false;
    int nM, nN, nwg, G, c;
    __host__ __device__ void init(int M, int N, int G_, int c_) { nM = M / BM; nN = N / BM; nwg = nM * nN; G = G_; c = c_; }
    __host__ __device__ bool next(int i, Unit& u) const {
        const long L = (long)i * G + c; if (L >= nwg) return false;
        int wgid = (int)L; { const int q = nwg / NXCD, r = nwg % NXCD, xcd = wgid % NXCD, off = wgid / NXCD; wgid = (xcd < r ? xcd * (q + 1) : r * (q + 1) + (xcd - r) * q) + off; }
        const int nig = WGM * nN, gid = wgid / nig, fm = gid * WGM, gsz = (nM - fm) < WGM ? (nM - fm) : WGM;
        u.pm = fm + ((wgid % nig) % gsz); u.pn = (wgid % nig) / gsz; return true;
    }
    __device__ __forceinline__ void a_ready(const Unit&) const {}
    __device__ __forceinline__ void done(const Unit&) const {}
};

__device__ __forceinline__ unsigned cvt_pk_bf16(float lo, float hi) { unsigned r; asm volatile("v_cvt_pk_bf16_f32 %0, %1, %2" : "=v"(r) : "v"(lo), "v"(hi)); return r; }
typedef float f32x2 __attribute__((ext_vector_type(2)));
__device__ __forceinline__ f32x2 gelu_pk(f32x2 v) {
    const f32x2 av = __builtin_elementwise_abs(v), d = av * 0.2316418882f + 1.0f;
    f32x2 t; t.x = __builtin_amdgcn_rcpf(d.x); t.y = __builtin_amdgcn_rcpf(d.y);
    f32x2 q = t * 0.5307027145f + (-0.7265760135f); q = q * t + 0.7107068705f; q = q * t + (-0.142248368f); q = q * t + 0.127414796f; q = q * t;
    const f32x2 s = (v * v) * (-0.72134752044f);
    f32x2 e; e.x = __builtin_amdgcn_exp2f(s.x); e.y = __builtin_amdgcn_exp2f(s.y);
    const f32x2 m = v * (q * e), r = v - m;
    f32x2 o; o.x = v.x < 0.f ? m.x : r.x; o.y = v.y < 0.f ? m.y : r.y; return o;
}

template <int ACT  > struct EpiBf16 {
    static constexpr bool PERM = true, AFTER_DRAIN = false; static_assert(ACT == 0 || ACT == 1, "EpiBf16: ACT is 0 (none) or 1 (gelu_pk)");
    bf16_t* O; int ldc; const float* bias; int split_cols; size_t split_stride; float scale0;
    __device__ __forceinline__ void operator()(const f32x4 (&acc)[2][2][4][2], const Unit& u, int wr, int wc, int fr, int fq) const {
        const int row0 = u.pm * BM + wr * 64 + fr; int colt = u.pn * BM; bf16_t* base = O;
        float sc = 1.f; if (split_cols) { const int t = colt / split_cols; base += (size_t)t * split_stride; colt -= t * split_cols; if (t == 0) sc = scale0; }
        const int col0 = colt + wc * 32 + 8 * fq, bcol0 = u.pn * BM + wc * 32 + 8 * fq;
        f32x4 bv[2][2];
#pragma unroll
        for (int bj = 0; bj < 2; ++bj)
#pragma unroll
            for (int n = 0; n < 2; ++n) bv[bj][n] = bias ? *(const f32x4*)(bias + bcol0 + bj * HALF + 4 * n) : (f32x4){0.f, 0.f, 0.f, 0.f};
#pragma unroll
        for (int ai = 0; ai < 2; ++ai)
#pragma unroll
            for (int m = 0; m < 4; ++m) { bf16_t* rowp = base + (size_t)(row0 + ai * HALF + m * 16) * ldc + col0;
#pragma unroll
                for (int bj = 0; bj < 2; ++bj) { f32x4 v0 = acc[ai][bj][m][0] + bv[bj][0], v1 = acc[ai][bj][m][1] + bv[bj][1];
                    if (ACT == 1) { f32x2 a = gelu_pk((f32x2){v0[0], v0[1]}), b = gelu_pk((f32x2){v0[2], v0[3]}), c = gelu_pk((f32x2){v1[0], v1[1]}), d = gelu_pk((f32x2){v1[2], v1[3]});
                        v0 = (f32x4){a.x, a.y, b.x, b.y}; v1 = (f32x4){c.x, c.y, d.x, d.y}; }
                    v0 = v0 * sc; v1 = v1 * sc; u32x4 w; w.x = cvt_pk_bf16(v0[0], v0[1]); w.y = cvt_pk_bf16(v0[2], v0[3]); w.z = cvt_pk_bf16(v1[0], v1[1]); w.w = cvt_pk_bf16(v1[2], v1[3]);
                    *(u32x4*)(rowp + bj * HALF) = w; } }
    }
};


template <class Epi, class Sched, bool ALIGN_EPI = false, bool SP2 = false, bool GATH = false>
__device__ __forceinline__ void gemm_phase(PG8_LAS unsigned char* lds, const Gemm g, const Sched& S, const Epi& E) {
    const int tid = threadIdx.x, wid = __builtin_amdgcn_readfirstlane(tid >> 6), lane = tid & 63, wr = wid >> 2, wc = wid & 3, fr = lane & 15, fq = lane >> 4;
    const int K = g.K, nt = K / BK;
    unsigned voffA[2], voffB[2];
#pragma unroll
    for (int i = 0; i < 2; ++i) { int R, C; stage_rc(tid * 16 + i * 8192, R, C); const int Rb = Epi::PERM ? ((R & ~31) + perm32(R & 31)) : R;
        voffA[i] = (unsigned)(R * K + C) * 2u; voffB[i] = (unsigned)(Rb * K + C) * 2u; }
    static_assert(!GATH || SP2, "GATH is implemented for the SP2 loop only");
    int gR[2]; unsigned gC[2]; unsigned ogC[2][2], ogN[2][2];
    if constexpr (GATH) {
#pragma unroll
        for (int i = 0; i < 2; ++i) { int R, C; stage_rc(tid * 16 + i * 8192, R, C); gR[i] = R; gC[i] = (unsigned)C * 2u; }
    }
#define PG8_OG(og, U_) do { _Pragma("unroll") for (int h_ = 0; h_ < 2; ++h_) _Pragma("unroll") for (int i_ = 0; i_ < 2; ++i_) { const int rr_ = h_ * HALF + gR[i_]; \
        og[h_][i_] = (unsigned)(rr_ < (U_).nv ? g.rowtok[(U_).rt * BM + rr_] : 0) * (unsigned)(K * 2) + gC[i_]; } } while (0)
    const size_t kstep = (size_t)(BK * 2);
    const size_t hstep = (size_t)HALF * K * 2;
    const size_t tstep = 2 * hstep;
    const unsigned ldsw = (unsigned)wid * 1024u;
    const int aoff = lds_byte(wr * 64 + fr, fq * 8), boff = lds_byte(wc * 32 + fr, fq * 8);
#define PG8_SA(b, h) (((b) * 2 + (h)) * HTB)
#define PG8_SB(b, h) ((4 + (b) * 2 + (h)) * HTB)
#define PG8_STAGE(bufoff, gbase, voff) do { _Pragma("unroll") for (int _i = 0; _i < 2; ++_i) \
        __builtin_amdgcn_global_load_lds((const unsigned*)((const char*)(gbase) + (voff)[_i]), (PG8_LAS unsigned*)(lds + (bufoff) + ldsw + _i * 8192), 16, 0, 0); } while (0)
#define PG8_STAGE_G(bufoff, kptr, og) do { _Pragma("unroll") for (int _i = 0; _i < 2; ++_i) \
        __builtin_amdgcn_global_load_lds((const unsigned*)((const char*)(kptr) + (og)[_i]), (PG8_LAS unsigned*)(lds + (bufoff) + ldsw + _i * 8192), 16, 0, 0); } while (0)
#define PG8_STAGE_A(bufoff, tp, kp, h, sel) do { if constexpr (GATH) { unsigned og_[2] = {(sel) ? ogN[h][0] : ogC[h][0], (sel) ? ogN[h][1] : ogC[h][1]}; PG8_STAGE_G(bufoff, kp, og_); } \
        else { PG8_STAGE(bufoff, (tp) + (h) * hstep, voffA); } } while (0)
#define PG8_LDA(dst, b, h) do { _Pragma("unroll") for (int m = 0; m < 4; ++m) _Pragma("unroll") for (int k = 0; k < 2; ++k) dst[m][k] = *(const PG8_LAS bf16x8*)(lds + PG8_SA(b, h) + aoff + m * 2048 + k * 1024); } while (0)
#define PG8_LDB(dst, b, h) do { _Pragma("unroll") for (int n = 0; n < 2; ++n) _Pragma("unroll") for (int k = 0; k < 2; ++k) dst[n][k] = *(const PG8_LAS bf16x8*)(lds + PG8_SB(b, h) + boff + n * 2048 + k * 1024); } while (0)
#define PG8_MMA(ai, bj, At, Bt) do { __builtin_amdgcn_s_setprio(1); _Pragma("unroll") for (int m = 0; m < 4; ++m) _Pragma("unroll") for (int n = 0; n < 2; ++n) _Pragma("unroll") for (int k = 0; k < 2; ++k) \
        acc[ai][bj][m][n] = __builtin_amdgcn_mfma_f32_16x16x32_bf16(Bt[n][k], At[m][k], acc[ai][bj][m][n], 0, 0, 0); __builtin_amdgcn_s_setprio(0); } while (0)
#define PG8_WAIT_V(n) asm volatile("s_waitcnt vmcnt(" #n ")" ::: "memory")
#define PG8_WAIT_L(n) asm volatile("s_waitcnt lgkmcnt(" #n ")" ::: "memory")
#define PG8_BAR __builtin_amdgcn_s_barrier()
#define PG8_SCHED __builtin_amdgcn_sched_barrier(0)
    Unit cur, nxt; int ui = 0;
    if (!S.next(0, cur)) return;
    f32x4 acc[2][2][4][2];
#pragma unroll
    for (int a = 0; a < 2; ++a)
#pragma unroll
        for (int b = 0; b < 2; ++b)
#pragma unroll
            for (int m = 0; m < 4; ++m)
#pragma unroll
                for (int n = 0; n < 2; ++n) acc[a][b][m][n] = (f32x4){0.f, 0.f, 0.f, 0.f};
    bf16x8 At[4][2], B0[2][2], B1[2][2];
    const char* cA = (const char*)g.A + (size_t)cur.pm * tstep; const char* cB = (const char*)g.Bt + (size_t)cur.pn * tstep;
    const char* const gA = (const char*)g.A;
    if constexpr (GATH) { PG8_OG(ogC, cur); }
    S.a_ready(cur);
    if constexpr (SP2) {
        PG8_STAGE(PG8_SB(0, 0), cB, voffB); PG8_STAGE(PG8_SB(0, 1), cB + hstep, voffB); PG8_STAGE_A(PG8_SA(0, 0), cA, gA, 0, false); PG8_STAGE_A(PG8_SA(0, 1), cA, gA, 1, false);
        if (wr == 1) PG8_BAR;
        PG8_WAIT_V(2); PG8_BAR;
        PG8_STAGE(PG8_SB(1, 0), cB + kstep, voffB); PG8_STAGE_A(PG8_SA(1, 0), cA + kstep, gA + kstep, 0, false); PG8_STAGE(PG8_SB(1, 1), cB + hstep + kstep, voffB);
        PG8_WAIT_V(6); PG8_BAR;
    } else {
        PG8_STAGE(PG8_SB(0, 0), cB, voffB); PG8_STAGE(PG8_SA(0, 0), cA, voffA); PG8_STAGE(PG8_SB(0, 1), cB + hstep, voffB); PG8_STAGE(PG8_SA(0, 1), cA + hstep, voffA);
        if (wr == 1) PG8_BAR;
        PG8_WAIT_V(4); PG8_BAR;
        PG8_STAGE(PG8_SB(1, 0), cB + kstep, voffB); PG8_STAGE(PG8_SA(1, 0), cA + kstep, voffA); PG8_STAGE(PG8_SB(1, 1), cB + hstep + kstep, voffB);
        PG8_WAIT_V(6); PG8_BAR;
    }
    for (;;) {
        const bool has_next = S.next(ui + 1, nxt);
        if constexpr (GATH) { if (has_next) { PG8_OG(ogN, nxt); } }
        const char* nA = has_next ? (const char*)g.A + (size_t)nxt.pm * tstep : cA; const char* nB = has_next ? (const char*)g.Bt + (size_t)nxt.pn * tstep : cB;
        const bool h1 = !Sched::HALF_SKIP || cur.nv > HALF;
        for (int t = 0; t < nt; t += 2) {
            const bool last = (t == nt - 2);
            const char* a1 = cA + (size_t)(t + 1) * kstep;
            const char* a2 = last ? nA : cA + (size_t)(t + 2) * kstep; const char* b2 = last ? nB : cB + (size_t)(t + 2) * kstep;
            const char* a3 = a2 + kstep; const char* b3 = b2 + kstep;
            const bool gsel = last && has_next; const char* ga1 = gA + (size_t)(t + 1) * kstep; const char* ga2 = last ? gA : gA + (size_t)(t + 2) * kstep; const char* ga3 = ga2 + kstep;
            if (last && has_next) S.a_ready(nxt);
            if constexpr (SP2) {
            PG8_LDB(B0, 0, 0); PG8_LDB(B1, 0, 1); PG8_SCHED; PG8_LDA(At, 0, 0); PG8_STAGE_A(PG8_SA(1, 1), a1, ga1, 1, false);
            PG8_WAIT_V(8); PG8_WAIT_L(0); PG8_BAR; PG8_MMA(0, 0, At, B0); PG8_MMA(0, 1, At, B1); PG8_BAR; PG8_SCHED;
            PG8_LDA(At, 0, 1); PG8_STAGE(PG8_SB(0, 0), b2, voffB); PG8_STAGE(PG8_SB(0, 1), b2 + hstep, voffB); PG8_STAGE_A(PG8_SA(0, 0), a2, ga2, 0, gsel);
            PG8_WAIT_V(8); PG8_WAIT_L(0); PG8_BAR; if (h1) { PG8_MMA(1, 0, At, B0); PG8_MMA(1, 1, At, B1); } PG8_BAR; PG8_SCHED;
            PG8_LDB(B0, 1, 0); PG8_LDB(B1, 1, 1); PG8_SCHED; PG8_LDA(At, 1, 0); PG8_STAGE_A(PG8_SA(0, 1), a2, ga2, 1, gsel);
            PG8_WAIT_V(8); PG8_WAIT_L(0); PG8_BAR; PG8_MMA(0, 0, At, B0); PG8_MMA(0, 1, At, B1); PG8_BAR; PG8_SCHED;
            PG8_LDA(At, 1, 1); PG8_STAGE(PG8_SB(1, 0), b3, voffB); PG8_STAGE(PG8_SB(1, 1), b3 + hstep, voffB); PG8_STAGE_A(PG8_SA(1, 0), a3, ga3, 0, gsel);
            PG8_WAIT_V(8); PG8_WAIT_L(0); PG8_BAR; if (h1) { PG8_MMA(1, 0, At, B0); PG8_MMA(1, 1, At, B1); } PG8_BAR; PG8_SCHED;
            } else {
            PG8_LDB(B0, 0, 0); PG8_SCHED; PG8_LDA(At, 0, 0); PG8_STAGE(PG8_SA(1, 1), a1 + hstep, voffA);
            PG8_WAIT_L(8); PG8_BAR; PG8_WAIT_L(0); PG8_MMA(0, 0, At, B0); PG8_BAR; PG8_SCHED;
            PG8_LDB(B1, 0, 1); PG8_STAGE(PG8_SB(0, 0), b2, voffB);
            PG8_BAR; PG8_WAIT_L(0); PG8_MMA(0, 1, At, B1); PG8_BAR;
            PG8_LDA(At, 0, 1); PG8_STAGE(PG8_SA(0, 0), a2, voffA);
            PG8_BAR; PG8_WAIT_L(0); PG8_MMA(1, 0, At, B0); PG8_BAR; PG8_SCHED;
            PG8_STAGE(PG8_SB(0, 1), b2 + hstep, voffB);
            PG8_WAIT_V(6); PG8_BAR; PG8_MMA(1, 1, At, B1); PG8_BAR;
            PG8_LDB(B0, 1, 0); PG8_SCHED; PG8_LDA(At, 1, 0); PG8_STAGE(PG8_SA(0, 1), a2 + hstep, voffA);
            PG8_WAIT_L(8); PG8_BAR; PG8_WAIT_L(0); PG8_MMA(0, 0, At, B0); PG8_BAR; PG8_SCHED;
            PG8_LDB(B1, 1, 1); PG8_STAGE(PG8_SB(1, 0), b3, voffB);
            PG8_BAR; PG8_WAIT_L(0); PG8_MMA(0, 1, At, B1); PG8_BAR;
            PG8_LDA(At, 1, 1); PG8_STAGE(PG8_SA(1, 0), a3, voffA);
            PG8_BAR; PG8_WAIT_L(0); PG8_MMA(1, 0, At, B0); PG8_BAR; PG8_SCHED;
            PG8_STAGE(PG8_SB(1, 1), b3 + hstep, voffB);
            PG8_WAIT_V(6); PG8_BAR; PG8_MMA(1, 1, At, B1); PG8_BAR;
            }
        }
        if constexpr (ALIGN_EPI) { if (wr == 0) PG8_BAR; }
        if constexpr (!Epi::AFTER_DRAIN) { E(acc, cur, wr, wc, fr, fq); S.done(cur); }
        if (!has_next) break;
#pragma unroll
        for (int a = 0; a < 2; ++a)
#pragma unroll
            for (int b = 0; b < 2; ++b)
#pragma unroll
                for (int m = 0; m < 4; ++m)
#pragma unroll
                    for (int n = 0; n < 2; ++n) acc[a][b][m][n] = (f32x4){0.f, 0.f, 0.f, 0.f};
        cur = nxt; cA = nA; cB = nB; ++ui;
        if constexpr (GATH) { ogC[0][0] = ogN[0][0]; ogC[0][1] = ogN[0][1]; ogC[1][0] = ogN[1][0]; ogC[1][1] = ogN[1][1]; }
        if constexpr (ALIGN_EPI) { if (wr == 1) PG8_BAR; }
    }
    PG8_WAIT_V(0);
    if constexpr (!ALIGN_EPI) { if (wr == 0) PG8_BAR; }
    PG8_BAR;
    if constexpr (Epi::AFTER_DRAIN) { E.fused(acc, cur, wr, wc, fr, fq, lds, wid, lane); S.done(cur); }
#undef PG8_SA
#undef PG8_SB
#undef PG8_STAGE
#undef PG8_LDA
#undef PG8_STAGE_G
#undef PG8_STAGE_A
#undef PG8_OG
#undef PG8_LDB
#undef PG8_MMA
#undef PG8_WAIT_V
#undef PG8_WAIT_L
#undef PG8_BAR
#undef PG8_SCHED
}

__device__ __forceinline__ float gelu_tanh_f(float x) { const float t = x + 0.044715f * x * x * x; return x * __builtin_amdgcn_rcpf(1.0f + __builtin_amdgcn_exp2f(-2.302208198f * t)); }
__device__ __forceinline__ float silu_f(float x) { return x * __builtin_amdgcn_rcpf(1.0f + __builtin_amdgcn_exp2f(-1.4426950408889634f * x)); }
__device__ __forceinline__ float sigm_f(float x) { return __builtin_amdgcn_rcpf(1.0f + __builtin_amdgcn_exp2f(-1.4426950408889634f * x)); }
template <int ACT  > struct EpiBf16X {
    static constexpr bool PERM = true, AFTER_DRAIN = false;
    bf16_t* O; int ldc; const float* bias; int split_cols; size_t split_stride; float scale0;
    __device__ __forceinline__ void operator()(const f32x4 (&acc)[2][2][4][2], const Unit& u, int wr, int wc, int fr, int fq) const {
        const int row0 = u.pm * BM + wr * 64 + fr; int colt = u.pn * BM; bf16_t* base = O;
        float sc = 1.f; if (split_cols) { const int t = colt / split_cols; base += (size_t)t * split_stride; colt -= t * split_cols; if (t == 0) sc = scale0; }
        const int col0 = colt + wc * 32 + 8 * fq, bcol0 = u.pn * BM + wc * 32 + 8 * fq;
        f32x4 bv[2][2];
#pragma unroll
        for (int bj = 0; bj < 2; ++bj)
#pragma unroll
            for (int n = 0; n < 2; ++n) bv[bj][n] = bias ? *(const f32x4*)(bias + bcol0 + bj * HALF + 4 * n) : (f32x4){0.f, 0.f, 0.f, 0.f};
#pragma unroll
        for (int ai = 0; ai < 2; ++ai)
#pragma unroll
            for (int m = 0; m < 4; ++m) { bf16_t* rowp = base + (size_t)(row0 + ai * HALF + m * 16) * ldc + col0;
#pragma unroll
                for (int bj = 0; bj < 2; ++bj) { f32x4 v0 = acc[ai][bj][m][0] + bv[bj][0], v1 = acc[ai][bj][m][1] + bv[bj][1];
                    if (ACT == 2) {
#pragma unroll
                        for (int i = 0; i < 4; ++i) { v0[i] = gelu_tanh_f(v0[i]); v1[i] = gelu_tanh_f(v1[i]); } }
                    v0 = v0 * sc; v1 = v1 * sc; u32x4 w; w.x = cvt_pk_bf16(v0[0], v0[1]); w.y = cvt_pk_bf16(v0[2], v0[3]); w.z = cvt_pk_bf16(v1[0], v1[1]); w.w = cvt_pk_bf16(v1[2], v1[3]);
                    *(u32x4*)(rowp + bj * HALF) = w; } }
    }
};
struct EpiResid {
    static constexpr bool PERM = true, AFTER_DRAIN = false;
    bf16_t* H; float alpha;
    __device__ __forceinline__ void operator()(const f32x4 (&acc)[2][2][4][2], const Unit& u, int wr, int wc, int fr, int fq) const {
        const int row0 = u.pm * BM + wr * 64 + fr, col0 = u.pn * BM + wc * 32 + 8 * fq;
#pragma unroll
        for (int ai = 0; ai < 2; ++ai) {
            u32x4 hres[4][2];
#pragma unroll
            for (int m = 0; m < 4; ++m)
#pragma unroll
                for (int bj = 0; bj < 2; ++bj) hres[m][bj] = *(const u32x4*)(H + (size_t)(row0 + ai * HALF + m * 16) * 1024 + col0 + bj * HALF);
#pragma unroll
            for (int m = 0; m < 4; ++m) { bf16_t* rowp = H + (size_t)(row0 + ai * HALF + m * 16) * 1024 + col0;
#pragma unroll
                for (int bj = 0; bj < 2; ++bj) { const u32x4 h = hres[m][bj]; const f32x4 a0 = acc[ai][bj][m][0], a1 = acc[ai][bj][m][1]; u32x4 w;
                    w.x = cvt_pk_bf16(alpha * __uint_as_float(h.x << 16) + a0[0], alpha * __uint_as_float(h.x & 0xffff0000u) + a0[1]);
                    w.y = cvt_pk_bf16(alpha * __uint_as_float(h.y << 16) + a0[2], alpha * __uint_as_float(h.y & 0xffff0000u) + a0[3]);
                    w.z = cvt_pk_bf16(alpha * __uint_as_float(h.z << 16) + a1[0], alpha * __uint_as_float(h.z & 0xffff0000u) + a1[1]);
                    w.w = cvt_pk_bf16(alpha * __uint_as_float(h.w << 16) + a1[2], alpha * __uint_as_float(h.w & 0xffff0000u) + a1[3]);
                    *(u32x4*)(rowp + bj * HALF) = w; } }
        }
    }
};
struct EpiSwiglu {
    static constexpr bool PERM = true, AFTER_DRAIN = false;
    bf16_t* H1;
    __device__ __forceinline__ void operator()(const f32x4 (&acc)[2][2][4][2], const Unit& u, int wr, int wc, int fr, int fq) const {
        const int row0 = u.pm * BM + wr * 64 + fr, col0 = (u.pn & 3) * 128 + wc * 32 + 8 * fq;
#pragma unroll
        for (int ai = 0; ai < 2; ++ai)
#pragma unroll
            for (int m = 0; m < 4; ++m) { bf16_t* rowp = H1 + (size_t)(row0 + ai * HALF + m * 16) * 512 + col0;
                f32x4 h0, h1;
#pragma unroll
                for (int i = 0; i < 4; ++i) { h0[i] = silu_f(acc[ai][0][m][0][i]) * acc[ai][1][m][0][i]; h1[i] = silu_f(acc[ai][0][m][1][i]) * acc[ai][1][m][1][i]; }
                u32x4 w; w.x = cvt_pk_bf16(h0[0], h0[1]); w.y = cvt_pk_bf16(h0[2], h0[3]); w.z = cvt_pk_bf16(h1[0], h1[1]); w.w = cvt_pk_bf16(h1[2], h1[3]);
                *(u32x4*)rowp = w; }
    }
};
struct EpiDown {
    static constexpr bool PERM = true, AFTER_DRAIN = false;
    bf16_t* Yd; const float* rowg;
    __device__ __forceinline__ void operator()(const f32x4 (&acc)[2][2][4][2], const Unit& u, int wr, int wc, int fr, int fq) const {
        const int row0 = u.pm * BM + wr * 64 + fr, col0 = (u.pn & 3) * BM + wc * 32 + 8 * fq;
        float scv[2][4];
#pragma unroll
        for (int ai = 0; ai < 2; ++ai)
#pragma unroll
            for (int m = 0; m < 4; ++m) scv[ai][m] = rowg[u.rt * BM + wr * 64 + fr + ai * HALF + m * 16];
#pragma unroll
        for (int ai = 0; ai < 2; ++ai)
#pragma unroll
            for (int m = 0; m < 4; ++m) { const int row = row0 + ai * HALF + m * 16; const float sc = scv[ai][m]; bf16_t* rowp = Yd + (size_t)row * 1024 + col0;
#pragma unroll
                for (int bj = 0; bj < 2; ++bj) { const f32x4 v0 = acc[ai][bj][m][0] * sc, v1 = acc[ai][bj][m][1] * sc;
                    u32x4 w; w.x = cvt_pk_bf16(v0[0], v0[1]); w.y = cvt_pk_bf16(v0[2], v0[3]); w.z = cvt_pk_bf16(v1[0], v1[1]); w.w = cvt_pk_bf16(v1[2], v1[3]);
                    *(u32x4*)(rowp + bj * HALF) = w; } }
    }
};
struct EpiRw1 {
    static constexpr bool PERM = true, AFTER_DRAIN = false;
    bf16_t* RKV; bf16_t* L1; int Trows;
    __device__ __forceinline__ void operator()(const f32x4 (&acc)[2][2][4][2], const Unit& u, int wr, int wc, int fr, int fq) const {
        const int t0 = (u.pm & 63) * BM + wr * 64 + fr;
        if (u.pn < 12) { const int cc = u.pn >> 2, col0 = (u.pn & 3) * BM + wc * 32 + 8 * fq;
#pragma unroll
            for (int ai = 0; ai < 2; ++ai)
#pragma unroll
                for (int m = 0; m < 4; ++m) { bf16_t* rowp = RKV + (size_t)cc * Trows * 1024 + (size_t)(t0 + ai * HALF + m * 16) * 1024 + col0;
#pragma unroll
                    for (int bj = 0; bj < 2; ++bj) { const f32x4 v0 = acc[ai][bj][m][0], v1 = acc[ai][bj][m][1];
                        u32x4 w; w.x = cvt_pk_bf16(v0[0], v0[1]); w.y = cvt_pk_bf16(v0[2], v0[3]); w.z = cvt_pk_bf16(v1[0], v1[1]); w.w = cvt_pk_bf16(v1[2], v1[3]);
                        *(u32x4*)(rowp + bj * HALF) = w; } }
        } else { const int j = u.pn - 12, col0 = wc * 32 + 8 * fq;
#pragma unroll
            for (int ai = 0; ai < 2; ++ai)
#pragma unroll
                for (int m = 0; m < 4; ++m) { bf16_t* rowp = L1 + (size_t)j * Trows * 128 + (size_t)(t0 + ai * HALF + m * 16) * 128 + col0;
                    f32x4 v0 = acc[ai][0][m][0], v1 = acc[ai][0][m][1];
#pragma unroll
                    for (int i = 0; i < 4; ++i) { if (j == 0) { v0[i] = 2.f * sigm_f(2.f * v0[i]) - 1.f; v1[i] = 2.f * sigm_f(2.f * v1[i]) - 1.f; } else if (j == 2) { v0[i] = sigm_f(v0[i]); v1[i] = sigm_f(v1[i]); } }
                    u32x4 w; w.x = cvt_pk_bf16(v0[0], v0[1]); w.y = cvt_pk_bf16(v0[2], v0[3]); w.z = cvt_pk_bf16(v1[0], v1[1]); w.w = cvt_pk_bf16(v1[2], v1[3]);
                    *(u32x4*)rowp = w; }
        }
    }
};
struct EpiRw2 {
    static constexpr bool PERM = true, AFTER_DRAIN = false;
    float* Wdec; bf16_t* A; bf16_t* G; const float* w0; const float* a0;
    __device__ __forceinline__ void operator()(const f32x4 (&acc)[2][2][4][2], const Unit& u, int wr, int wc, int fr, int fq) const {
        const int j = u.pn >> 2, t0 = (u.pm & 63) * BM + wr * 64 + fr, col0 = (u.pn & 3) * BM + wc * 32 + 8 * fq;
#pragma unroll
        for (int ai = 0; ai < 2; ++ai)
#pragma unroll
            for (int m = 0; m < 4; ++m) { const size_t ro = (size_t)(t0 + ai * HALF + m * 16) * 1024 + col0;
#pragma unroll
                for (int bj = 0; bj < 2; ++bj) { f32x4 v0 = acc[ai][bj][m][0], v1 = acc[ai][bj][m][1]; const size_t o = ro + bj * HALF;
                    if (j == 0) { const f32x4 b0 = __builtin_bit_cast(f32x4, *(const u32x4*)(w0 + col0 + bj * HALF)), b1 = __builtin_bit_cast(f32x4, *(const u32x4*)(w0 + col0 + bj * HALF + 4));
#pragma unroll
                        for (int i = 0; i < 4; ++i) { v0[i] = -0.8750387749f * sigm_f(v0[i] + b0[i]); v1[i] = -0.8750387749f * sigm_f(v1[i] + b1[i]); }
                        *(f32x4*)(Wdec + o) = v0; *(f32x4*)(Wdec + o + 4) = v1;
                    } else { if (j == 1) { const f32x4 b0 = __builtin_bit_cast(f32x4, *(const u32x4*)(a0 + col0 + bj * HALF)), b1 = __builtin_bit_cast(f32x4, *(const u32x4*)(a0 + col0 + bj * HALF + 4));
#pragma unroll
                            for (int i = 0; i < 4; ++i) { v0[i] = sigm_f(v0[i] + b0[i]); v1[i] = sigm_f(v1[i] + b1[i]); } }
                        u32x4 w; w.x = cvt_pk_bf16(v0[0], v0[1]); w.y = cvt_pk_bf16(v0[2], v0[3]); w.z = cvt_pk_bf16(v1[0], v1[1]); w.w = cvt_pk_bf16(v1[2], v1[3]);
                        if (j == 1) *(u32x4*)(A + o) = w; else *(u32x4*)(G + o) = w; } } }
    }
};
struct Rw1Order { static constexpr bool HALF_SKIP = false; int G, c;
    __device__ __forceinline__ bool next(int i, Unit& u) const { const int L = i * G + c; if (L >= 960) return false;
        if (L < 768) { const int cc = L >> 8, mt = (L & 255) >> 2, pn = L & 3; u.pm = cc * 64 + mt; u.pn = cc * 4 + pn; } else { const int L2 = L - 768, cc = 3 + (L2 >> 6), mt = L2 & 63; u.pm = cc * 64 + mt; u.pn = 9 + cc; }
        return true; }
    __device__ __forceinline__ void a_ready(const Unit&) const {}
    __device__ __forceinline__ void done(const Unit&) const {} };
struct Rw2Order { static constexpr bool HALF_SKIP = false; int G, c;
    __device__ __forceinline__ bool next(int i, Unit& u) const { const int L = i * G + c; if (L >= 768) return false; const int j = L >> 8, mt = (L & 255) >> 2, pn = L & 3; u.pm = j * 64 + mt; u.pn = j * 4 + pn; return true; }
    __device__ __forceinline__ void a_ready(const Unit&) const {}
    __device__ __forceinline__ void done(const Unit&) const {} };
constexpr int MOE_TAB = 131072;
struct MoeOrder { static constexpr bool HALF_SKIP = true;
    const PG8_LAS int* tab; int G, c;
    __device__ __forceinline__ bool next(int i, Unit& u) const {
        const int nt = __builtin_amdgcn_readfirstlane(tab[768]);
        const int L = i * G + c; if (L >= nt * 4) return false; const int mt = L >> 2;
        const int e = __builtin_amdgcn_readfirstlane(tab[mt]), j = __builtin_amdgcn_readfirstlane(tab[256 + mt]);
        u.pm = mt; u.pn = e * 4 + (L & 3); u.rt = e * (ECAP / BM) + j; u.nv = __builtin_amdgcn_readfirstlane(tab[512 + mt]); return true; }
    __device__ __forceinline__ void a_ready(const Unit&) const {}
    __device__ __forceinline__ void done(const Unit&) const {} };
}

namespace attn_body {
using bf16=__hip_bfloat16;
using bf16x8=__attribute__((ext_vector_type(8)))short;
using s16x4=__attribute__((ext_vector_type(4)))short;
using f32x16=__attribute__((ext_vector_type(16)))float;
using u32x4=__attribute__((ext_vector_type(4)))unsigned;
using f32x4_t=__attribute__((ext_vector_type(4)))float;
constexpr int BATCH=4,NHEAD=16,SEQ=4096,D=64,DM=NHEAD*D;
constexpr int NW=8,QBLK=32,QB=QBLK*NW,KVBLK=64,NQB=SEQ/QB;
constexpr int ATTN_PITCH=DM, ATTN_UNIT_ROWS=QB;
__device__ __forceinline__ int crow(int r,int hi){return (r&3)+8*(r>>2)+4*hi;}
#define SBAR() __builtin_amdgcn_sched_barrier(0)
__device__ __forceinline__ void cmask(f32x16&p0,f32x16&p1,int jb,int qrel,int hi){
  const float NEG=-INFINITY; int kb=64*jb+4*hi;
  #pragma unroll
  for(int r=0;r<16;++r){int kv=kb+(r&3)+8*(r>>2); if(kv>qrel)p0[r]=NEG; if(kv+32>qrel)p1[r]=NEG;}
}

constexpr int NSLOT=3, SLOTB=8192;
constexpr int LDS_K=0, LDS_V=NSLOT*SLOTB, LDS_WS=2*NSLOT*SLOTB, LDS_OST=LDS_WS+NW*64*4, LDS_CB=LDS_OST+NW*4096, LDS_BYTES=LDS_CB+SEQ*8;
constexpr float C2=0.125f*1.4426950408889634f;
__device__ __forceinline__ void glds16(const void*gsrc,unsigned lds_dst){unsigned keep;
  asm volatile("s_mov_b32 %0, m0\n\ts_mov_b32 m0, %2\n\ts_nop 0\n\tglobal_load_lds_dwordx4 %1, off\n\ts_mov_b32 m0, %0":"=&s"(keep):"v"(gsrc),"s"(lds_dst):"memory");}
__device__ __forceinline__ void glds16s(unsigned voff,const void*sbase,unsigned lds_dst){unsigned keep;
  asm volatile("s_mov_b32 %0, m0\n\ts_mov_b32 m0, %2\n\ts_nop 2\n\tglobal_load_lds_dwordx4 %1, %3\n\ts_mov_b32 m0, %0":"=&s"(keep):"v"(voff),"s"(lds_dst),"s"(sbase):"memory");}
__device__ __forceinline__ float max3f(float a,float b,float c){float r;asm("v_max3_f32 %0, %1, %2, %3":"=v"(r):"v"(a),"v"(b),"v"(c));return r;}
__device__ __forceinline__ float max2f(float a,float b){float r;asm("v_max_f32_e32 %0, %1, %2":"=v"(r):"v"(a),"v"(b));return r;}
__device__ __forceinline__ float fadd_s(float a,float b){float r;asm("v_add_f32_e32 %0, %1, %2":"=v"(r):"v"(a),"v"(b));return r;}
__device__ __forceinline__ float fsub_s(float a,float b){float r;asm("v_sub_f32_e32 %0, %1, %2":"=v"(r):"v"(a),"v"(b));return r;}
typedef float f32x2_t __attribute__((ext_vector_type(2))); typedef __bf16 bf16x2_t __attribute__((ext_vector_type(2)));
__device__ __forceinline__ unsigned cvtpk_s(float lo,float hi){f32x2_t v={lo,hi};bf16x2_t b=__builtin_convertvector(v,bf16x2_t);return __builtin_bit_cast(unsigned,b);}
#define WAIT_BAR(N) asm volatile("s_waitcnt vmcnt(" #N ") lgkmcnt(0)\n\ts_barrier":::"memory")
typedef unsigned u32x2_t __attribute__((ext_vector_type(2)));
__device__ __forceinline__ unsigned bfr_(float x){unsigned u=__float_as_uint(x);return (u+0x7fffu+((u>>16)&1u))>>16;}
__device__ __forceinline__ void split3(float v,unsigned&h1,unsigned&h2,unsigned&h3){h1=bfr_(v);const float r1=v-__uint_as_float(h1<<16);h2=bfr_(r1);const float r2=r1-__uint_as_float(h2<<16);h3=bfr_(r2);}

__device__ __forceinline__ void qkt(f32x16&p0,f32x16&p1,const char*Kslot,const bf16x8*qr,const f32x16&negm,int r32,int hi){
  const char*kb=Kslot+hi*1024+r32*16;
  #pragma unroll
  for(int d0=0;d0<4;++d0){
    const bf16x8 b0=*reinterpret_cast<const bf16x8*>(kb+d0*2048);
    const bf16x8 b1=*reinterpret_cast<const bf16x8*>(kb+d0*2048+512);
    if(d0==0){p0=__builtin_amdgcn_mfma_f32_32x32x16_bf16(b0,qr[0],negm,0,0,0);p1=__builtin_amdgcn_mfma_f32_32x32x16_bf16(b1,qr[0],negm,0,0,0);}
    else{p0=__builtin_amdgcn_mfma_f32_32x32x16_bf16(b0,qr[d0],p0,0,0,0);p1=__builtin_amdgcn_mfma_f32_32x32x16_bf16(b1,qr[d0],p1,0,0,0);}}
}
typedef __attribute__((address_space(3))) const char* lds_cptr;
typedef short v4i16_t __attribute__((ext_vector_type(4)));
__device__ __forceinline__ void kload8(bf16x8*kf,lds_cptr kp){
  kf[0]=*(const __attribute__((address_space(3))) bf16x8*)(kp);      kf[1]=*(const __attribute__((address_space(3))) bf16x8*)(kp+512);
  kf[2]=*(const __attribute__((address_space(3))) bf16x8*)(kp+2048); kf[3]=*(const __attribute__((address_space(3))) bf16x8*)(kp+2560);
  kf[4]=*(const __attribute__((address_space(3))) bf16x8*)(kp+4096); kf[5]=*(const __attribute__((address_space(3))) bf16x8*)(kp+4608);
  kf[6]=*(const __attribute__((address_space(3))) bf16x8*)(kp+6144); kf[7]=*(const __attribute__((address_space(3))) bf16x8*)(kp+6656);
}
__device__ __forceinline__ void kload2(bf16x8*kf,lds_cptr kp,int j){ kf[2*j]=*(const __attribute__((address_space(3))) bf16x8*)(kp+j*2048); kf[2*j+1]=*(const __attribute__((address_space(3))) bf16x8*)(kp+j*2048+512); }
__device__ __forceinline__ s16x4 vtr(lds_cptr p){ return __builtin_bit_cast(s16x4,__builtin_amdgcn_ds_read_tr16_b64_v4i16((__attribute__((address_space(3))) v4i16_t*)p)); }
__device__ __forceinline__ float rowmax(const f32x16&p0,const f32x16&p1){
  float a=max3f(p0[0],p0[1],p1[0]),b=max3f(p0[2],p0[3],p1[1]);a=max3f(a,p1[2],p1[3]);
  #pragma unroll
  for(int r=4;r<16;r+=4){a=max3f(a,p0[r],p0[r+1]);b=max3f(b,p0[r+2],p0[r+3]);a=max3f(a,p1[r],p1[r+1]);b=max3f(b,p1[r+2],p1[r+3]);}
  const float m=max2f(a,b);
  auto rr=__builtin_amdgcn_permlane32_swap(__float_as_uint(m),__float_as_uint(m),false,false);
  return max2f(__uint_as_float(rr[0]),__uint_as_float(rr[1]));
}
__device__ __forceinline__ void pv(f32x16*o,int vb,bf16x8 pa0,bf16x8 pa1,bf16x8 pa2,bf16x8 pa3){
  #pragma unroll
  for(int d0=0;d0<2;++d0){s16x4 lo[4],hi[4];
    #pragma unroll
    for(int ks=0;ks<4;++ks){
      asm volatile("ds_read_b64_tr_b16 %0,%1 offset:%c2":"=&v"(lo[ks]):"v"(vb),"i"(d0*4096+ks*1024):"memory");
      asm volatile("ds_read_b64_tr_b16 %0,%1 offset:%c2":"=&v"(hi[ks]):"v"(vb),"i"(d0*4096+ks*1024+512):"memory");}
    asm volatile("s_waitcnt lgkmcnt(0)":::"memory");SBAR();
    #define PK(k) (bf16x8){lo[k][0],lo[k][1],lo[k][2],lo[k][3],hi[k][0],hi[k][1],hi[k][2],hi[k][3]}
    o[d0]=__builtin_amdgcn_mfma_f32_32x32x16_bf16(pa0,PK(0),o[d0],0,0,0);
    o[d0]=__builtin_amdgcn_mfma_f32_32x32x16_bf16(pa1,PK(1),o[d0],0,0,0);
    o[d0]=__builtin_amdgcn_mfma_f32_32x32x16_bf16(pa2,PK(2),o[d0],0,0,0);
    o[d0]=__builtin_amdgcn_mfma_f32_32x32x16_bf16(pa3,PK(3),o[d0],0,0,0);
    #undef PK
  }
}

#ifndef ATTN_STORE16
#define ATTN_STORE16(p,v) (*(u32x4*)(p)=(v))
#endif
template<int THRL> __device__ __forceinline__ void attn_unit(int b,int h,int qb,const bf16*Q,const bf16*__restrict__ K,const bf16*__restrict__ V,bf16*O,const float*CBg,const bf16*OGg,bool loadcb,float bnd2,char*shm){
  const int tid=threadIdx.x,lane=tid&63,r32=lane&31,hi=lane>>5; const int wid=__builtin_amdgcn_readfirstlane(tid>>6);
  const long rowbase=(long)b*SEQ; const int q0=qb*QB;
  const bf16*Qw=Q+(rowbase+q0+wid*QBLK)*DM+h*D;
  const bf16*Kh=K+rowbase*DM+h*D,*Vh=V+rowbase*DM+h*D;
  const unsigned lds0=(unsigned)(uintptr_t)shm;
  float*wsf=(float*)(shm+LDS_WS)+wid*64;
  int ln2_=lane; asm volatile("":"+v"(ln2_));
  const unsigned koff=(unsigned)(ln2_*DM+wid*8)*2u;
  const unsigned voff=(unsigned)((16*(wid&3)+(ln2_>>2))*DM+(wid>>2)*32+(ln2_&3)*8)*2u;
  const unsigned kdst=lds0+LDS_K+wid*1024, vdst=lds0+LDS_V+wid*1024;
  #define DMA_K(t,slot) glds16s(koff,Kh+(long)(t)*KVBLK*DM,(unsigned)__builtin_amdgcn_readfirstlane(kdst+(slot)))
  #define DMA_V(t,slot) glds16s(voff,Vh+(long)(t)*KVBLK*DM,(unsigned)__builtin_amdgcn_readfirstlane(vdst+(slot)))
  const int vb0=(int)(lds0+LDS_V)+((lane>>4)&1)*32+(lane&3)*8+(4*hi+((lane&15)>>2))*64;
  const char*Kbase=shm+LDS_K; bf16x8 kf[8];
  const lds_cptr shm3=(lds_cptr)shm; const lds_cptr kp0=shm3+LDS_K+hi*1024+r32*16; const lds_cptr vp0=shm3+LDS_V+((lane>>4)&1)*32+(lane&3)*8+(4*hi+((lane&15)>>2))*64;
  int NT=(q0+QB)/KVBLK;
  typedef __attribute__((address_space(3))) const u32x2_t* lds_u2p; lds_u2p bt=(lds_u2p)(shm3+LDS_CB)+r32;
  if(loadcb){ const float*src=CBg+(long)(b*NHEAD+h)*SEQ; u32x2_t*dst=(u32x2_t*)(shm+LDS_CB);
    #pragma unroll
    for(int i=0;i<8;++i){ const int kv=tid+512*i; unsigned h1,h2,h3; split3(src[kv],h1,h2,h3); dst[kv]=(u32x2_t){h1|(h2<<16),h3|0x3F800000u}; }
    asm volatile("s_waitcnt vmcnt(0) lgkmcnt(0)\n\ts_barrier":::"memory"); }
  { const lds_u2p b0_=(lds_u2p)(shm3+LDS_CB);
    #define BTV(kv) ({ const u32x2_t e_=b0_[kv]; __uint_as_float(e_.x<<16)+__uint_as_float(e_.x&0xffff0000u)+__uint_as_float(e_.y<<16); })
    const float bq0_=BTV(q0); int cand_=NT-4;
    while(cand_>=2){ const float d_=bq0_-BTV(64*cand_-1); if(__builtin_amdgcn_readfirstlane(d_>=bnd2?1:0))break; cand_-=2; }
    #undef BTV
    const int T0_=cand_>=2?cand_:0; Kh+=(long)T0_*KVBLK*DM; Vh+=(long)T0_*KVBLK*DM; bt+=64*T0_; NT-=T0_; }
  u32x4 Bq; const unsigned hm_=hi?0u:0xffffffffu;
  #define SETBQ(mh) do{ unsigned h1_,h2_,h3_; split3(-(mh),h1_,h2_,h3_); Bq.x=0x3F803F80u&hm_; Bq.y=(0x3F80u|(h1_<<16))&hm_; Bq.z=(h2_|(h3_<<16))&hm_; Bq.w=0u; }while(0)
  #define BIASM(P0,P1,t) do{ const u32x2_t a0_=bt[64*(t)],a1_=bt[64*(t)+32]; \
      P0=__builtin_amdgcn_mfma_f32_32x32x16_bf16(__builtin_bit_cast(bf16x8,(u32x4){a0_.x,a0_.y,0x3F803F80u,0u}),__builtin_bit_cast(bf16x8,Bq),P0,0,0,0); \
      P1=__builtin_amdgcn_mfma_f32_32x32x16_bf16(__builtin_bit_cast(bf16x8,(u32x4){a1_.x,a1_.y,0x3F803F80u,0u}),__builtin_bit_cast(bf16x8,Bq),P1,0,0,0); }while(0)
  SETBQ(0.f);
  DMA_K(0,0);DMA_V(0,0);DMA_K(1,SLOTB);
  bf16x8 qr[4];
  #pragma unroll
  for(int d0=0;d0<4;++d0)qr[d0]=*reinterpret_cast<const bf16x8*>(&Qw[(long)r32*DM+d0*16+hi*8]);
  float mhat=0.f,l_reg=0.f;f32x16 o[2];o[0]=f32x16{};o[1]=f32x16{};const f32x16 zero16=f32x16{};
  const int qrel=wid*QBLK+r32;
  #define CMASK(P0,P1,t) do{int jb_=(t)-(NT-4); if(jb_>=0)cmask(P0,P1,jb_,qrel,hi);}while(0)
  bool resc=false;
  #define START(P0,P1) do{ const float rm=rowmax(P0,P1); resc=false; \
    { const float dl=rm; mhat=fadd_s(mhat,dl); \
      _Pragma("unroll") for(int r=0;r<16;++r){P0[r]=fsub_s(P0[r],dl);P1[r]=fsub_s(P1[r],dl);} \
      SETBQ(mhat); } \
    _Pragma("unroll") for(int r=0;r<16;++r)P0[r]=__builtin_amdgcn_exp2f(P0[r]); }while(0)
  #define RESC() do{ if(resc){ asm volatile("s_waitcnt lgkmcnt(0)":::"memory"); \
      _Pragma("unroll") for(int d_=0;d_<2;++d_) _Pragma("unroll") for(int r=0;r<16;++r)o[d_][r]*=wsf[crow(r,hi)]; } }while(0)
  f32x16 pA0,pA1,pB0,pB1;
  int sl_prev=0,sl_cur=0,sl_next=SLOTB;
  #define ROT() do{sl_prev=sl_cur;sl_cur=sl_next;sl_next=(sl_next==(NSLOT-1)*SLOTB)?0:sl_next+SLOTB;}while(0)
  DMA_K(2,2*SLOTB);
  WAIT_BAR(3);
  qkt(pA0,pA1,Kbase,qr,zero16,r32,hi);BIASM(pA0,pA1,0);asm volatile("s_nop 15\n\ts_nop 7":"+v"(pA0),"+v"(pA1));CMASK(pA0,pA1,0);
  START(pA0,pA1);
  _Pragma("unroll") for(int r=0;r<16;++r)pA1[r]=__builtin_amdgcn_exp2f(pA1[r]);
  WAIT_BAR(0);
  DMA_K(3,0);DMA_V(1,SLOTB);
  ROT();
  kload8(kf,kp0+sl_cur);
  WAIT_BAR(2);
  s16x4 vlo[8],vhi[8]; u32x4 pw0,pw1,pw2,pw3;
  #define PKW(P,B) cvtpk_s(P[B],P[B+1])
  #define PAF(k) __builtin_bit_cast(bf16x8,pw##k)
  #define VFR(i) (bf16x8){vlo[i][0],vlo[i][1],vlo[i][2],vlo[i][3],vhi[i][0],vhi[i][1],vhi[i][2],vhi[i][3]}
  #define PIN(x) asm volatile("":"+v"(x))
  #define MX3(a,b,c) __builtin_fmaxf(__builtin_fmaxf((a),(b)),(c))
  #define GAPA(MF,A0,A1,A2,A3,W0,W1,PW) do{ MF; sacc+=A0; sacc+=A1; sacc+=A2; sacc+=A3; PIN(sacc); W0; W1; PIN(PW); SBAR(); }while(0)
  #define EX(v) __builtin_amdgcn_exp2f(v)
  #define GAPB(MF,X,B) do{ MF; X[B]=EX(X[B]); X[B+1]=EX(X[B+1]); X[B+2]=EX(X[B+2]); X[B+3]=EX(X[B+3]); PIN(X); SBAR(); }while(0)
  #define VRD(i) do{ vlo[i]=vtr(vp_+(((i)>>2)*4096+((i)&3)*1024)); vhi[i]=vtr(vp_+(((i)>>2)*4096+((i)&3)*1024+512)); }while(0)
  #define KRD(G,j) do{ if(G){ kload2(kf,kp0+sl_next,j); SBAR(); } }while(0)
  #define STEP(C0,C1,P0,P1,t,GK,GV,GL) do{ SBAR(); \
    const lds_cptr vp_=vp0+sl_prev; \
    VRD(0); SBAR(); float sacc=(P0[0]+P0[1]); \
    GAPA(C0=__builtin_amdgcn_mfma_f32_32x32x16_bf16(kf[0],qr[0],zero16,0,0,0), P0[2],P0[3],P0[4],P0[5],     pw0[0]=PKW(P0,0), pw0[1]=PKW(P0,2), pw0); \
    VRD(4); SBAR(); GAPA(C1=__builtin_amdgcn_mfma_f32_32x32x16_bf16(kf[1],qr[0],zero16,0,0,0), P0[6],P0[7],P0[8],P0[9],     pw0[2]=PKW(P0,4), pw0[3]=PKW(P0,6), pw0); \
    VRD(1); SBAR(); GAPA(C0=__builtin_amdgcn_mfma_f32_32x32x16_bf16(kf[2],qr[1],C0,0,0,0),   P0[10],P0[11],P0[12],P0[13], pw1[0]=PKW(P0,8), pw1[1]=PKW(P0,10), pw1); \
    VRD(5); SBAR(); GAPA(C1=__builtin_amdgcn_mfma_f32_32x32x16_bf16(kf[3],qr[1],C1,0,0,0),   P0[14],P0[15],P1[0],P1[1],   pw1[2]=PKW(P0,12),pw1[3]=PKW(P0,14), pw1); \
    VRD(2); SBAR(); GAPA(C0=__builtin_amdgcn_mfma_f32_32x32x16_bf16(kf[4],qr[2],C0,0,0,0),   P1[2],P1[3],P1[4],P1[5],     pw2[0]=PKW(P1,0), pw2[1]=PKW(P1,2), pw2); \
    VRD(6); SBAR(); GAPA(C1=__builtin_amdgcn_mfma_f32_32x32x16_bf16(kf[5],qr[2],C1,0,0,0),   P1[6],P1[7],P1[8],P1[9],     pw2[2]=PKW(P1,4), pw2[3]=PKW(P1,6), pw2); \
    VRD(3); SBAR(); GAPA(C0=__builtin_amdgcn_mfma_f32_32x32x16_bf16(kf[6],qr[3],C0,0,0,0),   P1[10],P1[11],P1[12],P1[13], pw3[0]=PKW(P1,8), pw3[1]=PKW(P1,10), pw3); \
    VRD(7); SBAR(); GAPA(C1=__builtin_amdgcn_mfma_f32_32x32x16_bf16(kf[7],qr[3],C1,0,0,0),   P1[14],P1[15],0.f,0.f,       pw3[2]=PKW(P1,12),pw3[3]=PKW(P1,14), pw3); \
    l_reg+=sacc; \
    if(GK){DMA_K((t)+3,sl_cur);} if(GV){DMA_V((t)+1,sl_next);} \
    BIASM(C0,C1,t); CMASK(C0,C1,t); \
    { float a=MX3(C0[0],C0[1],C1[0]),b=MX3(C0[2],C0[3],C1[1]); a=MX3(a,C1[2],C1[3]); \
      _Pragma("unroll") for(int r=4;r<16;r+=4){a=MX3(a,C0[r],C0[r+1]);b=MX3(b,C0[r+2],C0[r+3]);a=MX3(a,C1[r],C1[r+1]);b=MX3(b,C1[r+2],C1[r+3]);} \
      float rm=__builtin_fmaxf(a,b); { auto rr=__builtin_amdgcn_permlane32_swap(__float_as_uint(rm),__float_as_uint(rm),false,false); rm=__builtin_fmaxf(__uint_as_float(rr[0]),__uint_as_float(rr[1])); } \
      resc=false; \
      if(__builtin_expect(__any(rm>(float)THRL),0)){ const float dl=__builtin_fmaxf(rm,0.f); mhat+=dl; \
        _Pragma("unroll") for(int r=0;r<16;++r){C0[r]-=dl;C1[r]-=dl;} \
        SETBQ(mhat); \
        const float f=__builtin_amdgcn_exp2f(-dl); l_reg*=f; if(hi==0)wsf[r32]=f; resc=true; } } \
    SBAR(); \
    GAPB(o[0]=__builtin_amdgcn_mfma_f32_32x32x16_bf16(PAF(0),VFR(0),o[0],0,0,0), C0,0); \
    GAPB(o[1]=__builtin_amdgcn_mfma_f32_32x32x16_bf16(PAF(0),VFR(4),o[1],0,0,0), C0,4); \
    KRD(GL,0); GAPB(o[0]=__builtin_amdgcn_mfma_f32_32x32x16_bf16(PAF(1),VFR(1),o[0],0,0,0), C0,8); \
    KRD(GL,1); GAPB(o[1]=__builtin_amdgcn_mfma_f32_32x32x16_bf16(PAF(1),VFR(5),o[1],0,0,0), C0,12); \
    KRD(GL,2); GAPB(o[0]=__builtin_amdgcn_mfma_f32_32x32x16_bf16(PAF(2),VFR(2),o[0],0,0,0), C1,0); \
    KRD(GL,3); GAPB(o[1]=__builtin_amdgcn_mfma_f32_32x32x16_bf16(PAF(2),VFR(6),o[1],0,0,0), C1,4); \
    GAPB(o[0]=__builtin_amdgcn_mfma_f32_32x32x16_bf16(PAF(3),VFR(3),o[0],0,0,0), C1,8); \
    GAPB(o[1]=__builtin_amdgcn_mfma_f32_32x32x16_bf16(PAF(3),VFR(7),o[1],0,0,0), C1,12); \
    }while(0)
  int t=1;
  #undef CMASK
  #define CMASK(P0,P1,t) do{}while(0)
  for(;t+5<NT;t+=2){
    STEP(pB0,pB1,pA0,pA1,t,true,true,true);     WAIT_BAR(2); RESC(); ROT();
    STEP(pA0,pA1,pB0,pB1,t+1,true,true,true);   WAIT_BAR(2); RESC(); ROT();
  }
  #undef CMASK
  #define CMASK(P0,P1,t) do{int jb_=(t)-(NT-4); if(jb_>=0)cmask(P0,P1,jb_,qrel,hi);}while(0)
  #define ENDW(tt) do{ if((tt)+3<NT){WAIT_BAR(2);} else if((tt)+2<NT){WAIT_BAR(1);} else {WAIT_BAR(0);} }while(0)
  for(;t+1<NT;t+=2){
    STEP(pB0,pB1,pA0,pA1,t,(t+3<NT),(t+1<NT),(t+1<NT));       ENDW(t);   RESC(); ROT();
    STEP(pA0,pA1,pB0,pB1,t+1,(t+4<NT),(t+2<NT),(t+2<NT));     ENDW(t+1); RESC(); ROT();
  }
  STEP(pB0,pB1,pA0,pA1,NT-1,false,false,false); RESC();
  { float sacc=pB0[0]+pB0[1]; _Pragma("unroll") for(int r=2;r<16;++r)sacc+=pB0[r]; _Pragma("unroll") for(int r=0;r<16;++r)sacc+=pB1[r]; l_reg+=sacc;
    pw0=(u32x4){PKW(pB0,0),PKW(pB0,2),PKW(pB0,4),PKW(pB0,6)};pw1=(u32x4){PKW(pB0,8),PKW(pB0,10),PKW(pB0,12),PKW(pB0,14)};pw2=(u32x4){PKW(pB1,0),PKW(pB1,2),PKW(pB1,4),PKW(pB1,6)};pw3=(u32x4){PKW(pB1,8),PKW(pB1,10),PKW(pB1,12),PKW(pB1,14)};
    SBAR(); pv(o,vb0+sl_cur,PAF(0),PAF(1),PAF(2),PAF(3)); }
  #undef PKW
  #undef PAF
  #undef VFR
  #undef PIN
  #undef MX3
  #undef GAPA
  #undef GAPB
  #undef EX
  #undef VRD
  #undef KRD
  #undef STEP
  #undef ENDW
  {auto rr=__builtin_amdgcn_permlane32_swap(__float_as_uint(l_reg),__float_as_uint(l_reg),false,false);l_reg=__uint_as_float(rr[0])+__uint_as_float(rr[1]);}
  if(hi==0)wsf[32+r32]=l_reg;asm volatile("s_waitcnt lgkmcnt(0)":::"memory");
  float rli[16];
  #pragma unroll
  for(int r=0;r<16;++r)rli[r]=__builtin_amdgcn_rcpf(wsf[32+crow(r,hi)]);
  bf16*Ow=O+(rowbase+q0+wid*QBLK)*DM+h*D;
  { bf16*stg=(bf16*)(shm+LDS_OST)+wid*2048;
    #pragma unroll
    for(int r=0;r<16;++r){const int orow=crow(r,hi);
      #pragma unroll
      for(int d0=0;d0<2;++d0)stg[orow*64+d0*32+r32]=__float2bfloat16(o[d0][r]*rli[r]);}
    asm volatile("s_waitcnt lgkmcnt(0)":::"memory");
    int ln_=lane; asm volatile("":"+v"(ln_));
    #pragma unroll
    for(int i=0;i<4;++i){const int row=i*8+(ln_>>3),ch=ln_&7; u32x4 v=*(const u32x4*)(stg+row*64+ch*8);
      if(OGg){ const u32x4 gt=*(const u32x4*)(OGg+(rowbase+q0+wid*QBLK+row)*DM+h*D+ch*8);
        _Pragma("unroll") for(int e=0;e<4;++e){ const float a0=__uint_as_float(v[e]<<16)*__builtin_amdgcn_rcpf(1.f+__builtin_amdgcn_exp2f(-1.4426950408889634f*__uint_as_float(gt[e]<<16)));
          const float a1=__uint_as_float(v[e]&0xffff0000u)*__builtin_amdgcn_rcpf(1.f+__builtin_amdgcn_exp2f(-1.4426950408889634f*__uint_as_float(gt[e]&0xffff0000u))); v[e]=cvtpk_s(a0,a1); } }
      ATTN_STORE16(Ow+(long)row*DM+ch*8,v);} }
  asm volatile("s_waitcnt lgkmcnt(0)\n\ts_barrier":::"memory");
  #undef BIASM
  #undef SETBQ
  #undef DMA_K
  #undef DMA_V
  #undef CMASK
  #undef START
  #undef RESC
  #undef ROT
}
constexpr int ATTN_LDS_BYTES=LDS_BYTES;
struct AttnTensors { const bf16* Q; const bf16* K; const bf16* V; bf16* O; const float* CB; const bf16* OG; };
struct AttnUnit { int bh; int qb; };
struct StaticOrder {
  int vcu,G;
  __device__ __forceinline__ explicit StaticOrder(int grid,int block):vcu((grid%8==0)?(block%8)*(grid/8)+block/8:block),G(grid){}
  __device__ __forceinline__ bool next(int i,AttnUnit&u)const{ const int vc=vcu+(i>>2)*G; if(vc>=256)return false; const int s=vc&3,k=i&3; u.bh=vc>>2; u.qb=(k==0)?s:(k==1)?7-s:(k==2)?8+s:15-s; return true; }
  __device__ __forceinline__ void a_ready(const AttnUnit&)const{}
  __device__ __forceinline__ void done(const AttnUnit&)const{}
};
template<class Sched,int THRL=60> __device__ __forceinline__ void attn_phase(char*lds,const AttnTensors&T,const Sched&S){
  AttnUnit u;
  int prev=-1; float bnd2=1e30f;
  for(int i=0;S.next(i,u);++i){ S.a_ready(u);
    if(u.bh!=prev){
      int tid=threadIdx.x; asm volatile("":"+v"(tid)); const int lane=tid&63,wid=tid>>6; const long rb=(long)(u.bh/NHEAD)*SEQ*DM+(u.bh%NHEAD)*D; float mq=0.f,mk=0.f;
      for(int r=tid;r<SEQ;r+=512){ float sq=0.f,sk=0.f;
        #pragma unroll
        for(int cch=0;cch<8;++cch){ const u32x4 a=*(const u32x4*)(T.Q+rb+(long)r*DM+cch*8), c=*(const u32x4*)(T.K+rb+(long)r*DM+cch*8);
          #pragma unroll
          for(int e=0;e<4;++e){ const float a0=__uint_as_float(a[e]<<16),a1=__uint_as_float(a[e]&0xffff0000u),c0=__uint_as_float(c[e]<<16),c1=__uint_as_float(c[e]&0xffff0000u); sq+=a0*a0+a1*a1; sk+=c0*c0+c1*c1; } }
        mq=fmaxf(mq,sq); mk=fmaxf(mk,sk); }
      #pragma unroll
      for(int o=1;o<64;o<<=1){ mq=fmaxf(mq,__shfl_xor(mq,o)); mk=fmaxf(mk,__shfl_xor(mk,o)); }
      float*red=(float*)(lds+LDS_WS);
      if(lane==0){ red[wid*2]=mq; red[wid*2+1]=mk; }
      asm volatile("s_waitcnt lgkmcnt(0)\n\ts_barrier":::"memory");
      float aq=0.f,ak=0.f;
      #pragma unroll
      for(int w=0;w<NW;++w){ aq=fmaxf(aq,red[w*2]); ak=fmaxf(ak,red[w*2+1]); }
      asm volatile("s_waitcnt lgkmcnt(0)\n\ts_barrier":::"memory");
      bnd2=__uint_as_float((unsigned)__builtin_amdgcn_readfirstlane((int)__float_as_uint(2.f*sqrtf(aq*ak)*1.01f+48.f))); }
    attn_unit<THRL>(u.bh/NHEAD,u.bh%NHEAD,u.qb,T.Q,T.K,T.V,T.O,T.CB,T.OG,u.bh!=prev,bnd2,lds); prev=u.bh; S.done(u); }
}

constexpr int SB_K=0, SB_V=2*SLOTB, SB_FLAG=4*SLOTB, SB_OST=SB_FLAG+256, SB_BYTES=SB_OST+NW*4096;
constexpr float SB_THR=48.0f;
__device__ __forceinline__ void sb_unit(int b,int h,int qb,const bf16*Q,const bf16*__restrict__ K,const bf16*__restrict__ V,bf16*O,char*shm){
  const int tid=threadIdx.x,lane=tid&63,r32=lane&31,hi=lane>>5; const int wid=__builtin_amdgcn_readfirstlane(tid>>6);
  const long rowbase=(long)b*SEQ; const int q0=qb*QB;
  const bf16*Qw=Q+(rowbase+q0+wid*QBLK)*DM+h*D;
  const bf16*Kh=K+rowbase*DM+h*D,*Vh=V+rowbase*DM+h*D;
  const unsigned lds0=(unsigned)(uintptr_t)shm;
  const unsigned koff=(unsigned)(lane*DM+wid*8)*2u;
  const unsigned voff=(unsigned)((16*(wid&3)+(lane>>2))*DM+(wid>>2)*32+(lane&3)*8)*2u;
  const unsigned kdst=lds0+SB_K+wid*1024, vdst=lds0+SB_V+wid*1024;
  #define SB_DMA_K(t,slot) glds16s(koff,Kh+(long)(t)*KVBLK*DM,(unsigned)__builtin_amdgcn_readfirstlane(kdst+(slot)))
  #define SB_DMA_V(t,slot) glds16s(voff,Vh+(long)(t)*KVBLK*DM,(unsigned)__builtin_amdgcn_readfirstlane(vdst+(slot)))
  const int vb0=(int)(lds0+SB_V)+((lane>>4)&1)*32+(lane&3)*8+(4*hi+((lane&15)>>2))*64;
  volatile unsigned*flag=(volatile unsigned*)(shm+SB_FLAG);
  int j=(q0+QB)/KVBLK-1;
  SB_DMA_K(j,0);SB_DMA_V(j,0);
  bf16x8 qr[4];
  #pragma unroll
  for(int d0=0;d0<4;++d0)qr[d0]=*reinterpret_cast<const bf16x8*>(&Qw[(long)r32*DM+d0*16+hi*8]);
  f32x16 o[2];o[0]=f32x16{};o[1]=f32x16{};
  const f32x16 zero16=f32x16{};
  float carry=0.f; bool mydone=false;
  const int qw0=q0+wid*QBLK, tq=qw0+r32;
  int slot=0;
  for(int it=0;j>=0;--j,++it){
    WAIT_BAR(0);
    if(it>0){ unsigned all=1u;
      #pragma unroll
      for(int w=0;w<NW;++w)all&=flag[((it-1)&1)*8+w];
      if(__builtin_amdgcn_readfirstlane(all))break; }
    if(j>0){SB_DMA_K(j-1,slot^SLOTB);SB_DMA_V(j-1,slot^SLOTB);}
    if(64*j<=qw0+30&&!mydone){
      f32x16 p0,p1;
      qkt(p0,p1,shm+SB_K+slot,qr,zero16,r32,hi);
      if(64*j+64>qw0){ const int kb=64*j+4*hi;
        #pragma unroll
        for(int r=0;r<16;++r){const int kv=kb+(r&3)+8*(r>>2); if(!(kv<tq))p0[r]=-INFINITY; if(!(kv+32<tq))p1[r]=-INFINITY;} }
      f32x16 s0,s1;
      #pragma unroll
      for(int r=0;r<16;++r){ s0[r]=__builtin_fmaxf(p0[r],0.f)+__builtin_amdgcn_logf(1.f+__builtin_amdgcn_exp2f(-__builtin_fabsf(p0[r])));
                             s1[r]=__builtin_fmaxf(p1[r],0.f)+__builtin_amdgcn_logf(1.f+__builtin_amdgcn_exp2f(-__builtin_fabsf(p1[r]))); }
      float w1[2][4],w0[2][4],gl[2][4],gh[2][4];
      #pragma unroll
      for(int g=0;g<4;++g){ w1[0][g]=s0[4*g+3]+s0[4*g+2]; w0[0][g]=w1[0][g]+s0[4*g+1]; const float gs0=w0[0][g]+s0[4*g];
                            w1[1][g]=s1[4*g+3]+s1[4*g+2]; w0[1][g]=w1[1][g]+s1[4*g+1]; const float gs1=w0[1][g]+s1[4*g];
        auto ra=__builtin_amdgcn_permlane32_swap(__float_as_uint(gs0),__float_as_uint(gs0),false,false); gl[0][g]=__uint_as_float(ra[0]); gh[0][g]=__uint_as_float(ra[1]);
        auto rb=__builtin_amdgcn_permlane32_swap(__float_as_uint(gs1),__float_as_uint(gs1),false,false); gl[1][g]=__uint_as_float(rb[0]); gh[1][g]=__uint_as_float(rb[1]); }
      float run=carry, base[2][4];
      #pragma unroll
      for(int blk=1;blk>=0;--blk)
        #pragma unroll
        for(int g=3;g>=0;--g){ const float eh=run; run+=gh[blk][g]; const float el=run; run+=gl[blk][g]; base[blk][g]=hi?eh:el; }
      carry=run;
      #pragma unroll
      for(int g=0;g<4;++g){
        p0[4*g+3]=__builtin_amdgcn_exp2f(p0[4*g+3]-s0[4*g+3]-base[0][g]);
        p0[4*g+2]=__builtin_amdgcn_exp2f(p0[4*g+2]-s0[4*g+2]-base[0][g]-s0[4*g+3]);
        p0[4*g+1]=__builtin_amdgcn_exp2f(p0[4*g+1]-s0[4*g+1]-base[0][g]-w1[0][g]);
        p0[4*g  ]=__builtin_amdgcn_exp2f(p0[4*g  ]-s0[4*g  ]-base[0][g]-w0[0][g]);
        p1[4*g+3]=__builtin_amdgcn_exp2f(p1[4*g+3]-s1[4*g+3]-base[1][g]);
        p1[4*g+2]=__builtin_amdgcn_exp2f(p1[4*g+2]-s1[4*g+2]-base[1][g]-s1[4*g+3]);
        p1[4*g+1]=__builtin_amdgcn_exp2f(p1[4*g+1]-s1[4*g+1]-base[1][g]-w1[1][g]);
        p1[4*g  ]=__builtin_amdgcn_exp2f(p1[4*g  ]-s1[4*g  ]-base[1][g]-w0[1][g]); }
      u32x4 pw0,pw1,pw2,pw3;
      pw0=(u32x4){cvtpk_s(p0[0],p0[1]),cvtpk_s(p0[2],p0[3]),cvtpk_s(p0[4],p0[5]),cvtpk_s(p0[6],p0[7])};
      pw1=(u32x4){cvtpk_s(p0[8],p0[9]),cvtpk_s(p0[10],p0[11]),cvtpk_s(p0[12],p0[13]),cvtpk_s(p0[14],p0[15])};
      pw2=(u32x4){cvtpk_s(p1[0],p1[1]),cvtpk_s(p1[2],p1[3]),cvtpk_s(p1[4],p1[5]),cvtpk_s(p1[6],p1[7])};
      pw3=(u32x4){cvtpk_s(p1[8],p1[9]),cvtpk_s(p1[10],p1[11]),cvtpk_s(p1[12],p1[13]),cvtpk_s(p1[14],p1[15])};
      SBAR(); pv(o,vb0+slot,__builtin_bit_cast(bf16x8,pw0),__builtin_bit_cast(bf16x8,pw1),__builtin_bit_cast(bf16x8,pw2),__builtin_bit_cast(bf16x8,pw3));
      mydone=__all(carry>SB_THR)!=0;
    }
    if(lane==0)flag[(it&1)*8+wid]=mydone?1u:0u;
    slot^=SLOTB;
  }
  bf16*Ow=O+(rowbase+q0+wid*QBLK)*DM+h*D;
  { bf16*stg=(bf16*)(shm+SB_OST)+wid*2048;
    #pragma unroll
    for(int r=0;r<16;++r){const int orow=crow(r,hi);
      #pragma unroll
      for(int d0=0;d0<2;++d0)stg[orow*64+d0*32+r32]=__float2bfloat16(o[d0][r]);}
    asm volatile("s_waitcnt lgkmcnt(0)":::"memory");
    #pragma unroll
    for(int i=0;i<4;++i){const int row=i*8+(lane>>3),ch=lane&7; const u32x4 v=*(const u32x4*)(stg+row*64+ch*8); *(u32x4*)(Ow+(long)row*DM+ch*8)=v;} }
  asm volatile("s_waitcnt vmcnt(0) lgkmcnt(0)\n\ts_barrier":::"memory");
  #undef SB_DMA_K
  #undef SB_DMA_V
}
struct SbOrder {
  int vcu,G;
  __device__ __forceinline__ explicit SbOrder(int grid,int block):vcu((grid%8==0)?(block%8)*(grid/8)+block/8:block),G(grid){}
  __device__ __forceinline__ bool next(int i,AttnUnit&u)const{ const int L=(vcu+(i>>2)*G)*4+(i&3); if(L>=BATCH*NHEAD*NQB)return false; u.bh=L/NQB; u.qb=L%NQB; return true; }
};
template<class Sched> __device__ __forceinline__ void sb_phase(char*lds,const AttnTensors&T,const Sched&S){
  AttnUnit u;
  for(int i=0;S.next(i,u);++i) sb_unit(u.bh/NHEAD,u.bh%NHEAD,u.qb,T.Q,T.K,T.V,T.O,lds);
}
#undef SBAR
#undef WAIT_BAR
}

struct Params {
    const float* in[38];
    float* out; unsigned char* ws;
    int ph_lo, ph_hi, li, pad;
};
enum { I_X = 0, I_LN1G, I_LN1B, I_LN2G, I_LN2B, I_FOX_WIN, I_FOX_BF, I_FOX_WOUT, I_GM_WIN, I_GM_BIN, I_GM_LNG, I_GM_LNB, I_GM_WS, I_GM_BS, I_GM_WOUT,
       I_SB_WIN, I_SB_WOUT, I_RW_MU, I_RW_WRKV, I_RW_W0, I_RW_W1, I_RW_W2, I_RW_A0, I_RW_A1, I_RW_A2, I_RW_G1, I_RW_G2, I_RW_KK, I_RW_KA, I_RW_RK,
       I_RW_GNG, I_RW_GNB, I_RW_WOUT, I_ROUTER_W, I_ROUTER_B, I_MOE_G, I_MOE_U, I_MOE_D };

struct Ctx { int tid, lane, wave, gw, ngw; unsigned char* lds; };

__device__ __forceinline__ void tr_tile(const float* src, int ld, bf16* dst, int ldt, float* scr, int lane) {
    float tv[32];
#pragma unroll
    for (int i = 0; i < 32; ++i) tv[i] = src[(size_t)(2 * i + (lane >> 5)) * ld + (lane & 31)];
#pragma unroll
    for (int i = 0; i < 32; ++i) scr[(2 * i + (lane >> 5)) * 33 + (lane & 31)] = tv[i];
    LDS_WAIT();
    const int c = lane & 7;
#pragma unroll
    for (int j = 0; j < 4; ++j) { const int n = (lane >> 3) + 8 * j; const float* s = scr + (8 * c) * 33 + n;
        u32x4 o; o.x = pk2(s[0 * 33], s[1 * 33]); o.y = pk2(s[2 * 33], s[3 * 33]); o.z = pk2(s[4 * 33], s[5 * 33]); o.w = pk2(s[6 * 33], s[7 * 33]);
        *(u32x4*)(dst + (size_t)n * ldt + 8 * c) = o; }
    LDS_WAIT();
}
__device__ __forceinline__ void conv_matrix(const Ctx& c, const float* W, int ld, int K, int ncols, bf16* WT, int ldt, int mode) {
    float* scr = (float*)(c.lds + c.wave * 16384);
    const int nblk = ncols / 32, nit = (K / 64) * nblk;
    for (int it = c.gw; it < nit; it += c.ngw) {
        const int kb = it / nblk, nb = it % nblk, n0 = nb * 32, k0 = kb * 64;
        int orow = n0; if (mode) orow = (n0 >> 7) * 256 + (n0 & 127) + (mode == 2 ? 128 : 0);
        tr_tile(W + (size_t)k0 * ld + n0, ld, WT + (size_t)orow * ldt + k0, ldt, scr, c.lane);
    }
}
__device__ __forceinline__ void conv_moe_items(const Ctx& c, const Params& p, int l, int it0, int it1, int w, int nw) {
    float* scr = (float*)(c.lds + c.wave * 16384);
    bf16* gu = (bf16*)(p.ws + WS_GU + (size_t)(l & 1) * WS_MOE_ALT); bf16* dn = (bf16*)(p.ws + WS_DOWN + (size_t)(l & 1) * WS_MOE_ALT);
    for (int it = it0 + w; it < it1; it += nw) {
        const int mtx = it >> 8, sub = it & 255, kind = mtx / 16, e = mtx % 16;
        if (kind < 2) {
            const float* W = p.in[kind == 0 ? I_MOE_G : I_MOE_U] + (size_t)(l * 16 + e) * 1024 * 512;
            const int kb = sub / 16, nb = sub % 16, n0 = nb * 32, k0 = kb * 64;
            const int orow = (n0 >> 7) * 256 + (n0 & 127) + (kind == 1 ? 128 : 0);
            tr_tile(W + (size_t)k0 * 512 + n0, 512, gu + (size_t)e * 1024 * 1024 + (size_t)orow * 1024 + k0, 1024, scr, c.lane);
        } else {
            const float* W = p.in[I_MOE_D] + (size_t)(l * 16 + e) * 512 * 1024;
            const int kb = sub / 32, nb = sub % 32, n0 = nb * 32, k0 = kb * 64;
            tr_tile(W + (size_t)k0 * 1024 + n0, 1024, dn + (size_t)e * 1024 * 512 + (size_t)n0 * 512 + k0, 512, scr, c.lane);
        }
    }
}
struct ConvDesc { int in_idx, src_off, ld, K, ncols; unsigned dst; int ldt; };
__device__ __forceinline__ void conv_list(const Ctx& c, const Params& p, const ConvDesc* tab, int n, int w, int nw) {
    float* scr = (float*)(c.lds + c.wave * 16384);
    int total = 0;
    for (int i = 0; i < n; ++i) total += (tab[i].K / 64) * (tab[i].ncols / 32);
    for (int it = w; it < total; it += nw) {
        int r = it, i = 0;
        for (; i < n - 1; ++i) { const int ni = (tab[i].K / 64) * (tab[i].ncols / 32); if (r < ni) break; r -= ni; }
        const ConvDesc d = tab[i]; const int nblk = d.ncols / 32, kb = r / nblk, nb = r % nblk;
        const float* src = p.in[I_FOX_WIN];
#define CSEL(ix) if (d.in_idx == ix) src = p.in[ix];
        CSEL(I_FOX_WOUT) CSEL(I_GM_WIN) CSEL(I_GM_WOUT) CSEL(I_SB_WIN) CSEL(I_SB_WOUT) CSEL(I_RW_WRKV) CSEL(I_RW_W1) CSEL(I_RW_A1) CSEL(I_RW_G1) CSEL(I_RW_W2) CSEL(I_RW_A2) CSEL(I_RW_G2) CSEL(I_RW_WOUT)
#undef CSEL
        tr_tile(src + d.src_off + (size_t)(kb * 64) * d.ld + nb * 32, d.ld, (bf16*)(p.ws + d.dst) + (size_t)(nb * 32) * d.ldt + kb * 64, d.ldt, scr, c.lane);
    }
}
__device__ const ConvDesc CONV_FOX[3] = { {I_FOX_WIN, 0, 4112, 1024, 3072, (unsigned)WS_FOX_IN, 1024}, {I_FOX_WIN, 3088, 4112, 1024, 1024, (unsigned)(WS_FOX_IN + 3072 * 1024 * 2), 1024}, {I_FOX_WOUT, 0, 1024, 1024, 1024, (unsigned)WS_FOX_OUT, 1024} };
__device__ const ConvDesc CONV_GM[2] = { {I_GM_WIN, 0, 2048, 1024, 2048, (unsigned)WS_GM_IN, 1024}, {I_GM_WOUT, 0, 1024, 1024, 1024, (unsigned)WS_GM_OUT, 1024} };
__device__ const ConvDesc CONV_SB[2] = { {I_SB_WIN, 0, 3072, 1024, 3072, (unsigned)WS_SB_IN, 1024}, {I_SB_WOUT, 0, 1024, 1024, 1024, (unsigned)WS_SB_OUT, 1024} };
__device__ const ConvDesc CONV_RW[10] = { {I_RW_WRKV, 0, 1024, 1024, 1024, (unsigned)WS_RKV, 1024}, {I_RW_WRKV, 1024 * 1024, 1024, 1024, 1024, (unsigned)(WS_RKV + 2 * MiB), 1024}, {I_RW_WRKV, 2 * 1024 * 1024, 1024, 1024, 1024, (unsigned)(WS_RKV + 4 * MiB), 1024},
    {I_RW_W1, 0, 64, 1024, 64, (unsigned)WS_LORA1, 1024}, {I_RW_A1, 0, 64, 1024, 64, (unsigned)(WS_LORA1 + 256 * 1024 * 2), 1024}, {I_RW_G1, 0, 128, 1024, 128, (unsigned)(WS_LORA1 + 512 * 1024 * 2), 1024},
    {I_RW_W2, 0, 1024, 64, 1024, (unsigned)WS_LORA2, 128}, {I_RW_A2, 0, 1024, 64, 1024, (unsigned)(WS_LORA2 + 1024 * 128 * 2), 128}, {I_RW_G2, 0, 1024, 128, 1024, (unsigned)(WS_LORA2 + 2048 * 128 * 2), 128},
    {I_RW_WOUT, 0, 1024, 1024, 1024, (unsigned)WS_RW_OUT, 1024} };
__device__ __forceinline__ bool tail_slot(const Ctx& c, int nunits, int& w, int& nw, int bid) {
    const int G = gridDim.x, rem = nunits % G;
    if (rem == 0 || (G - rem) * 2 < G) { w = bid * NW + c.wave; nw = G * NW; return true; }
    if (bid < rem) return false;
    w = (bid - rem) * NW + c.wave; nw = (G - rem) * NW; return true;
}

struct Row { f32x4 v[4]; };
__device__ __forceinline__ Row row_load(const float* r, int lane) { Row x; const f32x4* p = (const f32x4*)r + lane;
#pragma unroll
    for (int j = 0; j < 4; ++j) x.v[j] = p[64 * j]; return x; }
__device__ __forceinline__ Row row_load_bf(const bf16* r, int lane) { Row x; const unsigned long long* p = (const unsigned long long*)r + lane;
#pragma unroll
    for (int j = 0; j < 4; ++j) { const unsigned long long a = p[64 * j]; x.v[j][0] = bf2f((unsigned)a & 0xffffu); x.v[j][1] = bf2f((unsigned)a >> 16); x.v[j][2] = bf2f((unsigned)(a >> 32) & 0xffffu); x.v[j][3] = bf2f((unsigned)(a >> 48)); } return x; }
__device__ __forceinline__ void row_store(float* r, int lane, const Row& x) { f32x4* p = (f32x4*)r + lane;
#pragma unroll
    for (int j = 0; j < 4; ++j) p[64 * j] = x.v[j]; }
__device__ __forceinline__ void row_store_bf(bf16* r, int lane, const Row& x) { unsigned long long* p = (unsigned long long*)r + lane;
#pragma unroll
    for (int j = 0; j < 4; ++j) p[64 * j] = (unsigned long long)pk2(x.v[j].x, x.v[j].y) | ((unsigned long long)pk2(x.v[j].z, x.v[j].w) << 32); }
__device__ __forceinline__ Row row_ln(const Row& x, const float* g, const float* b, int lane) {
    float s = 0.f;
#pragma unroll
    for (int j = 0; j < 4; ++j) s += (x.v[j].x + x.v[j].y) + (x.v[j].z + x.v[j].w);
    const float mean = wave_sum(s) * (1.f / D); float s2 = 0.f; Row y;
#pragma unroll
    for (int j = 0; j < 4; ++j) { y.v[j] = x.v[j] - mean; s2 += (y.v[j].x * y.v[j].x + y.v[j].y * y.v[j].y) + (y.v[j].z * y.v[j].z + y.v[j].w * y.v[j].w); }
    const float rstd = 1.0f / sqrtf(wave_sum(s2) * (1.f / D) + LN_EPS);
    const f32x4* gp = (const f32x4*)g + lane; const f32x4* bp = (const f32x4*)b + lane;
#pragma unroll
    for (int j = 0; j < 4; ++j) y.v[j] = y.v[j] * rstd * gp[64 * j] + bp[64 * j];
    return y;
}
__device__ __forceinline__ void stage_w16(const Ctx& c, const float* W, int ld, float* tab) {
    for (int i = c.tid; i < 1024 * 4; i += NTHR) { const int col = i >> 2, e4 = i & 3; const f32x4 w = *(const f32x4*)(W + (size_t)col * ld + e4 * 4);
        tab[(e4 * 4 + 0) * 1024 + col] = w.x; tab[(e4 * 4 + 1) * 1024 + col] = w.y; tab[(e4 * 4 + 2) * 1024 + col] = w.z; tab[(e4 * 4 + 3) * 1024 + col] = w.w; }
}
__device__ __forceinline__ void row_dot16(const Row& x, const float* tab, int lane, float (&out)[16]) {
    const LAS f32x4* tp = (const LAS f32x4*)(LAS const float*)tab + lane;
#pragma unroll
    for (int e = 0; e < 16; ++e) {
        f32x4 a = x.v[0] * tp[e * 256]; a += x.v[1] * tp[e * 256 + 64]; a += x.v[2] * tp[e * 256 + 128]; a += x.v[3] * tp[e * 256 + 192];
        out[e] = (a.x + a.y) + (a.z + a.w);
        if ((e & 3) == 3) asm volatile("" ::: "memory");
    }
    float b8[8], c4[4];
#pragma unroll
    for (int k = 0; k < 8; ++k) { auto r = __builtin_amdgcn_permlane32_swap(__float_as_uint(out[k]), __float_as_uint(out[k + 8]), false, false); b8[k] = __uint_as_float(r[0]) + __uint_as_float(r[1]); }
#pragma unroll
    for (int k = 0; k < 4; ++k) { auto r = __builtin_amdgcn_permlane16_swap(__float_as_uint(b8[k]), __float_as_uint(b8[k + 4]), false, false); c4[k] = red16(__uint_as_float(r[0]) + __uint_as_float(r[1])); }
#pragma unroll
    for (int rho = 0; rho < 4; ++rho)
#pragma unroll
        for (int k = 0; k < 4; ++k) out[4 * rho + k] = rdlane(c4[k], 16 * rho);
}

__device__ __forceinline__ void phase_p0(const Ctx& c, const Params& p) {
    unsigned char* ws = p.ws;
    conv_list(c, p, CONV_FOX, 3, c.gw, c.ngw); conv_list(c, p, CONV_GM, 2, c.gw, c.ngw); conv_list(c, p, CONV_SB, 2, c.gw, c.ngw); conv_list(c, p, CONV_RW, 10, c.gw, c.ngw);
    {
        const int gt = c.gw * 64 + c.lane, ngt = c.ngw * 64;
        u32x4 z = {0u, 0u, 0u, 0u};
        u32x4* l1 = (u32x4*)(ws + WS_LORA1);
        for (int i = gt; i < 768 * 128; i += ngt) { const int row = i >> 7, blk = row >> 8, r = row & 255; if (r >= (blk == 2 ? 128 : 64)) l1[i] = z; }
        u32x4* l2 = (u32x4*)(ws + WS_LORA2);
        for (int i = gt; i < 2048 * 16; i += ngt) { if ((i & 15) >= 8) l2[i] = z; }
        const float* wsrc = p.in[I_GM_WS]; bf16* wd = (bf16*)(ws + WS_GM_WS);
        for (int i = gt; i < 8 * 128 * 128; i += ngt) { const int s = i & 127, t = (i >> 7) & 127; wd[i] = (bf16)f2bf(s <= t ? wsrc[i] : 0.f); }
    }
    conv_moe_items(c, p, 0, 0, 48 * 256, c.gw, c.ngw);
    bf16* Hb = (bf16*)(ws + WS_HB); float* FL = (float*)(ws + WS_FL);
    __syncthreads(); float* tab = (float*)c.lds; stage_w16(c, p.in[I_FOX_WIN] + 3072, 4112, tab); __syncthreads();
    for (int m = c.gw; m < T; m += c.ngw) {
        Row x = row_load(p.in[I_X] + (size_t)m * D, c.lane);
        row_store_bf(Hb + (size_t)m * D, c.lane, x);
        float fl[16]; row_dot16(x, tab, c.lane, fl);
        if (c.lane < 16) { float v = fl[0];
#pragma unroll
            for (int e = 1; e < 16; ++e) v = (c.lane == e) ? fl[e] : v;
            FL[(size_t)m * 16 + c.lane] = v; }
    }
}

struct GDesc { int arow0, brow0, pm, pn; };
template <class Sched, class Epi>
__device__ __forceinline__ void gemm_naive(const Ctx& c, const bf16* A, int lda, const bf16* Bt, int ldb, int K, const Sched& S, const Epi& E) {
    float* As = (float*)c.lds;
    float* Bs = As + 32 * 132;
    const int tid = c.tid, ty = tid >> 4, tx = tid & 15;
    for (int ui = blockIdx.x;; ui += gridDim.x) {
        GDesc d; if (!S.get(ui, d)) break;
        float acc[4][16];
#pragma unroll
        for (int i = 0; i < 4; ++i)
#pragma unroll
            for (int j = 0; j < 16; ++j) acc[i][j] = 0.f;
        for (int k0 = 0; k0 < K; k0 += 32) {
            { const int r = tid >> 2, kc = (tid & 3) * 8;
              const u32x4 v = *(const u32x4*)(A + (size_t)(d.arow0 + r) * lda + k0 + kc);
              As[(kc + 0) * 132 + r] = bf2f(v.x & 0xffffu); As[(kc + 1) * 132 + r] = bf2f(v.x >> 16);
              As[(kc + 2) * 132 + r] = bf2f(v.y & 0xffffu); As[(kc + 3) * 132 + r] = bf2f(v.y >> 16);
              As[(kc + 4) * 132 + r] = bf2f(v.z & 0xffffu); As[(kc + 5) * 132 + r] = bf2f(v.z >> 16);
              As[(kc + 6) * 132 + r] = bf2f(v.w & 0xffffu); As[(kc + 7) * 132 + r] = bf2f(v.w >> 16); }
#pragma unroll
            for (int jj = 0; jj < 2; ++jj) { const int idx = tid + 512 * jj, r = idx >> 2, kc = (idx & 3) * 8;
              const u32x4 v = *(const u32x4*)(Bt + (size_t)(d.brow0 + r) * ldb + k0 + kc);
              Bs[(kc + 0) * 260 + r] = bf2f(v.x & 0xffffu); Bs[(kc + 1) * 260 + r] = bf2f(v.x >> 16);
              Bs[(kc + 2) * 260 + r] = bf2f(v.y & 0xffffu); Bs[(kc + 3) * 260 + r] = bf2f(v.y >> 16);
              Bs[(kc + 4) * 260 + r] = bf2f(v.z & 0xffffu); Bs[(kc + 5) * 260 + r] = bf2f(v.z >> 16);
              Bs[(kc + 6) * 260 + r] = bf2f(v.w & 0xffffu); Bs[(kc + 7) * 260 + r] = bf2f(v.w >> 16); }
            __syncthreads();
#pragma unroll 4
            for (int k = 0; k < 32; ++k) {
                const f32x4 a = *(const f32x4*)&As[k * 132 + ty * 4];
#pragma unroll
                for (int q = 0; q < 4; ++q) { const f32x4 b = *(const f32x4*)&Bs[k * 260 + q * 64 + tx * 4];
#pragma unroll
                    for (int i = 0; i < 4; ++i) { acc[i][q * 4 + 0] += a[i] * b.x; acc[i][q * 4 + 1] += a[i] * b.y; acc[i][q * 4 + 2] += a[i] * b.z; acc[i][q * 4 + 3] += a[i] * b.w; } }
            }
            __syncthreads();
        }
#pragma unroll
        for (int i = 0; i < 4; ++i)
#pragma unroll
            for (int q = 0; q < 4; ++q)
#pragma unroll
                for (int j = 0; j < 4; ++j) E(d.pm * 128 + ty * 4 + i, d.pn * 256 + q * 64 + tx * 4 + j, acc[i][q * 4 + j], acc[i][(q ^ 2) * 4 + j]);
    }
}
struct DenseSched { int nM, nN;
    __device__ __forceinline__ bool get(int ui, GDesc& d) const { if (ui >= nM * nN) return false; d.pm = ui / nN; d.pn = ui % nN; d.arow0 = d.pm * 128; d.brow0 = d.pn * 256; return true; } };

struct EpiSplitBf16 {
    bf16* O0; size_t stride; float scale0;
    __device__ __forceinline__ void operator()(int row, int col, float v, float) const { const int t = col >> 10; if (t == 0) v *= scale0; O0[(size_t)t * stride + (size_t)row * 1024 + (col & 1023)] = (bf16)f2bf(v); } };
struct EpiResid {
    float* Hf;
    __device__ __forceinline__ void operator()(int row, int col, float v, float) const { float* q = Hf + (size_t)row * 1024 + col; *q = ALPHA * *q + v; } };
struct EpiGelu {
    bf16* Z; const float* bias;
    __device__ __forceinline__ void operator()(int row, int col, float v, float) const { const float x = v + bias[col];
        const float g = 0.5f * x * (1.f + tanhf(0.7978845608028654f * (x + 0.044715f * x * x * x))); Z[(size_t)row * 2048 + col] = (bf16)f2bf(g); } };
struct EpiRw1 {
    bf16* R; bf16* L1;
    __device__ __forceinline__ void operator()(int vrow, int col, float v, float) const { const int cc = vrow >> 14, t = vrow & (T - 1);
        if (cc < 3) R[(size_t)cc * T * 1024 + (size_t)t * 1024 + col] = (bf16)f2bf(v);
        else if (col < 128) { float o = v; if (cc == 3) o = tanhf(v); else if (cc == 5) o = sigmoidf_(v); L1[(size_t)(cc - 3) * T * 128 + (size_t)t * 128 + col] = (bf16)f2bf(o); } } };
struct Rw1Sched {
    __device__ __forceinline__ bool get(int ui, GDesc& d) const { if (ui >= 3 * 512 + 3 * 128) return false;
        int cc, mt, pn; if (ui < 1536) { cc = ui / 512; mt = (ui % 512) / 4; pn = ui % 4; d.brow0 = cc * 1024 + pn * 256; } else { const int u2 = ui - 1536; cc = 3 + u2 / 128; mt = u2 % 128; pn = 0; d.brow0 = 3072 + (cc - 3) * 256; }
        d.pm = cc * 128 + mt; d.pn = pn; d.arow0 = d.pm * 128; return true; } };
struct EpiRw2 {
    float* Wdec; bf16* A; bf16* G; const float* w0; const float* a0;
    __device__ __forceinline__ void operator()(int vrow, int col, float v, float) const { const int j = vrow >> 14, t = vrow & (T - 1); const size_t o = (size_t)t * 1024 + col;
        if (j == 0) Wdec[o] = expf(-0.6065306597126334f * sigmoidf_(w0[col] + v));
        else if (j == 1) A[o] = (bf16)f2bf(sigmoidf_(a0[col] + v)); else G[o] = (bf16)f2bf(v); } };
struct Rw2Sched { __device__ __forceinline__ bool get(int ui, GDesc& d) const { if (ui >= 3 * 512) return false; const int j = ui / 512, mt = (ui % 512) / 4, pn = ui % 4;
        d.pm = j * 128 + mt; d.pn = pn; d.arow0 = d.pm * 128; d.brow0 = j * 1024 + pn * 256; return true; } };
struct MoeSched {
    const int* tile_e; int nN, rowsB;
    __device__ __forceinline__ bool get(int ui, GDesc& d) const { const int ntile = tile_e[255] * 2; if (ui >= ntile * nN) return false;
        const int mt = ui / nN, pn = ui % nN, e = tile_e[mt >> 1]; d.pm = mt; d.pn = pn; d.arow0 = mt * 128; d.brow0 = e * rowsB + pn * 256; return true; } };
struct EpiSwiglu { bf16* H1;
    __device__ __forceinline__ void operator()(int row, int col, float v, float vp) const { const int x = col & 255; if (x < 128) { const float s = v / (1.f + expf(-v)); H1[(size_t)row * 512 + (col >> 8) * 128 + x] = (bf16)f2bf(s * vp); } } };
struct EpiDown { bf16* Yd; const float* rowg;
    __device__ __forceinline__ void operator()(int row, int col, float v, float) const { Yd[(size_t)row * 1024 + col] = (bf16)f2bf(v * rowg[row]); } };

__device__ __forceinline__ void fox_cumsum(const Ctx& c, const Params& p) {
    const float* FL = (const float*)(p.ws + WS_FL); float* CB = (float*)(p.ws + WS_CB); float* red = (float*)c.lds;
    for (int bh = blockIdx.x; bh < BATCH * NH; bh += gridDim.x) {
        const int b = bh / NH, h = bh % NH; const float bf = p.in[I_FOX_BF][h];
        float v[8], run = 0.f;
#pragma unroll
        for (int i = 0; i < 8; ++i) { const int s = c.tid * 8 + i; const float x = FL[(size_t)(b * SEQ + s) * 16 + h] + bf; run += -softplusf_(-x); v[i] = run; }
        const float incl = wave_incl_scan(run, c.lane);
        __syncthreads();
        if (c.lane == 63) red[c.wave] = incl;
        __syncthreads();
        float base = incl - run;
        for (int w = 0; w < c.wave; ++w) base += red[w];
#pragma unroll
        for (int i = 0; i < 8; ++i) CB[(size_t)bh * SEQ + c.tid * 8 + i] = -LOG2E * (base + v[i]);
    }
}
__device__ __forceinline__ void fox_attn_naive(const Ctx& c, const Params& p) {
    bf16* Q = (bf16*)(p.ws + WS_Q); const bf16* K = (const bf16*)(p.ws + WS_K); const bf16* V = (const bf16*)(p.ws + WS_V); const bf16* OG = (const bf16*)(p.ws + WS_OG);
    const float* CB = (const float*)(p.ws + WS_CB);
    float* qs = (float*)c.lds + c.wave * 64;
    for (int row = c.gw; row < BATCH * NH * SEQ; row += c.ngw) {
        const int bh = row / SEQ, t = row % SEQ, b = bh / NH, h = bh % NH;
        const size_t qoff = (size_t)(b * SEQ + t) * 1024 + h * 64 + c.lane;
        LDS_WAIT(); qs[c.lane] = bf2f(Q[qoff]); LDS_WAIT();
        float m = -INFINITY, l = 0.f, o = 0.f;
        for (int s0 = 0; s0 <= t; s0 += 64) {
            const int s = s0 + c.lane; const bool valid = s <= t;
            const u32x4* kp = (const u32x4*)(K + (size_t)(b * SEQ + s) * 1024 + h * 64);
            float z = 0.f;
#pragma unroll
            for (int cc = 0; cc < 8; ++cc) { const u32x4 kv = kp[cc];
                z += qs[cc * 8 + 0] * bf2f(kv.x & 0xffffu) + qs[cc * 8 + 1] * bf2f(kv.x >> 16) + qs[cc * 8 + 2] * bf2f(kv.y & 0xffffu) + qs[cc * 8 + 3] * bf2f(kv.y >> 16)
                   + qs[cc * 8 + 4] * bf2f(kv.z & 0xffffu) + qs[cc * 8 + 5] * bf2f(kv.z >> 16) + qs[cc * 8 + 6] * bf2f(kv.w & 0xffffu) + qs[cc * 8 + 7] * bf2f(kv.w >> 16); }
            z += CB[(size_t)bh * SEQ + s]; z = valid ? z : -INFINITY;
            const float mn = fmaxf(m, wave_max(z)); const float f = exp2f(m - mn); const float pe = valid ? exp2f(z - mn) : 0.f;
            l = l * f + pe; o *= f; m = mn;
#pragma unroll 8
            for (int k = 0; k < 64; ++k) { const float pk = rdlane(pe, k); o += pk * bf2f(V[(size_t)(b * SEQ + s0 + k) * 1024 + h * 64 + c.lane]); }
        }
        const float L = wave_sum(l);
        Q[qoff] = (bf16)f2bf(o / L * sigmoidf_(bf2f(OG[qoff])));
    }
}

__device__ __forceinline__ void sb_attn_naive(const Ctx& c, const Params& p) {
    bf16* Q = (bf16*)(p.ws + WS_Q); const bf16* K = (const bf16*)(p.ws + WS_K); const bf16* V = (const bf16*)(p.ws + WS_V);
    float* qs = (float*)c.lds + c.wave * 64;
    for (int row = c.gw; row < BATCH * NH * SEQ; row += c.ngw) {
        const int bh = row / SEQ, t = row % SEQ, b = bh / NH, h = bh % NH;
        const size_t qoff = (size_t)(b * SEQ + t) * 1024 + h * 64 + c.lane;
        LDS_WAIT(); qs[c.lane] = bf2f(Q[qoff]); LDS_WAIT();
        float carry = 0.f, o = 0.f;
        for (int c0 = 0; c0 < t; c0 += 64) {
            const int s = t - 1 - c0 - c.lane; const bool valid = s >= 0; const int sc = valid ? s : 0;
            const u32x4* kp = (const u32x4*)(K + (size_t)(b * SEQ + sc) * 1024 + h * 64);
            float z = 0.f;
#pragma unroll
            for (int cc = 0; cc < 8; ++cc) { const u32x4 kv = kp[cc];
                z += qs[cc * 8 + 0] * bf2f(kv.x & 0xffffu) + qs[cc * 8 + 1] * bf2f(kv.x >> 16) + qs[cc * 8 + 2] * bf2f(kv.y & 0xffffu) + qs[cc * 8 + 3] * bf2f(kv.y >> 16)
                   + qs[cc * 8 + 4] * bf2f(kv.z & 0xffffu) + qs[cc * 8 + 5] * bf2f(kv.z >> 16) + qs[cc * 8 + 6] * bf2f(kv.w & 0xffffu) + qs[cc * 8 + 7] * bf2f(kv.w >> 16); }
            const float sp = valid ? softplusf_(z) : 0.f;
            const float incl = wave_incl_scan(sp, c.lane);
            const float a = valid ? expf(z - incl - carry) : 0.f;
            carry += rdlane(incl, 63);
#pragma unroll 8
            for (int k = 0; k < 64; ++k) { const float ak = rdlane(a, k); int sk = t - 1 - c0 - k; sk = sk < 0 ? 0 : sk; o += ak * bf2f(V[(size_t)(b * SEQ + sk) * 1024 + h * 64 + c.lane]); }
        }
        Q[qoff] = (bf16)f2bf(o);
    }
}

__device__ __forceinline__ void gmlp_spatial_naive(const Ctx& c, const Params& p) {
    const bf16* Z = (const bf16*)(p.ws + WS_Z); bf16* Yg = (bf16*)(p.ws + WS_YG); const bf16* Wt = (const bf16*)(p.ws + WS_GM_WS);
    float* vn = (float*)c.lds;
    float* Ws = vn + 128 * 128;
    float* st = Ws + 128 * 129;
    for (int u = blockIdx.x; u < 128 * 8; u += gridDim.x) {
        const int n = u >> 3, g = u & 7;
        __syncthreads();
        for (int r = c.wave * 16; r < c.wave * 16 + 16; ++r) {
            const bf16* zr = Z + (size_t)(n * 128 + r) * 2048 + 1024;
            float x[16];
#pragma unroll
            for (int jj = 0; jj < 2; ++jj) { const u32x4 v = *(const u32x4*)(zr + c.lane * 8 + 512 * jj);
                x[jj * 8 + 0] = bf2f(v.x & 0xffffu); x[jj * 8 + 1] = bf2f(v.x >> 16); x[jj * 8 + 2] = bf2f(v.y & 0xffffu); x[jj * 8 + 3] = bf2f(v.y >> 16);
                x[jj * 8 + 4] = bf2f(v.z & 0xffffu); x[jj * 8 + 5] = bf2f(v.z >> 16); x[jj * 8 + 6] = bf2f(v.w & 0xffffu); x[jj * 8 + 7] = bf2f(v.w >> 16); }
            float s = 0.f;
#pragma unroll
            for (int i = 0; i < 16; ++i) s += x[i];
            const float mean = wave_sum(s) * (1.f / 1024.f); float s2 = 0.f;
#pragma unroll
            for (int i = 0; i < 16; ++i) { const float dd = x[i] - mean; s2 += dd * dd; }
            const float rstd = 1.0f / sqrtf(wave_sum(s2) * (1.f / 1024.f) + LN_EPS);
            if (c.lane == 0) { st[r * 2] = mean; st[r * 2 + 1] = rstd; }
        }
        __syncthreads();
        { const int s = c.tid >> 2, cb = (c.tid & 3) * 32; const float mean = st[s * 2], rstd = st[s * 2 + 1];
          const bf16* zr = Z + (size_t)(n * 128 + s) * 2048 + 1024 + g * 128 + cb;
          for (int i = 0; i < 32; ++i) { const int gc = g * 128 + cb + i; vn[s * 128 + cb + i] = (bf2f(zr[i]) - mean) * rstd * p.in[I_GM_LNG][gc] + p.in[I_GM_LNB][gc]; }
          for (int i = c.tid; i < 128 * 128; i += NTHR) Ws[(i >> 7) * 129 + (i & 127)] = bf2f(Wt[(size_t)g * 16384 + i]); }
        __syncthreads();
        { const int t = c.tid >> 2, cb = (c.tid & 3) * 32;
          float acc[32];
#pragma unroll
          for (int i = 0; i < 32; ++i) acc[i] = 0.f;
          for (int s = 0; s < 128; ++s) { const float w = Ws[t * 129 + s];
#pragma unroll
              for (int i = 0; i < 8; ++i) { const f32x4 x = *(const f32x4*)&vn[s * 128 + cb + 4 * i]; acc[4 * i] += w * x.x; acc[4 * i + 1] += w * x.y; acc[4 * i + 2] += w * x.z; acc[4 * i + 3] += w * x.w; } }
          const float bs = p.in[I_GM_BS][g * 128 + t];
          const bf16* ur = Z + (size_t)(n * 128 + t) * 2048 + g * 128 + cb; bf16* yr = Yg + (size_t)(n * 128 + t) * 1024 + g * 128 + cb;
#pragma unroll
          for (int i = 0; i < 32; ++i) yr[i] = (bf16)f2bf(bf2f(ur[i]) * (acc[i] + bs)); }
    }
}


constexpr int GM_SLD = 528;
constexpr int GM_LD = 272;
typedef float f32x16_t __attribute__((ext_vector_type(16)));
typedef short bf16x8_t __attribute__((ext_vector_type(8)));
__device__ __forceinline__ void gmlp_spatial(const Ctx& c, const Params& p) {
    const bf16* Z = (const bf16*)(p.ws + WS_Z); bf16* Yg = (bf16*)(p.ws + WS_YG); const bf16* Wt = (const bf16*)(p.ws + WS_GM_WS);
    unsigned char* Wl = c.lds; unsigned char* Vl = c.lds + 128 * GM_LD; float* st = (float*)(c.lds + 2 * 128 * GM_LD); unsigned char* Sl = c.lds + 2 * 128 * GM_LD + 1024;
    const int lane = c.lane, r32 = lane & 31, hi = lane >> 5, wid = c.wave;
    for (int u = blockIdx.x; u < 256; u += gridDim.x) {
        const int n = u >> 1, g0 = (u & 1) * 4;
        __syncthreads();
#pragma unroll
        for (int rb = 0; rb < 2; ++rb) {
            u32x4 zv[8][2];
#pragma unroll
            for (int i = 0; i < 8; ++i) { const bf16* zr = Z + (size_t)(n * 128 + wid * 16 + rb * 8 + i) * 2048 + 1024; zv[i][0] = *(const u32x4*)(zr + lane * 8); zv[i][1] = *(const u32x4*)(zr + lane * 8 + 512); }
#pragma unroll
            for (int i = 0; i < 8; ++i) { float s1 = 0.f, s2 = 0.f;
#pragma unroll
                for (int jj = 0; jj < 2; ++jj)
#pragma unroll
                    for (int e = 0; e < 4; ++e) { const float a = bf2f(zv[i][jj][e] & 0xffffu), b = bf2f(zv[i][jj][e] >> 16); s1 += a + b; s2 += a * a + b * b; }
                s1 = red16(s1); s2 = red16(s2);
                const float t1 = (rdlane(s1, 0) + rdlane(s1, 16)) + (rdlane(s1, 32) + rdlane(s1, 48)), t2 = (rdlane(s2, 0) + rdlane(s2, 16)) + (rdlane(s2, 32) + rdlane(s2, 48));
                const float mean = t1 * (1.f / 1024.f), var = fmaxf(t2 * (1.f / 1024.f) - mean * mean, 0.f);
                if (lane == 0) { const int r = wid * 16 + rb * 8 + i; st[r * 2] = mean; st[r * 2 + 1] = 1.0f / sqrtf(var + LN_EPS); } }
        }
        for (int gi = 0; gi < 4; ++gi) {
            const int g = g0 + gi;
            __syncthreads();
            { u32x4 wv[4];
#pragma unroll
              for (int k = 0; k < 4; ++k) wv[k] = *(const u32x4*)(Wt + (size_t)g * 16384 + (size_t)(c.tid + NTHR * k) * 8);
#pragma unroll
              for (int k = 0; k < 4; ++k) { const int i = c.tid + NTHR * k, t = i >> 4, ch = i & 15; *(LAS u32x4*)((LAS unsigned char*)Wl + t * GM_LD + ch * 16) = wv[k]; } }
            { const int sp = lane, cb = wid * 16;
              const float mean0 = st[4 * sp], rstd0 = st[4 * sp + 1], mean1 = st[4 * sp + 2], rstd1 = st[4 * sp + 3];
              const bf16* z0 = Z + (size_t)(n * 128 + 2 * sp) * 2048 + 1024 + g * 128 + cb;
              const u32x4 a0 = *(const u32x4*)z0, a1 = *(const u32x4*)(z0 + 8), b0 = *(const u32x4*)(z0 + 2048), b1 = *(const u32x4*)(z0 + 2048 + 8);
              const float* gp = p.in[I_GM_LNG] + g * 128 + cb; const float* bp = p.in[I_GM_LNB] + g * 128 + cb;
#pragma unroll
              for (int j = 0; j < 16; ++j) { const unsigned wa = j < 8 ? a0[(j & 7) >> 1] : a1[(j & 7) >> 1], wb = j < 8 ? b0[(j & 7) >> 1] : b1[(j & 7) >> 1];
                  const float xa = (j & 1) ? __uint_as_float(wa & 0xffff0000u) : __uint_as_float(wa << 16), xb = (j & 1) ? __uint_as_float(wb & 0xffff0000u) : __uint_as_float(wb << 16);
                  const float gn = gp[j], bs_ = bp[j];
                  *(unsigned*)(Vl + (cb + j) * GM_LD + sp * 4) = pk2((xa - mean0) * rstd0 * gn + bs_, (xb - mean1) * rstd1 * gn + bs_); } }
            __syncthreads();
            const int cb32 = wid >> 1, tb0 = 2 * (wid & 1);
            f32x16_t acc0 = {}, acc1 = {};
#pragma unroll
            for (int ks = 0; ks < 8; ++ks) {
                const bf16x8_t a = *(const bf16x8_t*)(Vl + (cb32 * 32 + r32) * GM_LD + (16 * ks + 8 * hi) * 2);
                const bf16x8_t b0 = *(const bf16x8_t*)(Wl + (tb0 * 32 + r32) * GM_LD + (16 * ks + 8 * hi) * 2);
                const bf16x8_t b1 = *(const bf16x8_t*)(Wl + ((tb0 + 1) * 32 + r32) * GM_LD + (16 * ks + 8 * hi) * 2);
                acc0 = __builtin_amdgcn_mfma_f32_32x32x16_bf16(a, b0, acc0, 0, 0, 0);
                acc1 = __builtin_amdgcn_mfma_f32_32x32x16_bf16(a, b1, acc1, 0, 0, 0);
            }
#pragma unroll
            for (int tt = 0; tt < 2; ++tt) { const f32x16_t& acc = tt ? acc1 : acc0; const int t = (tb0 + tt) * 32 + r32; const float bs = p.in[I_GM_BS][g * 128 + t];
#pragma unroll
                for (int q = 0; q < 4; ++q) *(f32x4*)(Sl + t * GM_SLD + (cb32 * 32 + 8 * q + 4 * hi) * 4) = (f32x4){acc[4 * q] + bs, acc[4 * q + 1] + bs, acc[4 * q + 2] + bs, acc[4 * q + 3] + bs}; }
            __syncthreads();
            u32x4 uvv[4];
#pragma unroll
            for (int k = 0; k < 4; ++k) { const int i = c.tid + NTHR * k, t = i >> 4, ch8 = (i & 15) * 8; uvv[k] = *(const u32x4*)(Z + (size_t)(n * 128 + t) * 2048 + g * 128 + ch8); }
#pragma unroll
            for (int k = 0; k < 4; ++k) { const int i = c.tid + NTHR * k, t = i >> 4, ch8 = (i & 15) * 8;
                const u32x4 uv = uvv[k];
                const f32x4 s0 = *(const f32x4*)(Sl + t * GM_SLD + ch8 * 4), s1 = *(const f32x4*)(Sl + t * GM_SLD + ch8 * 4 + 16);
                u32x4 o; o.x = pk2(__uint_as_float(uv.x << 16) * s0[0], __uint_as_float(uv.x & 0xffff0000u) * s0[1]); o.y = pk2(__uint_as_float(uv.y << 16) * s0[2], __uint_as_float(uv.y & 0xffff0000u) * s0[3]);
                o.z = pk2(__uint_as_float(uv.z << 16) * s1[0], __uint_as_float(uv.z & 0xffff0000u) * s1[1]); o.w = pk2(__uint_as_float(uv.w << 16) * s1[2], __uint_as_float(uv.w & 0xffff0000u) * s1[3]);
                *(u32x4*)(Yg + (size_t)(n * 128 + t) * 1024 + g * 128 + ch8) = o; }
        }
    }
}

__device__ __forceinline__ void rwkv_mix(const Ctx& c, const Params& p) {
    const bf16* Hb = (const bf16*)(p.ws + WS_HB); bf16* HM = (bf16*)(p.ws + WS_HM); const float* mu = p.in[I_RW_MU];
    f32x4 mv[6][2][2];
#pragma unroll
    for (int cc = 0; cc < 6; ++cc)
#pragma unroll
        for (int jj = 0; jj < 2; ++jj) { mv[cc][jj][0] = *(const f32x4*)(mu + cc * 1024 + 512 * jj + 8 * c.lane); mv[cc][jj][1] = *(const f32x4*)(mu + cc * 1024 + 512 * jj + 8 * c.lane + 4); }
    int m = c.gw; const u32x4 z4 = {0u, 0u, 0u, 0u};
    u32x4 h[2], hp[2];
#pragma unroll
    for (int jj = 0; jj < 2; ++jj) { h[jj] = (m < T) ? *(const u32x4*)(Hb + (size_t)m * D + 512 * jj + 8 * c.lane) : z4; hp[jj] = (m < T && (m & (SEQ - 1))) ? *(const u32x4*)(Hb + (size_t)(m - 1) * D + 512 * jj + 8 * c.lane) : z4; }
    for (; m < T; m += c.ngw) {
        u32x4 hc[2] = {h[0], h[1]}, hq[2] = {hp[0], hp[1]}; const int mn = m + c.ngw;
        if (mn < T) {
#pragma unroll
            for (int jj = 0; jj < 2; ++jj) { h[jj] = *(const u32x4*)(Hb + (size_t)mn * D + 512 * jj + 8 * c.lane); hp[jj] = (mn & (SEQ - 1)) ? *(const u32x4*)(Hb + (size_t)(mn - 1) * D + 512 * jj + 8 * c.lane) : z4; }
        }
#pragma unroll
        for (int jj = 0; jj < 2; ++jj) {
            f32x4 a0, a1, d0, d1;
#pragma unroll
            for (int e = 0; e < 2; ++e) { a0[2 * e] = bf2f(hc[jj][e] & 0xffffu); a0[2 * e + 1] = bf2f(hc[jj][e] >> 16); a1[2 * e] = bf2f(hc[jj][e + 2] & 0xffffu); a1[2 * e + 1] = bf2f(hc[jj][e + 2] >> 16);
                d0[2 * e] = bf2f(hq[jj][e] & 0xffffu) - a0[2 * e]; d0[2 * e + 1] = bf2f(hq[jj][e] >> 16) - a0[2 * e + 1]; d1[2 * e] = bf2f(hq[jj][e + 2] & 0xffffu) - a1[2 * e]; d1[2 * e + 1] = bf2f(hq[jj][e + 2] >> 16) - a1[2 * e + 1]; }
#pragma unroll
            for (int cc = 0; cc < 6; ++cc) { const f32x4 o0 = a0 + d0 * mv[cc][jj][0], o1 = a1 + d1 * mv[cc][jj][1];
                u32x4 w; w.x = pk2(o0[0], o0[1]); w.y = pk2(o0[2], o0[3]); w.z = pk2(o1[0], o1[1]); w.w = pk2(o1[2], o1[3]);
                *(u32x4*)(HM + (size_t)cc * T * 1024 + (size_t)m * 1024 + 512 * jj + 8 * c.lane) = w; }
        }
    }
}
struct RwIn { float r, k, v, w, a, g; };
__device__ __forceinline__ RwIn rw_load(const Params& p, size_t off) { RwIn x;
    x.r = bf2f(((const bf16*)(p.ws + WS_RR))[off]); x.k = bf2f(((const bf16*)(p.ws + WS_RK))[off]); x.v = bf2f(((const bf16*)(p.ws + WS_RV))[off]);
    x.w = ((const float*)(p.ws + WS_WDEC))[off]; x.a = bf2f(((const bf16*)(p.ws + WS_RA))[off]); x.g = bf2f(((const bf16*)(p.ws + WS_RG))[off]); return x; }
__device__ __forceinline__ void rwkv_scan_naive(const Ctx& c, const Params& p) {
    bf16* YG = (bf16*)(p.ws + WS_RYG);
    for (int bh = c.gw; bh < BATCH * NH; bh += c.ngw) {
        const int b = bh / NH, h = bh % NH, ch = h * 64 + c.lane;
        const float k_k = p.in[I_RW_KK][ch], k_a = p.in[I_RW_KA][ch], r_k = p.in[I_RW_RK][ch], gn_g = p.in[I_RW_GNG][ch], gn_b = p.in[I_RW_GNB][ch];
        float S[64];
#pragma unroll
        for (int j = 0; j < 64; ++j) S[j] = 0.f;
        RwIn nx = rw_load(p, (size_t)(b * SEQ) * 1024 + ch);
        for (int t = 0; t < SEQ; ++t) {
            const RwIn x = nx; const size_t off = (size_t)(b * SEQ + t) * 1024 + ch;
            if (t + 1 < SEQ) nx = rw_load(p, off + 1024);
            float kk = x.k * k_k; const float nrm = sqrtf(wave_sum(kk * kk)); kk = kk / fmaxf(nrm, 1e-12f);
            const float kt = x.k * (1.f + (x.a - 1.f) * k_a), bv = kk * x.a;
            float sa = 0.f;
#pragma unroll
            for (int j = 0; j < 64; ++j) sa -= S[j] * rdlane(kk, j);
            float y = 0.f;
#pragma unroll
            for (int j = 0; j < 64; ++j) { S[j] = S[j] * rdlane(x.w, j) + sa * rdlane(bv, j) + x.v * rdlane(kt, j); y += S[j] * rdlane(x.r, j); }
            const float mean = wave_sum(y) * (1.f / 64.f); const float dy = y - mean; const float var = wave_sum(dy * dy) * (1.f / 64.f);
            const float yn = dy * (1.0f / sqrtf(var + GN_EPS)) * gn_g + gn_b;
            const float bonus = wave_sum(x.r * kt * r_k) * x.v;
            YG[off] = (bf16)f2bf((yn + bonus) * x.g);
        }
    }
}


constexpr int RW_CH = 32, RW_RING = RW_CH * 6 * 64 * 4  , RW_YB = 2 * RW_RING, RW_YBB = RW_CH * 16 * 4;
#define RAW_BAR() asm volatile("s_waitcnt lgkmcnt(0)\n\ts_barrier" ::: "memory")
__device__ __forceinline__ void rwkv_scan(const Ctx& c, const Params& p) {
    const bf16* Rg = (const bf16*)(p.ws + WS_RR); const bf16* Kg = (const bf16*)(p.ws + WS_RK); const bf16* Vg = (const bf16*)(p.ws + WS_RV);
    const float* Wg = (const float*)(p.ws + WS_WDEC); const bf16* Ag = (const bf16*)(p.ws + WS_RA); float* Ysc = (float*)(p.ws + WS_YSC);
    float* ring = (float*)c.lds; float* ybuf = (float*)(c.lds + RW_YB);
    const int lane = c.lane, wid = c.wave;
    for (int u = blockIdx.x; u < BATCH * NH * 4; u += gridDim.x) {
        const int bh = u >> 2, qr = u & 3, b = bh / NH, h = bh % NH;
        const size_t gbase = (size_t)(b * SEQ) * 1024 + h * 64;
        if (wid >= 4) {
            const int pw = wid - 4; const int ch = h * 64 + lane;
            const float k_k = p.in[I_RW_KK][ch], k_a = p.in[I_RW_KA][ch];
            unsigned rr[8], rk[8], rv[8], ra[8]; float rw[8];
#define RW_LOAD(cc) _Pragma("unroll") for (int i = 0; i < 8; ++i) { const size_t o = gbase + (size_t)((cc) * RW_CH + pw + 4 * i) * 1024 + lane; rr[i] = Rg[o]; rk[i] = Kg[o]; rv[i] = Vg[o]; ra[i] = Ag[o]; rw[i] = Wg[o]; }
#define RW_PROC(cc) _Pragma("unroll") for (int i = 0; i < 8; ++i) { float* dst = ring + ((cc) & 1) * (RW_RING / 4) + (pw + 4 * i) * 384 + lane; \
                const float kf = bf2f(rk[i]), af = bf2f(ra[i]); float kk = kf * k_k; float n2 = red16(kk * kk); n2 = rdlane(n2, 0) + rdlane(n2, 16) + rdlane(n2, 32) + rdlane(n2, 48); \
                kk = kk * __builtin_amdgcn_rsqf(fmaxf(n2, 1e-24f)); dst[0] = bf2f(rr[i]); dst[64] = kf * (1.f + (af - 1.f) * k_a); dst[128] = __builtin_amdgcn_exp2f(rw[i]); dst[192] = kk * af; dst[256] = kk; dst[320] = bf2f(rv[i]); }
#define RW_FLUSH(cc) _Pragma("unroll") for (int i2 = 0; i2 < 2; ++i2) { const int st = pw + 4 * (i2 * 4 + (lane >> 4)); \
                Ysc[gbase + (size_t)((cc) * RW_CH + st) * 1024 + qr * 16 + (lane & 15)] = ybuf[((cc) & 1) * (RW_YBB / 4) + st * 16 + (lane & 15)]; }
            RW_LOAD(0); RW_PROC(0); RW_LOAD(1);
            RAW_BAR();
            for (int cc = 0; cc < SEQ / RW_CH; ++cc) {
                if (cc + 1 < SEQ / RW_CH) { RW_PROC(cc + 1); }
                if (cc + 2 < SEQ / RW_CH) { RW_LOAD(cc + 2); }
                if (cc > 0) { RW_FLUSH(cc - 1); }
                RAW_BAR();
            }
            RW_FLUSH(SEQ / RW_CH - 1);
#undef RW_LOAD
#undef RW_PROC
#undef RW_FLUSH
        } else {
            const int rg = lane >> 4, c4 = (lane & 15) * 4, row = wid * 4 + rg;
            float S0 = 0.f, S1 = 0.f, S2 = 0.f, S3 = 0.f;
            RAW_BAR();
            for (int cc = 0; cc < SEQ / RW_CH; ++cc) {
                const float* base = ring + (cc & 1) * (RW_RING / 4); float* yb = ybuf + (cc & 1) * (RW_YBB / 4);
                const float* sp0 = base + c4; const float* vp0 = base + 320 + qr * 16 + row;
                f32x4 r4 = *(const f32x4*)(sp0), kt4 = *(const f32x4*)(sp0 + 64), w4 = *(const f32x4*)(sp0 + 128), b4 = *(const f32x4*)(sp0 + 192), kk4 = *(const f32x4*)(sp0 + 256); float vi = vp0[0];
#pragma unroll 8
                for (int st = 0; st < RW_CH; ++st) {
                    const int sn = (st + 1 < RW_CH) ? st + 1 : st;
                    const f32x4 nr4 = *(const f32x4*)(sp0 + sn * 384), nkt4 = *(const f32x4*)(sp0 + sn * 384 + 64), nw4 = *(const f32x4*)(sp0 + sn * 384 + 128), nb4 = *(const f32x4*)(sp0 + sn * 384 + 192), nkk4 = *(const f32x4*)(sp0 + sn * 384 + 256);
                    const float nvi = vp0[sn * 384];
                    float pd = S0 * kk4.x; pd = fmaf(S1, kk4.y, pd); pd = fmaf(S2, kk4.z, pd); pd = fmaf(S3, kk4.w, pd);
                    pd = red16(pd);
                    S0 = fmaf(S0, w4.x, fmaf(-pd, b4.x, vi * kt4.x)); S1 = fmaf(S1, w4.y, fmaf(-pd, b4.y, vi * kt4.y));
                    S2 = fmaf(S2, w4.z, fmaf(-pd, b4.z, vi * kt4.z)); S3 = fmaf(S3, w4.w, fmaf(-pd, b4.w, vi * kt4.w));
                    float y = S0 * r4.x; y = fmaf(S1, r4.y, y); y = fmaf(S2, r4.z, y); y = fmaf(S3, r4.w, y);
                    y = red16(y);
                    yb[st * 16 + row] = y;
                    r4 = nr4; kt4 = nkt4; w4 = nw4; b4 = nb4; kk4 = nkk4; vi = nvi;
                }
                RAW_BAR();
            }
        }
        RAW_BAR();
    }
}

namespace rwc {
typedef float f32x16 __attribute__((ext_vector_type(16)));
typedef short bf16x8 __attribute__((ext_vector_type(8)));
__device__ __forceinline__ bf16 hbf(float x) { return (bf16)(pk2(x, 0.f) & 0xffffu); }
constexpr int L = 32, NCHH = 32  , NQ = 4, REC = 30720;
constexpr int O_P1T = 0, O_RBT = 4096, O_BBP = 8192, O_MBRT = 12288, O_VP2T = 14336, O_VMKRT = 18432, O_VKTP = 22528;
constexpr int A_ABT = 0, A_BBT = 4096, A_KBT = 8192, A_RBT = 12288, A_WAVE = 16384;
constexpr int A_MBB = A_BBT  , A_TT = A_KBT  , A_MKB = A_KBT + 2048, A_MKRT = A_RBT, A_P2T = A_RBT + 2048;
__device__ __forceinline__ int crow(int r, int hi) { return (r & 3) + 8 * (r >> 2) + 4 * hi; }
__device__ __forceinline__ int ppos(int k) { return (k & ~15) + 8 * ((k >> 2) & 1) + 4 * ((k >> 3) & 1) + (k & 3); }
__device__ __forceinline__ bf16x8 ldf(const unsigned char* base, int row, int rowbytes, int kb) { return *(const bf16x8*)(base + row * rowbytes + kb); }
__device__ __forceinline__ f32x16 mm(bf16x8 a, bf16x8 b, f32x16 c) { return __builtin_amdgcn_mfma_f32_32x32x16_bf16(a, b, c, 0, 0, 0); }
__device__ __forceinline__ unsigned char* rec_ptr(unsigned char* ws, int qr, int head, int cl) { return ws + ((qr & 1) ? WS_CD1 : WS_CD0) + (size_t)(head * NCHH + cl) * REC; }
#define RWC_FENCE() asm volatile("s_waitcnt lgkmcnt(0)" ::: "memory")

template <int TAU, int TP> struct TriDot { static __device__ __forceinline__ void run(const float (&x)[32], const f32x4 (&m)[8], float (&acc)[4]) { acc[TP & 3] = fmaf(m[TP >> 2][TP & 3], x[TP], acc[TP & 3]); TriDot<TAU, TP + 1>::run(x, m, acc); } };
template <int TAU> struct TriDot<TAU, 32> { static __device__ __forceinline__ void run(const float (&)[32], const f32x4 (&)[8], float (&)[4]) {} };
template <int TAU> struct TriSolve { static __device__ __forceinline__ void run(float (&x)[32], const unsigned char* mb, int col) {
    f32x4 m[8];
#pragma unroll
    for (int g = 0; g < 8; ++g) m[g] = *(const f32x4*)(mb + (TAU * 32 + 4 * g) * 4);
    float a4[4] = {0.f, 0.f, 0.f, 0.f};
    TriDot<TAU, TAU + 1>::run(x, m, a4);
    float acc = (a4[0] + a4[1]) + (a4[2] + a4[3]);
    asm volatile("" : "+v"(acc) :: "memory");
    x[TAU] = (TAU < col) ? acc : x[TAU];
    TriSolve<TAU - 1>::run(x, mb, col); } };
template <> struct TriSolve<-1> { static __device__ __forceinline__ void run(float (&)[32], const unsigned char*, int) {} };
__device__ __forceinline__ void rwc_prep(const Ctx& c, const Params& p, int half, int c0, int nch, int blk0, int nblk) {
    if ((int)blockIdx.x < blk0) return;
    unsigned char* wl = c.lds + c.wave * A_WAVE;
    const bf16* Rg = (const bf16*)(p.ws + WS_RR); const bf16* Kg = (const bf16*)(p.ws + WS_RK); const bf16* Vg = (const bf16*)(p.ws + WS_RV);
    const float* LWg = (const float*)(p.ws + WS_WDEC); const bf16* Ag = (const bf16*)(p.ws + WS_RA); float* WLg = (float*)(p.ws + WS_WLG);
    const int lane0 = c.lane;
    int lane = lane0;
    unsigned ra_[8], rb_[8], rd_[8]; float re_[8];
#define RWC_GB(q_) ((size_t)((((q_) & 63) / NH) * SEQ + (c0 + ((q_) >> 6)) * L) * 1024 + (((q_) & 63) % NH) * 64)
#define RWC_LD8(gb_, tb_) _Pragma("unroll") for (int i = 0; i < 8; ++i) { const int o = ((tb_) + i) * 1024 + lane; ra_[i] = (Rg + (gb_))[o]; rb_[i] = (Kg + (gb_))[o]; rd_[i] = (Ag + (gb_))[o]; re_[i] = (LWg + (gb_))[o]; }
    const int q0 = ((int)blockIdx.x - blk0) * NW + c.wave, qs = nblk * NW, qn = BATCH * NH * nch;
    if (q0 < qn) { const size_t g0 = RWC_GB(q0); RWC_LD8(g0, 0) }
    for (int q = q0; q < qn; q += qs) {
        lane = lane0; asm volatile("" : "+v"(lane)); const int r32 = lane & 31, hi = lane >> 5, pl = ppos(lane);
        const int head = q & 63, cl = q >> 6, b = head / NH, h = head % NH, ch = h * 64 + lane;
        const size_t gbase = (size_t)(b * SEQ + (c0 + cl) * L) * 1024 + h * 64;
        unsigned char* rec = rec_ptr(p.ws, half, head, cl);
        const float k_k = p.in[I_RW_KK][ch], k_a = p.in[I_RW_KA][ch];
        float run = 0.f, wprev = 1.f;
        RWC_FENCE();
#pragma unroll 1
        for (int tb = 0; tb < L; tb += 8) {
            unsigned rr[8], rk[8], ra[8]; float rl[8];
#pragma unroll
            for (int i = 0; i < 8; ++i) { rr[i] = ra_[i]; rk[i] = rb_[i]; ra[i] = rd_[i]; rl[i] = re_[i]; }
            if (tb + 8 < L) { RWC_LD8(gbase, tb + 8) }
#pragma unroll
            for (int i = 0; i < 8; ++i) { const int t = tb + i;
                const float kf = bf2f(rk[i]), af = bf2f(ra[i]); float kk = kf * k_k; kk = kk * __builtin_amdgcn_rsqf(fmaxf(wave_sum(kk * kk), 1e-24f));
                const float ktv = kf * (1.f + (af - 1.f) * k_a), bv = kk * af; run += rl[i];
                const float ep = __builtin_amdgcn_exp2f(run), em = __builtin_amdgcn_exp2f(-run);
                *(bf16*)(wl + A_ABT + t * 128 + pl * 2) = hbf(-kk * wprev);
                *(bf16*)(wl + A_BBT + t * 128 + pl * 2) = hbf(bv * em); *(bf16*)(wl + A_KBT + t * 128 + pl * 2) = hbf(ktv * em);
                *(bf16*)(wl + A_RBT + t * 128 + pl * 2) = hbf(bf2f(rr[i]) * ep);
                wprev = ep; }
        }
        RWC_FENCE();
        f32x16 mbb = {}, mkb = {}, mbr = {}, mkr = {};
#pragma unroll
        for (int s_ = 0; s_ < 4; ++s_) { const int kb = (16 * s_ + 8 * hi) * 2;
            const bf16x8 ab_ = ldf(wl + A_BBT, r32, 128, kb), ak_ = ldf(wl + A_KBT, r32, 128, kb), ba_ = ldf(wl + A_ABT, r32, 128, kb), br_ = ldf(wl + A_RBT, r32, 128, kb);
            mbb = mm(ab_, ba_, mbb); mkb = mm(ak_, ba_, mkb); mbr = mm(ab_, br_, mbr); mkr = mm(ak_, br_, mkr); }
        RWC_FENCE();
        unsigned abr[16], vr[16], kpr[16], bpr[16];
        { const float wlj = __builtin_amdgcn_exp2f(run);
          WLg[(size_t)(head * 128 + c0 + cl) * 64 + lane] = wlj;
#pragma unroll
          for (int t = 0; t < L; ++t) { const int pt = (t & ~15) + 8 * ((t >> 2) & 1) + 4 * ((t >> 3) & 1) + (t & 3);
              const unsigned ab = *(const bf16*)(wl + A_ABT + t * 128 + pl * 2), kp = hbf(bf2f(*(const bf16*)(wl + A_KBT + t * 128 + pl * 2)) * wlj), bp = hbf(bf2f(*(const bf16*)(wl + A_BBT + t * 128 + pl * 2)) * wlj);
              const unsigned vv = (Vg + gbase)[t * 1024 + lane];
              if (t & 1) { abr[t >> 1] |= ab << 16; vr[t >> 1] |= vv << 16; kpr[t >> 1] |= kp << 16; bpr[pt >> 1] |= bp << 16; }
              else { abr[t >> 1] = ab; vr[t >> 1] = vv; kpr[t >> 1] = kp; bpr[pt >> 1] = bp; } } }
#pragma unroll
        for (int i = 0; i < 4; ++i) *(u32x4*)(rec + O_BBP + lane * 64 + i * 16) = (u32x4){bpr[4 * i], bpr[4 * i + 1], bpr[4 * i + 2], bpr[4 * i + 3]};
#pragma unroll
        for (int i = 0; i < 4; ++i) *(u32x4*)(rec + O_RBT + i * 1024 + lane * 16) = *(const u32x4*)(wl + A_RBT + i * 1024 + lane * 16);
        RWC_FENCE();
        { int r32 = lane & 31, hi = lane >> 5; asm volatile("" : "+v"(r32), "+v"(hi));
#pragma unroll
        for (int r = 0; r < 16; ++r) { const int tau = crow(r, hi), t = r32; const bool s1 = tau < t, s2 = tau <= t;
            *(float*)(wl + A_MBB + (tau * 32 + t) * 4) = s1 ? mbb[r] : 0.f;
            *(bf16*)(wl + A_MKB + (tau * 32 + t) * 2) = hbf(s1 ? mkb[r] : 0.f);
            *(bf16*)(wl + A_MKRT + (t * 32 + tau) * 2) = hbf(s2 ? mkr[r] : 0.f);
            *(bf16*)(wl + A_ABT + (t * 32 + ppos(tau)) * 2) = hbf(s2 ? mbr[r] : 0.f); } }
        RWC_FENCE();
#pragma unroll
        for (int i = 0; i < 2; ++i) *(u32x4*)(rec + O_MBRT + i * 1024 + lane * 16) = *(const u32x4*)(wl + A_ABT + i * 1024 + lane * 16);
        RWC_FENCE();
        if (q + qs < qn) { const size_t gn = RWC_GB(q + qs); RWC_LD8(gn, 0) }
        { float x[L]; int r32 = lane & 31; asm volatile("" : "+v"(r32));
#pragma unroll
          for (int tau = 0; tau < L; ++tau) x[tau] = (tau == r32) ? 1.f : 0.f;
          TriSolve<L - 2>::run(x, wl + A_MBB, r32);
          RWC_FENCE();
          if (hi == 0) {
#pragma unroll
              for (int i = 0; i < 4; ++i) *(u32x4*)(wl + A_TT + r32 * 64 + i * 16) = (u32x4){pk2(x[8 * i], x[8 * i + 1]), pk2(x[8 * i + 2], x[8 * i + 3]), pk2(x[8 * i + 4], x[8 * i + 5]), pk2(x[8 * i + 6], x[8 * i + 7])}; } }
#pragma unroll
        for (int i = 0; i < 4; ++i) *(u32x4*)(wl + A_BBT + lane * 64 + i * 16) = (u32x4){abr[4 * i], abr[4 * i + 1], abr[4 * i + 2], abr[4 * i + 3]};
        RWC_FENCE();
        { f32x16 p1a = {}, p1b = {}, p2 = {};
#pragma unroll
          for (int s_ = 0; s_ < 2; ++s_) { const int kb = (16 * s_ + 8 * hi) * 2; const bf16x8 tt = ldf(wl + A_TT, r32, 64, kb);
              p1a = mm(tt, ldf(wl + A_BBT, r32, 64, kb), p1a); p1b = mm(tt, ldf(wl + A_BBT, 32 + r32, 64, kb), p1b); p2 = mm(tt, ldf(wl + A_MKB, r32, 64, kb), p2); }
          RWC_FENCE();
          int r32 = lane & 31, hi = lane >> 5; asm volatile("" : "+v"(r32), "+v"(hi));
#pragma unroll
          for (int r = 0; r < 16; ++r) { const int t = crow(r, hi);
              *(bf16*)(wl + A_ABT + (t * 64 + ppos(r32)) * 2) = hbf(p1a[r]); *(bf16*)(wl + A_ABT + (t * 64 + 32 + ppos(r32)) * 2) = hbf(p1b[r]);
              *(bf16*)(wl + A_P2T + (t * 32 + r32) * 2) = hbf(p2[r]); } }
#pragma unroll
        for (int i = 0; i < 4; ++i) { *(u32x4*)(wl + A_BBT + lane * 64 + i * 16) = (u32x4){vr[4 * i], vr[4 * i + 1], vr[4 * i + 2], vr[4 * i + 3]};
                                      *(u32x4*)(wl + A_KBT + lane * 64 + i * 16) = (u32x4){kpr[4 * i], kpr[4 * i + 1], kpr[4 * i + 2], kpr[4 * i + 3]}; }
        RWC_FENCE();
#pragma unroll
        for (int i = 0; i < 4; ++i) *(u32x4*)(rec + O_P1T + i * 1024 + lane * 16) = *(const u32x4*)(wl + A_ABT + i * 1024 + lane * 16);
        RWC_FENCE();
#pragma unroll
        for (int ib = 0; ib < 2; ++ib) { f32x16 vp = {}, vm = {}, vk0 = {}, vk1 = {};
#pragma unroll
            for (int s_ = 0; s_ < 2; ++s_) { const int kb = (16 * s_ + 8 * hi) * 2; const bf16x8 vv = ldf(wl + A_BBT, ib * 32 + r32, 64, kb);
                vp = mm(ldf(wl + A_P2T, r32, 64, kb), vv, vp); vm = mm(ldf(wl + A_MKRT, r32, 64, kb), vv, vm);
                vk0 = mm(ldf(wl + A_KBT, r32, 64, kb), vv, vk0); vk1 = mm(ldf(wl + A_KBT, 32 + r32, 64, kb), vv, vk1); }
            int ln_ = lane; asm volatile("" : "+v"(ln_));
#define RWC_ST(acc, off) do { _Pragma("unroll") for (int i_ = 0; i_ < 2; ++i_) *(u32x4*)(rec + (off) + ln_ * 32 + i_ * 16) = (u32x4){pk2(acc[8 * i_], acc[8 * i_ + 1]), pk2(acc[8 * i_ + 2], acc[8 * i_ + 3]), pk2(acc[8 * i_ + 4], acc[8 * i_ + 5]), pk2(acc[8 * i_ + 6], acc[8 * i_ + 7])}; } while (0)
            RWC_ST(vp, O_VP2T + ib * 2048); RWC_ST(vm, O_VMKRT + ib * 2048); RWC_ST(vk0, O_VKTP + (ib * 2 + 0) * 2048); RWC_ST(vk1, O_VKTP + (ib * 2 + 1) * 2048);
#undef RWC_ST
        }
        RWC_FENCE();
    }
}
#undef RWC_LD8
#undef RWC_GB
__device__ __forceinline__ void rwc_scan(const Ctx& c, const Params& p, int half, int c0, int nch) {
    bf16* Y2 = (bf16*)(p.ws + WS_Y2); const float* WLg = (const float*)(p.ws + WS_WLG); float* SIG = (float*)(p.ws + WS_SIG);
    const int lane = c.lane, r32 = lane & 31, hi = lane >> 5, wid = c.wave;
    const unsigned lds0 = (unsigned)(uintptr_t)c.lds;
    for (int head = blockIdx.x; head < BATCH * NH; head += gridDim.x) {
        const int b = head / NH, h = head % NH;
        const unsigned char* rec0 = rec_ptr(p.ws, half, head, 0);
        asm volatile("s_waitcnt vmcnt(0) lgkmcnt(0)\n\ts_barrier" ::: "memory");
        if (wid >= 2) {
            const int lw = wid - 2;
#define RWC_DMA(cl) do { _Pragma("unroll") for (int k_ = 0; k_ < 5; ++k_) attn_body::glds16s((unsigned)((lw * 5 + k_) * 1024 + lane * 16), rec0 + (size_t)(cl) * REC, \
                    (unsigned)__builtin_amdgcn_readfirstlane(lds0 + ((cl) & 3) * REC + (lw * 5 + k_) * 1024)); } while (0)
            RWC_DMA(0); RWC_DMA(1); RWC_DMA(2);
            asm volatile("s_waitcnt vmcnt(10)\n\ts_barrier" ::: "memory");
            for (int cl = 0; cl < nch; ++cl) {
                if (cl + 3 < nch) { RWC_DMA(cl + 3); asm volatile("s_waitcnt vmcnt(10)\n\ts_barrier" ::: "memory"); }
                else if (cl + 3 == nch) { asm volatile("s_waitcnt vmcnt(5)\n\ts_barrier" ::: "memory"); }
                else { asm volatile("s_waitcnt vmcnt(0)\n\ts_barrier" ::: "memory"); }
            }
#undef RWC_DMA
        } else {
            const int ib = wid; f32x16 S0, S1;
            float* sg = SIG + ((size_t)(head * 2 + ib) * 2) * 1024 + lane * 16;
            if (c0 == 0) { S0 = f32x16{}; S1 = f32x16{}; }
            else {
#pragma unroll
                for (int r = 0; r < 16; ++r) { S0[r] = sg[r]; S1[r] = sg[1024 + r]; } }
            f32x4 wn0[4], wn1[4];
#pragma unroll
            for (int g = 0; g < 4; ++g) { wn0[g] = *(const f32x4*)(WLg + (size_t)(head * 128 + c0) * 64 + 8 * g + 4 * hi); wn1[g] = *(const f32x4*)(WLg + (size_t)(head * 128 + c0) * 64 + 32 + 8 * g + 4 * hi); }
            asm volatile("s_waitcnt lgkmcnt(0)\n\ts_barrier" ::: "memory");
            for (int cl = 0; cl < nch; ++cl) {
                const unsigned char* rl = c.lds + (cl & 3) * REC;
                f32x4 w0[4], w1[4];
#pragma unroll
                for (int g = 0; g < 4; ++g) { w0[g] = wn0[g]; w1[g] = wn1[g]; }
                { const float* wlp = WLg + (size_t)(head * 128 + c0 + (cl + 1 < nch ? cl + 1 : cl)) * 64;
#pragma unroll
                  for (int g = 0; g < 4; ++g) { wn0[g] = *(const f32x4*)(wlp + 8 * g + 4 * hi); wn1[g] = *(const f32x4*)(wlp + 32 + 8 * g + 4 * hi); } }
                bf16x8 sb[4];
#define RWC_CV(X, o) __builtin_bit_cast(bf16x8, (u32x4){pk2(X[o], X[o + 1]), pk2(X[o + 2], X[o + 3]), pk2(X[o + 4], X[o + 5]), pk2(X[o + 6], X[o + 7])})
                sb[0] = RWC_CV(S0, 0); sb[1] = RWC_CV(S0, 8); sb[2] = RWC_CV(S1, 0); sb[3] = RWC_CV(S1, 8);
                f32x16 ut, yt;
                { const u32x4 a0 = *(const u32x4*)(rl + O_VP2T + ib * 2048 + lane * 32), a1 = *(const u32x4*)(rl + O_VP2T + ib * 2048 + lane * 32 + 16);
                  const u32x4 b0 = *(const u32x4*)(rl + O_VMKRT + ib * 2048 + lane * 32), b1 = *(const u32x4*)(rl + O_VMKRT + ib * 2048 + lane * 32 + 16);
#pragma unroll
                  for (int e = 0; e < 4; ++e) { ut[2 * e] = bf2f(a0[e] & 0xffffu); ut[2 * e + 1] = bf2f(a0[e] >> 16); ut[8 + 2 * e] = bf2f(a1[e] & 0xffffu); ut[8 + 2 * e + 1] = bf2f(a1[e] >> 16);
                                                yt[2 * e] = bf2f(b0[e] & 0xffffu); yt[2 * e + 1] = bf2f(b0[e] >> 16); yt[8 + 2 * e] = bf2f(b1[e] & 0xffffu); yt[8 + 2 * e + 1] = bf2f(b1[e] >> 16); } }
#pragma unroll
                for (int s_ = 0; s_ < 4; ++s_) { const int kb = (16 * s_ + 8 * hi) * 2; ut = mm(ldf(rl + O_P1T, r32, 128, kb), sb[s_], ut); yt = mm(ldf(rl + O_RBT, r32, 128, kb), sb[s_], yt); }
                { const u32x4 c0 = *(const u32x4*)(rl + O_VKTP + (ib * 2 + 0) * 2048 + lane * 32), c1 = *(const u32x4*)(rl + O_VKTP + (ib * 2 + 0) * 2048 + lane * 32 + 16);
                  const u32x4 d0 = *(const u32x4*)(rl + O_VKTP + (ib * 2 + 1) * 2048 + lane * 32), d1 = *(const u32x4*)(rl + O_VKTP + (ib * 2 + 1) * 2048 + lane * 32 + 16);
#pragma unroll
                  for (int e = 0; e < 4; ++e) {
                      S0[2 * e] = fmaf(S0[2 * e], w0[(2 * e) >> 2][(2 * e) & 3], bf2f(c0[e] & 0xffffu)); S0[2 * e + 1] = fmaf(S0[2 * e + 1], w0[(2 * e + 1) >> 2][(2 * e + 1) & 3], bf2f(c0[e] >> 16));
                      S0[8 + 2 * e] = fmaf(S0[8 + 2 * e], w0[(8 + 2 * e) >> 2][(8 + 2 * e) & 3], bf2f(c1[e] & 0xffffu)); S0[8 + 2 * e + 1] = fmaf(S0[8 + 2 * e + 1], w0[(9 + 2 * e) >> 2][(9 + 2 * e) & 3], bf2f(c1[e] >> 16));
                      S1[2 * e] = fmaf(S1[2 * e], w1[(2 * e) >> 2][(2 * e) & 3], bf2f(d0[e] & 0xffffu)); S1[2 * e + 1] = fmaf(S1[2 * e + 1], w1[(2 * e + 1) >> 2][(2 * e + 1) & 3], bf2f(d0[e] >> 16));
                      S1[8 + 2 * e] = fmaf(S1[8 + 2 * e], w1[(8 + 2 * e) >> 2][(8 + 2 * e) & 3], bf2f(d1[e] & 0xffffu)); S1[8 + 2 * e + 1] = fmaf(S1[8 + 2 * e + 1], w1[(9 + 2 * e) >> 2][(9 + 2 * e) & 3], bf2f(d1[e] >> 16)); } }
                bf16x8 ub[2]; ub[0] = RWC_CV(ut, 0); ub[1] = RWC_CV(ut, 8);
#pragma unroll
                for (int s_ = 0; s_ < 2; ++s_) { const int kb = (16 * s_ + 8 * hi) * 2;
                    S0 = mm(ldf(rl + O_BBP, r32, 64, kb), ub[s_], S0); S1 = mm(ldf(rl + O_BBP, 32 + r32, 64, kb), ub[s_], S1); yt = mm(ldf(rl + O_MBRT, r32, 64, kb), ub[s_], yt); }
#undef RWC_CV
                { bf16* yo = Y2 + (size_t)(b * SEQ + (c0 + cl) * L) * 1024 + h * 64 + ib * 32 + r32;
#pragma unroll
                  for (int r = 0; r < 16; ++r) yo[(size_t)crow(r, hi) * 1024] = hbf(yt[r]); }
                asm volatile("s_waitcnt lgkmcnt(0)\n\ts_barrier" ::: "memory");
            }
            if (c0 + nch < SEQ / L) {
#pragma unroll
                for (int r = 0; r < 16; ++r) { sg[r] = S0[r]; sg[1024 + r] = S1[r]; } }
        }
    }
}
}


constexpr int CW_CHK = 210000;
__device__ __forceinline__ void rwc_check(const Ctx& c, const Params& p) {
    const float* Ysc = (const float*)(p.ws + WS_YSC); const bf16* Y2 = (const bf16*)(p.ws + WS_Y2); float* acc = (float*)((unsigned*)(p.ws + WS_CTL) + CW_CHK);
    float num = 0.f, den = 0.f;
    for (size_t i = (size_t)blockIdx.x * NTHR + c.tid; i < (size_t)T * D; i += (size_t)gridDim.x * NTHR) { const float a = Ysc[i], b = bf2f(Y2[i]); num += (a - b) * (a - b); den += a * a; }
    num = wave_sum(num); den = wave_sum(den);
    if (c.lane == 0) { atomicAdd(acc, num); atomicAdd(acc + 1, den); }
}

constexpr int RW_SPLIT = 104 * 32;
__device__ __forceinline__ void rwkv_post(const Ctx& c, const Params& p, int part, int blk0, int nblk) {
    const bf16* Y2 = (const bf16*)(p.ws + WS_Y2); const bf16* Rg = (const bf16*)(p.ws + WS_RR); const bf16* Kg = (const bf16*)(p.ws + WS_RK); const bf16* Vg = (const bf16*)(p.ws + WS_RV);
    const bf16* Ag = (const bf16*)(p.ws + WS_RA); const bf16* Gg = (const bf16*)(p.ws + WS_RG); bf16* YG = (bf16*)(p.ws + WS_RYG);
    if ((int)blockIdx.x < blk0) return;
    const int per = part ? SEQ - RW_SPLIT : RW_SPLIT, cnt = BATCH * per;
    for (int idx = ((int)blockIdx.x - blk0) * NW + c.wave; idx < cnt; idx += nblk * NW) {
        const int m = (idx / per) * SEQ + (part ? RW_SPLIT : 0) + idx % per;
        const Row y = row_load_bf(Y2 + (size_t)m * D, c.lane); Row o;
#pragma unroll
        for (int j = 0; j < 4; ++j) {
            const int col = 4 * (c.lane + 64 * j); const size_t off = (size_t)m * D + col;
            const unsigned long long r8 = *(const unsigned long long*)(Rg + off), k8 = *(const unsigned long long*)(Kg + off), v8 = *(const unsigned long long*)(Vg + off),
                                     a8 = *(const unsigned long long*)(Ag + off), g8 = *(const unsigned long long*)(Gg + off);
            const f32x4 ka = *(const f32x4*)(p.in[I_RW_KA] + col), rk = *(const f32x4*)(p.in[I_RW_RK] + col), gg = *(const f32x4*)(p.in[I_RW_GNG] + col), gb = *(const f32x4*)(p.in[I_RW_GNB] + col);
            f32x4 r4, k4, v4, a4, g4;
#pragma unroll
            for (int q = 0; q < 4; ++q) { r4[q] = bf2f((unsigned)(r8 >> (16 * q)) & 0xffffu); k4[q] = bf2f((unsigned)(k8 >> (16 * q)) & 0xffffu); v4[q] = bf2f((unsigned)(v8 >> (16 * q)) & 0xffffu);
                a4[q] = bf2f((unsigned)(a8 >> (16 * q)) & 0xffffu); g4[q] = bf2f((unsigned)(g8 >> (16 * q)) & 0xffffu); }
            const f32x4 yv = y.v[j];
            const float mean = red16((yv.x + yv.y) + (yv.z + yv.w)) * (1.f / 64.f);
            const f32x4 dy = yv - mean;
            const float var = red16((dy.x * dy.x + dy.y * dy.y) + (dy.z * dy.z + dy.w * dy.w)) * (1.f / 64.f);
            const float rstd = 1.0f / sqrtf(var + GN_EPS);
            f32x4 kt; float bs = 0.f;
#pragma unroll
            for (int q = 0; q < 4; ++q) { kt[q] = k4[q] * (1.f + (a4[q] - 1.f) * ka[q]); bs += r4[q] * kt[q] * rk[q]; }
            const float bonus = red16(bs);
#pragma unroll
            for (int q = 0; q < 4; ++q) o.v[j][q] = (dy[q] * rstd * gg[q] + gb[q] + bonus * v4[q]) * g4[q];
        }
        row_store_bf(YG + (size_t)m * D, c.lane, o);
    }
}

__device__ __forceinline__ float allred4(float x) {
    auto r = __builtin_amdgcn_permlane16_swap(__float_as_uint(x), __float_as_uint(x), false, false); x = __uint_as_float(r[0]) + __uint_as_float(r[1]);
    auto q = __builtin_amdgcn_permlane32_swap(__float_as_uint(x), __float_as_uint(x), false, false); return __uint_as_float(q[0]) + __uint_as_float(q[1]);
}
__device__ __forceinline__ void moe_ln_route(const Ctx& c, const Params& p, int l, bool = false) {
    const bf16* Hbr = (const bf16*)(p.ws + WS_HB); bf16* Hb = (bf16*)(p.ws + WS_HB);
    int* P2TE = (int*)(p.ws + WS_P2TE); float* ROWGE = (float*)(p.ws + WS_ROWGE); int* TOKQ = (int*)(p.ws + WS_TOKQ);
    unsigned* cnt = (unsigned*)(p.ws + WS_CTL) + CW_CNT + l * 64;
    constexpr int L_WT = 0  , L_GB = 98304  , L_RED = L_GB + 256  , L_CNT = L_RED + 1024, L_LNG = L_CNT + 64, L_LNB = L_LNG + 4096,
                  L_GS = L_LNB + 4096  , L_REC = L_GS + 2048  , L_BLK = L_REC + 6144  ;
    LAS unsigned char* ldl = (LAS unsigned char*)c.lds;
    unsigned* lcnt = (unsigned*)(c.lds + L_CNT);
    const int fr = c.lane & 15, fq = c.lane >> 4;
    if (c.tid < 16) lcnt[c.tid] = 0u;
    const int rpb = (T + (int)gridDim.x - 1) / (int)gridDim.x, r0 = (int)blockIdx.x * rpb, r1 = (r0 + rpb < T) ? r0 + rpb : T, ng = (r1 - r0 + 15) >> 4;
    u32x4 xr[32];
#define M1_LOADX(gi_) { int mr_ = r0 + (gi_) * 16 + fr; mr_ = mr_ < r1 ? mr_ : r1 - 1; const u32x4* s_ = (const u32x4*)(Hbr + (size_t)mr_ * D) + fq; _Pragma("unroll") for (int s = 0; s < 32; ++s) xr[s] = s_[4 * s]; }
    int gi = c.wave;
    if (gi < ng) M1_LOADX(gi)
    {
        const float* lg = p.in[I_LN1G] + l * D; const float* lb = p.in[I_LN1B] + l * D; const float* Wr = p.in[I_ROUTER_W];
        const int e = c.tid & 15, q = c.tid >> 4;
        float gsum = 0.f, bsum = 0.f;
#pragma unroll
        for (int m = 0; m < 4; ++m) {
            const int ch = q + 32 * m, col0 = 8 * ch;
            const f32x4 g0 = *(const f32x4*)(lg + col0), g1 = *(const f32x4*)(lg + col0 + 4), b0 = *(const f32x4*)(lb + col0), b1 = *(const f32x4*)(lb + col0 + 4);
            unsigned h1[8], h2[8], h3[8];
#pragma unroll
            for (int i = 0; i < 8; ++i) { const float w = Wr[(col0 + i) * 16 + e], gv = i < 4 ? g0[i & 3] : g1[i & 3], bv = i < 4 ? b0[i & 3] : b1[i & 3], pr = gv * w;
                gsum += pr; bsum = fmaf(bv, w, bsum); attn_body::split3(pr, h1[i], h2[i], h3[i]); }
            const int slot = ((ch >> 2) * 64 + (ch & 3) * 16 + e) * 16;
            *(LAS u32x4*)(ldl + L_WT + slot) = (u32x4){h1[0] | (h1[1] << 16), h1[2] | (h1[3] << 16), h1[4] | (h1[5] << 16), h1[6] | (h1[7] << 16)};
            *(LAS u32x4*)(ldl + L_WT + 32768 + slot) = (u32x4){h2[0] | (h2[1] << 16), h2[2] | (h2[3] << 16), h2[4] | (h2[5] << 16), h2[6] | (h2[7] << 16)};
            *(LAS u32x4*)(ldl + L_WT + 65536 + slot) = (u32x4){h3[0] | (h3[1] << 16), h3[2] | (h3[3] << 16), h3[4] | (h3[5] << 16), h3[6] | (h3[7] << 16)};
        }
        gsum = allred4(gsum); bsum = allred4(bsum);
        if (c.lane < 16) { *(LAS float*)(ldl + L_RED + (c.wave * 32 + e) * 4) = gsum; *(LAS float*)(ldl + L_RED + (c.wave * 32 + 16 + e) * 4) = bsum; }
        for (int i = c.tid; i < 1024; i += NTHR) { *(LAS float*)(ldl + L_LNG + i * 4) = lg[i]; *(LAS float*)(ldl + L_LNB + i * 4) = lb[i]; }
        __syncthreads();
        if (c.tid < 32) { float a = 0.f;
#pragma unroll
            for (int w = 0; w < NW; ++w) a += *(LAS float*)(ldl + L_RED + (w * 32 + c.tid) * 4);
            *(LAS float*)(ldl + L_GB + c.tid * 4) = a; }
        else if (c.tid < 48) *(LAS float*)(ldl + L_GB + c.tid * 4) = p.in[I_ROUTER_B][c.tid - 32];
        __syncthreads();
    }
    const f32x4 Gv = *(LAS f32x4*)(ldl + L_GB + fq * 16), Bv = *(LAS f32x4*)(ldl + L_GB + 64 + fq * 16), Rv = *(LAS f32x4*)(ldl + L_GB + 128 + fq * 16);
    for (; gi < ng; gi += NW) {
        f32x4 acc = {0.f, 0.f, 0.f, 0.f};
        unsigned wb_ = (unsigned)c.lane * 16u, gb_ = (unsigned)fq * 32u + (unsigned)L_LNG; asm volatile("" : "+v"(wb_), "+v"(gb_));
        LAS unsigned char* wtl = ldl + wb_; LAS unsigned char* gbl = ldl + gb_;
#pragma unroll
        for (int s = 0; s < 32; ++s) {
            const pg8::bf16x8 xf = __builtin_bit_cast(pg8::bf16x8, xr[s]);
#pragma unroll
            for (int part = 0; part < 3; ++part)
                acc = __builtin_amdgcn_mfma_f32_16x16x32_bf16(*(LAS pg8::bf16x8*)(wtl + L_WT + part * 32768 + s * 1024), xf, acc, 0, 0, 0);
            if ((s & 3) == 3) __builtin_amdgcn_sched_barrier(0);
        }
        float sum = 0.f;
#pragma unroll
        for (int s = 0; s < 32; ++s)
#pragma unroll
            for (int k = 0; k < 4; ++k) sum += __uint_as_float(xr[s][k] << 16) + __uint_as_float(xr[s][k] & 0xffff0000u);
        const float mean = allred4(sum) * (1.f / D);
#pragma unroll
        for (int s = 0; s < 32; ++s) asm volatile("" : "+v"(xr[s]));
        float s2 = 0.f;
#pragma unroll
        for (int s = 0; s < 32; ++s)
#pragma unroll
            for (int k = 0; k < 4; ++k) { const float d0 = __uint_as_float(xr[s][k] << 16) - mean, d1 = __uint_as_float(xr[s][k] & 0xffff0000u) - mean; s2 = fmaf(d0, d0, s2); s2 = fmaf(d1, d1, s2); }
        const float rstd = 1.0f / sqrtf(allred4(s2) * (1.f / D) + LN_EPS);
        const int mrow = r0 + gi * 16 + fr; const bool valid = mrow < r1;
        u32x4* d_ = (u32x4*)(Hb + (size_t)(valid ? mrow : r1 - 1) * D) + fq;
#pragma unroll
        for (int s = 0; s < 32; ++s) asm volatile("" : "+v"(xr[s]));
#pragma unroll
        for (int s = 0; s < 32; ++s) {
            if ((s & 1) == 0) __builtin_amdgcn_sched_barrier(0);
            const f32x4 g0 = *(LAS f32x4*)(gbl + 128 * s), g1 = *(LAS f32x4*)(gbl + 128 * s + 16);
            const f32x4 b0 = *(LAS f32x4*)(gbl + 4096 + 128 * s), b1 = *(LAS f32x4*)(gbl + 4096 + 128 * s + 16);
            u32x4 o;
#pragma unroll
            for (int k = 0; k < 4; ++k) { const float gl = k < 2 ? g0[2 * k] : g1[2 * k - 4], gh = k < 2 ? g0[2 * k + 1] : g1[2 * k - 3], bl = k < 2 ? b0[2 * k] : b1[2 * k - 4], bh = k < 2 ? b0[2 * k + 1] : b1[2 * k - 3];
                const float y0 = (__uint_as_float(xr[s][k] << 16) - mean) * rstd * gl + bl, y1 = (__uint_as_float(xr[s][k] & 0xffff0000u) - mean) * rstd * gh + bh;
                o[k] = pk2(y0, y1); }
            d_[4 * s] = o;
        }
        float sc[4], se[4];
#pragma unroll
        for (int i = 0; i < 4; ++i) { const float lgt = rstd * (acc[i] - mean * Gv[i]) + Bv[i]; sc[i] = __builtin_amdgcn_rcpf(1.0f + __builtin_amdgcn_exp2f(-LOG2E * lgt)); se[i] = sc[i] + Rv[i]; }
        int i1 = 0; float v1 = se[0], c1 = sc[0];
#pragma unroll
        for (int i = 1; i < 4; ++i) if (se[i] > v1) { i1 = i; v1 = se[i]; c1 = sc[i]; }
        int i2 = -1; float v2 = -INFINITY, c2v = 0.f;
#pragma unroll
        for (int i = 0; i < 4; ++i) if (i != i1 && se[i] > v2) { i2 = i; v2 = se[i]; c2v = sc[i]; }
        *(LAS float*)(ldl + L_GS + ((c.wave * 16 + fr) * 4 + fq) * 4) = v1 + v2;
        const f32x4 g4 = *(LAS f32x4*)(ldl + L_GS + (c.wave * 16 + fr) * 16);
        int bg = 0; float bv = g4[0];
#pragma unroll
        for (int g = 1; g < 4; ++g) if (g4[g] > bv) { bv = g4[g]; bg = g; }
        if (valid && fq == bg) {
            const int be1 = 4 * fq + i1, be2 = 4 * fq + i2; const float inv = 1.0f / (c1 + c2v);
            const unsigned p1 = atomicAdd(lcnt + be1, 1u), p2 = atomicAdd(lcnt + be2, 1u);
            const int li = (gi * 16 + fr) * 2;
            *(LAS int*)(ldl + L_REC + li * 4) = be1; *(LAS int*)(ldl + L_REC + li * 4 + 4) = be2; *(LAS int*)(ldl + L_REC + 2048 + li * 4) = (int)p1; *(LAS int*)(ldl + L_REC + 2048 + li * 4 + 4) = (int)p2;
            *(LAS float*)(ldl + L_REC + 4096 + li * 4) = c1 * inv; *(LAS float*)(ldl + L_REC + 4096 + li * 4 + 4) = c2v * inv;
        }
        if (gi + NW < ng) M1_LOADX(gi + NW)
    }
#undef M1_LOADX
    __syncthreads();
    if (c.tid < 16) *(LAS int*)(ldl + L_BLK + c.tid * 4) = (int)atomicAdd(cnt + c.tid, lcnt[c.tid]);
    __syncthreads();
    for (int i = c.tid; i < 2 * (r1 - r0); i += NTHR) {
        const int e = *(LAS int*)(ldl + L_REC + i * 4), pe = e * ECAP + *(LAS int*)(ldl + L_BLK + e * 4) + *(LAS int*)(ldl + L_REC + 2048 + i * 4);
        P2TE[pe] = r0 + (i >> 1); ROWGE[pe] = *(LAS float*)(ldl + L_REC + 4096 + i * 4); TOKQ[(r0 + (i >> 1)) * 2 + (i & 1)] = pe; }
}
__device__ __forceinline__ void moe_expert_tiles(const unsigned* cnt, int e, int& f, int& F, int& P, int& rem, int& nt) {
    const int ne = (int)__hip_atomic_load(cnt + e, __ATOMIC_RELAXED, __HIP_MEMORY_SCOPE_AGENT); f = ne >> 8; rem = ne & 255;
    int Ft = 0, Fe = 0, rank = 0, np = 0;
#pragma unroll
    for (int q = 0; q < 16; ++q) { const int nq = (int)__hip_atomic_load(cnt + q, __ATOMIC_RELAXED, __HIP_MEMORY_SCOPE_AGENT), fq = nq >> 8, rq = nq & 255;
        Ft += fq; Fe += q < e ? fq : 0; np += rq > 0 ? 1 : 0; rank += (rq > rem || (rq == rem && q < e)) ? 1 : 0; }
    F = Fe; P = Ft + rank; nt = Ft + np;
}
__device__ __forceinline__ void moe_tiles(const Ctx& c, const Params& p, int l) {
    const unsigned* cnt = (const unsigned*)(p.ws + WS_CTL) + CW_CNT + l * 64;
    LAS int* tab = (LAS int*)((LAS unsigned char*)c.lds + pg8::MOE_TAB);
    LAS int* et = tab + 772;
    if (c.tid < 16) { int f, F, P, rem, nt; moe_expert_tiles(cnt, c.tid, f, F, P, rem, nt); et[c.tid] = f; et[16 + c.tid] = F; et[32 + c.tid] = P; et[48 + c.tid] = rem; if (c.tid == 0) tab[768] = nt; }
    __syncthreads();
    if (c.tid < 256) { const int mt = c.tid; int e_ = 0, j_ = 0, nv_ = 0;
#pragma unroll
        for (int e = 0; e < 16; ++e) { const int f = et[e], F = et[16 + e], P = et[32 + e], rem = et[48 + e];
            if (mt >= F && mt < F + f) { e_ = e; j_ = mt - F; nv_ = 256; }
            if (rem > 0 && mt == P) { e_ = e; j_ = f; nv_ = rem; } }
        tab[mt] = e_; tab[256 + mt] = j_; tab[512 + mt] = nv_; }
    __syncthreads();
}
__device__ __forceinline__ void moe_combine(const Ctx& c, const Params& p, int l, float* outp, bool dry = false) {
    const bf16* Hbr = (const bf16*)(p.ws + WS_HB); bf16* Hb = (bf16*)(p.ws + (dry ? WS_ACT + 264 * MiB : WS_HB)); const bf16* Yd = (const bf16*)(p.ws + WS_YD); const int* TOKP = (const int*)(p.ws + WS_TOKQ);
    if (dry) outp = nullptr;
    LAS int* et = (LAS int*)(LAS unsigned char*)c.lds;
    if (c.tid < 16) { const unsigned* cnt = (const unsigned*)(p.ws + WS_CTL) + CW_CNT + l * 64; int f, F, P, rem, nt; moe_expert_tiles(cnt, c.tid, f, F, P, rem, nt); et[c.tid] = f; et[16 + c.tid] = F; et[32 + c.tid] = P; }
    __syncthreads();
#define M5_POS(q_) ({ const int e_ = (q_) >> 14, j_ = ((q_) & (ECAP - 1)) >> 8; ((j_ < et[e_] ? et[16 + e_] + j_ : et[32 + e_]) << 8) + ((q_) & 255); })
    for (int m0 = c.gw; m0 < T; m0 += 2 * c.ngw) {
        const int m1 = (m0 + c.ngw < T) ? m0 + c.ngw : m0;
        const int qa0 = TOKP[m0 * 2], qa1 = TOKP[m0 * 2 + 1], qb0 = TOKP[m1 * 2], qb1 = TOKP[m1 * 2 + 1];
        const int pa0 = M5_POS(qa0), pa1 = M5_POS(qa1), pb0 = M5_POS(qb0), pb1 = M5_POS(qb1);
        Row xa = row_load_bf(Hbr + (size_t)m0 * D, c.lane), xb = row_load_bf(Hbr + (size_t)m1 * D, c.lane);
        unsigned long long ya0[4], ya1[4], yb0[4], yb1[4];
#pragma unroll
        for (int j = 0; j < 4; ++j) { ya0[j] = ((const unsigned long long*)(Yd + (size_t)pa0 * D) + c.lane)[64 * j]; ya1[j] = ((const unsigned long long*)(Yd + (size_t)pa1 * D) + c.lane)[64 * j];
                                      yb0[j] = ((const unsigned long long*)(Yd + (size_t)pb0 * D) + c.lane)[64 * j]; yb1[j] = ((const unsigned long long*)(Yd + (size_t)pb1 * D) + c.lane)[64 * j]; }
#define M5_ADD(RW, YA, YB) _Pragma("unroll") for (int j = 0; j < 4; ++j) { const unsigned long long a = YA[j], b = YB[j]; \
            RW.v[j][0] = ALPHA * RW.v[j][0] + bf2f((unsigned)a & 0xffffu) + bf2f((unsigned)b & 0xffffu); RW.v[j][1] = ALPHA * RW.v[j][1] + bf2f(((unsigned)a >> 16)) + bf2f(((unsigned)b >> 16)); \
            RW.v[j][2] = ALPHA * RW.v[j][2] + bf2f((unsigned)(a >> 32) & 0xffffu) + bf2f((unsigned)(b >> 32) & 0xffffu); RW.v[j][3] = ALPHA * RW.v[j][3] + bf2f((unsigned)(a >> 48)) + bf2f((unsigned)(b >> 48)); }
        M5_ADD(xa, ya0, ya1) M5_ADD(xb, yb0, yb1)
#undef M5_ADD
#undef M5_POS
        const Row oa = row_ln(xa, p.in[I_LN2G] + l * D, p.in[I_LN2B] + l * D, c.lane), ob = row_ln(xb, p.in[I_LN2G] + l * D, p.in[I_LN2B] + l * D, c.lane);
        if (outp) { row_store(outp + (size_t)m0 * D, c.lane, oa); if (m1 != m0) row_store(outp + (size_t)m1 * D, c.lane, ob); }
        else { row_store_bf(Hb + (size_t)m0 * D, c.lane, oa); if (m1 != m0) row_store_bf(Hb + (size_t)m1 * D, c.lane, ob); }
    }
}

enum { PH_P0 = 0,
       PH_F1, PH_F3, PH_F4, PH_M1_0, PH_M3_0, PH_M4_0, PH_M5_0,
       PH_G1, PH_G2, PH_G3, PH_M1_1, PH_M3_1, PH_M4_1, PH_M5_1,
       PH_S1, PH_S2, PH_S3, PH_M1_2, PH_M3_2, PH_M4_2, PH_M5_2,
       PH_R0, PH_R1, PH_R2, PH_RC0, PH_RC1, PH_RC2, PH_RC3, PH_RC4, PH_RC5, PH_R4B, PH_R5, PH_M1_3, PH_M3_3, PH_M4_3, PH_M5_3, NPHASE };

#define RP_P0 RP1
#define RP_F1 RP1
#define RP_F3 RP1
#define RP_M34 RP1
#define RP_G2 RP1
#define RP_S2 RP1
#define RP_R4 RP1
#define RP0(...) {}
#define RP4B(...) { __VA_ARGS__; xcd_barrier(bar); __VA_ARGS__; xcd_barrier(bar); __VA_ARGS__; xcd_barrier(bar); __VA_ARGS__; xcd_barrier(bar); }
#define RP_M1D RP0
#define RP_M2 RP1
#define RP_M5D RP0
__global__ void __launch_bounds__(NTHR, 2) fwd_kernel(Params p) {
    extern __shared__ __attribute__((aligned(16))) unsigned char lds[];
    Ctx c; c.tid = threadIdx.x; c.lane = c.tid & 63; c.wave = __builtin_amdgcn_readfirstlane(c.tid >> 6); c.gw = blockIdx.x * NW + c.wave; c.ngw = gridDim.x * NW; c.lds = lds;
    volatile LAS unsigned* MISC = (volatile LAS unsigned*)((LAS unsigned char*)lds + MISC_OFF);
    if (c.tid < 32) MISC[c.tid] = 0u;
    __syncthreads();
    unsigned* ctl = (unsigned*)(p.ws + WS_CTL);
    XcdBarrier bar = xcd_barrier_post(ctl + CW_BAR + p.li * XCD_BAR_WORDS, MISC + 8);
    const int lo = p.ph_lo, hi = p.ph_hi;
    unsigned char* ws = p.ws;
#define PHASE(k, ...) if (lo <= (k) && (k) < hi) { Ctx c; { int t_ = threadIdx.x; asm volatile("" : "+v"(t_)); c.tid = t_; c.lane = t_ & 63; c.wave = __builtin_amdgcn_readfirstlane(t_ >> 6); c.gw = blockIdx.x * NW + c.wave; c.ngw = gridDim.x * NW; c.lds = lds; } \
        __VA_ARGS__; if ((k) + 1 < hi) xcd_barrier(bar); }
#define RP1(...) { __VA_ARGS__; }
#define RP5(...) { __VA_ARGS__; xcd_barrier(bar); __VA_ARGS__; xcd_barrier(bar); __VA_ARGS__; xcd_barrier(bar); __VA_ARGS__; xcd_barrier(bar); __VA_ARGS__; }

    PHASE(PH_P0, RP_P0(phase_p0(c, p)));
    LAS unsigned char* ldsr = (LAS unsigned char*)lds;
    const int G = gridDim.x, bid = blockIdx.x;
    const int vbid = (G % 8 == 0) ? (bid % 8) * (G / 8) + bid / 8 : bid;
#define GEMM_DENSE(Aoff, Boff, N, K, EPI_T, ...) { pg8::Gemm g{(const bf16*)(ws + (Aoff)), (const bf16*)(ws + (Boff)), T, (N), (K), nullptr}; pg8::StaticOrder S; S.init(T, (N), G, bid); \
        EPI_T E{__VA_ARGS__}; pg8::gemm_phase<EPI_T, pg8::StaticOrder, true, true>(ldsr, g, S, E); }
    PHASE(PH_F1, { fox_cumsum(c, p); __syncthreads();
        RP_F1(GEMM_DENSE(WS_HB, WS_FOX_IN, 4096, 1024, pg8::EpiBf16X<0>, (bf16*)(ws + WS_Q), 1024, nullptr, 1024, (size_t)T * 1024, C2)) });
    PHASE(PH_F3, RP_F3({ const attn_body::AttnTensors AT{(const attn_body::bf16*)(ws + WS_Q), (const attn_body::bf16*)(ws + WS_K), (const attn_body::bf16*)(ws + WS_V), (attn_body::bf16*)(ws + WS_O),
                                                  (const float*)(ws + WS_CB), (const attn_body::bf16*)(ws + WS_OG)};
        const attn_body::StaticOrder S(G, bid); attn_body::attn_phase<attn_body::StaticOrder>((char*)lds, AT, S); }));
    PHASE(PH_F4, GEMM_DENSE(WS_O, WS_FOX_OUT, 1024, 1024, pg8::EpiResid, (bf16*)(ws + WS_HB), ALPHA));
#define MOE_BLOCK(L, K1, K3, K4, K5, OUTP, NEXTCONV) \
    PHASE(K1, { RP_M1D(moe_ln_route(c, p, L, true)); moe_ln_route(c, p, L); }); \
    PHASE(K3, RP_M34({ moe_tiles(c, p, L); pg8::Gemm g{(const bf16*)(ws + WS_HB), (const bf16*)(ws + WS_GU + (size_t)((L) & 1) * WS_MOE_ALT), MPAD_MAX, 16 * 1024, 1024, (const int*)(ws + WS_P2TE)}; pg8::MoeOrder S{(const LAS int*)(ldsr + pg8::MOE_TAB), G, vbid}; \
        pg8::EpiSwiglu E{(bf16*)(ws + WS_H1)}; pg8::gemm_phase<pg8::EpiSwiglu, pg8::MoeOrder, true, true, true>(ldsr, g, S, E); \
        if (NEXTCONV) { int w_, nw_; if (tail_slot(c, 4 * __builtin_amdgcn_readfirstlane(*(const LAS int*)(ldsr + pg8::MOE_TAB + 768 * 4)), w_, nw_, vbid)) conv_moe_items(c, p, (L) + 1, 0, 32 * 256, w_, nw_); } })); \
    PHASE(K4, RP_M34({ moe_tiles(c, p, L); pg8::Gemm g{(const bf16*)(ws + WS_H1), (const bf16*)(ws + WS_DOWN + (size_t)((L) & 1) * WS_MOE_ALT), MPAD_MAX, 16 * 1024, 512, nullptr}; pg8::MoeOrder S{(const LAS int*)(ldsr + pg8::MOE_TAB), G, vbid}; \
        pg8::EpiDown E{(bf16*)(ws + WS_YD), (const float*)(ws + WS_ROWGE)}; pg8::gemm_phase<pg8::EpiDown, pg8::MoeOrder, true, true>(ldsr, g, S, E); \
        if (NEXTCONV) { int w_, nw_; if (tail_slot(c, 4 * __builtin_amdgcn_readfirstlane(*(const LAS int*)(ldsr + pg8::MOE_TAB + 768 * 4)), w_, nw_, vbid)) { conv_moe_items(c, p, (L) + 1, 32 * 256, 48 * 256, w_, nw_); \
             } } })); \
    PHASE(K5, { RP_M5D(moe_combine(c, p, L, OUTP, true)); moe_combine(c, p, L, OUTP); });
    MOE_BLOCK(0, PH_M1_0, PH_M3_0, PH_M4_0, PH_M5_0, nullptr, true)
    PHASE(PH_G1, GEMM_DENSE(WS_HB, WS_GM_IN, 2048, 1024, pg8::EpiBf16X<2>, (bf16*)(ws + WS_Z), 2048, p.in[I_GM_BIN], 0, 0, 1.f));
    PHASE(PH_G2, RP_G2(gmlp_spatial(c, p)));
    PHASE(PH_G3, GEMM_DENSE(WS_YG, WS_GM_OUT, 1024, 1024, pg8::EpiResid, (bf16*)(ws + WS_HB), ALPHA));
    MOE_BLOCK(1, PH_M1_1, PH_M3_1, PH_M4_1, PH_M5_1, nullptr, true)
    PHASE(PH_S1, GEMM_DENSE(WS_HB, WS_SB_IN, 3072, 1024, pg8::EpiBf16X<0>, (bf16*)(ws + WS_Q), 1024, nullptr, 1024, (size_t)T * 1024, C2));
    PHASE(PH_S2, RP_S2({ const attn_body::AttnTensors AT{(const attn_body::bf16*)(ws + WS_Q), (const attn_body::bf16*)(ws + WS_K), (const attn_body::bf16*)(ws + WS_V), (attn_body::bf16*)(ws + WS_O), nullptr, nullptr};
        const attn_body::SbOrder S(G, bid); attn_body::sb_phase<attn_body::SbOrder>((char*)lds, AT, S); }));
    PHASE(PH_S3, GEMM_DENSE(WS_O, WS_SB_OUT, 1024, 1024, pg8::EpiResid, (bf16*)(ws + WS_HB), ALPHA));
    MOE_BLOCK(2, PH_M1_2, PH_M3_2, PH_M4_2, PH_M5_2, nullptr, true)
    PHASE(PH_R0, rwkv_mix(c, p));
    PHASE(PH_R1, { pg8::Gemm g{(const bf16*)(ws + WS_HM), (const bf16*)(ws + WS_RKV), 6 * T, 15 * 256, 1024, nullptr}; pg8::Rw1Order S{G, vbid};
        pg8::EpiRw1 E{(bf16*)(ws + WS_RR), (bf16*)(ws + WS_L1), T}; pg8::gemm_phase<pg8::EpiRw1, pg8::Rw1Order, true, true>(ldsr, g, S, E); });
    PHASE(PH_R2, { pg8::Gemm g{(const bf16*)(ws + WS_L1), (const bf16*)(ws + WS_LORA2), 3 * T, 3 * 1024, 128, nullptr}; pg8::Rw2Order S{G, vbid};
        pg8::EpiRw2 E{(float*)(ws + WS_WDEC), (bf16*)(ws + WS_RA), (bf16*)(ws + WS_RG), p.in[I_RW_W0], p.in[I_RW_A0]}; pg8::gemm_phase<pg8::EpiRw2, pg8::Rw2Order, true, true>(ldsr, g, S, E); });
    const bool split_ok = G >= 128;
#define RW_STAGE(K, ST, C0, NCH, NC0, NNCH) PHASE(K, { if (split_ok) { if (bid < 64) rwc::rwc_scan(c, p, ST, C0, NCH); else rwc::rwc_prep(c, p, (ST) + 1, NC0, NNCH, 64, G - 64); } \
        else { rwc::rwc_scan(c, p, ST, C0, NCH); __syncthreads(); rwc::rwc_prep(c, p, (ST) + 1, NC0, NNCH, 0, G); } });
    PHASE(PH_RC0, rwc::rwc_prep(c, p, 0, 0, 32, 0, G));
    RW_STAGE(PH_RC1, 0, 0, 32, 32, 24)
    RW_STAGE(PH_RC2, 1, 32, 24, 56, 24)
    RW_STAGE(PH_RC3, 2, 56, 24, 80, 24)
    RW_STAGE(PH_RC4, 3, 80, 24, 104, 24)
#undef RW_STAGE
    PHASE(PH_RC5, { if (split_ok) { if (bid < 64) rwc::rwc_scan(c, p, 4, 104, 24); else rwkv_post(c, p, 0, 64, G - 64); } else { rwc::rwc_scan(c, p, 4, 104, 24); __syncthreads(); rwkv_post(c, p, 0, 0, G); } });
    PHASE(PH_R4B, rwkv_post(c, p, 1, 0, G));
    PHASE(PH_R5, GEMM_DENSE(WS_RYG, WS_RW_OUT, 1024, 1024, pg8::EpiResid, (bf16*)(ws + WS_HB), ALPHA));
    MOE_BLOCK(3, PH_M1_3, PH_M3_3, PH_M4_3, PH_M5_3, p.out, false)
#undef PHASE
}

#ifndef N_LAUNCH_MODE
#define N_LAUNCH_MODE 1
#endif
extern "C" void kernel_launch(void* const* d_in, const int* in_sizes, int n_in, void* d_out, int out_size, void* d_ws, size_t ws_size, hipStream_t stream) {
    static int grid = 0;
    if (grid == 0) {
        if (n_in != 38 || in_sizes[0] != T * D || out_size != T * D || ws_size < WS_END) { fprintf(stderr, "kernel_launch: unexpected shapes (n_in %d, ws %zu)\n", n_in, ws_size); grid = -1; return; }
        int dev = 0, cus = 0;
        if (hipGetDevice(&dev) != hipSuccess || hipDeviceGetAttribute(&cus, hipDeviceAttributeMultiprocessorCount, dev) != hipSuccess) { grid = -1; return; }
        if (hipFuncSetAttribute((const void*)fwd_kernel, hipFuncAttributeMaxDynamicSharedMemorySize, LDS_BYTES) != hipSuccess) { fprintf(stderr, "kernel_launch: hipFuncSetAttribute failed\n"); grid = -1; return; }
        int per_cu = 0; (void)hipOccupancyMaxActiveBlocksPerMultiprocessor(&per_cu, (const void*)fwd_kernel, NTHR, LDS_BYTES); (void)hipGetLastError();
        grid = cus > 0 ? cus : 256;
    }
    if (grid < 0) return;
    (void)hipMemsetAsync((char*)d_ws + WS_CTL, 0, CTL_BYTES, stream);
    Params a{};
    for (int i = 0; i < 38; ++i) a.in[i] = (const float*)d_in[i];
    a.out = (float*)d_out; a.ws = (unsigned char*)d_ws; a.pad = 0;
    if (N_LAUNCH_MODE == 1) { a.ph_lo = 0; a.ph_hi = NPHASE; a.li = 0; hipLaunchKernelGGL(fwd_kernel, dim3(grid), dim3(NTHR), LDS_BYTES, stream, a); }
    else for (int k = 0; k < NPHASE; ++k) { a.ph_lo = k; a.ph_hi = k + 1; a.li = k; hipLaunchKernelGGL(fwd_kernel, dim3(grid), dim3(NTHR), LDS_BYTES, stream, a); }
}
```

```cpp
#include <hip/hip_runtime.h>
#include <cstdio>
#include <cstdint>
#include <hip/hip_bf16.h>
#include <cmath>

#define LAS __attribute__((address_space(3)))
typedef unsigned short bf16;
typedef unsigned u32x4 __attribute__((ext_vector_type(4)));
typedef float f32x4 __attribute__((ext_vector_type(4)));

constexpr int D = 1024, BATCH = 4, SEQ = 4096, T = BATCH * SEQ, NH = 16, HD = 64;
constexpr int NEXP = 16, DEXP = 512;
constexpr float ALPHA = 1.6817928305074290f;
constexpr float LN_EPS = 1e-5f, GN_EPS = 64e-5f;
constexpr float LOG2E = 1.4426950408889634f;
constexpr float C2 = 0.125f * LOG2E;
constexpr int NW = 8, NTHR = 512;
constexpr int MPAD_MAX = 36864;

constexpr size_t MiB = 1u << 20;
constexpr size_t WS_CTL = 0, CTL_BYTES = 1 * MiB;
constexpr size_t WS_FOX_IN = 2 * MiB, WS_FOX_OUT = 10 * MiB, WS_GM_IN = 12 * MiB, WS_GM_OUT = 16 * MiB, WS_GM_WS = 18 * MiB;
constexpr size_t WS_SB_IN = 19 * MiB, WS_SB_OUT = 25 * MiB, WS_RKV = 27 * MiB, WS_LORA1 = 33 * MiB, WS_LORA2 = 35 * MiB, WS_RW_OUT = 134 * MiB;
constexpr size_t WS_GU = 38 * MiB, WS_DOWN = 70 * MiB, WS_MOE_ALT = 48 * MiB;
constexpr size_t WS_HF = 86 * MiB, WS_HB = 150 * MiB;
constexpr size_t WS_TOKE = 182 * MiB, WS_TOKG = WS_TOKE + 128 * 1024, WS_TOKP = WS_TOKG + 128 * 1024, WS_ROWG = WS_TOKP + 128 * 1024, WS_TILEE = WS_ROWG + 256 * 1024, WS_BLKB = WS_TILEE + 4096, WS_TOKQ = WS_BLKB + 32768, WS_P2T = WS_TOKQ + 128 * 1024;
constexpr size_t WS_FL = 184 * MiB, WS_CB = 185 * MiB;
constexpr int ECAP = 16384;
constexpr size_t WS_P2TE = 140 * MiB, WS_ROWGE = 141 * MiB;
constexpr size_t WS_ACT = 186 * MiB;
constexpr size_t WS_Q = WS_ACT, WS_K = WS_ACT + 32 * MiB, WS_V = WS_ACT + 64 * MiB, WS_OG = WS_ACT + 96 * MiB, WS_O = WS_ACT + 128 * MiB;
constexpr size_t WS_Z = WS_ACT, WS_YG = WS_ACT + 64 * MiB;
constexpr size_t WS_HM = WS_ACT, WS_RR = WS_ACT + 192 * MiB, WS_RK = WS_RR + 32 * MiB, WS_RV = WS_RK + 32 * MiB, WS_L1 = WS_RV + 32 * MiB;
constexpr size_t WS_WDEC = WS_ACT, WS_RA = WS_ACT + 64 * MiB, WS_RG = WS_ACT + 96 * MiB, WS_YSC = WS_ACT + 128 * MiB  , WS_RYG = WS_ACT  ;
constexpr size_t WS_XS = WS_ACT, WS_H1 = WS_ACT + 72 * MiB, WS_YD = WS_ACT + 108 * MiB;
constexpr size_t WS_CD0 = 2 * MiB, WS_CD1 = WS_ACT + 128 * MiB;
constexpr size_t WS_WLG = 136 * MiB;
constexpr size_t WS_SIG = 138 * MiB;
constexpr size_t WS_Y2 = WS_L1;
constexpr size_t WS_END = WS_Y2 + 32 * MiB;
constexpr int CW_BAR = 4096;
constexpr int CW_CNT = 200000;

constexpr int LDS_BYTES = 147456;
constexpr int MISC_OFF = LDS_BYTES - 256;

__device__ __forceinline__ float bf2f(unsigned b) { return __uint_as_float(b << 16); }
__device__ __forceinline__ unsigned f2bf(float f) { unsigned u = __float_as_uint(f); return (u + 0x7fffu + ((u >> 16) & 1u)) >> 16; }
typedef float f32x2_hw __attribute__((ext_vector_type(2))); typedef __bf16 bf16x2_hw __attribute__((ext_vector_type(2)));
__device__ __forceinline__ unsigned pk2(float lo, float hi) { f32x2_hw v = {lo, hi}; bf16x2_hw b = __builtin_convertvector(v, bf16x2_hw); return __builtin_bit_cast(unsigned, b); }
template <int CTRL> __device__ __forceinline__ float dppf(float v) { return __int_as_float(__builtin_amdgcn_update_dpp(0, __float_as_int(v), CTRL, 0xf, 0xf, true)); }
__device__ __forceinline__ float red16(float x) { x += dppf<0xB1>(x); x += dppf<0x4E>(x); x += dppf<0x141>(x); x += dppf<0x140>(x); return x; }
__device__ __forceinline__ float wave_sum(float v) {
    v = red16(v);
    return (__uint_as_float(__builtin_amdgcn_readlane(__float_as_uint(v), 0)) + __uint_as_float(__builtin_amdgcn_readlane(__float_as_uint(v), 16)))
         + (__uint_as_float(__builtin_amdgcn_readlane(__float_as_uint(v), 32)) + __uint_as_float(__builtin_amdgcn_readlane(__float_as_uint(v), 48)));
}
__device__ __forceinline__ float wave_max(float v) {
#pragma unroll
    for (int o = 1; o < 64; o <<= 1) v = fmaxf(v, __shfl_xor(v, o));
    return v;
}
__device__ __forceinline__ float wave_incl_scan(float v, int lane) {
#pragma unroll
    for (int o = 1; o < 64; o <<= 1) { float t = __shfl_up(v, o); if (lane >= o) v += t; }
    return v;
}
__device__ __forceinline__ float rdlane(float v, int l) { return __uint_as_float(__builtin_amdgcn_readlane(__float_as_uint(v), l)); }
__device__ __forceinline__ float sigmoidf_(float x) { return 1.0f / (1.0f + expf(-x)); }
__device__ __forceinline__ float softplusf_(float x) { return fmaxf(x, 0.f) + log1pf(expf(-fabsf(x))); }
#define LDS_WAIT() asm volatile("s_waitcnt lgkmcnt(0)" ::: "memory")

#define XB_TMO      128
#define XB_XCNT(j)  (256  + 64 * (j))
#define XB_XSUB(j)  (1280 + 64 * (j))
#define XB_XGEN(j)  (2304 + 64 * (j))
#define XB_TOP      3328
#define XB_TOPGEN   3392
#define XCD_BAR_WORDS 3456
#define XB_SPIN_CAP (1u << 24)
__device__ __forceinline__ unsigned xb_ld(unsigned* p)              { return __hip_atomic_load(p, __ATOMIC_RELAXED, __HIP_MEMORY_SCOPE_AGENT); }
__device__ __forceinline__ unsigned xb_add(unsigned* p, unsigned v) { return __hip_atomic_fetch_add(p, v, __ATOMIC_RELAXED, __HIP_MEMORY_SCOPE_AGENT); }
__device__ __forceinline__ unsigned xb_xcc_id() { return (unsigned)__builtin_amdgcn_s_getreg((3 << 11) | 20) & 0xFu; }
#define XB_SPIN(cond, bar) do { unsigned _sp = 0; while (cond) { __builtin_amdgcn_s_sleep(1); \
    if ((++_sp & 255u) == 0u) { if (xb_ld(&(bar)[XB_TMO])) break; if (_sp > XB_SPIN_CAP) { atomicAdd(&(bar)[XB_TMO], 1u); break; } } } } while (0)
struct XcdBarrier { unsigned* bar; unsigned x; volatile LAS unsigned* st; };
__device__ __forceinline__ XcdBarrier xcd_barrier_post(unsigned* bar, volatile LAS unsigned* st) {
    XcdBarrier b; b.bar = bar; b.x = xb_xcc_id(); b.st = st;
    if (threadIdx.x == 0) (void)xb_add(&bar[XB_XCNT(b.x)], 1u);
    return b;
}
__device__ __forceinline__ void xcd_barrier_complete(unsigned* bar, unsigned x, unsigned& nloc, unsigned& nx) {
    const unsigned G = gridDim.x * gridDim.y * gridDim.z;
    unsigned sum, cnt, mine, sp = 0u;
    for (;;) {
        sum = 0u; cnt = 0u; mine = 0u;
#pragma unroll
        for (unsigned j = 0; j < 16; ++j) { const unsigned c = xb_ld(&bar[XB_XCNT(j)]); sum += c; cnt += (c > 0u) ? 1u : 0u; mine = (j == x) ? c : mine; }
        if (sum == G) break;
        __builtin_amdgcn_s_sleep(1);
        if ((++sp & 255u) == 0u) { if (xb_ld(&bar[XB_TMO])) break; if (sp > XB_SPIN_CAP) { atomicAdd(&bar[XB_TMO], 1u); break; } }
    }
    nloc = mine > 0u ? mine : 1u; nx = cnt > 0u ? cnt : 1u;
}
__device__ __forceinline__ void xcd_barrier(const XcdBarrier& b) {
    asm volatile("s_waitcnt vmcnt(0)" ::: "memory");
    __syncthreads();
    if (threadIdx.x == 0) {
        unsigned* bar = b.bar;
        __builtin_amdgcn_s_waitcnt(0);
        unsigned nloc = b.st[0], nx = b.st[1];
        if (nloc == 0u) { xcd_barrier_complete(bar, b.x, nloc, nx); b.st[0] = nloc; b.st[1] = nx; }
        const unsigned old = xb_add(&bar[XB_XSUB(b.x)], 1u);
        const unsigned gen = old / nloc;
        if (old + 1u == (gen + 1u) * nloc) {
            __builtin_amdgcn_fence(__ATOMIC_RELEASE, "agent");
            asm volatile("s_waitcnt vmcnt(0)" ::: "memory");
            const unsigned og = xb_add(&bar[XB_TOP], 1u);
            const unsigned tg = og / nx;
            if (og + 1u == (tg + 1u) * nx) xb_add(&bar[XB_TOPGEN], 1u);
            else XB_SPIN(xb_ld(&bar[XB_TOPGEN]) == tg, bar);
            __builtin_amdgcn_fence(__ATOMIC_ACQUIRE, "agent");
            xb_add(&bar[XB_XGEN(b.x)], 1u);
            asm volatile("s_waitcnt vmcnt(0)" ::: "memory");
        } else {
            XB_SPIN(xb_ld(&bar[XB_XGEN(b.x)]) == gen, bar);
            __builtin_amdgcn_fence(__ATOMIC_ACQUIRE, "agent");
            asm volatile("s_waitcnt vmcnt(0)" ::: "memory");
        }
    }
    __syncthreads();
}

namespace pg8 {
#define PG8_LAS __attribute__((address_space(3)))
typedef unsigned short bf16_t;
typedef short bf16x8 __attribute__((ext_vector_type(8)));
typedef float f32x4 __attribute__((ext_vector_type(4)));
typedef unsigned u32x4 __attribute__((ext_vector_type(4)));
constexpr int BM = 256, BK = 64, HALF = 128, HTB = HALF * BK * 2  , STAGE_BYTES = 8 * HTB, NXCD = 8, WGM = 8;

__host__ __device__ __forceinline__ int lds_byte(int r, int c) { const int st = (r >> 4) * 2 + (c >> 5), rr = r & 15, cc = c & 31, ob = rr * 64 + cc * 2; return st * 1024 + (ob ^ (((ob >> 9) & 1) << 5)); }
__host__ __device__ __forceinline__ void stage_rc(int b, int& R, int& C) { const int st = b / 1024, sb = b % 1024, swz = sb ^ (((sb >> 9) & 1) << 5); R = (st >> 1) * 16 + swz / 64; C = (st & 1) * 32 + (swz % 64) / 2; }
__host__ __device__ __forceinline__ int perm32(int rho) { const int n = rho >> 4, i = rho & 15; return 8 * (i >> 2) + 4 * n + (i & 3); }

struct Unit { int pm, pn, rt, nv; };
struct Gemm { const bf16_t* A; const bf16_t* Bt; int M, N, K; const int* rowtok; };

struct StaticOrder {
    int nM, nN, nwg, G, c;
    __host__ __device__ void init(int M, int N, int G_, int c_) { nM = M / BM; nN = N / BM; nwg = nM * nN; G = G_; c = c_; }
    __host__ __device__ bool next(int i, Unit& u) const {
        const long L = (long)i * G + c; if (L >= nwg) return false;
        int wgid = (int)L; { const int q = nwg / NXCD, r = nwg % NXCD, xcd = wgid % NXCD, off = wgid / NXCD; wgid = (xcd < r ? xcd * (q + 1) : r * (q + 1) + (xcd - r) * q) + off; }
        const int nig = WGM * nN, gid = wgid / nig, fm = gid * WGM, gsz = (nM - fm) < WGM ? (nM - fm) : WGM;
        u.pm = fm + ((wgid % nig) % gsz); u.pn = (wgid % nig) / gsz; return true;
    }
    __device__ __forceinline__ void a_ready(const Unit&) const {}
    __device__ __forceinline__ void done(const Unit&) const {}
};

__device__ __forceinline__ unsigned cvt_pk_bf16(float lo, float hi) { unsigned r; asm volatile("v_cvt_pk_bf16_f32 %0, %1, %2" : "=v"(r) : "v"(lo), "v"(hi)); return r; }
typedef float f32x2 __attribute__((ext_vector_type(2)));
__device__ __forceinline__ f32x2 gelu_pk(f32x2 v) {
    const f32x2 av = __builtin_elementwise_abs(v), d = av * 0.2316418882f + 1.0f;
    f32x2 t; t.x = __builtin_amdgcn_rcpf(d.x); t.y = __builtin_amdgcn_rcpf(d.y);
    f32x2 q = t * 0.5307027145f + (-0.7265760135f); q = q * t + 0.7107068705f; q = q * t + (-0.142248368f); q = q * t + 0.127414796f; q = q * t;
    const f32x2 s = (v * v) * (-0.72134752044f);
    f32x2 e; e.x = __builtin_amdgcn_exp2f(s.x); e.y = __builtin_amdgcn_exp2f(s.y);
    const f32x2 m = v * (q * e), r = v - m;
    f32x2 o; o.x = v.x < 0.f ? m.x : r.x; o.y = v.y < 0.f ? m.y : r.y; return o;
}

template <int ACT  > struct EpiBf16 {
    static constexpr bool PERM = true, AFTER_DRAIN = false; static_assert(ACT == 0 || ACT == 1, "EpiBf16: ACT is 0 (none) or 1 (gelu_pk)");
    bf16_t* O; int ldc; const float* bias; int split_cols; size_t split_stride; float scale0;
    __device__ __forceinline__ void operator()(const f32x4 (&acc)[2][2][4][2], const Unit& u, int wr, int wc, int fr, int fq) const {
        const int row0 = u.pm * BM + wr * 64 + fr; int colt = u.pn * BM; bf16_t* base = O;
        float sc = 1.f; if (split_cols) { const int t = colt / split_cols; base += (size_t)t * split_stride; colt -= t * split_cols; if (t == 0) sc = scale0; }
        const int col0 = colt + wc * 32 + 8 * fq, bcol0 = u.pn * BM + wc * 32 + 8 * fq;
        f32x4 bv[2][2];
#pragma unroll
        for (int bj = 0; bj < 2; ++bj)
#pragma unroll
            for (int n = 0; n < 2; ++n) bv[bj][n] = bias ? *(const f32x4*)(bias + bcol0 + bj * HALF + 4 * n) : (f32x4){0.f, 0.f, 0.f, 0.f};
#pragma unroll
        for (int ai = 0; ai < 2; ++ai)
#pragma unroll
            for (int m = 0; m < 4; ++m) { bf16_t* rowp = base + (size_t)(row0 + ai * HALF + m * 16) * ldc + col0;
#pragma unroll
                for (int bj = 0; bj < 2; ++bj) { f32x4 v0 = acc[ai][bj][m][0] + bv[bj][0], v1 = acc[ai][bj][m][1] + bv[bj][1];
                    if (ACT == 1) { f32x2 a = gelu_pk((f32x2){v0[0], v0[1]}), b = gelu_pk((f32x2){v0[2], v0[3]}), c = gelu_pk((f32x2){v1[0], v1[1]}), d = gelu_pk((f32x2){v1[2], v1[3]});
                        v0 = (f32x4){a.x, a.y, b.x, b.y}; v1 = (f32x4){c.x, c.y, d.x, d.y}; }
                    v0 = v0 * sc; v1 = v1 * sc; u32x4 w; w.x = cvt_pk_bf16(v0[0], v0[1]); w.y = cvt_pk_bf16(v0[2], v0[3]); w.z = cvt_pk_bf16(v1[0], v1[1]); w.w = cvt_pk_bf16(v1[2], v1[3]);
                    *(u32x4*)(rowp + bj * HALF) = w; } }
    }
};


template <class Epi, class Sched, bool ALIGN_EPI = false, bool SP2 = false, bool GATH = false>
__device__ __forceinline__ void gemm_phase(PG8_LAS unsigned char* lds, const Gemm g, const Sched& S, const Epi& E) {
    const int tid = threadIdx.x, wid = __builtin_amdgcn_readfirstlane(tid >> 6), lane = tid & 63, wr = wid >> 2, wc = wid & 3, fr = lane & 15, fq = lane >> 4;
    const int K = g.K, nt = K / BK;
    unsigned voffA[2], voffB[2];
#pragma unroll
    for (int i = 0; i < 2; ++i) { int R, C; stage_rc(tid * 16 + i * 8192, R, C); const int Rb = Epi::PERM ? ((R & ~31) + perm32(R & 31)) : R;
        voffA[i] = (unsigned)(R * K + C) * 2u; voffB[i] = (unsigned)(Rb * K + C) * 2u; }
    static_assert(!GATH || SP2, "GATH is implemented for the SP2 loop only");
    int gR[2]; unsigned gC[2]; unsigned ogC[2][2], ogN[2][2];
    if constexpr (GATH) {
#pragma unroll
        for (int i = 0; i < 2; ++i) { int R, C; stage_rc(tid * 16 + i * 8192, R, C); gR[i] = R; gC[i] = (unsigned)C * 2u; }
    }
#define PG8_OG(og, U_) do { _Pragma("unroll") for (int h_ = 0; h_ < 2; ++h_) _Pragma("unroll") for (int i_ = 0; i_ < 2; ++i_) { const int rr_ = h_ * HALF + gR[i_]; \
        og[h_][i_] = (unsigned)(rr_ < (U_).nv ? g.rowtok[(U_).rt * BM + rr_] : 0) * (unsigned)(K * 2) + gC[i_]; } } while (0)
    const size_t kstep = (size_t)(BK * 2);
    const size_t hstep = (size_t)HALF * K * 2;
    const size_t tstep = 2 * hstep;
    const unsigned ldsw = (unsigned)wid * 1024u;
    const int aoff = lds_byte(wr * 64 + fr, fq * 8), boff = lds_byte(wc * 32 + fr, fq * 8);
#define PG8_SA(b, h) (((b) * 2 + (h)) * HTB)
#define PG8_SB(b, h) ((4 + (b) * 2 + (h)) * HTB)
#define PG8_STAGE(bufoff, gbase, voff) do { _Pragma("unroll") for (int _i = 0; _i < 2; ++_i) \
        __builtin_amdgcn_global_load_lds((const unsigned*)((const char*)(gbase) + (voff)[_i]), (PG8_LAS unsigned*)(lds + (bufoff) + ldsw + _i * 8192), 16, 0, 0); } while (0)
#define PG8_STAGE_G(bufoff, kptr, og) do { _Pragma("unroll") for (int _i = 0; _i < 2; ++_i) \
        __builtin_amdgcn_global_load_lds((const unsigned*)((const char*)(kptr) + (og)[_i]), (PG8_LAS unsigned*)(lds + (bufoff) + ldsw + _i * 8192), 16, 0, 0); } while (0)
#define PG8_STAGE_A(bufoff, tp, kp, h, sel) do { if constexpr (GATH) { unsigned og_[2] = {(sel) ? ogN[h][0] : ogC[h][0], (sel) ? ogN[h][1] : ogC[h][1]}; PG8_STAGE_G(bufoff, kp, og_); } \
        else { PG8_STAGE(bufoff, (tp) + (h) * hstep, voffA); } } while (0)
#define PG8_LDA(dst, b, h) do { _Pragma("unroll") for (int m = 0; m < 4; ++m) _Pragma("unroll") for (int k = 0; k < 2; ++k) dst[m][k] = *(const PG8_LAS bf16x8*)(lds + PG8_SA(b, h) + aoff + m * 2048 + k * 1024); } while (0)
#define PG8_LDB(dst, b, h) do { _Pragma("unroll") for (int n = 0; n < 2; ++n) _Pragma("unroll") for (int k = 0; k < 2; ++k) dst[n][k] = *(const PG8_LAS bf16x8*)(lds + PG8_SB(b, h) + boff + n * 2048 + k * 1024); } while (0)
#define PG8_MMA(ai, bj, At, Bt) do { __builtin_amdgcn_s_setprio(1); _Pragma("unroll") for (int m = 0; m < 4; ++m) _Pragma("unroll") for (int n = 0; n < 2; ++n) _Pragma("unroll") for (int k = 0; k < 2; ++k) \
        acc[ai][bj][m][n] = __builtin_amdgcn_mfma_f32_16x16x32_bf16(Bt[n][k], At[m][k], acc[ai][bj][m][n], 0, 0, 0); __builtin_amdgcn_s_setprio(0); } while (0)
#define PG8_WAIT_V(n) asm volatile("s_waitcnt vmcnt(" #n ")" ::: "memory")
#define PG8_WAIT_L(n) asm volatile("s_waitcnt lgkmcnt(" #n ")" ::: "memory")
#define PG8_BAR __builtin_amdgcn_s_barrier()
#define PG8_SCHED __builtin_amdgcn_sched_barrier(0)
    Unit cur, nxt; int ui = 0;
    if (!S.next(0, cur)) return;
    f32x4 acc[2][2][4][2];
#pragma unroll
    for (int a = 0; a < 2; ++a)
#pragma unroll
        for (int b = 0; b < 2; ++b)
#pragma unroll
            for (int m = 0; m < 4; ++m)
#pragma unroll
                for (int n = 0; n < 2; ++n) acc[a][b][m][n] = (f32x4){0.f, 0.f, 0.f, 0.f};
    bf16x8 At[4][2], B0[2][2], B1[2][2];
    const char* cA = (const char*)g.A + (size_t)cur.pm * tstep; const char* cB = (const char*)g.Bt + (size_t)cur.pn * tstep;
    const char* const gA = (const char*)g.A;
    if constexpr (GATH) { PG8_OG(ogC, cur); }
    S.a_ready(cur);
    if constexpr (SP2) {
        PG8_STAGE(PG8_SB(0, 0), cB, voffB); PG8_STAGE(PG8_SB(0, 1), cB + hstep, voffB); PG8_STAGE_A(PG8_SA(0, 0), cA, gA, 0, false); PG8_STAGE_A(PG8_SA(0, 1), cA, gA, 1, false);
        if (wr == 1) PG8_BAR;
        PG8_WAIT_V(2); PG8_BAR;
        PG8_STAGE(PG8_SB(1, 0), cB + kstep, voffB); PG8_STAGE_A(PG8_SA(1, 0), cA + kstep, gA + kstep, 0, false); PG8_STAGE(PG8_SB(1, 1), cB + hstep + kstep, voffB);
        PG8_WAIT_V(6); PG8_BAR;
    } else {
        PG8_STAGE(PG8_SB(0, 0), cB, voffB); PG8_STAGE(PG8_SA(0, 0), cA, voffA); PG8_STAGE(PG8_SB(0, 1), cB + hstep, voffB); PG8_STAGE(PG8_SA(0, 1), cA + hstep, voffA);
        if (wr == 1) PG8_BAR;
        PG8_WAIT_V(4); PG8_BAR;
        PG8_STAGE(PG8_SB(1, 0), cB + kstep, voffB); PG8_STAGE(PG8_SA(1, 0), cA + kstep, voffA); PG8_STAGE(PG8_SB(1, 1), cB + hstep + kstep, voffB);
        PG8_WAIT_V(6); PG8_BAR;
    }
    for (;;) {
        const bool has_next = S.next(ui + 1, nxt);
        if constexpr (GATH) { if (has_next) { PG8_OG(ogN, nxt); } }
        const char* nA = has_next ? (const char*)g.A + (size_t)nxt.pm * tstep : cA; const char* nB = has_next ? (const char*)g.Bt + (size_t)nxt.pn * tstep : cB;
        for (int t = 0; t < nt; t += 2) {
            const bool last = (t == nt - 2);
            const char* a1 = cA + (size_t)(t + 1) * kstep;
            const char* a2 = last ? nA : cA + (size_t)(t + 2) * kstep; const char* b2 = last ? nB : cB + (size_t)(t + 2) * kstep;
            const char* a3 = a2 + kstep; const char* b3 = b2 + kstep;
            const bool gsel = last && has_next; const char* ga1 = gA + (size_t)(t + 1) * kstep; const char* ga2 = last ? gA : gA + (size_t)(t + 2) * kstep; const char* ga3 = ga2 + kstep;
            if (last && has_next) S.a_ready(nxt);
            if constexpr (SP2) {
            PG8_LDB(B0, 0, 0); PG8_LDB(B1, 0, 1); PG8_SCHED; PG8_LDA(At, 0, 0); PG8_STAGE_A(PG8_SA(1, 1), a1, ga1, 1, false);
            PG8_WAIT_V(8); PG8_WAIT_L(0); PG8_BAR; PG8_MMA(0, 0, At, B0); PG8_MMA(0, 1, At, B1); PG8_BAR; PG8_SCHED;
            PG8_LDA(At, 0, 1); PG8_STAGE(PG8_SB(0, 0), b2, voffB); PG8_STAGE(PG8_SB(0, 1), b2 + hstep, voffB); PG8_STAGE_A(PG8_SA(0, 0), a2, ga2, 0, gsel);
            PG8_WAIT_V(8); PG8_WAIT_L(0); PG8_BAR; PG8_MMA(1, 0, At, B0); PG8_MMA(1, 1, At, B1); PG8_BAR; PG8_SCHED;
            PG8_LDB(B0, 1, 0); PG8_LDB(B1, 1, 1); PG8_SCHED; PG8_LDA(At, 1, 0); PG8_STAGE_A(PG8_SA(0, 1), a2, ga2, 1, gsel);
            PG8_WAIT_V(8); PG8_WAIT_L(0); PG8_BAR; PG8_MMA(0, 0, At, B0); PG8_MMA(0, 1, At, B1); PG8_BAR; PG8_SCHED;
            PG8_LDA(At, 1, 1); PG8_STAGE(PG8_SB(1, 0), b3, voffB); PG8_STAGE(PG8_SB(1, 1), b3 + hstep, voffB); PG8_STAGE_A(PG8_SA(1, 0), a3, ga3, 0, gsel);
            PG8_WAIT_V(8); PG8_WAIT_L(0); PG8_BAR; PG8_MMA(1, 0, At, B0); PG8_MMA(1, 1, At, B1); PG8_BAR; PG8_SCHED;
            } else {
            PG8_LDB(B0, 0, 0); PG8_SCHED; PG8_LDA(At, 0, 0); PG8_STAGE(PG8_SA(1, 1), a1 + hstep, voffA);
            PG8_WAIT_L(8); PG8_BAR; PG8_WAIT_L(0); PG8_MMA(0, 0, At, B0); PG8_BAR; PG8_SCHED;
            PG8_LDB(B1, 0, 1); PG8_STAGE(PG8_SB(0, 0), b2, voffB);
            PG8_BAR; PG8_WAIT_L(0); PG8_MMA(0, 1, At, B1); PG8_BAR;
            PG8_LDA(At, 0, 1); PG8_STAGE(PG8_SA(0, 0), a2, voffA);
            PG8_BAR; PG8_WAIT_L(0); PG8_MMA(1, 0, At, B0); PG8_BAR; PG8_SCHED;
            PG8_STAGE(PG8_SB(0, 1), b2 + hstep, voffB);
            PG8_WAIT_V(6); PG8_BAR; PG8_MMA(1, 1, At, B1); PG8_BAR;
            PG8_LDB(B0, 1, 0); PG8_SCHED; PG8_LDA(At, 1, 0); PG8_STAGE(PG8_SA(0, 1), a2 + hstep, voffA);
            PG8_WAIT_L(8); PG8_BAR; PG8_WAIT_L(0); PG8_MMA(0, 0, At, B0); PG8_BAR; PG8_SCHED;
            PG8_LDB(B1, 1, 1); PG8_STAGE(PG8_SB(1, 0), b3, voffB);
            PG8_BAR; PG8_WAIT_L(0); PG8_MMA(0, 1, At, B1); PG8_BAR;
            PG8_LDA(At, 1, 1); PG8_STAGE(PG8_SA(1, 0), a3, voffA);
            PG8_BAR; PG8_WAIT_L(0); PG8_MMA(1, 0, At, B0); PG8_BAR; PG8_SCHED;
            PG8_STAGE(PG8_SB(1, 1), b3 + hstep, voffB);
            PG8_WAIT_V(6); PG8_BAR; PG8_MMA(1, 1, At, B1); PG8_BAR;
            }
        }
        if constexpr (ALIGN_EPI) { if (wr == 0) PG8_BAR; }
        if constexpr (!Epi::AFTER_DRAIN) { E(acc, cur, wr, wc, fr, fq); S.done(cur); }
        if (!has_next) break;
#pragma unroll
        for (int a = 0; a < 2; ++a)
#pragma unroll
            for (int b = 0; b < 2; ++b)
#pragma unroll
                for (int m = 0; m < 4; ++m)
#pragma unroll
                    for (int n = 0; n < 2; ++n) acc[a][b][m][n] = (f32x4){0.f, 0.f, 0.f, 0.f};
        cur = nxt; cA = nA; cB = nB; ++ui;
        if constexpr (GATH) { ogC[0][0] = ogN[0][0]; ogC[0][1] = ogN[0][1]; ogC[1][0] = ogN[1][0]; ogC[1][1] = ogN[1][1]; }
        if constexpr (ALIGN_EPI) { if (wr == 1) PG8_BAR; }
    }
    PG8_WAIT_V(0);
    if constexpr (!ALIGN_EPI) { if (wr == 0) PG8_BAR; }
    PG8_BAR;
    if constexpr (Epi::AFTER_DRAIN) { E.fused(acc, cur, wr, wc, fr, fq, lds, wid, lane); S.done(cur); }
#undef PG8_SA
#undef PG8_SB
#undef PG8_STAGE
#undef PG8_LDA
#undef PG8_STAGE_G
#undef PG8_STAGE_A
#undef PG8_OG
#undef PG8_LDB
#undef PG8_MMA
#undef PG8_WAIT_V
#undef PG8_WAIT_L
#undef PG8_BAR
#undef PG8_SCHED
}

__device__ __forceinline__ float gelu_tanh_f(float x) { const float t = x + 0.044715f * x * x * x; return x * __builtin_amdgcn_rcpf(1.0f + __builtin_amdgcn_exp2f(-2.302208198f * t)); }
__device__ __forceinline__ float silu_f(float x) { return x * __builtin_amdgcn_rcpf(1.0f + __builtin_amdgcn_exp2f(-1.4426950408889634f * x)); }
__device__ __forceinline__ float sigm_f(float x) { return __builtin_amdgcn_rcpf(1.0f + __builtin_amdgcn_exp2f(-1.4426950408889634f * x)); }
template <int ACT  > struct EpiBf16X {
    static constexpr bool PERM = true, AFTER_DRAIN = false;
    bf16_t* O; int ldc; const float* bias; int split_cols; size_t split_stride; float scale0;
    __device__ __forceinline__ void operator()(const f32x4 (&acc)[2][2][4][2], const Unit& u, int wr, int wc, int fr, int fq) const {
        const int row0 = u.pm * BM + wr * 64 + fr; int colt = u.pn * BM; bf16_t* base = O;
        float sc = 1.f; if (split_cols) { const int t = colt / split_cols; base += (size_t)t * split_stride; colt -= t * split_cols; if (t == 0) sc = scale0; }
        const int col0 = colt + wc * 32 + 8 * fq, bcol0 = u.pn * BM + wc * 32 + 8 * fq;
        f32x4 bv[2][2];
#pragma unroll
        for (int bj = 0; bj < 2; ++bj)
#pragma unroll
            for (int n = 0; n < 2; ++n) bv[bj][n] = bias ? *(const f32x4*)(bias + bcol0 + bj * HALF + 4 * n) : (f32x4){0.f, 0.f, 0.f, 0.f};
#pragma unroll
        for (int ai = 0; ai < 2; ++ai)
#pragma unroll
            for (int m = 0; m < 4; ++m) { bf16_t* rowp = base + (size_t)(row0 + ai * HALF + m * 16) * ldc + col0;
#pragma unroll
                for (int bj = 0; bj < 2; ++bj) { f32x4 v0 = acc[ai][bj][m][0] + bv[bj][0], v1 = acc[ai][bj][m][1] + bv[bj][1];
                    if (ACT == 2) {
#pragma unroll
                        for (int i = 0; i < 4; ++i) { v0[i] = gelu_tanh_f(v0[i]); v1[i] = gelu_tanh_f(v1[i]); } }
                    v0 = v0 * sc; v1 = v1 * sc; u32x4 w; w.x = cvt_pk_bf16(v0[0], v0[1]); w.y = cvt_pk_bf16(v0[2], v0[3]); w.z = cvt_pk_bf16(v1[0], v1[1]); w.w = cvt_pk_bf16(v1[2], v1[3]);
                    *(u32x4*)(rowp + bj * HALF) = w; } }
    }
};
struct EpiResid {
    static constexpr bool PERM = true, AFTER_DRAIN = false;
    bf16_t* H; float alpha;
    __device__ __forceinline__ void operator()(const f32x4 (&acc)[2][2][4][2], const Unit& u, int wr, int wc, int fr, int fq) const {
        const int row0 = u.pm * BM + wr * 64 + fr, col0 = u.pn * BM + wc * 32 + 8 * fq;
#pragma unroll
        for (int ai = 0; ai < 2; ++ai) {
            u32x4 hres[4][2];
#pragma unroll
            for (int m = 0; m < 4; ++m)
#pragma unroll
                for (int bj = 0; bj < 2; ++bj) hres[m][bj] = *(const u32x4*)(H + (size_t)(row0 + ai * HALF + m * 16) * 1024 + col0 + bj * HALF);
#pragma unroll
            for (int m = 0; m < 4; ++m) { bf16_t* rowp = H + (size_t)(row0 + ai * HALF + m * 16) * 1024 + col0;
#pragma unroll
                for (int bj = 0; bj < 2; ++bj) { const u32x4 h = hres[m][bj]; const f32x4 a0 = acc[ai][bj][m][0], a1 = acc[ai][bj][m][1]; u32x4 w;
                    w.x = cvt_pk_bf16(alpha * __uint_as_float(h.x << 16) + a0[0], alpha * __uint_as_float(h.x & 0xffff0000u) + a0[1]);
                    w.y = cvt_pk_bf16(alpha * __uint_as_float(h.y << 16) + a0[2], alpha * __uint_as_float(h.y & 0xffff0000u) + a0[3]);
                    w.z = cvt_pk_bf16(alpha * __uint_as_float(h.z << 16) + a1[0], alpha * __uint_as_float(h.z & 0xffff0000u) + a1[1]);
                    w.w = cvt_pk_bf16(alpha * __uint_as_float(h.w << 16) + a1[2], alpha * __uint_as_float(h.w & 0xffff0000u) + a1[3]);
                    *(u32x4*)(rowp + bj * HALF) = w; } }
        }
    }
};
struct EpiSwiglu {
    static constexpr bool PERM = true, AFTER_DRAIN = false;
    bf16_t* H1;
    __device__ __forceinline__ void operator()(const f32x4 (&acc)[2][2][4][2], const Unit& u, int wr, int wc, int fr, int fq) const {
        const int row0 = u.pm * BM + wr * 64 + fr, col0 = (u.pn & 3) * 128 + wc * 32 + 8 * fq;
#pragma unroll
        for (int ai = 0; ai < 2; ++ai)
#pragma unroll
            for (int m = 0; m < 4; ++m) { bf16_t* rowp = H1 + (size_t)(row0 + ai * HALF + m * 16) * 512 + col0;
                f32x4 h0, h1;
#pragma unroll
                for (int i = 0; i < 4; ++i) { h0[i] = silu_f(acc[ai][0][m][0][i]) * acc[ai][1][m][0][i]; h1[i] = silu_f(acc[ai][0][m][1][i]) * acc[ai][1][m][1][i]; }
                u32x4 w; w.x = cvt_pk_bf16(h0[0], h0[1]); w.y = cvt_pk_bf16(h0[2], h0[3]); w.z = cvt_pk_bf16(h1[0], h1[1]); w.w = cvt_pk_bf16(h1[2], h1[3]);
                *(u32x4*)rowp = w; }
    }
};
struct EpiDown {
    static constexpr bool PERM = true, AFTER_DRAIN = false;
    bf16_t* Yd; const float* rowg;
    __device__ __forceinline__ void operator()(const f32x4 (&acc)[2][2][4][2], const Unit& u, int wr, int wc, int fr, int fq) const {
        const int row0 = u.pm * BM + wr * 64 + fr, col0 = (u.pn & 3) * BM + wc * 32 + 8 * fq;
        float scv[2][4];
#pragma unroll
        for (int ai = 0; ai < 2; ++ai)
#pragma unroll
            for (int m = 0; m < 4; ++m) scv[ai][m] = rowg[u.rt * BM + wr * 64 + fr + ai * HALF + m * 16];
#pragma unroll
        for (int ai = 0; ai < 2; ++ai)
#pragma unroll
            for (int m = 0; m < 4; ++m) { const int row = row0 + ai * HALF + m * 16; const float sc = scv[ai][m]; bf16_t* rowp = Yd + (size_t)row * 1024 + col0;
#pragma unroll
                for (int bj = 0; bj < 2; ++bj) { const f32x4 v0 = acc[ai][bj][m][0] * sc, v1 = acc[ai][bj][m][1] * sc;
                    u32x4 w; w.x = cvt_pk_bf16(v0[0], v0[1]); w.y = cvt_pk_bf16(v0[2], v0[3]); w.z = cvt_pk_bf16(v1[0], v1[1]); w.w = cvt_pk_bf16(v1[2], v1[3]);
                    *(u32x4*)(rowp + bj * HALF) = w; } }
    }
};
struct EpiRw1 {
    static constexpr bool PERM = true, AFTER_DRAIN = false;
    bf16_t* RKV; bf16_t* L1; int Trows;
    __device__ __forceinline__ void operator()(const f32x4 (&acc)[2][2][4][2], const Unit& u, int wr, int wc, int fr, int fq) const {
        const int t0 = (u.pm & 63) * BM + wr * 64 + fr;
        if (u.pn < 12) { const int cc = u.pn >> 2, col0 = (u.pn & 3) * BM + wc * 32 + 8 * fq;
#pragma unroll
            for (int ai = 0; ai < 2; ++ai)
#pragma unroll
                for (int m = 0; m < 4; ++m) { bf16_t* rowp = RKV + (size_t)cc * Trows * 1024 + (size_t)(t0 + ai * HALF + m * 16) * 1024 + col0;
#pragma unroll
                    for (int bj = 0; bj < 2; ++bj) { const f32x4 v0 = acc[ai][bj][m][0], v1 = acc[ai][bj][m][1];
                        u32x4 w; w.x = cvt_pk_bf16(v0[0], v0[1]); w.y = cvt_pk_bf16(v0[2], v0[3]); w.z = cvt_pk_bf16(v1[0], v1[1]); w.w = cvt_pk_bf16(v1[2], v1[3]);
                        *(u32x4*)(rowp + bj * HALF) = w; } }
        } else { const int j = u.pn - 12, col0 = wc * 32 + 8 * fq;
#pragma unroll
            for (int ai = 0; ai < 2; ++ai)
#pragma unroll
                for (int m = 0; m < 4; ++m) { bf16_t* rowp = L1 + (size_t)j * Trows * 128 + (size_t)(t0 + ai * HALF + m * 16) * 128 + col0;
                    f32x4 v0 = acc[ai][0][m][0], v1 = acc[ai][0][m][1];
#pragma unroll
                    for (int i = 0; i < 4; ++i) { if (j == 0) { v0[i] = 2.f * sigm_f(2.f * v0[i]) - 1.f; v1[i] = 2.f * sigm_f(2.f * v1[i]) - 1.f; } else if (j == 2) { v0[i] = sigm_f(v0[i]); v1[i] = sigm_f(v1[i]); } }
                    u32x4 w; w.x = cvt_pk_bf16(v0[0], v0[1]); w.y = cvt_pk_bf16(v0[2], v0[3]); w.z = cvt_pk_bf16(v1[0], v1[1]); w.w = cvt_pk_bf16(v1[2], v1[3]);
                    *(u32x4*)rowp = w; }
        }
    }
};
struct EpiRw2 {
    static constexpr bool PERM = true, AFTER_DRAIN = false;
    float* Wdec; bf16_t* A; bf16_t* G; const float* w0; const float* a0;
    __device__ __forceinline__ void operator()(const f32x4 (&acc)[2][2][4][2], const Unit& u, int wr, int wc, int fr, int fq) const {
        const int j = u.pn >> 2, t0 = (u.pm & 63) * BM + wr * 64 + fr, col0 = (u.pn & 3) * BM + wc * 32 + 8 * fq;
#pragma unroll
        for (int ai = 0; ai < 2; ++ai)
#pragma unroll
            for (int m = 0; m < 4; ++m) { const size_t ro = (size_t)(t0 + ai * HALF + m * 16) * 1024 + col0;
#pragma unroll
                for (int bj = 0; bj < 2; ++bj) { f32x4 v0 = acc[ai][bj][m][0], v1 = acc[ai][bj][m][1]; const size_t o = ro + bj * HALF;
                    if (j == 0) { const f32x4 b0 = __builtin_bit_cast(f32x4, *(const u32x4*)(w0 + col0 + bj * HALF)), b1 = __builtin_bit_cast(f32x4, *(const u32x4*)(w0 + col0 + bj * HALF + 4));
#pragma unroll
                        for (int i = 0; i < 4; ++i) { v0[i] = -0.8750387749f * sigm_f(v0[i] + b0[i]); v1[i] = -0.8750387749f * sigm_f(v1[i] + b1[i]); }
                        *(f32x4*)(Wdec + o) = v0; *(f32x4*)(Wdec + o + 4) = v1;
                    } else { if (j == 1) { const f32x4 b0 = __builtin_bit_cast(f32x4, *(const u32x4*)(a0 + col0 + bj * HALF)), b1 = __builtin_bit_cast(f32x4, *(const u32x4*)(a0 + col0 + bj * HALF + 4));
#pragma unroll
                            for (int i = 0; i < 4; ++i) { v0[i] = sigm_f(v0[i] + b0[i]); v1[i] = sigm_f(v1[i] + b1[i]); } }
                        u32x4 w; w.x = cvt_pk_bf16(v0[0], v0[1]); w.y = cvt_pk_bf16(v0[2], v0[3]); w.z = cvt_pk_bf16(v1[0], v1[1]); w.w = cvt_pk_bf16(v1[2], v1[3]);
                        if (j == 1) *(u32x4*)(A + o) = w; else *(u32x4*)(G + o) = w; } } }
    }
};
struct Rw1Order { int G, c;
    __device__ __forceinline__ bool next(int i, Unit& u) const { const int L = i * G + c; if (L >= 960) return false;
        if (L < 768) { const int cc = L >> 8, mt = (L & 255) >> 2, pn = L & 3; u.pm = cc * 64 + mt; u.pn = cc * 4 + pn; } else { const int L2 = L - 768, cc = 3 + (L2 >> 6), mt = L2 & 63; u.pm = cc * 64 + mt; u.pn = 9 + cc; }
        return true; }
    __device__ __forceinline__ void a_ready(const Unit&) const {}
    __device__ __forceinline__ void done(const Unit&) const {} };
struct Rw2Order { int G, c;
    __device__ __forceinline__ bool next(int i, Unit& u) const { const int L = i * G + c; if (L >= 768) return false; const int j = L >> 8, mt = (L & 255) >> 2, pn = L & 3; u.pm = j * 64 + mt; u.pn = j * 4 + pn; return true; }
    __device__ __forceinline__ void a_ready(const Unit&) const {}
    __device__ __forceinline__ void done(const Unit&) const {} };
constexpr int MOE_TAB = 131072;
struct MoeOrder { const PG8_LAS int* tab; int G, c;
    __device__ __forceinline__ bool next(int i, Unit& u) const {
        const int nt = __builtin_amdgcn_readfirstlane(tab[768]);
        const int L = i * G + c; if (L >= nt * 4) return false; const int mt = L >> 2;
        const int e = __builtin_amdgcn_readfirstlane(tab[mt]), j = __builtin_amdgcn_readfirstlane(tab[256 + mt]);
        u.pm = mt; u.pn = e * 4 + (L & 3); u.rt = e * (ECAP / BM) + j; u.nv = __builtin_amdgcn_readfirstlane(tab[512 + mt]); return true; }
    __device__ __forceinline__ void a_ready(const Unit&) const {}
    __device__ __forceinline__ void done(const Unit&) const {} };
}

namespace attn_body {
using bf16=__hip_bfloat16;
using bf16x8=__attribute__((ext_vector_type(8)))short;
using s16x4=__attribute__((ext_vector_type(4)))short;
using f32x16=__attribute__((ext_vector_type(16)))float;
using u32x4=__attribute__((ext_vector_type(4)))unsigned;
using f32x4_t=__attribute__((ext_vector_type(4)))float;
constexpr int BATCH=4,NHEAD=16,SEQ=4096,D=64,DM=NHEAD*D;
constexpr int NW=8,QBLK=32,QB=QBLK*NW,KVBLK=64,NQB=SEQ/QB;
constexpr int ATTN_PITCH=DM, ATTN_UNIT_ROWS=QB;
__device__ __forceinline__ int crow(int r,int hi){return (r&3)+8*(r>>2)+4*hi;}
#define SBAR() __builtin_amdgcn_sched_barrier(0)
__device__ __forceinline__ void cmask(f32x16&p0,f32x16&p1,int jb,int qrel,int hi){
  const float NEG=-INFINITY; int kb=64*jb+4*hi;
  #pragma unroll
  for(int r=0;r<16;++r){int kv=kb+(r&3)+8*(r>>2); if(kv>qrel)p0[r]=NEG; if(kv+32>qrel)p1[r]=NEG;}
}

constexpr int NSLOT=3, SLOTB=8192;
constexpr int LDS_K=0, LDS_V=NSLOT*SLOTB, LDS_WS=2*NSLOT*SLOTB, LDS_OST=LDS_WS+NW*64*4, LDS_CB=LDS_OST+NW*4096, LDS_BYTES=LDS_CB+SEQ*8;
constexpr float C2=0.125f*1.4426950408889634f;
__device__ __forceinline__ void glds16(const void*gsrc,unsigned lds_dst){unsigned keep;
  asm volatile("s_mov_b32 %0, m0\n\ts_mov_b32 m0, %2\n\ts_nop 0\n\tglobal_load_lds_dwordx4 %1, off\n\ts_mov_b32 m0, %0":"=&s"(keep):"v"(gsrc),"s"(lds_dst):"memory");}
__device__ __forceinline__ void glds16s(unsigned voff,const void*sbase,unsigned lds_dst){unsigned keep;
  asm volatile("s_mov_b32 %0, m0\n\ts_mov_b32 m0, %2\n\ts_nop 2\n\tglobal_load_lds_dwordx4 %1, %3\n\ts_mov_b32 m0, %0":"=&s"(keep):"v"(voff),"s"(lds_dst),"s"(sbase):"memory");}
__device__ __forceinline__ float max3f(float a,float b,float c){float r;asm("v_max3_f32 %0, %1, %2, %3":"=v"(r):"v"(a),"v"(b),"v"(c));return r;}
__device__ __forceinline__ float max2f(float a,float b){float r;asm("v_max_f32_e32 %0, %1, %2":"=v"(r):"v"(a),"v"(b));return r;}
__device__ __forceinline__ float fadd_s(float a,float b){float r;asm("v_add_f32_e32 %0, %1, %2":"=v"(r):"v"(a),"v"(b));return r;}
__device__ __forceinline__ float fsub_s(float a,float b){float r;asm("v_sub_f32_e32 %0, %1, %2":"=v"(r):"v"(a),"v"(b));return r;}
typedef float f32x2_t __attribute__((ext_vector_type(2))); typedef __bf16 bf16x2_t __attribute__((ext_vector_type(2)));
__device__ __forceinline__ unsigned cvtpk_s(float lo,float hi){f32x2_t v={lo,hi};bf16x2_t b=__builtin_convertvector(v,bf16x2_t);return __builtin_bit_cast(unsigned,b);}
#define WAIT_BAR(N) asm volatile("s_waitcnt vmcnt(" #N ") lgkmcnt(0)\n\ts_barrier":::"memory")
typedef unsigned u32x2_t __attribute__((ext_vector_type(2)));
__device__ __forceinline__ unsigned bfr_(float x){unsigned u=__float_as_uint(x);return (u+0x7fffu+((u>>16)&1u))>>16;}
__device__ __forceinline__ void split3(float v,unsigned&h1,unsigned&h2,unsigned&h3){h1=bfr_(v);const float r1=v-__uint_as_float(h1<<16);h2=bfr_(r1);const float r2=r1-__uint_as_float(h2<<16);h3=bfr_(r2);}

__device__ __forceinline__ void qkt(f32x16&p0,f32x16&p1,const char*Kslot,const bf16x8*qr,const f32x16&negm,int r32,int hi){
  const char*kb=Kslot+hi*1024+r32*16;
  #pragma unroll
  for(int d0=0;d0<4;++d0){
    const bf16x8 b0=*reinterpret_cast<const bf16x8*>(kb+d0*2048);
    const bf16x8 b1=*reinterpret_cast<const bf16x8*>(kb+d0*2048+512);
    if(d0==0){p0=__builtin_amdgcn_mfma_f32_32x32x16_bf16(b0,qr[0],negm,0,0,0);p1=__builtin_amdgcn_mfma_f32_32x32x16_bf16(b1,qr[0],negm,0,0,0);}
    else{p0=__builtin_amdgcn_mfma_f32_32x32x16_bf16(b0,qr[d0],p0,0,0,0);p1=__builtin_amdgcn_mfma_f32_32x32x16_bf16(b1,qr[d0],p1,0,0,0);}}
}
typedef __attribute__((address_space(3))) const char* lds_cptr;
typedef short v4i16_t __attribute__((ext_vector_type(4)));
__device__ __forceinline__ void kload8(bf16x8*kf,lds_cptr kp){
  kf[0]=*(const __attribute__((address_space(3))) bf16x8*)(kp);      kf[1]=*(const __attribute__((address_space(3))) bf16x8*)(kp+512);
  kf[2]=*(const __attribute__((address_space(3))) bf16x8*)(kp+2048); kf[3]=*(const __attribute__((address_space(3))) bf16x8*)(kp+2560);
  kf[4]=*(const __attribute__((address_space(3))) bf16x8*)(kp+4096); kf[5]=*(const __attribute__((address_space(3))) bf16x8*)(kp+4608);
  kf[6]=*(const __attribute__((address_space(3))) bf16x8*)(kp+6144); kf[7]=*(const __attribute__((address_space(3))) bf16x8*)(kp+6656);
}
__device__ __forceinline__ void kload2(bf16x8*kf,lds_cptr kp,int j){ kf[2*j]=*(const __attribute__((address_space(3))) bf16x8*)(kp+j*2048); kf[2*j+1]=*(const __attribute__((address_space(3))) bf16x8*)(kp+j*2048+512); }
__device__ __forceinline__ s16x4 vtr(lds_cptr p){ return __builtin_bit_cast(s16x4,__builtin_amdgcn_ds_read_tr16_b64_v4i16((__attribute__((address_space(3))) v4i16_t*)p)); }
__device__ __forceinline__ float rowmax(const f32x16&p0,const f32x16&p1){
  float a=max3f(p0[0],p0[1],p1[0]),b=max3f(p0[2],p0[3],p1[1]);a=max3f(a,p1[2],p1[3]);
  #pragma unroll
  for(int r=4;r<16;r+=4){a=max3f(a,p0[r],p0[r+1]);b=max3f(b,p0[r+2],p0[r+3]);a=max3f(a,p1[r],p1[r+1]);b=max3f(b,p1[r+2],p1[r+3]);}
  const float m=max2f(a,b);
  auto rr=__builtin_amdgcn_permlane32_swap(__float_as_uint(m),__float_as_uint(m),false,false);
  return max2f(__uint_as_float(rr[0]),__uint_as_float(rr[1]));
}
__device__ __forceinline__ void pv(f32x16*o,int vb,bf16x8 pa0,bf16x8 pa1,bf16x8 pa2,bf16x8 pa3){
  #pragma unroll
  for(int d0=0;d0<2;++d0){s16x4 lo[4],hi[4];
    #pragma unroll
    for(int ks=0;ks<4;++ks){
      asm volatile("ds_read_b64_tr_b16 %0,%1 offset:%c2":"=&v"(lo[ks]):"v"(vb),"i"(d0*4096+ks*1024):"memory");
      asm volatile("ds_read_b64_tr_b16 %0,%1 offset:%c2":"=&v"(hi[ks]):"v"(vb),"i"(d0*4096+ks*1024+512):"memory");}
    asm volatile("s_waitcnt lgkmcnt(0)":::"memory");SBAR();
    #define PK(k) (bf16x8){lo[k][0],lo[k][1],lo[k][2],lo[k][3],hi[k][0],hi[k][1],hi[k][2],hi[k][3]}
    o[d0]=__builtin_amdgcn_mfma_f32_32x32x16_bf16(pa0,PK(0),o[d0],0,0,0);
    o[d0]=__builtin_amdgcn_mfma_f32_32x32x16_bf16(pa1,PK(1),o[d0],0,0,0);
    o[d0]=__builtin_amdgcn_mfma_f32_32x32x16_bf16(pa2,PK(2),o[d0],0,0,0);
    o[d0]=__builtin_amdgcn_mfma_f32_32x32x16_bf16(pa3,PK(3),o[d0],0,0,0);
    #undef PK
  }
}

#ifndef ATTN_STORE16
#define ATTN_STORE16(p,v) (*(u32x4*)(p)=(v))
#endif
template<int THRL> __device__ __forceinline__ void attn_unit(int b,int h,int qb,const bf16*Q,const bf16*__restrict__ K,const bf16*__restrict__ V,bf16*O,const float*CBg,const bf16*OGg,bool loadcb,float bnd2,char*shm){
  const int tid=threadIdx.x,lane=tid&63,r32=lane&31,hi=lane>>5; const int wid=__builtin_amdgcn_readfirstlane(tid>>6);
  const long rowbase=(long)b*SEQ; const int q0=qb*QB;
  const bf16*Qw=Q+(rowbase+q0+wid*QBLK)*DM+h*D;
  const bf16*Kh=K+rowbase*DM+h*D,*Vh=V+rowbase*DM+h*D;
  const unsigned lds0=(unsigned)(uintptr_t)shm;
  float*wsf=(float*)(shm+LDS_WS)+wid*64;
  int ln2_=lane; asm volatile("":"+v"(ln2_));
  const unsigned koff=(unsigned)(ln2_*DM+wid*8)*2u;
  const unsigned voff=(unsigned)((16*(wid&3)+(ln2_>>2))*DM+(wid>>2)*32+(ln2_&3)*8)*2u;
  const unsigned kdst=lds0+LDS_K+wid*1024, vdst=lds0+LDS_V+wid*1024;
  #define DMA_K(t,slot) glds16s(koff,Kh+(long)(t)*KVBLK*DM,(unsigned)__builtin_amdgcn_readfirstlane(kdst+(slot)))
  #define DMA_V(t,slot) glds16s(voff,Vh+(long)(t)*KVBLK*DM,(unsigned)__builtin_amdgcn_readfirstlane(vdst+(slot)))
  const int vb0=(int)(lds0+LDS_V)+((lane>>4)&1)*32+(lane&3)*8+(4*hi+((lane&15)>>2))*64;
  const char*Kbase=shm+LDS_K; bf16x8 kf[8];
  const lds_cptr shm3=(lds_cptr)shm; const lds_cptr kp0=shm3+LDS_K+hi*1024+r32*16; const lds_cptr vp0=shm3+LDS_V+((lane>>4)&1)*32+(lane&3)*8+(4*hi+((lane&15)>>2))*64;
  int NT=(q0+QB)/KVBLK;
  typedef __attribute__((address_space(3))) const u32x2_t* lds_u2p; lds_u2p bt=(lds_u2p)(shm3+LDS_CB)+r32;
  if(loadcb){ const float*src=CBg+(long)(b*NHEAD+h)*SEQ; u32x2_t*dst=(u32x2_t*)(shm+LDS_CB);
    #pragma unroll
    for(int i=0;i<8;++i){ const int kv=tid+512*i; unsigned h1,h2,h3; split3(src[kv],h1,h2,h3); dst[kv]=(u32x2_t){h1|(h2<<16),h3|0x3F800000u}; }
    asm volatile("s_waitcnt vmcnt(0) lgkmcnt(0)\n\ts_barrier":::"memory"); }
  { const lds_u2p b0_=(lds_u2p)(shm3+LDS_CB);
    #define BTV(kv) ({ const u32x2_t e_=b0_[kv]; __uint_as_float(e_.x<<16)+__uint_as_float(e_.x&0xffff0000u)+__uint_as_float(e_.y<<16); })
    const float bq0_=BTV(q0); int cand_=NT-4;
    while(cand_>=2){ const float d_=bq0_-BTV(64*cand_-1); if(__builtin_amdgcn_readfirstlane(d_>=bnd2?1:0))break; cand_-=2; }
    #undef BTV
    const int T0_=cand_>=2?cand_:0; Kh+=(long)T0_*KVBLK*DM; Vh+=(long)T0_*KVBLK*DM; bt+=64*T0_; NT-=T0_; }
  u32x4 Bq; const unsigned hm_=hi?0u:0xffffffffu;
  #define SETBQ(mh) do{ unsigned h1_,h2_,h3_; split3(-(mh),h1_,h2_,h3_); Bq.x=0x3F803F80u&hm_; Bq.y=(0x3F80u|(h1_<<16))&hm_; Bq.z=(h2_|(h3_<<16))&hm_; Bq.w=0u; }while(0)
  #define BIASM(P0,P1,t) do{ const u32x2_t a0_=bt[64*(t)],a1_=bt[64*(t)+32]; \
      P0=__builtin_amdgcn_mfma_f32_32x32x16_bf16(__builtin_bit_cast(bf16x8,(u32x4){a0_.x,a0_.y,0x3F803F80u,0u}),__builtin_bit_cast(bf16x8,Bq),P0,0,0,0); \
      P1=__builtin_amdgcn_mfma_f32_32x32x16_bf16(__builtin_bit_cast(bf16x8,(u32x4){a1_.x,a1_.y,0x3F803F80u,0u}),__builtin_bit_cast(bf16x8,Bq),P1,0,0,0); }while(0)
  SETBQ(0.f);
  DMA_K(0,0);DMA_V(0,0);DMA_K(1,SLOTB);
  bf16x8 qr[4];
  #pragma unroll
  for(int d0=0;d0<4;++d0)qr[d0]=*reinterpret_cast<const bf16x8*>(&Qw[(long)r32*DM+d0*16+hi*8]);
  float mhat=0.f,l_reg=0.f;f32x16 o[2];o[0]=f32x16{};o[1]=f32x16{};const f32x16 zero16=f32x16{};
  const int qrel=wid*QBLK+r32;
  #define CMASK(P0,P1,t) do{int jb_=(t)-(NT-4); if(jb_>=0)cmask(P0,P1,jb_,qrel,hi);}while(0)
  bool resc=false;
  #define START(P0,P1) do{ const float rm=rowmax(P0,P1); resc=false; \
    { const float dl=rm; mhat=fadd_s(mhat,dl); \
      _Pragma("unroll") for(int r=0;r<16;++r){P0[r]=fsub_s(P0[r],dl);P1[r]=fsub_s(P1[r],dl);} \
      SETBQ(mhat); } \
    _Pragma("unroll") for(int r=0;r<16;++r)P0[r]=__builtin_amdgcn_exp2f(P0[r]); }while(0)
  #define RESC() do{ if(resc){ asm volatile("s_waitcnt lgkmcnt(0)":::"memory"); \
      _Pragma("unroll") for(int d_=0;d_<2;++d_) _Pragma("unroll") for(int r=0;r<16;++r)o[d_][r]*=wsf[crow(r,hi)]; } }while(0)
  f32x16 pA0,pA1,pB0,pB1;
  int sl_prev=0,sl_cur=0,sl_next=SLOTB;
  #define ROT() do{sl_prev=sl_cur;sl_cur=sl_next;sl_next=(sl_next==(NSLOT-1)*SLOTB)?0:sl_next+SLOTB;}while(0)
  DMA_K(2,2*SLOTB);
  WAIT_BAR(3);
  qkt(pA0,pA1,Kbase,qr,zero16,r32,hi);BIASM(pA0,pA1,0);asm volatile("s_nop 15\n\ts_nop 7":"+v"(pA0),"+v"(pA1));CMASK(pA0,pA1,0);
  START(pA0,pA1);
  _Pragma("unroll") for(int r=0;r<16;++r)pA1[r]=__builtin_amdgcn_exp2f(pA1[r]);
  WAIT_BAR(0);
  DMA_K(3,0);DMA_V(1,SLOTB);
  ROT();
  kload8(kf,kp0+sl_cur);
  WAIT_BAR(2);
  s16x4 vlo[8],vhi[8]; u32x4 pw0,pw1,pw2,pw3;
  #define PKW(P,B) cvtpk_s(P[B],P[B+1])
  #define PAF(k) __builtin_bit_cast(bf16x8,pw##k)
  #define VFR(i) (bf16x8){vlo[i][0],vlo[i][1],vlo[i][2],vlo[i][3],vhi[i][0],vhi[i][1],vhi[i][2],vhi[i][3]}
  #define PIN(x) asm volatile("":"+v"(x))
  #define MX3(a,b,c) __builtin_fmaxf(__builtin_fmaxf((a),(b)),(c))
  #define GAPA(MF,A0,A1,A2,A3,W0,W1,PW) do{ MF; sacc+=A0; sacc+=A1; sacc+=A2; sacc+=A3; PIN(sacc); W0; W1; PIN(PW); SBAR(); }while(0)
  #define EX(v) __builtin_amdgcn_exp2f(v)
  #define GAPB(MF,X,B) do{ MF; X[B]=EX(X[B]); X[B+1]=EX(X[B+1]); X[B+2]=EX(X[B+2]); X[B+3]=EX(X[B+3]); PIN(X); SBAR(); }while(0)
  #define VRD(i) do{ vlo[i]=vtr(vp_+(((i)>>2)*4096+((i)&3)*1024)); vhi[i]=vtr(vp_+(((i)>>2)*4096+((i)&3)*1024+512)); }while(0)
  #define KRD(G,j) do{ if(G){ kload2(kf,kp0+sl_next,j); SBAR(); } }while(0)
  #define STEP(C0,C1,P0,P1,t,GK,GV,GL) do{ SBAR(); \
    const lds_cptr vp_=vp0+sl_prev; \
    VRD(0); SBAR(); float sacc=(P0[0]+P0[1]); \
    GAPA(C0=__builtin_amdgcn_mfma_f32_32x32x16_bf16(kf[0],qr[0],zero16,0,0,0), P0[2],P0[3],P0[4],P0[5],     pw0[0]=PKW(P0,0), pw0[1]=PKW(P0,2), pw0); \
    VRD(4); SBAR(); GAPA(C1=__builtin_amdgcn_mfma_f32_32x32x16_bf16(kf[1],qr[0],zero16,0,0,0), P0[6],P0[7],P0[8],P0[9],     pw0[2]=PKW(P0,4), pw0[3]=PKW(P0,6), pw0); \
    VRD(1); SBAR(); GAPA(C0=__builtin_amdgcn_mfma_f32_32x32x16_bf16(kf[2],qr[1],C0,0,0,0),   P0[10],P0[11],P0[12],P0[13], pw1[0]=PKW(P0,8), pw1[1]=PKW(P0,10), pw1); \
    VRD(5); SBAR(); GAPA(C1=__builtin_amdgcn_mfma_f32_32x32x16_bf16(kf[3],qr[1],C1,0,0,0),   P0[14],P0[15],P1[0],P1[1],   pw1[2]=PKW(P0,12),pw1[3]=PKW(P0,14), pw1); \
    VRD(2); SBAR(); GAPA(C0=__builtin_amdgcn_mfma_f32_32x32x16_bf16(kf[4],qr[2],C0,0,0,0),   P1[2],P1[3],P1[4],P1[5],     pw2[0]=PKW(P1,0), pw2[1]=PKW(P1,2), pw2); \
    VRD(6); SBAR(); GAPA(C1=__builtin_amdgcn_mfma_f32_32x32x16_bf16(kf[5],qr[2],C1,0,0,0),   P1[6],P1[7],P1[8],P1[9],     pw2[2]=PKW(P1,4), pw2[3]=PKW(P1,6), pw2); \
    VRD(3); SBAR(); GAPA(C0=__builtin_amdgcn_mfma_f32_32x32x16_bf16(kf[6],qr[3],C0,0,0,0),   P1[10],P1[11],P1[12],P1[13], pw3[0]=PKW(P1,8), pw3[1]=PKW(P1,10), pw3); \
    VRD(7); SBAR(); GAPA(C1=__builtin_amdgcn_mfma_f32_32x32x16_bf16(kf[7],qr[3],C1,0,0,0),   P1[14],P1[15],0.f,0.f,       pw3[2]=PKW(P1,12),pw3[3]=PKW(P1,14), pw3); \
    l_reg+=sacc; \
    if(GK){DMA_K((t)+3,sl_cur);} if(GV){DMA_V((t)+1,sl_next);} \
    BIASM(C0,C1,t); CMASK(C0,C1,t); \
    { float a=MX3(C0[0],C0[1],C1[0]),b=MX3(C0[2],C0[3],C1[1]); a=MX3(a,C1[2],C1[3]); \
      _Pragma("unroll") for(int r=4;r<16;r+=4){a=MX3(a,C0[r],C0[r+1]);b=MX3(b,C0[r+2],C0[r+3]);a=MX3(a,C1[r],C1[r+1]);b=MX3(b,C1[r+2],C1[r+3]);} \
      float rm=__builtin_fmaxf(a,b); { auto rr=__builtin_amdgcn_permlane32_swap(__float_as_uint(rm),__float_as_uint(rm),false,false); rm=__builtin_fmaxf(__uint_as_float(rr[0]),__uint_as_float(rr[1])); } \
      resc=false; \
      if(__builtin_expect(__any(rm>(float)THRL),0)){ const float dl=__builtin_fmaxf(rm,0.f); mhat+=dl; \
        _Pragma("unroll") for(int r=0;r<16;++r){C0[r]-=dl;C1[r]-=dl;} \
        SETBQ(mhat); \
        const float f=__builtin_amdgcn_exp2f(-dl); l_reg*=f; if(hi==0)wsf[r32]=f; resc=true; } } \
    SBAR(); \
    GAPB(o[0]=__builtin_amdgcn_mfma_f32_32x32x16_bf16(PAF(0),VFR(0),o[0],0,0,0), C0,0); \
    GAPB(o[1]=__builtin_amdgcn_mfma_f32_32x32x16_bf16(PAF(0),VFR(4),o[1],0,0,0), C0,4); \
    KRD(GL,0); GAPB(o[0]=__builtin_amdgcn_mfma_f32_32x32x16_bf16(PAF(1),VFR(1),o[0],0,0,0), C0,8); \
    KRD(GL,1); GAPB(o[1]=__builtin_amdgcn_mfma_f32_32x32x16_bf16(PAF(1),VFR(5),o[1],0,0,0), C0,12); \
    KRD(GL,2); GAPB(o[0]=__builtin_amdgcn_mfma_f32_32x32x16_bf16(PAF(2),VFR(2),o[0],0,0,0), C1,0); \
    KRD(GL,3); GAPB(o[1]=__builtin_amdgcn_mfma_f32_32x32x16_bf16(PAF(2),VFR(6),o[1],0,0,0), C1,4); \
    GAPB(o[0]=__builtin_amdgcn_mfma_f32_32x32x16_bf16(PAF(3),VFR(3),o[0],0,0,0), C1,8); \
    GAPB(o[1]=__builtin_amdgcn_mfma_f32_32x32x16_bf16(PAF(3),VFR(7),o[1],0,0,0), C1,12); \
    }while(0)
  int t=1;
  #undef CMASK
  #define CMASK(P0,P1,t) do{}while(0)
  for(;t+5<NT;t+=2){
    STEP(pB0,pB1,pA0,pA1,t,true,true,true);     WAIT_BAR(2); RESC(); ROT();
    STEP(pA0,pA1,pB0,pB1,t+1,true,true,true);   WAIT_BAR(2); RESC(); ROT();
  }
  #undef CMASK
  #define CMASK(P0,P1,t) do{int jb_=(t)-(NT-4); if(jb_>=0)cmask(P0,P1,jb_,qrel,hi);}while(0)
  #define ENDW(tt) do{ if((tt)+3<NT){WAIT_BAR(2);} else if((tt)+2<NT){WAIT_BAR(1);} else {WAIT_BAR(0);} }while(0)
  for(;t+1<NT;t+=2){
    STEP(pB0,pB1,pA0,pA1,t,(t+3<NT),(t+1<NT),(t+1<NT));       ENDW(t);   RESC(); ROT();
    STEP(pA0,pA1,pB0,pB1,t+1,(t+4<NT),(t+2<NT),(t+2<NT));     ENDW(t+1); RESC(); ROT();
  }
  STEP(pB0,pB1,pA0,pA1,NT-1,false,false,false); RESC();
  { float sacc=pB0[0]+pB0[1]; _Pragma("unroll") for(int r=2;r<16;++r)sacc+=pB0[r]; _Pragma("unroll") for(int r=0;r<16;++r)sacc+=pB1[r]; l_reg+=sacc;
    pw0=(u32x4){PKW(pB0,0),PKW(pB0,2),PKW(pB0,4),PKW(pB0,6)};pw1=(u32x4){PKW(pB0,8),PKW(pB0,10),PKW(pB0,12),PKW(pB0,14)};pw2=(u32x4){PKW(pB1,0),PKW(pB1,2),PKW(pB1,4),PKW(pB1,6)};pw3=(u32x4){PKW(pB1,8),PKW(pB1,10),PKW(pB1,12),PKW(pB1,14)};
    SBAR(); pv(o,vb0+sl_cur,PAF(0),PAF(1),PAF(2),PAF(3)); }
  #undef PKW
  #undef PAF
  #undef VFR
  #undef PIN
  #undef MX3
  #undef GAPA
  #undef GAPB
  #undef EX
  #undef VRD
  #undef KRD
  #undef STEP
  #undef ENDW
  {auto rr=__builtin_amdgcn_permlane32_swap(__float_as_uint(l_reg),__float_as_uint(l_reg),false,false);l_reg=__uint_as_float(rr[0])+__uint_as_float(rr[1]);}
  if(hi==0)wsf[32+r32]=l_reg;asm volatile("s_waitcnt lgkmcnt(0)":::"memory");
  float rli[16];
  #pragma unroll
  for(int r=0;r<16;++r)rli[r]=__builtin_amdgcn_rcpf(wsf[32+crow(r,hi)]);
  bf16*Ow=O+(rowbase+q0+wid*QBLK)*DM+h*D;
  { bf16*stg=(bf16*)(shm+LDS_OST)+wid*2048;
    #pragma unroll
    for(int r=0;r<16;++r){const int orow=crow(r,hi);
      #pragma unroll
      for(int d0=0;d0<2;++d0)stg[orow*64+d0*32+r32]=__float2bfloat16(o[d0][r]*rli[r]);}
    asm volatile("s_waitcnt lgkmcnt(0)":::"memory");
    int ln_=lane; asm volatile("":"+v"(ln_));
    #pragma unroll
    for(int i=0;i<4;++i){const int row=i*8+(ln_>>3),ch=ln_&7; u32x4 v=*(const u32x4*)(stg+row*64+ch*8);
      if(OGg){ const u32x4 gt=*(const u32x4*)(OGg+(rowbase+q0+wid*QBLK+row)*DM+h*D+ch*8);
        _Pragma("unroll") for(int e=0;e<4;++e){ const float a0=__uint_as_float(v[e]<<16)*__builtin_amdgcn_rcpf(1.f+__builtin_amdgcn_exp2f(-1.4426950408889634f*__uint_as_float(gt[e]<<16)));
          const float a1=__uint_as_float(v[e]&0xffff0000u)*__builtin_amdgcn_rcpf(1.f+__builtin_amdgcn_exp2f(-1.4426950408889634f*__uint_as_float(gt[e]&0xffff0000u))); v[e]=cvtpk_s(a0,a1); } }
      ATTN_STORE16(Ow+(long)row*DM+ch*8,v);} }
  asm volatile("s_waitcnt lgkmcnt(0)\n\ts_barrier":::"memory");
  #undef BIASM
  #undef SETBQ
  #undef DMA_K
  #undef DMA_V
  #undef CMASK
  #undef START
  #undef RESC
  #undef ROT
}
constexpr int ATTN_LDS_BYTES=LDS_BYTES;
struct AttnTensors { const bf16* Q; const bf16* K; const bf16* V; bf16* O; const float* CB; const bf16* OG; };
struct AttnUnit { int bh; int qb; };
struct StaticOrder {
  int vcu,G;
  __device__ __forceinline__ explicit StaticOrder(int grid,int block):vcu((grid%8==0)?(block%8)*(grid/8)+block/8:block),G(grid){}
  __device__ __forceinline__ bool next(int i,AttnUnit&u)const{ const int vc=vcu+(i>>2)*G; if(vc>=256)return false; const int s=vc&3,k=i&3; u.bh=vc>>2; u.qb=(k==0)?s:(k==1)?7-s:(k==2)?8+s:15-s; return true; }
  __device__ __forceinline__ void a_ready(const AttnUnit&)const{}
  __device__ __forceinline__ void done(const AttnUnit&)const{}
};
template<class Sched,int THRL=60> __device__ __forceinline__ void attn_phase(char*lds,const AttnTensors&T,const Sched&S){
  AttnUnit u;
  int prev=-1; float bnd2=1e30f;
  for(int i=0;S.next(i,u);++i){ S.a_ready(u);
    if(u.bh!=prev){
      int tid=threadIdx.x; asm volatile("":"+v"(tid)); const int lane=tid&63,wid=tid>>6; const long rb=(long)(u.bh/NHEAD)*SEQ*DM+(u.bh%NHEAD)*D; float mq=0.f,mk=0.f;
      for(int r=tid;r<SEQ;r+=512){ float sq=0.f,sk=0.f;
        #pragma unroll
        for(int cch=0;cch<8;++cch){ const u32x4 a=*(const u32x4*)(T.Q+rb+(long)r*DM+cch*8), c=*(const u32x4*)(T.K+rb+(long)r*DM+cch*8);
          #pragma unroll
          for(int e=0;e<4;++e){ const float a0=__uint_as_float(a[e]<<16),a1=__uint_as_float(a[e]&0xffff0000u),c0=__uint_as_float(c[e]<<16),c1=__uint_as_float(c[e]&0xffff0000u); sq+=a0*a0+a1*a1; sk+=c0*c0+c1*c1; } }
        mq=fmaxf(mq,sq); mk=fmaxf(mk,sk); }
      #pragma unroll
      for(int o=1;o<64;o<<=1){ mq=fmaxf(mq,__shfl_xor(mq,o)); mk=fmaxf(mk,__shfl_xor(mk,o)); }
      float*red=(float*)(lds+LDS_WS);
      if(lane==0){ red[wid*2]=mq; red[wid*2+1]=mk; }
      asm volatile("s_waitcnt lgkmcnt(0)\n\ts_barrier":::"memory");
      float aq=0.f,ak=0.f;
      #pragma unroll
      for(int w=0;w<NW;++w){ aq=fmaxf(aq,red[w*2]); ak=fmaxf(ak,red[w*2+1]); }
      asm volatile("s_waitcnt lgkmcnt(0)\n\ts_barrier":::"memory");
      bnd2=__uint_as_float((unsigned)__builtin_amdgcn_readfirstlane((int)__float_as_uint(2.f*sqrtf(aq*ak)*1.01f+48.f))); }
    attn_unit<THRL>(u.bh/NHEAD,u.bh%NHEAD,u.qb,T.Q,T.K,T.V,T.O,T.CB,T.OG,u.bh!=prev,bnd2,lds); prev=u.bh; S.done(u); }
}

constexpr int SB_K=0, SB_V=2*SLOTB, SB_FLAG=4*SLOTB, SB_OST=SB_FLAG+256, SB_BYTES=SB_OST+NW*4096;
constexpr float SB_THR=48.0f;
__device__ __forceinline__ void sb_unit(int b,int h,int qb,const bf16*Q,const bf16*__restrict__ K,const bf16*__restrict__ V,bf16*O,char*shm){
  const int tid=threadIdx.x,lane=tid&63,r32=lane&31,hi=lane>>5; const int wid=__builtin_amdgcn_readfirstlane(tid>>6);
  const long rowbase=(long)b*SEQ; const int q0=qb*QB;
  const bf16*Qw=Q+(rowbase+q0+wid*QBLK)*DM+h*D;
  const bf16*Kh=K+rowbase*DM+h*D,*Vh=V+rowbase*DM+h*D;
  const unsigned lds0=(unsigned)(uintptr_t)shm;
  const unsigned koff=(unsigned)(lane*DM+wid*8)*2u;
  const unsigned voff=(unsigned)((16*(wid&3)+(lane>>2))*DM+(wid>>2)*32+(lane&3)*8)*2u;
  const unsigned kdst=lds0+SB_K+wid*1024, vdst=lds0+SB_V+wid*1024;
  #define SB_DMA_K(t,slot) glds16s(koff,Kh+(long)(t)*KVBLK*DM,(unsigned)__builtin_amdgcn_readfirstlane(kdst+(slot)))
  #define SB_DMA_V(t,slot) glds16s(voff,Vh+(long)(t)*KVBLK*DM,(unsigned)__builtin_amdgcn_readfirstlane(vdst+(slot)))
  const int vb0=(int)(lds0+SB_V)+((lane>>4)&1)*32+(lane&3)*8+(4*hi+((lane&15)>>2))*64;
  volatile unsigned*flag=(volatile unsigned*)(shm+SB_FLAG);
  int j=(q0+QB)/KVBLK-1;
  SB_DMA_K(j,0);SB_DMA_V(j,0);
  bf16x8 qr[4];
  #pragma unroll
  for(int d0=0;d0<4;++d0)qr[d0]=*reinterpret_cast<const bf16x8*>(&Qw[(long)r32*DM+d0*16+hi*8]);
  f32x16 o[2];o[0]=f32x16{};o[1]=f32x16{};
  const f32x16 zero16=f32x16{};
  float carry=0.f; bool mydone=false;
  const int qw0=q0+wid*QBLK, tq=qw0+r32;
  int slot=0;
  for(int it=0;j>=0;--j,++it){
    WAIT_BAR(0);
    if(it>0){ unsigned all=1u;
      #pragma unroll
      for(int w=0;w<NW;++w)all&=flag[((it-1)&1)*8+w];
      if(__builtin_amdgcn_readfirstlane(all))break; }
    if(j>0){SB_DMA_K(j-1,slot^SLOTB);SB_DMA_V(j-1,slot^SLOTB);}
    if(64*j<=qw0+30&&!mydone){
      f32x16 p0,p1;
      qkt(p0,p1,shm+SB_K+slot,qr,zero16,r32,hi);
      if(64*j+64>qw0){ const int kb=64*j+4*hi;
        #pragma unroll
        for(int r=0;r<16;++r){const int kv=kb+(r&3)+8*(r>>2); if(!(kv<tq))p0[r]=-INFINITY; if(!(kv+32<tq))p1[r]=-INFINITY;} }
      f32x16 s0,s1;
      #pragma unroll
      for(int r=0;r<16;++r){ s0[r]=__builtin_fmaxf(p0[r],0.f)+__builtin_amdgcn_logf(1.f+__builtin_amdgcn_exp2f(-__builtin_fabsf(p0[r])));
                             s1[r]=__builtin_fmaxf(p1[r],0.f)+__builtin_amdgcn_logf(1.f+__builtin_amdgcn_exp2f(-__builtin_fabsf(p1[r]))); }
      float w1[2][4],w0[2][4],gl[2][4],gh[2][4];
      #pragma unroll
      for(int g=0;g<4;++g){ w1[0][g]=s0[4*g+3]+s0[4*g+2]; w0[0][g]=w1[0][g]+s0[4*g+1]; const float gs0=w0[0][g]+s0[4*g];
                            w1[1][g]=s1[4*g+3]+s1[4*g+2]; w0[1][g]=w1[1][g]+s1[4*g+1]; const float gs1=w0[1][g]+s1[4*g];
        auto ra=__builtin_amdgcn_permlane32_swap(__float_as_uint(gs0),__float_as_uint(gs0),false,false); gl[0][g]=__uint_as_float(ra[0]); gh[0][g]=__uint_as_float(ra[1]);
        auto rb=__builtin_amdgcn_permlane32_swap(__float_as_uint(gs1),__float_as_uint(gs1),false,false); gl[1][g]=__uint_as_float(rb[0]); gh[1][g]=__uint_as_float(rb[1]); }
      float run=carry, base[2][4];
      #pragma unroll
      for(int blk=1;blk>=0;--blk)
        #pragma unroll
        for(int g=3;g>=0;--g){ const float eh=run; run+=gh[blk][g]; const float el=run; run+=gl[blk][g]; base[blk][g]=hi?eh:el; }
      carry=run;
      #pragma unroll
      for(int g=0;g<4;++g){
        p0[4*g+3]=__builtin_amdgcn_exp2f(p0[4*g+3]-s0[4*g+3]-base[0][g]);
        p0[4*g+2]=__builtin_amdgcn_exp2f(p0[4*g+2]-s0[4*g+2]-base[0][g]-s0[4*g+3]);
        p0[4*g+1]=__builtin_amdgcn_exp2f(p0[4*g+1]-s0[4*g+1]-base[0][g]-w1[0][g]);
        p0[4*g  ]=__builtin_amdgcn_exp2f(p0[4*g  ]-s0[4*g  ]-base[0][g]-w0[0][g]);
        p1[4*g+3]=__builtin_amdgcn_exp2f(p1[4*g+3]-s1[4*g+3]-base[1][g]);
        p1[4*g+2]=__builtin_amdgcn_exp2f(p1[4*g+2]-s1[4*g+2]-base[1][g]-s1[4*g+3]);
        p1[4*g+1]=__builtin_amdgcn_exp2f(p1[4*g+1]-s1[4*g+1]-base[1][g]-w1[1][g]);
        p1[4*g  ]=__builtin_amdgcn_exp2f(p1[4*g  ]-s1[4*g  ]-base[1][g]-w0[1][g]); }
      u32x4 pw0,pw1,pw2,pw3;
      pw0=(u32x4){cvtpk_s(p0[0],p0[1]),cvtpk_s(p0[2],p0[3]),cvtpk_s(p0[4],p0[5]),cvtpk_s(p0[6],p0[7])};
      pw1=(u32x4){cvtpk_s(p0[8],p0[9]),cvtpk_s(p0[10],p0[11]),cvtpk_s(p0[12],p0[13]),cvtpk_s(p0[14],p0[15])};
      pw2=(u32x4){cvtpk_s(p1[0],p1[1]),cvtpk_s(p1[2],p1[3]),cvtpk_s(p1[4],p1[5]),cvtpk_s(p1[6],p1[7])};
      pw3=(u32x4){cvtpk_s(p1[8],p1[9]),cvtpk_s(p1[10],p1[11]),cvtpk_s(p1[12],p1[13]),cvtpk_s(p1[14],p1[15])};
      SBAR(); pv(o,vb0+slot,__builtin_bit_cast(bf16x8,pw0),__builtin_bit_cast(bf16x8,pw1),__builtin_bit_cast(bf16x8,pw2),__builtin_bit_cast(bf16x8,pw3));
      mydone=__all(carry>SB_THR)!=0;
    }
    if(lane==0)flag[(it&1)*8+wid]=mydone?1u:0u;
    slot^=SLOTB;
  }
  bf16*Ow=O+(rowbase+q0+wid*QBLK)*DM+h*D;
  { bf16*stg=(bf16*)(shm+SB_OST)+wid*2048;
    #pragma unroll
    for(int r=0;r<16;++r){const int orow=crow(r,hi);
      #pragma unroll
      for(int d0=0;d0<2;++d0)stg[orow*64+d0*32+r32]=__float2bfloat16(o[d0][r]);}
    asm volatile("s_waitcnt lgkmcnt(0)":::"memory");
    #pragma unroll
    for(int i=0;i<4;++i){const int row=i*8+(lane>>3),ch=lane&7; const u32x4 v=*(const u32x4*)(stg+row*64+ch*8); *(u32x4*)(Ow+(long)row*DM+ch*8)=v;} }
  asm volatile("s_waitcnt vmcnt(0) lgkmcnt(0)\n\ts_barrier":::"memory");
  #undef SB_DMA_K
  #undef SB_DMA_V
}
struct SbOrder {
  int vcu,G;
  __device__ __forceinline__ explicit SbOrder(int grid,int block):vcu((grid%8==0)?(block%8)*(grid/8)+block/8:block),G(grid){}
  __device__ __forceinline__ bool next(int i,AttnUnit&u)const{ const int L=(vcu+(i>>2)*G)*4+(i&3); if(L>=BATCH*NHEAD*NQB)return false; u.bh=L/NQB; u.qb=L%NQB; return true; }
};
template<class Sched> __device__ __forceinline__ void sb_phase(char*lds,const AttnTensors&T,const Sched&S){
  AttnUnit u;
  for(int i=0;S.next(i,u);++i) sb_unit(u.bh/NHEAD,u.bh%NHEAD,u.qb,T.Q,T.K,T.V,T.O,lds);
}
#undef SBAR
#undef WAIT_BAR
}

struct Params {
    const float* in[38];
    float* out; unsigned char* ws;
    int ph_lo, ph_hi, li, pad;
};
enum { I_X = 0, I_LN1G, I_LN1B, I_LN2G, I_LN2B, I_FOX_WIN, I_FOX_BF, I_FOX_WOUT, I_GM_WIN, I_GM_BIN, I_GM_LNG, I_GM_LNB, I_GM_WS, I_GM_BS, I_GM_WOUT,
       I_SB_WIN, I_SB_WOUT, I_RW_MU, I_RW_WRKV, I_RW_W0, I_RW_W1, I_RW_W2, I_RW_A0, I_RW_A1, I_RW_A2, I_RW_G1, I_RW_G2, I_RW_KK, I_RW_KA, I_RW_RK,
       I_RW_GNG, I_RW_GNB, I_RW_WOUT, I_ROUTER_W, I_ROUTER_B, I_MOE_G, I_MOE_U, I_MOE_D };

struct Ctx { int tid, lane, wave, gw, ngw; unsigned char* lds; };

__device__ __forceinline__ void tr_tile(const float* src, int ld, bf16* dst, int ldt, float* scr, int lane) {
    float tv[32];
#pragma unroll
    for (int i = 0; i < 32; ++i) tv[i] = src[(size_t)(2 * i + (lane >> 5)) * ld + (lane & 31)];
#pragma unroll
    for (int i = 0; i < 32; ++i) scr[(2 * i + (lane >> 5)) * 33 + (lane & 31)] = tv[i];
    LDS_WAIT();
    const int c = lane & 7;
#pragma unroll
    for (int j = 0; j < 4; ++j) { const int n = (lane >> 3) + 8 * j; const float* s = scr + (8 * c) * 33 + n;
        u32x4 o; o.x = pk2(s[0 * 33], s[1 * 33]); o.y = pk2(s[2 * 33], s[3 * 33]); o.z = pk2(s[4 * 33], s[5 * 33]); o.w = pk2(s[6 * 33], s[7 * 33]);
        *(u32x4*)(dst + (size_t)n * ldt + 8 * c) = o; }
    LDS_WAIT();
}
__device__ __forceinline__ void conv_matrix(const Ctx& c, const float* W, int ld, int K, int ncols, bf16* WT, int ldt, int mode) {
    float* scr = (float*)(c.lds + c.wave * 16384);
    const int nblk = ncols / 32, nit = (K / 64) * nblk;
    for (int it = c.gw; it < nit; it += c.ngw) {
        const int kb = it / nblk, nb = it % nblk, n0 = nb * 32, k0 = kb * 64;
        int orow = n0; if (mode) orow = (n0 >> 7) * 256 + (n0 & 127) + (mode == 2 ? 128 : 0);
        tr_tile(W + (size_t)k0 * ld + n0, ld, WT + (size_t)orow * ldt + k0, ldt, scr, c.lane);
    }
}
__device__ __forceinline__ void conv_moe_items(const Ctx& c, const Params& p, int l, int it0, int it1, int w, int nw) {
    float* scr = (float*)(c.lds + c.wave * 16384);
    bf16* gu = (bf16*)(p.ws + WS_GU + (size_t)(l & 1) * WS_MOE_ALT); bf16* dn = (bf16*)(p.ws + WS_DOWN + (size_t)(l & 1) * WS_MOE_ALT);
    for (int it = it0 + w; it < it1; it += nw) {
        const int mtx = it >> 8, sub = it & 255, kind = mtx / 16, e = mtx % 16;
        if (kind < 2) {
            const float* W = p.in[kind == 0 ? I_MOE_G : I_MOE_U] + (size_t)(l * 16 + e) * 1024 * 512;
            const int kb = sub / 16, nb = sub % 16, n0 = nb * 32, k0 = kb * 64;
            const int orow = (n0 >> 7) * 256 + (n0 & 127) + (kind == 1 ? 128 : 0);
            tr_tile(W + (size_t)k0 * 512 + n0, 512, gu + (size_t)e * 1024 * 1024 + (size_t)orow * 1024 + k0, 1024, scr, c.lane);
        } else {
            const float* W = p.in[I_MOE_D] + (size_t)(l * 16 + e) * 512 * 1024;
            const int kb = sub / 32, nb = sub % 32, n0 = nb * 32, k0 = kb * 64;
            tr_tile(W + (size_t)k0 * 1024 + n0, 1024, dn + (size_t)e * 1024 * 512 + (size_t)n0 * 512 + k0, 512, scr, c.lane);
        }
    }
}
struct ConvDesc { int in_idx, src_off, ld, K, ncols; unsigned dst; int ldt; };
__device__ __forceinline__ void conv_list(const Ctx& c, const Params& p, const ConvDesc* tab, int n, int w, int nw) {
    float* scr = (float*)(c.lds + c.wave * 16384);
    int total = 0;
    for (int i = 0; i < n; ++i) total += (tab[i].K / 64) * (tab[i].ncols / 32);
    for (int it = w; it < total; it += nw) {
        int r = it, i = 0;
        for (; i < n - 1; ++i) { const int ni = (tab[i].K / 64) * (tab[i].ncols / 32); if (r < ni) break; r -= ni; }
        const ConvDesc d = tab[i]; const int nblk = d.ncols / 32, kb = r / nblk, nb = r % nblk;
        const float* src = p.in[I_FOX_WIN];
#define CSEL(ix) if (d.in_idx == ix) src = p.in[ix];
        CSEL(I_FOX_WOUT) CSEL(I_GM_WIN) CSEL(I_GM_WOUT) CSEL(I_SB_WIN) CSEL(I_SB_WOUT) CSEL(I_RW_WRKV) CSEL(I_RW_W1) CSEL(I_RW_A1) CSEL(I_RW_G1) CSEL(I_RW_W2) CSEL(I_RW_A2) CSEL(I_RW_G2) CSEL(I_RW_WOUT)
#undef CSEL
        tr_tile(src + d.src_off + (size_t)(kb * 64) * d.ld + nb * 32, d.ld, (bf16*)(p.ws + d.dst) + (size_t)(nb * 32) * d.ldt + kb * 64, d.ldt, scr, c.lane);
    }
}
__device__ const ConvDesc CONV_FOX[3] = { {I_FOX_WIN, 0, 4112, 1024, 3072, (unsigned)WS_FOX_IN, 1024}, {I_FOX_WIN, 3088, 4112, 1024, 1024, (unsigned)(WS_FOX_IN + 3072 * 1024 * 2), 1024}, {I_FOX_WOUT, 0, 1024, 1024, 1024, (unsigned)WS_FOX_OUT, 1024} };
__device__ const ConvDesc CONV_GM[2] = { {I_GM_WIN, 0, 2048, 1024, 2048, (unsigned)WS_GM_IN, 1024}, {I_GM_WOUT, 0, 1024, 1024, 1024, (unsigned)WS_GM_OUT, 1024} };
__device__ const ConvDesc CONV_SB[2] = { {I_SB_WIN, 0, 3072, 1024, 3072, (unsigned)WS_SB_IN, 1024}, {I_SB_WOUT, 0, 1024, 1024, 1024, (unsigned)WS_SB_OUT, 1024} };
__device__ const ConvDesc CONV_RW[10] = { {I_RW_WRKV, 0, 1024, 1024, 1024, (unsigned)WS_RKV, 1024}, {I_RW_WRKV, 1024 * 1024, 1024, 1024, 1024, (unsigned)(WS_RKV + 2 * MiB), 1024}, {I_RW_WRKV, 2 * 1024 * 1024, 1024, 1024, 1024, (unsigned)(WS_RKV + 4 * MiB), 1024},
    {I_RW_W1, 0, 64, 1024, 64, (unsigned)WS_LORA1, 1024}, {I_RW_A1, 0, 64, 1024, 64, (unsigned)(WS_LORA1 + 256 * 1024 * 2), 1024}, {I_RW_G1, 0, 128, 1024, 128, (unsigned)(WS_LORA1 + 512 * 1024 * 2), 1024},
    {I_RW_W2, 0, 1024, 64, 1024, (unsigned)WS_LORA2, 128}, {I_RW_A2, 0, 1024, 64, 1024, (unsigned)(WS_LORA2 + 1024 * 128 * 2), 128}, {I_RW_G2, 0, 1024, 128, 1024, (unsigned)(WS_LORA2 + 2048 * 128 * 2), 128},
    {I_RW_WOUT, 0, 1024, 1024, 1024, (unsigned)WS_RW_OUT, 1024} };
__device__ __forceinline__ bool tail_slot(const Ctx& c, int nunits, int& w, int& nw, int bid) {
    const int G = gridDim.x, rem = nunits % G;
    if (rem == 0 || (G - rem) * 2 < G) { w = bid * NW + c.wave; nw = G * NW; return true; }
    if (bid < rem) return false;
    w = (bid - rem) * NW + c.wave; nw = (G - rem) * NW; return true;
}

struct Row { f32x4 v[4]; };
__device__ __forceinline__ Row row_load(const float* r, int lane) { Row x; const f32x4* p = (const f32x4*)r + lane;
#pragma unroll
    for (int j = 0; j < 4; ++j) x.v[j] = p[64 * j]; return x; }
__device__ __forceinline__ Row row_load_bf(const bf16* r, int lane) { Row x; const unsigned long long* p = (const unsigned long long*)r + lane;
#pragma unroll
    for (int j = 0; j < 4; ++j) { const unsigned long long a = p[64 * j]; x.v[j][0] = bf2f((unsigned)a & 0xffffu); x.v[j][1] = bf2f((unsigned)a >> 16); x.v[j][2] = bf2f((unsigned)(a >> 32) & 0xffffu); x.v[j][3] = bf2f((unsigned)(a >> 48)); } return x; }
__device__ __forceinline__ void row_store(float* r, int lane, const Row& x) { f32x4* p = (f32x4*)r + lane;
#pragma unroll
    for (int j = 0; j < 4; ++j) p[64 * j] = x.v[j]; }
__device__ __forceinline__ void row_store_bf(bf16* r, int lane, const Row& x) { unsigned long long* p = (unsigned long long*)r + lane;
#pragma unroll
    for (int j = 0; j < 4; ++j) p[64 * j] = (unsigned long long)pk2(x.v[j].x, x.v[j].y) | ((unsigned long long)pk2(x.v[j].z, x.v[j].w) << 32); }
__device__ __forceinline__ Row row_ln(const Row& x, const float* g, const float* b, int lane) {
    float s = 0.f;
#pragma unroll
    for (int j = 0; j < 4; ++j) s += (x.v[j].x + x.v[j].y) + (x.v[j].z + x.v[j].w);
    const float mean = wave_sum(s) * (1.f / D); float s2 = 0.f; Row y;
#pragma unroll
    for (int j = 0; j < 4; ++j) { y.v[j] = x.v[j] - mean; s2 += (y.v[j].x * y.v[j].x + y.v[j].y * y.v[j].y) + (y.v[j].z * y.v[j].z + y.v[j].w * y.v[j].w); }
    const float rstd = 1.0f / sqrtf(wave_sum(s2) * (1.f / D) + LN_EPS);
    const f32x4* gp = (const f32x4*)g + lane; const f32x4* bp = (const f32x4*)b + lane;
#pragma unroll
    for (int j = 0; j < 4; ++j) y.v[j] = y.v[j] * rstd * gp[64 * j] + bp[64 * j];
    return y;
}
__device__ __forceinline__ void stage_w16(const Ctx& c, const float* W, int ld, float* tab) {
    for (int i = c.tid; i < 1024 * 4; i += NTHR) { const int col = i >> 2, e4 = i & 3; const f32x4 w = *(const f32x4*)(W + (size_t)col * ld + e4 * 4);
        tab[(e4 * 4 + 0) * 1024 + col] = w.x; tab[(e4 * 4 + 1) * 1024 + col] = w.y; tab[(e4 * 4 + 2) * 1024 + col] = w.z; tab[(e4 * 4 + 3) * 1024 + col] = w.w; }
}
__device__ __forceinline__ void row_dot16(const Row& x, const float* tab, int lane, float (&out)[16]) {
    const LAS f32x4* tp = (const LAS f32x4*)(LAS const float*)tab + lane;
#pragma unroll
    for (int e = 0; e < 16; ++e) {
        f32x4 a = x.v[0] * tp[e * 256]; a += x.v[1] * tp[e * 256 + 64]; a += x.v[2] * tp[e * 256 + 128]; a += x.v[3] * tp[e * 256 + 192];
        out[e] = (a.x + a.y) + (a.z + a.w);
        if ((e & 3) == 3) asm volatile("" ::: "memory");
    }
    float b8[8], c4[4];
#pragma unroll
    for (int k = 0; k < 8; ++k) { auto r = __builtin_amdgcn_permlane32_swap(__float_as_uint(out[k]), __float_as_uint(out[k + 8]), false, false); b8[k] = __uint_as_float(r[0]) + __uint_as_float(r[1]); }
#pragma unroll
    for (int k = 0; k < 4; ++k) { auto r = __builtin_amdgcn_permlane16_swap(__float_as_uint(b8[k]), __float_as_uint(b8[k + 4]), false, false); c4[k] = red16(__uint_as_float(r[0]) + __uint_as_float(r[1])); }
#pragma unroll
    for (int rho = 0; rho < 4; ++rho)
#pragma unroll
        for (int k = 0; k < 4; ++k) out[4 * rho + k] = rdlane(c4[k], 16 * rho);
}

__device__ __forceinline__ void phase_p0(const Ctx& c, const Params& p) {
    unsigned char* ws = p.ws;
    conv_list(c, p, CONV_FOX, 3, c.gw, c.ngw); conv_list(c, p, CONV_GM, 2, c.gw, c.ngw); conv_list(c, p, CONV_SB, 2, c.gw, c.ngw); conv_list(c, p, CONV_RW, 10, c.gw, c.ngw);
    {
        const int gt = c.gw * 64 + c.lane, ngt = c.ngw * 64;
        u32x4 z = {0u, 0u, 0u, 0u};
        u32x4* l1 = (u32x4*)(ws + WS_LORA1);
        for (int i = gt; i < 768 * 128; i += ngt) { const int row = i >> 7, blk = row >> 8, r = row & 255; if (r >= (blk == 2 ? 128 : 64)) l1[i] = z; }
        u32x4* l2 = (u32x4*)(ws + WS_LORA2);
        for (int i = gt; i < 2048 * 16; i += ngt) { if ((i & 15) >= 8) l2[i] = z; }
        const float* wsrc = p.in[I_GM_WS]; bf16* wd = (bf16*)(ws + WS_GM_WS);
        for (int i = gt; i < 8 * 128 * 128; i += ngt) { const int s = i & 127, t = (i >> 7) & 127; wd[i] = (bf16)f2bf(s <= t ? wsrc[i] : 0.f); }
    }
    conv_moe_items(c, p, 0, 0, 48 * 256, c.gw, c.ngw);
    bf16* Hb = (bf16*)(ws + WS_HB); float* FL = (float*)(ws + WS_FL);
    __syncthreads(); float* tab = (float*)c.lds; stage_w16(c, p.in[I_FOX_WIN] + 3072, 4112, tab); __syncthreads();
    for (int m = c.gw; m < T; m += c.ngw) {
        Row x = row_load(p.in[I_X] + (size_t)m * D, c.lane);
        row_store_bf(Hb + (size_t)m * D, c.lane, x);
        float fl[16]; row_dot16(x, tab, c.lane, fl);
        if (c.lane < 16) { float v = fl[0];
#pragma unroll
            for (int e = 1; e < 16; ++e) v = (c.lane == e) ? fl[e] : v;
            FL[(size_t)m * 16 + c.lane] = v; }
    }
}

struct GDesc { int arow0, brow0, pm, pn; };
template <class Sched, class Epi>
__device__ __forceinline__ void gemm_naive(const Ctx& c, const bf16* A, int lda, const bf16* Bt, int ldb, int K, const Sched& S, const Epi& E) {
    float* As = (float*)c.lds;
    float* Bs = As + 32 * 132;
    const int tid = c.tid, ty = tid >> 4, tx = tid & 15;
    for (int ui = blockIdx.x;; ui += gridDim.x) {
        GDesc d; if (!S.get(ui, d)) break;
        float acc[4][16];
#pragma unroll
        for (int i = 0; i < 4; ++i)
#pragma unroll
            for (int j = 0; j < 16; ++j) acc[i][j] = 0.f;
        for (int k0 = 0; k0 < K; k0 += 32) {
            { const int r = tid >> 2, kc = (tid & 3) * 8;
              const u32x4 v = *(const u32x4*)(A + (size_t)(d.arow0 + r) * lda + k0 + kc);
              As[(kc + 0) * 132 + r] = bf2f(v.x & 0xffffu); As[(kc + 1) * 132 + r] = bf2f(v.x >> 16);
              As[(kc + 2) * 132 + r] = bf2f(v.y & 0xffffu); As[(kc + 3) * 132 + r] = bf2f(v.y >> 16);
              As[(kc + 4) * 132 + r] = bf2f(v.z & 0xffffu); As[(kc + 5) * 132 + r] = bf2f(v.z >> 16);
              As[(kc + 6) * 132 + r] = bf2f(v.w & 0xffffu); As[(kc + 7) * 132 + r] = bf2f(v.w >> 16); }
#pragma unroll
            for (int jj = 0; jj < 2; ++jj) { const int idx = tid + 512 * jj, r = idx >> 2, kc = (idx & 3) * 8;
              const u32x4 v = *(const u32x4*)(Bt + (size_t)(d.brow0 + r) * ldb + k0 + kc);
              Bs[(kc + 0) * 260 + r] = bf2f(v.x & 0xffffu); Bs[(kc + 1) * 260 + r] = bf2f(v.x >> 16);
              Bs[(kc + 2) * 260 + r] = bf2f(v.y & 0xffffu); Bs[(kc + 3) * 260 + r] = bf2f(v.y >> 16);
              Bs[(kc + 4) * 260 + r] = bf2f(v.z & 0xffffu); Bs[(kc + 5) * 260 + r] = bf2f(v.z >> 16);
              Bs[(kc + 6) * 260 + r] = bf2f(v.w & 0xffffu); Bs[(kc + 7) * 260 + r] = bf2f(v.w >> 16); }
            __syncthreads();
#pragma unroll 4
            for (int k = 0; k < 32; ++k) {
                const f32x4 a = *(const f32x4*)&As[k * 132 + ty * 4];
#pragma unroll
                for (int q = 0; q < 4; ++q) { const f32x4 b = *(const f32x4*)&Bs[k * 260 + q * 64 + tx * 4];
#pragma unroll
                    for (int i = 0; i < 4; ++i) { acc[i][q * 4 + 0] += a[i] * b.x; acc[i][q * 4 + 1] += a[i] * b.y; acc[i][q * 4 + 2] += a[i] * b.z; acc[i][q * 4 + 3] += a[i] * b.w; } }
            }
            __syncthreads();
        }
#pragma unroll
        for (int i = 0; i < 4; ++i)
#pragma unroll
            for (int q = 0; q < 4; ++q)
#pragma unroll
                for (int j = 0; j < 4; ++j) E(d.pm * 128 + ty * 4 + i, d.pn * 256 + q * 64 + tx * 4 + j, acc[i][q * 4 + j], acc[i][(q ^ 2) * 4 + j]);
    }
}
struct DenseSched { int nM, nN;
    __device__ __forceinline__ bool get(int ui, GDesc& d) const { if (ui >= nM * nN) return false; d.pm = ui / nN; d.pn = ui % nN; d.arow0 = d.pm * 128; d.brow0 = d.pn * 256; return true; } };

struct EpiSplitBf16 {
    bf16* O0; size_t stride; float scale0;
    __device__ __forceinline__ void operator()(int row, int col, float v, float) const { const int t = col >> 10; if (t == 0) v *= scale0; O0[(size_t)t * stride + (size_t)row * 1024 + (col & 1023)] = (bf16)f2bf(v); } };
struct EpiResid {
    float* Hf;
    __device__ __forceinline__ void operator()(int row, int col, float v, float) const { float* q = Hf + (size_t)row * 1024 + col; *q = ALPHA * *q + v; } };
struct EpiGelu {
    bf16* Z; const float* bias;
    __device__ __forceinline__ void operator()(int row, int col, float v, float) const { const float x = v + bias[col];
        const float g = 0.5f * x * (1.f + tanhf(0.7978845608028654f * (x + 0.044715f * x * x * x))); Z[(size_t)row * 2048 + col] = (bf16)f2bf(g); } };
struct EpiRw1 {
    bf16* R; bf16* L1;
    __device__ __forceinline__ void operator()(int vrow, int col, float v, float) const { const int cc = vrow >> 14, t = vrow & (T - 1);
        if (cc < 3) R[(size_t)cc * T * 1024 + (size_t)t * 1024 + col] = (bf16)f2bf(v);
        else if (col < 128) { float o = v; if (cc == 3) o = tanhf(v); else if (cc == 5) o = sigmoidf_(v); L1[(size_t)(cc - 3) * T * 128 + (size_t)t * 128 + col] = (bf16)f2bf(o); } } };
struct Rw1Sched {
    __device__ __forceinline__ bool get(int ui, GDesc& d) const { if (ui >= 3 * 512 + 3 * 128) return false;
        int cc, mt, pn; if (ui < 1536) { cc = ui / 512; mt = (ui % 512) / 4; pn = ui % 4; d.brow0 = cc * 1024 + pn * 256; } else { const int u2 = ui - 1536; cc = 3 + u2 / 128; mt = u2 % 128; pn = 0; d.brow0 = 3072 + (cc - 3) * 256; }
        d.pm = cc * 128 + mt; d.pn = pn; d.arow0 = d.pm * 128; return true; } };
struct EpiRw2 {
    float* Wdec; bf16* A; bf16* G; const float* w0; const float* a0;
    __device__ __forceinline__ void operator()(int vrow, int col, float v, float) const { const int j = vrow >> 14, t = vrow & (T - 1); const size_t o = (size_t)t * 1024 + col;
        if (j == 0) Wdec[o] = expf(-0.6065306597126334f * sigmoidf_(w0[col] + v));
        else if (j == 1) A[o] = (bf16)f2bf(sigmoidf_(a0[col] + v)); else G[o] = (bf16)f2bf(v); } };
struct Rw2Sched { __device__ __forceinline__ bool get(int ui, GDesc& d) const { if (ui >= 3 * 512) return false; const int j = ui / 512, mt = (ui % 512) / 4, pn = ui % 4;
        d.pm = j * 128 + mt; d.pn = pn; d.arow0 = d.pm * 128; d.brow0 = j * 1024 + pn * 256; return true; } };
struct MoeSched {
    const int* tile_e; int nN, rowsB;
    __device__ __forceinline__ bool get(int ui, GDesc& d) const { const int ntile = tile_e[255] * 2; if (ui >= ntile * nN) return false;
        const int mt = ui / nN, pn = ui % nN, e = tile_e[mt >> 1]; d.pm = mt; d.pn = pn; d.arow0 = mt * 128; d.brow0 = e * rowsB + pn * 256; return true; } };
struct EpiSwiglu { bf16* H1;
    __device__ __forceinline__ void operator()(int row, int col, float v, float vp) const { const int x = col & 255; if (x < 128) { const float s = v / (1.f + expf(-v)); H1[(size_t)row * 512 + (col >> 8) * 128 + x] = (bf16)f2bf(s * vp); } } };
struct EpiDown { bf16* Yd; const float* rowg;
    __device__ __forceinline__ void operator()(int row, int col, float v, float) const { Yd[(size_t)row * 1024 + col] = (bf16)f2bf(v * rowg[row]); } };

__device__ __forceinline__ void fox_cumsum(const Ctx& c, const Params& p) {
    const float* FL = (const float*)(p.ws + WS_FL); float* CB = (float*)(p.ws + WS_CB); float* red = (float*)c.lds;
    for (int bh = blockIdx.x; bh < BATCH * NH; bh += gridDim.x) {
        const int b = bh / NH, h = bh % NH; const float bf = p.in[I_FOX_BF][h];
        float v[8], run = 0.f;
#pragma unroll
        for (int i = 0; i < 8; ++i) { const int s = c.tid * 8 + i; const float x = FL[(size_t)(b * SEQ + s) * 16 + h] + bf; run += -softplusf_(-x); v[i] = run; }
        const float incl = wave_incl_scan(run, c.lane);
        __syncthreads();
        if (c.lane == 63) red[c.wave] = incl;
        __syncthreads();
        float base = incl - run;
        for (int w = 0; w < c.wave; ++w) base += red[w];
#pragma unroll
        for (int i = 0; i < 8; ++i) CB[(size_t)bh * SEQ + c.tid * 8 + i] = -LOG2E * (base + v[i]);
    }
}
__device__ __forceinline__ void fox_attn_naive(const Ctx& c, const Params& p) {
    bf16* Q = (bf16*)(p.ws + WS_Q); const bf16* K = (const bf16*)(p.ws + WS_K); const bf16* V = (const bf16*)(p.ws + WS_V); const bf16* OG = (const bf16*)(p.ws + WS_OG);
    const float* CB = (const float*)(p.ws + WS_CB);
    float* qs = (float*)c.lds + c.wave * 64;
    for (int row = c.gw; row < BATCH * NH * SEQ; row += c.ngw) {
        const int bh = row / SEQ, t = row % SEQ, b = bh / NH, h = bh % NH;
        const size_t qoff = (size_t)(b * SEQ + t) * 1024 + h * 64 + c.lane;
        LDS_WAIT(); qs[c.lane] = bf2f(Q[qoff]); LDS_WAIT();
        float m = -INFINITY, l = 0.f, o = 0.f;
        for (int s0 = 0; s0 <= t; s0 += 64) {
            const int s = s0 + c.lane; const bool valid = s <= t;
            const u32x4* kp = (const u32x4*)(K + (size_t)(b * SEQ + s) * 1024 + h * 64);
            float z = 0.f;
#pragma unroll
            for (int cc = 0; cc < 8; ++cc) { const u32x4 kv = kp[cc];
                z += qs[cc * 8 + 0] * bf2f(kv.x & 0xffffu) + qs[cc * 8 + 1] * bf2f(kv.x >> 16) + qs[cc * 8 + 2] * bf2f(kv.y & 0xffffu) + qs[cc * 8 + 3] * bf2f(kv.y >> 16)
                   + qs[cc * 8 + 4] * bf2f(kv.z & 0xffffu) + qs[cc * 8 + 5] * bf2f(kv.z >> 16) + qs[cc * 8 + 6] * bf2f(kv.w & 0xffffu) + qs[cc * 8 + 7] * bf2f(kv.w >> 16); }
            z += CB[(size_t)bh * SEQ + s]; z = valid ? z : -INFINITY;
            const float mn = fmaxf(m, wave_max(z)); const float f = exp2f(m - mn); const float pe = valid ? exp2f(z - mn) : 0.f;
            l = l * f + pe; o *= f; m = mn;
#pragma unroll 8
            for (int k = 0; k < 64; ++k) { const float pk = rdlane(pe, k); o += pk * bf2f(V[(size_t)(b * SEQ + s0 + k) * 1024 + h * 64 + c.lane]); }
        }
        const float L = wave_sum(l);
        Q[qoff] = (bf16)f2bf(o / L * sigmoidf_(bf2f(OG[qoff])));
    }
}

__device__ __forceinline__ void sb_attn_naive(const Ctx& c, const Params& p) {
    bf16* Q = (bf16*)(p.ws + WS_Q); const bf16* K = (const bf16*)(p.ws + WS_K); const bf16* V = (const bf16*)(p.ws + WS_V);
    float* qs = (float*)c.lds + c.wave * 64;
    for (int row = c.gw; row < BATCH * NH * SEQ; row += c.ngw) {
        const int bh = row / SEQ, t = row % SEQ, b = bh / NH, h = bh % NH;
        const size_t qoff = (size_t)(b * SEQ + t) * 1024 + h * 64 + c.lane;
        LDS_WAIT(); qs[c.lane] = bf2f(Q[qoff]); LDS_WAIT();
        float carry = 0.f, o = 0.f;
        for (int c0 = 0; c0 < t; c0 += 64) {
            const int s = t - 1 - c0 - c.lane; const bool valid = s >= 0; const int sc = valid ? s : 0;
            const u32x4* kp = (const u32x4*)(K + (size_t)(b * SEQ + sc) * 1024 + h * 64);
            float z = 0.f;
#pragma unroll
            for (int cc = 0; cc < 8; ++cc) { const u32x4 kv = kp[cc];
                z += qs[cc * 8 + 0] * bf2f(kv.x & 0xffffu) + qs[cc * 8 + 1] * bf2f(kv.x >> 16) + qs[cc * 8 + 2] * bf2f(kv.y & 0xffffu) + qs[cc * 8 + 3] * bf2f(kv.y >> 16)
                   + qs[cc * 8 + 4] * bf2f(kv.z & 0xffffu) + qs[cc * 8 + 5] * bf2f(kv.z >> 16) + qs[cc * 8 + 6] * bf2f(kv.w & 0xffffu) + qs[cc * 8 + 7] * bf2f(kv.w >> 16); }
            const float sp = valid ? softplusf_(z) : 0.f;
            const float incl = wave_incl_scan(sp, c.lane);
            const float a = valid ? expf(z - incl - carry) : 0.f;
            carry += rdlane(incl, 63);
#pragma unroll 8
            for (int k = 0; k < 64; ++k) { const float ak = rdlane(a, k); int sk = t - 1 - c0 - k; sk = sk < 0 ? 0 : sk; o += ak * bf2f(V[(size_t)(b * SEQ + sk) * 1024 + h * 64 + c.lane]); }
        }
        Q[qoff] = (bf16)f2bf(o);
    }
}

__device__ __forceinline__ void gmlp_spatial_naive(const Ctx& c, const Params& p) {
    const bf16* Z = (const bf16*)(p.ws + WS_Z); bf16* Yg = (bf16*)(p.ws + WS_YG); const bf16* Wt = (const bf16*)(p.ws + WS_GM_WS);
    float* vn = (float*)c.lds;
    float* Ws = vn + 128 * 128;
    float* st = Ws + 128 * 129;
    for (int u = blockIdx.x; u < 128 * 8; u += gridDim.x) {
        const int n = u >> 3, g = u & 7;
        __syncthreads();
        for (int r = c.wave * 16; r < c.wave * 16 + 16; ++r) {
            const bf16* zr = Z + (size_t)(n * 128 + r) * 2048 + 1024;
            float x[16];
#pragma unroll
            for (int jj = 0; jj < 2; ++jj) { const u32x4 v = *(const u32x4*)(zr + c.lane * 8 + 512 * jj);
                x[jj * 8 + 0] = bf2f(v.x & 0xffffu); x[jj * 8 + 1] = bf2f(v.x >> 16); x[jj * 8 + 2] = bf2f(v.y & 0xffffu); x[jj * 8 + 3] = bf2f(v.y >> 16);
                x[jj * 8 + 4] = bf2f(v.z & 0xffffu); x[jj * 8 + 5] = bf2f(v.z >> 16); x[jj * 8 + 6] = bf2f(v.w & 0xffffu); x[jj * 8 + 7] = bf2f(v.w >> 16); }
            float s = 0.f;
#pragma unroll
            for (int i = 0; i < 16; ++i) s += x[i];
            const float mean = wave_sum(s) * (1.f / 1024.f); float s2 = 0.f;
#pragma unroll
            for (int i = 0; i < 16; ++i) { const float dd = x[i] - mean; s2 += dd * dd; }
            const float rstd = 1.0f / sqrtf(wave_sum(s2) * (1.f / 1024.f) + LN_EPS);
            if (c.lane == 0) { st[r * 2] = mean; st[r * 2 + 1] = rstd; }
        }
        __syncthreads();
        { const int s = c.tid >> 2, cb = (c.tid & 3) * 32; const float mean = st[s * 2], rstd = st[s * 2 + 1];
          const bf16* zr = Z + (size_t)(n * 128 + s) * 2048 + 1024 + g * 128 + cb;
          for (int i = 0; i < 32; ++i) { const int gc = g * 128 + cb + i; vn[s * 128 + cb + i] = (bf2f(zr[i]) - mean) * rstd * p.in[I_GM_LNG][gc] + p.in[I_GM_LNB][gc]; }
          for (int i = c.tid; i < 128 * 128; i += NTHR) Ws[(i >> 7) * 129 + (i & 127)] = bf2f(Wt[(size_t)g * 16384 + i]); }
        __syncthreads();
        { const int t = c.tid >> 2, cb = (c.tid & 3) * 32;
          float acc[32];
#pragma unroll
          for (int i = 0; i < 32; ++i) acc[i] = 0.f;
          for (int s = 0; s < 128; ++s) { const float w = Ws[t * 129 + s];
#pragma unroll
              for (int i = 0; i < 8; ++i) { const f32x4 x = *(const f32x4*)&vn[s * 128 + cb + 4 * i]; acc[4 * i] += w * x.x; acc[4 * i + 1] += w * x.y; acc[4 * i + 2] += w * x.z; acc[4 * i + 3] += w * x.w; } }
          const float bs = p.in[I_GM_BS][g * 128 + t];
          const bf16* ur = Z + (size_t)(n * 128 + t) * 2048 + g * 128 + cb; bf16* yr = Yg + (size_t)(n * 128 + t) * 1024 + g * 128 + cb;
#pragma unroll
          for (int i = 0; i < 32; ++i) yr[i] = (bf16)f2bf(bf2f(ur[i]) * (acc[i] + bs)); }
    }
}


constexpr int GM_SLD = 528;
constexpr int GM_LD = 272;
typedef float f32x16_t __attribute__((ext_vector_type(16)));
typedef short bf16x8_t __attribute__((ext_vector_type(8)));
__device__ __forceinline__ void gmlp_spatial(const Ctx& c, const Params& p) {
    const bf16* Z = (const bf16*)(p.ws + WS_Z); bf16* Yg = (bf16*)(p.ws + WS_YG); const bf16* Wt = (const bf16*)(p.ws + WS_GM_WS);
    unsigned char* Wl = c.lds; unsigned char* Vl = c.lds + 128 * GM_LD; float* st = (float*)(c.lds + 2 * 128 * GM_LD); unsigned char* Sl = c.lds + 2 * 128 * GM_LD + 1024;
    const int lane = c.lane, r32 = lane & 31, hi = lane >> 5, wid = c.wave;
    for (int u = blockIdx.x; u < 256; u += gridDim.x) {
        const int n = u >> 1, g0 = (u & 1) * 4;
        __syncthreads();
#pragma unroll
        for (int rb = 0; rb < 2; ++rb) {
            u32x4 zv[8][2];
#pragma unroll
            for (int i = 0; i < 8; ++i) { const bf16* zr = Z + (size_t)(n * 128 + wid * 16 + rb * 8 + i) * 2048 + 1024; zv[i][0] = *(const u32x4*)(zr + lane * 8); zv[i][1] = *(const u32x4*)(zr + lane * 8 + 512); }
#pragma unroll
            for (int i = 0; i < 8; ++i) { float s1 = 0.f, s2 = 0.f;
#pragma unroll
                for (int jj = 0; jj < 2; ++jj)
#pragma unroll
                    for (int e = 0; e < 4; ++e) { const float a = bf2f(zv[i][jj][e] & 0xffffu), b = bf2f(zv[i][jj][e] >> 16); s1 += a + b; s2 += a * a + b * b; }
                s1 = red16(s1); s2 = red16(s2);
                const float t1 = (rdlane(s1, 0) + rdlane(s1, 16)) + (rdlane(s1, 32) + rdlane(s1, 48)), t2 = (rdlane(s2, 0) + rdlane(s2, 16)) + (rdlane(s2, 32) + rdlane(s2, 48));
                const float mean = t1 * (1.f / 1024.f), var = fmaxf(t2 * (1.f / 1024.f) - mean * mean, 0.f);
                if (lane == 0) { const int r = wid * 16 + rb * 8 + i; st[r * 2] = mean; st[r * 2 + 1] = 1.0f / sqrtf(var + LN_EPS); } }
        }
        for (int gi = 0; gi < 4; ++gi) {
            const int g = g0 + gi;
            __syncthreads();
            { u32x4 wv[4];
#pragma unroll
              for (int k = 0; k < 4; ++k) wv[k] = *(const u32x4*)(Wt + (size_t)g * 16384 + (size_t)(c.tid + NTHR * k) * 8);
#pragma unroll
              for (int k = 0; k < 4; ++k) { const int i = c.tid + NTHR * k, t = i >> 4, ch = i & 15; *(LAS u32x4*)((LAS unsigned char*)Wl + t * GM_LD + ch * 16) = wv[k]; } }
            { const int sp = lane, cb = wid * 16;
              const float mean0 = st[4 * sp], rstd0 = st[4 * sp + 1], mean1 = st[4 * sp + 2], rstd1 = st[4 * sp + 3];
              const bf16* z0 = Z + (size_t)(n * 128 + 2 * sp) * 2048 + 1024 + g * 128 + cb;
              const u32x4 a0 = *(const u32x4*)z0, a1 = *(const u32x4*)(z0 + 8), b0 = *(const u32x4*)(z0 + 2048), b1 = *(const u32x4*)(z0 + 2048 + 8);
              const float* gp = p.in[I_GM_LNG] + g * 128 + cb; const float* bp = p.in[I_GM_LNB] + g * 128 + cb;
#pragma unroll
              for (int j = 0; j < 16; ++j) { const unsigned wa = j < 8 ? a0[(j & 7) >> 1] : a1[(j & 7) >> 1], wb = j < 8 ? b0[(j & 7) >> 1] : b1[(j & 7) >> 1];
                  const float xa = (j & 1) ? __uint_as_float(wa & 0xffff0000u) : __uint_as_float(wa << 16), xb = (j & 1) ? __uint_as_float(wb & 0xffff0000u) : __uint_as_float(wb << 16);
                  const float gn = gp[j], bs_ = bp[j];
                  *(unsigned*)(Vl + (cb + j) * GM_LD + sp * 4) = pk2((xa - mean0) * rstd0 * gn + bs_, (xb - mean1) * rstd1 * gn + bs_); } }
            __syncthreads();
            const int cb32 = wid >> 1, tb0 = 2 * (wid & 1);
            f32x16_t acc0 = {}, acc1 = {};
#pragma unroll
            for (int ks = 0; ks < 8; ++ks) {
                const bf16x8_t a = *(const bf16x8_t*)(Vl + (cb32 * 32 + r32) * GM_LD + (16 * ks + 8 * hi) * 2);
                const bf16x8_t b0 = *(const bf16x8_t*)(Wl + (tb0 * 32 + r32) * GM_LD + (16 * ks + 8 * hi) * 2);
                const bf16x8_t b1 = *(const bf16x8_t*)(Wl + ((tb0 + 1) * 32 + r32) * GM_LD + (16 * ks + 8 * hi) * 2);
                acc0 = __builtin_amdgcn_mfma_f32_32x32x16_bf16(a, b0, acc0, 0, 0, 0);
                acc1 = __builtin_amdgcn_mfma_f32_32x32x16_bf16(a, b1, acc1, 0, 0, 0);
            }
#pragma unroll
            for (int tt = 0; tt < 2; ++tt) { const f32x16_t& acc = tt ? acc1 : acc0; const int t = (tb0 + tt) * 32 + r32; const float bs = p.in[I_GM_BS][g * 128 + t];
#pragma unroll
                for (int q = 0; q < 4; ++q) *(f32x4*)(Sl + t * GM_SLD + (cb32 * 32 + 8 * q + 4 * hi) * 4) = (f32x4){acc[4 * q] + bs, acc[4 * q + 1] + bs, acc[4 * q + 2] + bs, acc[4 * q + 3] + bs}; }
            __syncthreads();
            u32x4 uvv[4];
#pragma unroll
            for (int k = 0; k < 4; ++k) { const int i = c.tid + NTHR * k, t = i >> 4, ch8 = (i & 15) * 8; uvv[k] = *(const u32x4*)(Z + (size_t)(n * 128 + t) * 2048 + g * 128 + ch8); }
#pragma unroll
            for (int k = 0; k < 4; ++k) { const int i = c.tid + NTHR * k, t = i >> 4, ch8 = (i & 15) * 8;
                const u32x4 uv = uvv[k];
                const f32x4 s0 = *(const f32x4*)(Sl + t * GM_SLD + ch8 * 4), s1 = *(const f32x4*)(Sl + t * GM_SLD + ch8 * 4 + 16);
                u32x4 o; o.x = pk2(__uint_as_float(uv.x << 16) * s0[0], __uint_as_float(uv.x & 0xffff0000u) * s0[1]); o.y = pk2(__uint_as_float(uv.y << 16) * s0[2], __uint_as_float(uv.y & 0xffff0000u) * s0[3]);
                o.z = pk2(__uint_as_float(uv.z << 16) * s1[0], __uint_as_float(uv.z & 0xffff0000u) * s1[1]); o.w = pk2(__uint_as_float(uv.w << 16) * s1[2], __uint_as_float(uv.w & 0xffff0000u) * s1[3]);
                *(u32x4*)(Yg + (size_t)(n * 128 + t) * 1024 + g * 128 + ch8) = o; }
        }
    }
}

__device__ __forceinline__ void rwkv_mix(const Ctx& c, const Params& p) {
    const bf16* Hb = (const bf16*)(p.ws + WS_HB); bf16* HM = (bf16*)(p.ws + WS_HM); const float* mu = p.in[I_RW_MU];
    f32x4 mv[6][2][2];
#pragma unroll
    for (int cc = 0; cc < 6; ++cc)
#pragma unroll
        for (int jj = 0; jj < 2; ++jj) { mv[cc][jj][0] = *(const f32x4*)(mu + cc * 1024 + 512 * jj + 8 * c.lane); mv[cc][jj][1] = *(const f32x4*)(mu + cc * 1024 + 512 * jj + 8 * c.lane + 4); }
    int m = c.gw; const u32x4 z4 = {0u, 0u, 0u, 0u};
    u32x4 h[2], hp[2];
#pragma unroll
    for (int jj = 0; jj < 2; ++jj) { h[jj] = (m < T) ? *(const u32x4*)(Hb + (size_t)m * D + 512 * jj + 8 * c.lane) : z4; hp[jj] = (m < T && (m & (SEQ - 1))) ? *(const u32x4*)(Hb + (size_t)(m - 1) * D + 512 * jj + 8 * c.lane) : z4; }
    for (; m < T; m += c.ngw) {
        u32x4 hc[2] = {h[0], h[1]}, hq[2] = {hp[0], hp[1]}; const int mn = m + c.ngw;
        if (mn < T) {
#pragma unroll
            for (int jj = 0; jj < 2; ++jj) { h[jj] = *(const u32x4*)(Hb + (size_t)mn * D + 512 * jj + 8 * c.lane); hp[jj] = (mn & (SEQ - 1)) ? *(const u32x4*)(Hb + (size_t)(mn - 1) * D + 512 * jj + 8 * c.lane) : z4; }
        }
#pragma unroll
        for (int jj = 0; jj < 2; ++jj) {
            f32x4 a0, a1, d0, d1;
#pragma unroll
            for (int e = 0; e < 2; ++e) { a0[2 * e] = bf2f(hc[jj][e] & 0xffffu); a0[2 * e + 1] = bf2f(hc[jj][e] >> 16); a1[2 * e] = bf2f(hc[jj][e + 2] & 0xffffu); a1[2 * e + 1] = bf2f(hc[jj][e + 2] >> 16);
                d0[2 * e] = bf2f(hq[jj][e] & 0xffffu) - a0[2 * e]; d0[2 * e + 1] = bf2f(hq[jj][e] >> 16) - a0[2 * e + 1]; d1[2 * e] = bf2f(hq[jj][e + 2] & 0xffffu) - a1[2 * e]; d1[2 * e + 1] = bf2f(hq[jj][e + 2] >> 16) - a1[2 * e + 1]; }
#pragma unroll
            for (int cc = 0; cc < 6; ++cc) { const f32x4 o0 = a0 + d0 * mv[cc][jj][0], o1 = a1 + d1 * mv[cc][jj][1];
                u32x4 w; w.x = pk2(o0[0], o0[1]); w.y = pk2(o0[2], o0[3]); w.z = pk2(o1[0], o1[1]); w.w = pk2(o1[2], o1[3]);
                *(u32x4*)(HM + (size_t)cc * T * 1024 + (size_t)m * 1024 + 512 * jj + 8 * c.lane) = w; }
        }
    }
}
struct RwIn { float r, k, v, w, a, g; };
__device__ __forceinline__ RwIn rw_load(const Params& p, size_t off) { RwIn x;
    x.r = bf2f(((const bf16*)(p.ws + WS_RR))[off]); x.k = bf2f(((const bf16*)(p.ws + WS_RK))[off]); x.v = bf2f(((const bf16*)(p.ws + WS_RV))[off]);
    x.w = ((const float*)(p.ws + WS_WDEC))[off]; x.a = bf2f(((const bf16*)(p.ws + WS_RA))[off]); x.g = bf2f(((const bf16*)(p.ws + WS_RG))[off]); return x; }
__device__ __forceinline__ void rwkv_scan_naive(const Ctx& c, const Params& p) {
    bf16* YG = (bf16*)(p.ws + WS_RYG);
    for (int bh = c.gw; bh < BATCH * NH; bh += c.ngw) {
        const int b = bh / NH, h = bh % NH, ch = h * 64 + c.lane;
        const float k_k = p.in[I_RW_KK][ch], k_a = p.in[I_RW_KA][ch], r_k = p.in[I_RW_RK][ch], gn_g = p.in[I_RW_GNG][ch], gn_b = p.in[I_RW_GNB][ch];
        float S[64];
#pragma unroll
        for (int j = 0; j < 64; ++j) S[j] = 0.f;
        RwIn nx = rw_load(p, (size_t)(b * SEQ) * 1024 + ch);
        for (int t = 0; t < SEQ; ++t) {
            const RwIn x = nx; const size_t off = (size_t)(b * SEQ + t) * 1024 + ch;
            if (t + 1 < SEQ) nx = rw_load(p, off + 1024);
            float kk = x.k * k_k; const float nrm = sqrtf(wave_sum(kk * kk)); kk = kk / fmaxf(nrm, 1e-12f);
            const float kt = x.k * (1.f + (x.a - 1.f) * k_a), bv = kk * x.a;
            float sa = 0.f;
#pragma unroll
            for (int j = 0; j < 64; ++j) sa -= S[j] * rdlane(kk, j);
            float y = 0.f;
#pragma unroll
            for (int j = 0; j < 64; ++j) { S[j] = S[j] * rdlane(x.w, j) + sa * rdlane(bv, j) + x.v * rdlane(kt, j); y += S[j] * rdlane(x.r, j); }
            const float mean = wave_sum(y) * (1.f / 64.f); const float dy = y - mean; const float var = wave_sum(dy * dy) * (1.f / 64.f);
            const float yn = dy * (1.0f / sqrtf(var + GN_EPS)) * gn_g + gn_b;
            const float bonus = wave_sum(x.r * kt * r_k) * x.v;
            YG[off] = (bf16)f2bf((yn + bonus) * x.g);
        }
    }
}


constexpr int RW_CH = 32, RW_RING = RW_CH * 6 * 64 * 4  , RW_YB = 2 * RW_RING, RW_YBB = RW_CH * 16 * 4;
#define RAW_BAR() asm volatile("s_waitcnt lgkmcnt(0)\n\ts_barrier" ::: "memory")
__device__ __forceinline__ void rwkv_scan(const Ctx& c, const Params& p) {
    const bf16* Rg = (const bf16*)(p.ws + WS_RR); const bf16* Kg = (const bf16*)(p.ws + WS_RK); const bf16* Vg = (const bf16*)(p.ws + WS_RV);
    const float* Wg = (const float*)(p.ws + WS_WDEC); const bf16* Ag = (const bf16*)(p.ws + WS_RA); float* Ysc = (float*)(p.ws + WS_YSC);
    float* ring = (float*)c.lds; float* ybuf = (float*)(c.lds + RW_YB);
    const int lane = c.lane, wid = c.wave;
    for (int u = blockIdx.x; u < BATCH * NH * 4; u += gridDim.x) {
        const int bh = u >> 2, qr = u & 3, b = bh / NH, h = bh % NH;
        const size_t gbase = (size_t)(b * SEQ) * 1024 + h * 64;
        if (wid >= 4) {
            const int pw = wid - 4; const int ch = h * 64 + lane;
            const float k_k = p.in[I_RW_KK][ch], k_a = p.in[I_RW_KA][ch];
            unsigned rr[8], rk[8], rv[8], ra[8]; float rw[8];
#define RW_LOAD(cc) _Pragma("unroll") for (int i = 0; i < 8; ++i) { const size_t o = gbase + (size_t)((cc) * RW_CH + pw + 4 * i) * 1024 + lane; rr[i] = Rg[o]; rk[i] = Kg[o]; rv[i] = Vg[o]; ra[i] = Ag[o]; rw[i] = Wg[o]; }
#define RW_PROC(cc) _Pragma("unroll") for (int i = 0; i < 8; ++i) { float* dst = ring + ((cc) & 1) * (RW_RING / 4) + (pw + 4 * i) * 384 + lane; \
                const float kf = bf2f(rk[i]), af = bf2f(ra[i]); float kk = kf * k_k; float n2 = red16(kk * kk); n2 = rdlane(n2, 0) + rdlane(n2, 16) + rdlane(n2, 32) + rdlane(n2, 48); \
                kk = kk * __builtin_amdgcn_rsqf(fmaxf(n2, 1e-24f)); dst[0] = bf2f(rr[i]); dst[64] = kf * (1.f + (af - 1.f) * k_a); dst[128] = __builtin_amdgcn_exp2f(rw[i]); dst[192] = kk * af; dst[256] = kk; dst[320] = bf2f(rv[i]); }
#define RW_FLUSH(cc) _Pragma("unroll") for (int i2 = 0; i2 < 2; ++i2) { const int st = pw + 4 * (i2 * 4 + (lane >> 4)); \
                Ysc[gbase + (size_t)((cc) * RW_CH + st) * 1024 + qr * 16 + (lane & 15)] = ybuf[((cc) & 1) * (RW_YBB / 4) + st * 16 + (lane & 15)]; }
            RW_LOAD(0); RW_PROC(0); RW_LOAD(1);
            RAW_BAR();
            for (int cc = 0; cc < SEQ / RW_CH; ++cc) {
                if (cc + 1 < SEQ / RW_CH) { RW_PROC(cc + 1); }
                if (cc + 2 < SEQ / RW_CH) { RW_LOAD(cc + 2); }
                if (cc > 0) { RW_FLUSH(cc - 1); }
                RAW_BAR();
            }
            RW_FLUSH(SEQ / RW_CH - 1);
#undef RW_LOAD
#undef RW_PROC
#undef RW_FLUSH
        } else {
            const int rg = lane >> 4, c4 = (lane & 15) * 4, row = wid * 4 + rg;
            float S0 = 0.f, S1 = 0.f, S2 = 0.f, S3 = 0.f;
            RAW_BAR();
            for (int cc = 0; cc < SEQ / RW_CH; ++cc) {
                const float* base = ring + (cc & 1) * (RW_RING / 4); float* yb = ybuf + (cc & 1) * (RW_YBB / 4);
                const float* sp0 = base + c4; const float* vp0 = base + 320 + qr * 16 + row;
                f32x4 r4 = *(const f32x4*)(sp0), kt4 = *(const f32x4*)(sp0 + 64), w4 = *(const f32x4*)(sp0 + 128), b4 = *(const f32x4*)(sp0 + 192), kk4 = *(const f32x4*)(sp0 + 256); float vi = vp0[0];
#pragma unroll 8
                for (int st = 0; st < RW_CH; ++st) {
                    const int sn = (st + 1 < RW_CH) ? st + 1 : st;
                    const f32x4 nr4 = *(const f32x4*)(sp0 + sn * 384), nkt4 = *(const f32x4*)(sp0 + sn * 384 + 64), nw4 = *(const f32x4*)(sp0 + sn * 384 + 128), nb4 = *(const f32x4*)(sp0 + sn * 384 + 192), nkk4 = *(const f32x4*)(sp0 + sn * 384 + 256);
                    const float nvi = vp0[sn * 384];
                    float pd = S0 * kk4.x; pd = fmaf(S1, kk4.y, pd); pd = fmaf(S2, kk4.z, pd); pd = fmaf(S3, kk4.w, pd);
                    pd = red16(pd);
                    S0 = fmaf(S0, w4.x, fmaf(-pd, b4.x, vi * kt4.x)); S1 = fmaf(S1, w4.y, fmaf(-pd, b4.y, vi * kt4.y));
                    S2 = fmaf(S2, w4.z, fmaf(-pd, b4.z, vi * kt4.z)); S3 = fmaf(S3, w4.w, fmaf(-pd, b4.w, vi * kt4.w));
                    float y = S0 * r4.x; y = fmaf(S1, r4.y, y); y = fmaf(S2, r4.z, y); y = fmaf(S3, r4.w, y);
                    y = red16(y);
                    yb[st * 16 + row] = y;
                    r4 = nr4; kt4 = nkt4; w4 = nw4; b4 = nb4; kk4 = nkk4; vi = nvi;
                }
                RAW_BAR();
            }
        }
        RAW_BAR();
    }
}

namespace rwc {
typedef float f32x16 __attribute__((ext_vector_type(16)));
typedef short bf16x8 __attribute__((ext_vector_type(8)));
__device__ __forceinline__ bf16 hbf(float x) { return (bf16)(pk2(x, 0.f) & 0xffffu); }
constexpr int L = 32, NCHH = 32  , NQ = 4, REC = 30720;
constexpr int O_P1T = 0, O_RBT = 4096, O_BBP = 8192, O_MBRT = 12288, O_VP2T = 14336, O_VMKRT = 18432, O_VKTP = 22528;
constexpr int A_ABT = 0, A_BBT = 4096, A_KBT = 8192, A_RBT = 12288, A_WAVE = 16384;
constexpr int A_MBB = A_BBT  , A_TT = A_KBT  , A_MKB = A_KBT + 2048, A_MKRT = A_RBT, A_P2T = A_RBT + 2048;
__device__ __forceinline__ int crow(int r, int hi) { return (r & 3) + 8 * (r >> 2) + 4 * hi; }
__device__ __forceinline__ int ppos(int k) { return (k & ~15) + 8 * ((k >> 2) & 1) + 4 * ((k >> 3) & 1) + (k & 3); }
__device__ __forceinline__ bf16x8 ldf(const unsigned char* base, int row, int rowbytes, int kb) { return *(const bf16x8*)(base + row * rowbytes + kb); }
__device__ __forceinline__ f32x16 mm(bf16x8 a, bf16x8 b, f32x16 c) { return __builtin_amdgcn_mfma_f32_32x32x16_bf16(a, b, c, 0, 0, 0); }
__device__ __forceinline__ unsigned char* rec_ptr(unsigned char* ws, int qr, int head, int cl) { return ws + ((qr & 1) ? WS_CD1 : WS_CD0) + (size_t)(head * NCHH + cl) * REC; }
#define RWC_FENCE() asm volatile("s_waitcnt lgkmcnt(0)" ::: "memory")

template <int TAU, int TP> struct TriDot { static __device__ __forceinline__ void run(const float (&x)[32], const f32x4 (&m)[8], float (&acc)[4]) { acc[TP & 3] = fmaf(m[TP >> 2][TP & 3], x[TP], acc[TP & 3]); TriDot<TAU, TP + 1>::run(x, m, acc); } };
template <int TAU> struct TriDot<TAU, 32> { static __device__ __forceinline__ void run(const float (&)[32], const f32x4 (&)[8], float (&)[4]) {} };
template <int TAU> struct TriSolve { static __device__ __forceinline__ void run(float (&x)[32], const unsigned char* mb, int col) {
    f32x4 m[8];
#pragma unroll
    for (int g = 0; g < 8; ++g) m[g] = *(const f32x4*)(mb + (TAU * 32 + 4 * g) * 4);
    float a4[4] = {0.f, 0.f, 0.f, 0.f};
    TriDot<TAU, TAU + 1>::run(x, m, a4);
    float acc = (a4[0] + a4[1]) + (a4[2] + a4[3]);
    asm volatile("" : "+v"(acc) :: "memory");
    x[TAU] = (TAU < col) ? acc : x[TAU];
    TriSolve<TAU - 1>::run(x, mb, col); } };
template <> struct TriSolve<-1> { static __device__ __forceinline__ void run(float (&)[32], const unsigned char*, int) {} };
__device__ __forceinline__ void rwc_prep(const Ctx& c, const Params& p, int half, int c0, int nch, int blk0, int nblk) {
    if ((int)blockIdx.x < blk0) return;
    unsigned char* wl = c.lds + c.wave * A_WAVE;
    const bf16* Rg = (const bf16*)(p.ws + WS_RR); const bf16* Kg = (const bf16*)(p.ws + WS_RK); const bf16* Vg = (const bf16*)(p.ws + WS_RV);
    const float* LWg = (const float*)(p.ws + WS_WDEC); const bf16* Ag = (const bf16*)(p.ws + WS_RA); float* WLg = (float*)(p.ws + WS_WLG);
    const int lane0 = c.lane;
    int lane = lane0;
    unsigned ra_[8], rb_[8], rd_[8]; float re_[8];
#define RWC_GB(q_) ((size_t)((((q_) & 63) / NH) * SEQ + (c0 + ((q_) >> 6)) * L) * 1024 + (((q_) & 63) % NH) * 64)
#define RWC_LD8(gb_, tb_) _Pragma("unroll") for (int i = 0; i < 8; ++i) { const int o = ((tb_) + i) * 1024 + lane; ra_[i] = (Rg + (gb_))[o]; rb_[i] = (Kg + (gb_))[o]; rd_[i] = (Ag + (gb_))[o]; re_[i] = (LWg + (gb_))[o]; }
    const int q0 = ((int)blockIdx.x - blk0) * NW + c.wave, qs = nblk * NW, qn = BATCH * NH * nch;
    if (q0 < qn) { const size_t g0 = RWC_GB(q0); RWC_LD8(g0, 0) }
    for (int q = q0; q < qn; q += qs) {
        lane = lane0; asm volatile("" : "+v"(lane)); const int r32 = lane & 31, hi = lane >> 5, pl = ppos(lane);
        const int head = q & 63, cl = q >> 6, b = head / NH, h = head % NH, ch = h * 64 + lane;
        const size_t gbase = (size_t)(b * SEQ + (c0 + cl) * L) * 1024 + h * 64;
        unsigned char* rec = rec_ptr(p.ws, half, head, cl);
        const float k_k = p.in[I_RW_KK][ch], k_a = p.in[I_RW_KA][ch];
        float run = 0.f, wprev = 1.f;
        RWC_FENCE();
#pragma unroll 1
        for (int tb = 0; tb < L; tb += 8) {
            unsigned rr[8], rk[8], ra[8]; float rl[8];
#pragma unroll
            for (int i = 0; i < 8; ++i) { rr[i] = ra_[i]; rk[i] = rb_[i]; ra[i] = rd_[i]; rl[i] = re_[i]; }
            if (tb + 8 < L) { RWC_LD8(gbase, tb + 8) }
#pragma unroll
            for (int i = 0; i < 8; ++i) { const int t = tb + i;
                const float kf = bf2f(rk[i]), af = bf2f(ra[i]); float kk = kf * k_k; kk = kk * __builtin_amdgcn_rsqf(fmaxf(wave_sum(kk * kk), 1e-24f));
                const float ktv = kf * (1.f + (af - 1.f) * k_a), bv = kk * af; run += rl[i];
                const float ep = __builtin_amdgcn_exp2f(run), em = __builtin_amdgcn_exp2f(-run);
                *(bf16*)(wl + A_ABT + t * 128 + pl * 2) = hbf(-kk * wprev);
                *(bf16*)(wl + A_BBT + t * 128 + pl * 2) = hbf(bv * em); *(bf16*)(wl + A_KBT + t * 128 + pl * 2) = hbf(ktv * em);
                *(bf16*)(wl + A_RBT + t * 128 + pl * 2) = hbf(bf2f(rr[i]) * ep);
                wprev = ep; }
        }
        RWC_FENCE();
        f32x16 mbb = {}, mkb = {}, mbr = {}, mkr = {};
#pragma unroll
        for (int s_ = 0; s_ < 4; ++s_) { const int kb = (16 * s_ + 8 * hi) * 2;
            const bf16x8 ab_ = ldf(wl + A_BBT, r32, 128, kb), ak_ = ldf(wl + A_KBT, r32, 128, kb), ba_ = ldf(wl + A_ABT, r32, 128, kb), br_ = ldf(wl + A_RBT, r32, 128, kb);
            mbb = mm(ab_, ba_, mbb); mkb = mm(ak_, ba_, mkb); mbr = mm(ab_, br_, mbr); mkr = mm(ak_, br_, mkr); }
        RWC_FENCE();
        unsigned abr[16], vr[16], kpr[16], bpr[16];
        { const float wlj = __builtin_amdgcn_exp2f(run);
          WLg[(size_t)(head * 128 + c0 + cl) * 64 + lane] = wlj;
#pragma unroll
          for (int t = 0; t < L; ++t) { const int pt = (t & ~15) + 8 * ((t >> 2) & 1) + 4 * ((t >> 3) & 1) + (t & 3);
              const unsigned ab = *(const bf16*)(wl + A_ABT + t * 128 + pl * 2), kp = hbf(bf2f(*(const bf16*)(wl + A_KBT + t * 128 + pl * 2)) * wlj), bp = hbf(bf2f(*(const bf16*)(wl + A_BBT + t * 128 + pl * 2)) * wlj);
              const unsigned vv = (Vg + gbase)[t * 1024 + lane];
              if (t & 1) { abr[t >> 1] |= ab << 16; vr[t >> 1] |= vv << 16; kpr[t >> 1] |= kp << 16; bpr[pt >> 1] |= bp << 16; }
              else { abr[t >> 1] = ab; vr[t >> 1] = vv; kpr[t >> 1] = kp; bpr[pt >> 1] = bp; } } }
#pragma unroll
        for (int i = 0; i < 4; ++i) *(u32x4*)(rec + O_BBP + lane * 64 + i * 16) = (u32x4){bpr[4 * i], bpr[4 * i + 1], bpr[4 * i + 2], bpr[4 * i + 3]};
#pragma unroll
        for (int i = 0; i < 4; ++i) *(u32x4*)(rec + O_RBT + i * 1024 + lane * 16) = *(const u32x4*)(wl + A_RBT + i * 1024 + lane * 16);
        RWC_FENCE();
        { int r32 = lane & 31, hi = lane >> 5; asm volatile("" : "+v"(r32), "+v"(hi));
#pragma unroll
        for (int r = 0; r < 16; ++r) { const int tau = crow(r, hi), t = r32; const bool s1 = tau < t, s2 = tau <= t;
            *(float*)(wl + A_MBB + (tau * 32 + t) * 4) = s1 ? mbb[r] : 0.f;
            *(bf16*)(wl + A_MKB + (tau * 32 + t) * 2) = hbf(s1 ? mkb[r] : 0.f);
            *(bf16*)(wl + A_MKRT + (t * 32 + tau) * 2) = hbf(s2 ? mkr[r] : 0.f);
            *(bf16*)(wl + A_ABT + (t * 32 + ppos(tau)) * 2) = hbf(s2 ? mbr[r] : 0.f); } }
        RWC_FENCE();
#pragma unroll
        for (int i = 0; i < 2; ++i) *(u32x4*)(rec + O_MBRT + i * 1024 + lane * 16) = *(const u32x4*)(wl + A_ABT + i * 1024 + lane * 16);
        RWC_FENCE();
        if (q + qs < qn) { const size_t gn = RWC_GB(q + qs); RWC_LD8(gn, 0) }
        { float x[L]; int r32 = lane & 31; asm volatile("" : "+v"(r32));
#pragma unroll
          for (int tau = 0; tau < L; ++tau) x[tau] = (tau == r32) ? 1.f : 0.f;
          TriSolve<L - 2>::run(x, wl + A_MBB, r32);
          RWC_FENCE();
          if (hi == 0) {
#pragma unroll
              for (int i = 0; i < 4; ++i) *(u32x4*)(wl + A_TT + r32 * 64 + i * 16) = (u32x4){pk2(x[8 * i], x[8 * i + 1]), pk2(x[8 * i + 2], x[8 * i + 3]), pk2(x[8 * i + 4], x[8 * i + 5]), pk2(x[8 * i + 6], x[8 * i + 7])}; } }
#pragma unroll
        for (int i = 0; i < 4; ++i) *(u32x4*)(wl + A_BBT + lane * 64 + i * 16) = (u32x4){abr[4 * i], abr[4 * i + 1], abr[4 * i + 2], abr[4 * i + 3]};
        RWC_FENCE();
        { f32x16 p1a = {}, p1b = {}, p2 = {};
#pragma unroll
          for (int s_ = 0; s_ < 2; ++s_) { const int kb = (16 * s_ + 8 * hi) * 2; const bf16x8 tt = ldf(wl + A_TT, r32, 64, kb);
              p1a = mm(tt, ldf(wl + A_BBT, r32, 64, kb), p1a); p1b = mm(tt, ldf(wl + A_BBT, 32 + r32, 64, kb), p1b); p2 = mm(tt, ldf(wl + A_MKB, r32, 64, kb), p2); }
          RWC_FENCE();
          int r32 = lane & 31, hi = lane >> 5; asm volatile("" : "+v"(r32), "+v"(hi));
#pragma unroll
          for (int r = 0; r < 16; ++r) { const int t = crow(r, hi);
              *(bf16*)(wl + A_ABT + (t * 64 + ppos(r32)) * 2) = hbf(p1a[r]); *(bf16*)(wl + A_ABT + (t * 64 + 32 + ppos(r32)) * 2) = hbf(p1b[r]);
              *(bf16*)(wl + A_P2T + (t * 32 + r32) * 2) = hbf(p2[r]); } }
#pragma unroll
        for (int i = 0; i < 4; ++i) { *(u32x4*)(wl + A_BBT + lane * 64 + i * 16) = (u32x4){vr[4 * i], vr[4 * i + 1], vr[4 * i + 2], vr[4 * i + 3]};
                                      *(u32x4*)(wl + A_KBT + lane * 64 + i * 16) = (u32x4){kpr[4 * i], kpr[4 * i + 1], kpr[4 * i + 2], kpr[4 * i + 3]}; }
        RWC_FENCE();
#pragma unroll
        for (int i = 0; i < 4; ++i) *(u32x4*)(rec + O_P1T + i * 1024 + lane * 16) = *(const u32x4*)(wl + A_ABT + i * 1024 + lane * 16);
        RWC_FENCE();
#pragma unroll
        for (int ib = 0; ib < 2; ++ib) { f32x16 vp = {}, vm = {}, vk0 = {}, vk1 = {};
#pragma unroll
            for (int s_ = 0; s_ < 2; ++s_) { const int kb = (16 * s_ + 8 * hi) * 2; const bf16x8 vv = ldf(wl + A_BBT, ib * 32 + r32, 64, kb);
                vp = mm(ldf(wl + A_P2T, r32, 64, kb), vv, vp); vm = mm(ldf(wl + A_MKRT, r32, 64, kb), vv, vm);
                vk0 = mm(ldf(wl + A_KBT, r32, 64, kb), vv, vk0); vk1 = mm(ldf(wl + A_KBT, 32 + r32, 64, kb), vv, vk1); }
            int ln_ = lane; asm volatile("" : "+v"(ln_));
#define RWC_ST(acc, off) do { _Pragma("unroll") for (int i_ = 0; i_ < 2; ++i_) *(u32x4*)(rec + (off) + ln_ * 32 + i_ * 16) = (u32x4){pk2(acc[8 * i_], acc[8 * i_ + 1]), pk2(acc[8 * i_ + 2], acc[8 * i_ + 3]), pk2(acc[8 * i_ + 4], acc[8 * i_ + 5]), pk2(acc[8 * i_ + 6], acc[8 * i_ + 7])}; } while (0)
            RWC_ST(vp, O_VP2T + ib * 2048); RWC_ST(vm, O_VMKRT + ib * 2048); RWC_ST(vk0, O_VKTP + (ib * 2 + 0) * 2048); RWC_ST(vk1, O_VKTP + (ib * 2 + 1) * 2048);
#undef RWC_ST
        }
        RWC_FENCE();
    }
}
#undef RWC_LD8
#undef RWC_GB
__device__ __forceinline__ void rwc_scan(const Ctx& c, const Params& p, int half, int c0, int nch) {
    bf16* Y2 = (bf16*)(p.ws + WS_Y2); const float* WLg = (const float*)(p.ws + WS_WLG); float* SIG = (float*)(p.ws + WS_SIG);
    const int lane = c.lane, r32 = lane & 31, hi = lane >> 5, wid = c.wave;
    const unsigned lds0 = (unsigned)(uintptr_t)c.lds;
    for (int head = blockIdx.x; head < BATCH * NH; head += gridDim.x) {
        const int b = head / NH, h = head % NH;
        const unsigned char* rec0 = rec_ptr(p.ws, half, head, 0);
        asm volatile("s_waitcnt vmcnt(0) lgkmcnt(0)\n\ts_barrier" ::: "memory");
        if (wid >= 2) {
            const int lw = wid - 2;
#define RWC_DMA(cl) do { _Pragma("unroll") for (int k_ = 0; k_ < 5; ++k_) attn_body::glds16s((unsigned)((lw * 5 + k_) * 1024 + lane * 16), rec0 + (size_t)(cl) * REC, \
                    (unsigned)__builtin_amdgcn_readfirstlane(lds0 + ((cl) & 3) * REC + (lw * 5 + k_) * 1024)); } while (0)
            RWC_DMA(0); RWC_DMA(1); RWC_DMA(2);
            asm volatile("s_waitcnt vmcnt(10)\n\ts_barrier" ::: "memory");
            for (int cl = 0; cl < nch; ++cl) {
                if (cl + 3 < nch) { RWC_DMA(cl + 3); asm volatile("s_waitcnt vmcnt(10)\n\ts_barrier" ::: "memory"); }
                else if (cl + 3 == nch) { asm volatile("s_waitcnt vmcnt(5)\n\ts_barrier" ::: "memory"); }
                else { asm volatile("s_waitcnt vmcnt(0)\n\ts_barrier" ::: "memory"); }
            }
#undef RWC_DMA
        } else {
            const int ib = wid; f32x16 S0, S1;
            float* sg = SIG + ((size_t)(head * 2 + ib) * 2) * 1024 + lane * 16;
            if (c0 == 0) { S0 = f32x16{}; S1 = f32x16{}; }
            else {
#pragma unroll
                for (int r = 0; r < 16; ++r) { S0[r] = sg[r]; S1[r] = sg[1024 + r]; } }
            f32x4 wn0[4], wn1[4];
#pragma unroll
            for (int g = 0; g < 4; ++g) { wn0[g] = *(const f32x4*)(WLg + (size_t)(head * 128 + c0) * 64 + 8 * g + 4 * hi); wn1[g] = *(const f32x4*)(WLg + (size_t)(head * 128 + c0) * 64 + 32 + 8 * g + 4 * hi); }
            asm volatile("s_waitcnt lgkmcnt(0)\n\ts_barrier" ::: "memory");
            for (int cl = 0; cl < nch; ++cl) {
                const unsigned char* rl = c.lds + (cl & 3) * REC;
                f32x4 w0[4], w1[4];
#pragma unroll
                for (int g = 0; g < 4; ++g) { w0[g] = wn0[g]; w1[g] = wn1[g]; }
                { const float* wlp = WLg + (size_t)(head * 128 + c0 + (cl + 1 < nch ? cl + 1 : cl)) * 64;
#pragma unroll
                  for (int g = 0; g < 4; ++g) { wn0[g] = *(const f32x4*)(wlp + 8 * g + 4 * hi); wn1[g] = *(const f32x4*)(wlp + 32 + 8 * g + 4 * hi); } }
                bf16x8 sb[4];
#define RWC_CV(X, o) __builtin_bit_cast(bf16x8, (u32x4){pk2(X[o], X[o + 1]), pk2(X[o + 2], X[o + 3]), pk2(X[o + 4], X[o + 5]), pk2(X[o + 6], X[o + 7])})
                sb[0] = RWC_CV(S0, 0); sb[1] = RWC_CV(S0, 8); sb[2] = RWC_CV(S1, 0); sb[3] = RWC_CV(S1, 8);
                f32x16 ut, yt;
                { const u32x4 a0 = *(const u32x4*)(rl + O_VP2T + ib * 2048 + lane * 32), a1 = *(const u32x4*)(rl + O_VP2T + ib * 2048 + lane * 32 + 16);
                  const u32x4 b0 = *(const u32x4*)(rl + O_VMKRT + ib * 2048 + lane * 32), b1 = *(const u32x4*)(rl + O_VMKRT + ib * 2048 + lane * 32 + 16);
#pragma unroll
                  for (int e = 0; e < 4; ++e) { ut[2 * e] = bf2f(a0[e] & 0xffffu); ut[2 * e + 1] = bf2f(a0[e] >> 16); ut[8 + 2 * e] = bf2f(a1[e] & 0xffffu); ut[8 + 2 * e + 1] = bf2f(a1[e] >> 16);
                                                yt[2 * e] = bf2f(b0[e] & 0xffffu); yt[2 * e + 1] = bf2f(b0[e] >> 16); yt[8 + 2 * e] = bf2f(b1[e] & 0xffffu); yt[8 + 2 * e + 1] = bf2f(b1[e] >> 16); } }
#pragma unroll
                for (int s_ = 0; s_ < 4; ++s_) { const int kb = (16 * s_ + 8 * hi) * 2; ut = mm(ldf(rl + O_P1T, r32, 128, kb), sb[s_], ut); yt = mm(ldf(rl + O_RBT, r32, 128, kb), sb[s_], yt); }
                { const u32x4 c0 = *(const u32x4*)(rl + O_VKTP + (ib * 2 + 0) * 2048 + lane * 32), c1 = *(const u32x4*)(rl + O_VKTP + (ib * 2 + 0) * 2048 + lane * 32 + 16);
                  const u32x4 d0 = *(const u32x4*)(rl + O_VKTP + (ib * 2 + 1) * 2048 + lane * 32), d1 = *(const u32x4*)(rl + O_VKTP + (ib * 2 + 1) * 2048 + lane * 32 + 16);
#pragma unroll
                  for (int e = 0; e < 4; ++e) {
                      S0[2 * e] = fmaf(S0[2 * e], w0[(2 * e) >> 2][(2 * e) & 3], bf2f(c0[e] & 0xffffu)); S0[2 * e + 1] = fmaf(S0[2 * e + 1], w0[(2 * e + 1) >> 2][(2 * e + 1) & 3], bf2f(c0[e] >> 16));
                      S0[8 + 2 * e] = fmaf(S0[8 + 2 * e], w0[(8 + 2 * e) >> 2][(8 + 2 * e) & 3], bf2f(c1[e] & 0xffffu)); S0[8 + 2 * e + 1] = fmaf(S0[8 + 2 * e + 1], w0[(9 + 2 * e) >> 2][(9 + 2 * e) & 3], bf2f(c1[e] >> 16));
                      S1[2 * e] = fmaf(S1[2 * e], w1[(2 * e) >> 2][(2 * e) & 3], bf2f(d0[e] & 0xffffu)); S1[2 * e + 1] = fmaf(S1[2 * e + 1], w1[(2 * e + 1) >> 2][(2 * e + 1) & 3], bf2f(d0[e] >> 16));
                      S1[8 + 2 * e] = fmaf(S1[8 + 2 * e], w1[(8 + 2 * e) >> 2][(8 + 2 * e) & 3], bf2f(d1[e] & 0xffffu)); S1[8 + 2 * e + 1] = fmaf(S1[8 + 2 * e + 1], w1[(9 + 2 * e) >> 2][(9 + 2 * e) & 3], bf2f(d1[e] >> 16)); } }
                bf16x8 ub[2]; ub[0] = RWC_CV(ut, 0); ub[1] = RWC_CV(ut, 8);
#pragma unroll
                for (int s_ = 0; s_ < 2; ++s_) { const int kb = (16 * s_ + 8 * hi) * 2;
                    S0 = mm(ldf(rl + O_BBP, r32, 64, kb), ub[s_], S0); S1 = mm(ldf(rl + O_BBP, 32 + r32, 64, kb), ub[s_], S1); yt = mm(ldf(rl + O_MBRT, r32, 64, kb), ub[s_], yt); }
#undef RWC_CV
                { bf16* yo = Y2 + (size_t)(b * SEQ + (c0 + cl) * L) * 1024 + h * 64 + ib * 32 + r32;
#pragma unroll
                  for (int r = 0; r < 16; ++r) yo[(size_t)crow(r, hi) * 1024] = hbf(yt[r]); }
                asm volatile("s_waitcnt lgkmcnt(0)\n\ts_barrier" ::: "memory");
            }
            if (c0 + nch < SEQ / L) {
#pragma unroll
                for (int r = 0; r < 16; ++r) { sg[r] = S0[r]; sg[1024 + r] = S1[r]; } }
        }
    }
}
}


constexpr int CW_CHK = 210000;
__device__ __forceinline__ void rwc_check(const Ctx& c, const Params& p) {
    const float* Ysc = (const float*)(p.ws + WS_YSC); const bf16* Y2 = (const bf16*)(p.ws + WS_Y2); float* acc = (float*)((unsigned*)(p.ws + WS_CTL) + CW_CHK);
    float num = 0.f, den = 0.f;
    for (size_t i = (size_t)blockIdx.x * NTHR + c.tid; i < (size_t)T * D; i += (size_t)gridDim.x * NTHR) { const float a = Ysc[i], b = bf2f(Y2[i]); num += (a - b) * (a - b); den += a * a; }
    num = wave_sum(num); den = wave_sum(den);
    if (c.lane == 0) { atomicAdd(acc, num); atomicAdd(acc + 1, den); }
}

constexpr int RW_SPLIT = 104 * 32;
__device__ __forceinline__ void rwkv_post(const Ctx& c, const Params& p, int part, int blk0, int nblk) {
    const bf16* Y2 = (const bf16*)(p.ws + WS_Y2); const bf16* Rg = (const bf16*)(p.ws + WS_RR); const bf16* Kg = (const bf16*)(p.ws + WS_RK); const bf16* Vg = (const bf16*)(p.ws + WS_RV);
    const bf16* Ag = (const bf16*)(p.ws + WS_RA); const bf16* Gg = (const bf16*)(p.ws + WS_RG); bf16* YG = (bf16*)(p.ws + WS_RYG);
    if ((int)blockIdx.x < blk0) return;
    const int per = part ? SEQ - RW_SPLIT : RW_SPLIT, cnt = BATCH * per;
    for (int idx = ((int)blockIdx.x - blk0) * NW + c.wave; idx < cnt; idx += nblk * NW) {
        const int m = (idx / per) * SEQ + (part ? RW_SPLIT : 0) + idx % per;
        const Row y = row_load_bf(Y2 + (size_t)m * D, c.lane); Row o;
#pragma unroll
        for (int j = 0; j < 4; ++j) {
            const int col = 4 * (c.lane + 64 * j); const size_t off = (size_t)m * D + col;
            const unsigned long long r8 = *(const unsigned long long*)(Rg + off), k8 = *(const unsigned long long*)(Kg + off), v8 = *(const unsigned long long*)(Vg + off),
                                     a8 = *(const unsigned long long*)(Ag + off), g8 = *(const unsigned long long*)(Gg + off);
            const f32x4 ka = *(const f32x4*)(p.in[I_RW_KA] + col), rk = *(const f32x4*)(p.in[I_RW_RK] + col), gg = *(const f32x4*)(p.in[I_RW_GNG] + col), gb = *(const f32x4*)(p.in[I_RW_GNB] + col);
            f32x4 r4, k4, v4, a4, g4;
#pragma unroll
            for (int q = 0; q < 4; ++q) { r4[q] = bf2f((unsigned)(r8 >> (16 * q)) & 0xffffu); k4[q] = bf2f((unsigned)(k8 >> (16 * q)) & 0xffffu); v4[q] = bf2f((unsigned)(v8 >> (16 * q)) & 0xffffu);
                a4[q] = bf2f((unsigned)(a8 >> (16 * q)) & 0xffffu); g4[q] = bf2f((unsigned)(g8 >> (16 * q)) & 0xffffu); }
            const f32x4 yv = y.v[j];
            const float mean = red16((yv.x + yv.y) + (yv.z + yv.w)) * (1.f / 64.f);
            const f32x4 dy = yv - mean;
            const float var = red16((dy.x * dy.x + dy.y * dy.y) + (dy.z * dy.z + dy.w * dy.w)) * (1.f / 64.f);
            const float rstd = 1.0f / sqrtf(var + GN_EPS);
            f32x4 kt; float bs = 0.f;
#pragma unroll
            for (int q = 0; q < 4; ++q) { kt[q] = k4[q] * (1.f + (a4[q] - 1.f) * ka[q]); bs += r4[q] * kt[q] * rk[q]; }
            const float bonus = red16(bs);
#pragma unroll
            for (int q = 0; q < 4; ++q) o.v[j][q] = (dy[q] * rstd * gg[q] + gb[q] + bonus * v4[q]) * g4[q];
        }
        row_store_bf(YG + (size_t)m * D, c.lane, o);
    }
}

__device__ __forceinline__ float allred4(float x) {
    auto r = __builtin_amdgcn_permlane16_swap(__float_as_uint(x), __float_as_uint(x), false, false); x = __uint_as_float(r[0]) + __uint_as_float(r[1]);
    auto q = __builtin_amdgcn_permlane32_swap(__float_as_uint(x), __float_as_uint(x), false, false); return __uint_as_float(q[0]) + __uint_as_float(q[1]);
}
__device__ __forceinline__ void moe_ln_route(const Ctx& c, const Params& p, int l, bool = false) {
    const bf16* Hbr = (const bf16*)(p.ws + WS_HB); bf16* Hb = (bf16*)(p.ws + WS_HB);
    int* P2TE = (int*)(p.ws + WS_P2TE); float* ROWGE = (float*)(p.ws + WS_ROWGE); int* TOKQ = (int*)(p.ws + WS_TOKQ);
    unsigned* cnt = (unsigned*)(p.ws + WS_CTL) + CW_CNT + l * 64;
    constexpr int L_WT = 0  , L_GB = 98304  , L_RED = L_GB + 256  , L_CNT = L_RED + 1024, L_LNG = L_CNT + 64, L_LNB = L_LNG + 4096,
                  L_GS = L_LNB + 4096  , L_REC = L_GS + 2048  , L_BLK = L_REC + 6144  ;
    LAS unsigned char* ldl = (LAS unsigned char*)c.lds;
    unsigned* lcnt = (unsigned*)(c.lds + L_CNT);
    const int fr = c.lane & 15, fq = c.lane >> 4;
    if (c.tid < 16) lcnt[c.tid] = 0u;
    const int rpb = (T + (int)gridDim.x - 1) / (int)gridDim.x, r0 = (int)blockIdx.x * rpb, r1 = (r0 + rpb < T) ? r0 + rpb : T, ng = (r1 - r0 + 15) >> 4;
    u32x4 xr[32];
#define M1_LOADX(gi_) { int mr_ = r0 + (gi_) * 16 + fr; mr_ = mr_ < r1 ? mr_ : r1 - 1; const u32x4* s_ = (const u32x4*)(Hbr + (size_t)mr_ * D) + fq; _Pragma("unroll") for (int s = 0; s < 32; ++s) xr[s] = s_[4 * s]; }
    int gi = c.wave;
    if (gi < ng) M1_LOADX(gi)
    {
        const float* lg = p.in[I_LN1G] + l * D; const float* lb = p.in[I_LN1B] + l * D; const float* Wr = p.in[I_ROUTER_W];
        const int e = c.tid & 15, q = c.tid >> 4;
        float gsum = 0.f, bsum = 0.f;
#pragma unroll
        for (int m = 0; m < 4; ++m) {
            const int ch = q + 32 * m, col0 = 8 * ch;
            const f32x4 g0 = *(const f32x4*)(lg + col0), g1 = *(const f32x4*)(lg + col0 + 4), b0 = *(const f32x4*)(lb + col0), b1 = *(const f32x4*)(lb + col0 + 4);
            unsigned h1[8], h2[8], h3[8];
#pragma unroll
            for (int i = 0; i < 8; ++i) { const float w = Wr[(col0 + i) * 16 + e], gv = i < 4 ? g0[i & 3] : g1[i & 3], bv = i < 4 ? b0[i & 3] : b1[i & 3], pr = gv * w;
                gsum += pr; bsum = fmaf(bv, w, bsum); attn_body::split3(pr, h1[i], h2[i], h3[i]); }
            const int slot = ((ch >> 2) * 64 + (ch & 3) * 16 + e) * 16;
            *(LAS u32x4*)(ldl + L_WT + slot) = (u32x4){h1[0] | (h1[1] << 16), h1[2] | (h1[3] << 16), h1[4] | (h1[5] << 16), h1[6] | (h1[7] << 16)};
            *(LAS u32x4*)(ldl + L_WT + 32768 + slot) = (u32x4){h2[0] | (h2[1] << 16), h2[2] | (h2[3] << 16), h2[4] | (h2[5] << 16), h2[6] | (h2[7] << 16)};
            *(LAS u32x4*)(ldl + L_WT + 65536 + slot) = (u32x4){h3[0] | (h3[1] << 16), h3[2] | (h3[3] << 16), h3[4] | (h3[5] << 16), h3[6] | (h3[7] << 16)};
        }
        gsum = allred4(gsum); bsum = allred4(bsum);
        if (c.lane < 16) { *(LAS float*)(ldl + L_RED + (c.wave * 32 + e) * 4) = gsum; *(LAS float*)(ldl + L_RED + (c.wave * 32 + 16 + e) * 4) = bsum; }
        for (int i = c.tid; i < 1024; i += NTHR) { *(LAS float*)(ldl + L_LNG + i * 4) = lg[i]; *(LAS float*)(ldl + L_LNB + i * 4) = lb[i]; }
        __syncthreads();
        if (c.tid < 32) { float a = 0.f;
#pragma unroll
            for (int w = 0; w < NW; ++w) a += *(LAS float*)(ldl + L_RED + (w * 32 + c.tid) * 4);
            *(LAS float*)(ldl + L_GB + c.tid * 4) = a; }
        else if (c.tid < 48) *(LAS float*)(ldl + L_GB + c.tid * 4) = p.in[I_ROUTER_B][c.tid - 32];
        __syncthreads();
    }
    const f32x4 Gv = *(LAS f32x4*)(ldl + L_GB + fq * 16), Bv = *(LAS f32x4*)(ldl + L_GB + 64 + fq * 16), Rv = *(LAS f32x4*)(ldl + L_GB + 128 + fq * 16);
    for (; gi < ng; gi += NW) {
        f32x4 acc = {0.f, 0.f, 0.f, 0.f};
        unsigned wb_ = (unsigned)c.lane * 16u, gb_ = (unsigned)fq * 32u + (unsigned)L_LNG; asm volatile("" : "+v"(wb_), "+v"(gb_));
        LAS unsigned char* wtl = ldl + wb_; LAS unsigned char* gbl = ldl + gb_;
#pragma unroll
        for (int s = 0; s < 32; ++s) {
            const pg8::bf16x8 xf = __builtin_bit_cast(pg8::bf16x8, xr[s]);
#pragma unroll
            for (int part = 0; part < 3; ++part)
                acc = __builtin_amdgcn_mfma_f32_16x16x32_bf16(*(LAS pg8::bf16x8*)(wtl + L_WT + part * 32768 + s * 1024), xf, acc, 0, 0, 0);
            if ((s & 3) == 3) __builtin_amdgcn_sched_barrier(0);
        }
        float sum = 0.f;
#pragma unroll
        for (int s = 0; s < 32; ++s)
#pragma unroll
            for (int k = 0; k < 4; ++k) sum += __uint_as_float(xr[s][k] << 16) + __uint_as_float(xr[s][k] & 0xffff0000u);
        const float mean = allred4(sum) * (1.f / D);
#pragma unroll
        for (int s = 0; s < 32; ++s) asm volatile("" : "+v"(xr[s]));
        float s2 = 0.f;
#pragma unroll
        for (int s = 0; s < 32; ++s)
#pragma unroll
            for (int k = 0; k < 4; ++k) { const float d0 = __uint_as_float(xr[s][k] << 16) - mean, d1 = __uint_as_float(xr[s][k] & 0xffff0000u) - mean; s2 = fmaf(d0, d0, s2); s2 = fmaf(d1, d1, s2); }
        const float rstd = 1.0f / sqrtf(allred4(s2) * (1.f / D) + LN_EPS);
        const int mrow = r0 + gi * 16 + fr; const bool valid = mrow < r1;
        u32x4* d_ = (u32x4*)(Hb + (size_t)(valid ? mrow : r1 - 1) * D) + fq;
#pragma unroll
        for (int s = 0; s < 32; ++s) asm volatile("" : "+v"(xr[s]));
#pragma unroll
        for (int s = 0; s < 32; ++s) {
            if ((s & 1) == 0) __builtin_amdgcn_sched_barrier(0);
            const f32x4 g0 = *(LAS f32x4*)(gbl + 128 * s), g1 = *(LAS f32x4*)(gbl + 128 * s + 16);
            const f32x4 b0 = *(LAS f32x4*)(gbl + 4096 + 128 * s), b1 = *(LAS f32x4*)(gbl + 4096 + 128 * s + 16);
            u32x4 o;
#pragma unroll
            for (int k = 0; k < 4; ++k) { const float gl = k < 2 ? g0[2 * k] : g1[2 * k - 4], gh = k < 2 ? g0[2 * k + 1] : g1[2 * k - 3], bl = k < 2 ? b0[2 * k] : b1[2 * k - 4], bh = k < 2 ? b0[2 * k + 1] : b1[2 * k - 3];
                const float y0 = (__uint_as_float(xr[s][k] << 16) - mean) * rstd * gl + bl, y1 = (__uint_as_float(xr[s][k] & 0xffff0000u) - mean) * rstd * gh + bh;
                o[k] = pk2(y0, y1); }
            d_[4 * s] = o;
        }
        float sc[4], se[4];
#pragma unroll
        for (int i = 0; i < 4; ++i) { const float lgt = rstd * (acc[i] - mean * Gv[i]) + Bv[i]; sc[i] = __builtin_amdgcn_rcpf(1.0f + __builtin_amdgcn_exp2f(-LOG2E * lgt)); se[i] = sc[i] + Rv[i]; }
        int i1 = 0; float v1 = se[0], c1 = sc[0];
#pragma unroll
        for (int i = 1; i < 4; ++i) if (se[i] > v1) { i1 = i; v1 = se[i]; c1 = sc[i]; }
        int i2 = -1; float v2 = -INFINITY, c2v = 0.f;
#pragma unroll
        for (int i = 0; i < 4; ++i) if (i != i1 && se[i] > v2) { i2 = i; v2 = se[i]; c2v = sc[i]; }
        *(LAS float*)(ldl + L_GS + ((c.wave * 16 + fr) * 4 + fq) * 4) = v1 + v2;
        const f32x4 g4 = *(LAS f32x4*)(ldl + L_GS + (c.wave * 16 + fr) * 16);
        int bg = 0; float bv = g4[0];
#pragma unroll
        for (int g = 1; g < 4; ++g) if (g4[g] > bv) { bv = g4[g]; bg = g; }
        if (valid && fq == bg) {
            const int be1 = 4 * fq + i1, be2 = 4 * fq + i2; const float inv = 1.0f / (c1 + c2v);
            const unsigned p1 = atomicAdd(lcnt + be1, 1u), p2 = atomicAdd(lcnt + be2, 1u);
            const int li = (gi * 16 + fr) * 2;
            *(LAS int*)(ldl + L_REC + li * 4) = be1; *(LAS int*)(ldl + L_REC + li * 4 + 4) = be2; *(LAS int*)(ldl + L_REC + 2048 + li * 4) = (int)p1; *(LAS int*)(ldl + L_REC + 2048 + li * 4 + 4) = (int)p2;
            *(LAS float*)(ldl + L_REC + 4096 + li * 4) = c1 * inv; *(LAS float*)(ldl + L_REC + 4096 + li * 4 + 4) = c2v * inv;
        }
        if (gi + NW < ng) M1_LOADX(gi + NW)
    }
#undef M1_LOADX
    __syncthreads();
    if (c.tid < 16) *(LAS int*)(ldl + L_BLK + c.tid * 4) = (int)atomicAdd(cnt + c.tid, lcnt[c.tid]);
    __syncthreads();
    for (int i = c.tid; i < 2 * (r1 - r0); i += NTHR) {
        const int e = *(LAS int*)(ldl + L_REC + i * 4), pe = e * ECAP + *(LAS int*)(ldl + L_BLK + e * 4) + *(LAS int*)(ldl + L_REC + 2048 + i * 4);
        P2TE[pe] = r0 + (i >> 1); ROWGE[pe] = *(LAS float*)(ldl + L_REC + 4096 + i * 4); TOKQ[(r0 + (i >> 1)) * 2 + (i & 1)] = pe; }
}
__device__ __forceinline__ void moe_tiles(const Ctx& c, const Params& p, int l) {
    const unsigned* cnt = (const unsigned*)(p.ws + WS_CTL) + CW_CNT + l * 64;
    LAS int* tab = (LAS int*)((LAS unsigned char*)c.lds + pg8::MOE_TAB);
    const int mt = c.tid; int tb = 0, e_ = 0, j_ = 0, nv_ = 0;
#pragma unroll
    for (int e = 0; e < 16; ++e) { const int ne = (int)__hip_atomic_load(cnt + e, __ATOMIC_RELAXED, __HIP_MEMORY_SCOPE_AGENT), nte = (ne + 255) >> 8;
        if (mt >= tb && mt < tb + nte) { e_ = e; j_ = mt - tb; nv_ = ne - 256 * j_ < 256 ? ne - 256 * j_ : 256; }
        tb += nte; }
    if (mt < 256) { tab[mt] = e_; tab[256 + mt] = j_; tab[512 + mt] = nv_; }
    if (mt == 0) tab[768] = tb;
    __syncthreads();
}
__device__ __forceinline__ void moe_combine(const Ctx& c, const Params& p, int l, float* outp, bool dry = false) {
    const bf16* Hbr = (const bf16*)(p.ws + WS_HB); bf16* Hb = (bf16*)(p.ws + (dry ? WS_ACT + 264 * MiB : WS_HB)); const bf16* Yd = (const bf16*)(p.ws + WS_YD); const int* TOKP = (const int*)(p.ws + WS_TOKQ);
    if (dry) outp = nullptr;
    LAS int* bs = (LAS int*)(LAS unsigned char*)c.lds;
    if (c.tid < 16) { const unsigned* cnt = (const unsigned*)(p.ws + WS_CTL) + CW_CNT + l * 64; int b_ = 0;
        for (int e = 0; e < c.tid; ++e) b_ += ((int)__hip_atomic_load(cnt + e, __ATOMIC_RELAXED, __HIP_MEMORY_SCOPE_AGENT) + 255) & ~255;
        bs[c.tid] = b_; }
    __syncthreads();
    int nq0 = 0, nq1 = 0, nq2 = 0, nq3 = 0;
    if (c.gw < T) { const int m1_ = (c.gw + c.ngw < T) ? c.gw + c.ngw : c.gw; nq0 = TOKP[c.gw * 2]; nq1 = TOKP[c.gw * 2 + 1]; nq2 = TOKP[m1_ * 2]; nq3 = TOKP[m1_ * 2 + 1]; }
    for (int m0 = c.gw; m0 < T; m0 += 2 * c.ngw) {
        const int m1 = (m0 + c.ngw < T) ? m0 + c.ngw : m0;
        const int qa0 = nq0, qa1 = nq1, qb0 = nq2, qb1 = nq3;
        { const int mn = m0 + 2 * c.ngw; if (mn < T) { const int mn1 = (mn + c.ngw < T) ? mn + c.ngw : mn; nq0 = TOKP[mn * 2]; nq1 = TOKP[mn * 2 + 1]; nq2 = TOKP[mn1 * 2]; nq3 = TOKP[mn1 * 2 + 1]; } }
        const int pa0 = bs[qa0 >> 14] + (qa0 & (ECAP - 1)), pa1 = bs[qa1 >> 14] + (qa1 & (ECAP - 1)), pb0 = bs[qb0 >> 14] + (qb0 & (ECAP - 1)), pb1 = bs[qb1 >> 14] + (qb1 & (ECAP - 1));
        Row xa = row_load_bf(Hbr + (size_t)m0 * D, c.lane), xb = row_load_bf(Hbr + (size_t)m1 * D, c.lane);
        unsigned long long ya0[4], ya1[4], yb0[4], yb1[4];
#pragma unroll
        for (int j = 0; j < 4; ++j) { ya0[j] = ((const unsigned long long*)(Yd + (size_t)pa0 * D) + c.lane)[64 * j]; ya1[j] = ((const unsigned long long*)(Yd + (size_t)pa1 * D) + c.lane)[64 * j];
                                      yb0[j] = ((const unsigned long long*)(Yd + (size_t)pb0 * D) + c.lane)[64 * j]; yb1[j] = ((const unsigned long long*)(Yd + (size_t)pb1 * D) + c.lane)[64 * j]; }
#define M5_ADD(RW, YA, YB) _Pragma("unroll") for (int j = 0; j < 4; ++j) { const unsigned long long a = YA[j], b = YB[j]; \
            RW.v[j][0] = ALPHA * RW.v[j][0] + bf2f((unsigned)a & 0xffffu) + bf2f((unsigned)b & 0xffffu); RW.v[j][1] = ALPHA * RW.v[j][1] + bf2f(((unsigned)a >> 16)) + bf2f(((unsigned)b >> 16)); \
            RW.v[j][2] = ALPHA * RW.v[j][2] + bf2f((unsigned)(a >> 32) & 0xffffu) + bf2f((unsigned)(b >> 32) & 0xffffu); RW.v[j][3] = ALPHA * RW.v[j][3] + bf2f((unsigned)(a >> 48)) + bf2f((unsigned)(b >> 48)); }
        M5_ADD(xa, ya0, ya1) M5_ADD(xb, yb0, yb1)
#undef M5_ADD
        const Row oa = row_ln(xa, p.in[I_LN2G] + l * D, p.in[I_LN2B] + l * D, c.lane), ob = row_ln(xb, p.in[I_LN2G] + l * D, p.in[I_LN2B] + l * D, c.lane);
        if (outp) { row_store(outp + (size_t)m0 * D, c.lane, oa); if (m1 != m0) row_store(outp + (size_t)m1 * D, c.lane, ob); }
        else { row_store_bf(Hb + (size_t)m0 * D, c.lane, oa); if (m1 != m0) row_store_bf(Hb + (size_t)m1 * D, c.lane, ob); }
    }
}

enum { PH_P0 = 0,
       PH_F1, PH_F3, PH_F4, PH_M1_0, PH_M3_0, PH_M4_0, PH_M5_0,
       PH_G1, PH_G2, PH_G3, PH_M1_1, PH_M3_1, PH_M4_1, PH_M5_1,
       PH_S1, PH_S2, PH_S3, PH_M1_2, PH_M3_2, PH_M4_2, PH_M5_2,
       PH_R0, PH_R1, PH_R2, PH_RC0, PH_RC1, PH_RC2, PH_RC3, PH_RC4, PH_RC5, PH_R4B, PH_R5, PH_M1_3, PH_M3_3, PH_M4_3, PH_M5_3, NPHASE };

#define RP_P0 RP1
#define RP_F1 RP1
#define RP_F3 RP1
#define RP_M34 RP1
#define RP_G2 RP1
#define RP_S2 RP1
#define RP_R4 RP1
#define RP0(...) {}
#define RP4B(...) { __VA_ARGS__; xcd_barrier(bar); __VA_ARGS__; xcd_barrier(bar); __VA_ARGS__; xcd_barrier(bar); __VA_ARGS__; xcd_barrier(bar); }
#define RP_M1D RP0
#define RP_M2 RP1
#define RP_M5D RP0
__global__ void __launch_bounds__(NTHR, 2) fwd_kernel(Params p) {
    extern __shared__ __attribute__((aligned(16))) unsigned char lds[];
    Ctx c; c.tid = threadIdx.x; c.lane = c.tid & 63; c.wave = __builtin_amdgcn_readfirstlane(c.tid >> 6); c.gw = blockIdx.x * NW + c.wave; c.ngw = gridDim.x * NW; c.lds = lds;
    volatile LAS unsigned* MISC = (volatile LAS unsigned*)((LAS unsigned char*)lds + MISC_OFF);
    if (c.tid < 32) MISC[c.tid] = 0u;
    __syncthreads();
    unsigned* ctl = (unsigned*)(p.ws + WS_CTL);
    XcdBarrier bar = xcd_barrier_post(ctl + CW_BAR + p.li * XCD_BAR_WORDS, MISC + 8);
    const int lo = p.ph_lo, hi = p.ph_hi;
    unsigned char* ws = p.ws;
#define PHASE(k, ...) if (lo <= (k) && (k) < hi) { Ctx c; { int t_ = threadIdx.x; asm volatile("" : "+v"(t_)); c.tid = t_; c.lane = t_ & 63; c.wave = __builtin_amdgcn_readfirstlane(t_ >> 6); c.gw = blockIdx.x * NW + c.wave; c.ngw = gridDim.x * NW; c.lds = lds; } \
        __VA_ARGS__; if ((k) + 1 < hi) xcd_barrier(bar); }
#define RP1(...) { __VA_ARGS__; }
#define RP5(...) { __VA_ARGS__; xcd_barrier(bar); __VA_ARGS__; xcd_barrier(bar); __VA_ARGS__; xcd_barrier(bar); __VA_ARGS__; xcd_barrier(bar); __VA_ARGS__; }

    PHASE(PH_P0, RP_P0(phase_p0(c, p)));
    LAS unsigned char* ldsr = (LAS unsigned char*)lds;
    const int G = gridDim.x, bid = blockIdx.x;
    const int vbid = (G % 8 == 0) ? (bid % 8) * (G / 8) + bid / 8 : bid;
#define GEMM_DENSE(Aoff, Boff, N, K, EPI_T, ...) { pg8::Gemm g{(const bf16*)(ws + (Aoff)), (const bf16*)(ws + (Boff)), T, (N), (K), nullptr}; pg8::StaticOrder S; S.init(T, (N), G, bid); \
        EPI_T E{__VA_ARGS__}; pg8::gemm_phase<EPI_T, pg8::StaticOrder, true, true>(ldsr, g, S, E); }
    PHASE(PH_F1, { fox_cumsum(c, p); __syncthreads();
        RP_F1(GEMM_DENSE(WS_HB, WS_FOX_IN, 4096, 1024, pg8::EpiBf16X<0>, (bf16*)(ws + WS_Q), 1024, nullptr, 1024, (size_t)T * 1024, C2)) });
    PHASE(PH_F3, RP_F3({ const attn_body::AttnTensors AT{(const attn_body::bf16*)(ws + WS_Q), (const attn_body::bf16*)(ws + WS_K), (const attn_body::bf16*)(ws + WS_V), (attn_body::bf16*)(ws + WS_O),
                                                  (const float*)(ws + WS_CB), (const attn_body::bf16*)(ws + WS_OG)};
        const attn_body::StaticOrder S(G, bid); attn_body::attn_phase<attn_body::StaticOrder>((char*)lds, AT, S); }));
    PHASE(PH_F4, GEMM_DENSE(WS_O, WS_FOX_OUT, 1024, 1024, pg8::EpiResid, (bf16*)(ws + WS_HB), ALPHA));
#define MOE_BLOCK(L, K1, K3, K4, K5, OUTP, NEXTCONV) \
    PHASE(K1, { RP_M1D(moe_ln_route(c, p, L, true)); moe_ln_route(c, p, L); }); \
    PHASE(K3, RP_M34({ moe_tiles(c, p, L); pg8::Gemm g{(const bf16*)(ws + WS_HB), (const bf16*)(ws + WS_GU + (size_t)((L) & 1) * WS_MOE_ALT), MPAD_MAX, 16 * 1024, 1024, (const int*)(ws + WS_P2TE)}; pg8::MoeOrder S{(const LAS int*)(ldsr + pg8::MOE_TAB), G, vbid}; \
        pg8::EpiSwiglu E{(bf16*)(ws + WS_H1)}; pg8::gemm_phase<pg8::EpiSwiglu, pg8::MoeOrder, true, true, true>(ldsr, g, S, E); \
        if (NEXTCONV) { int w_, nw_; if (tail_slot(c, 4 * __builtin_amdgcn_readfirstlane(*(const LAS int*)(ldsr + pg8::MOE_TAB + 768 * 4)), w_, nw_, vbid)) conv_moe_items(c, p, (L) + 1, 0, 32 * 256, w_, nw_); } })); \
    PHASE(K4, RP_M34({ moe_tiles(c, p, L); pg8::Gemm g{(const bf16*)(ws + WS_H1), (const bf16*)(ws + WS_DOWN + (size_t)((L) & 1) * WS_MOE_ALT), MPAD_MAX, 16 * 1024, 512, nullptr}; pg8::MoeOrder S{(const LAS int*)(ldsr + pg8::MOE_TAB), G, vbid}; \
        pg8::EpiDown E{(bf16*)(ws + WS_YD), (const float*)(ws + WS_ROWGE)}; pg8::gemm_phase<pg8::EpiDown, pg8::MoeOrder, true, true>(ldsr, g, S, E); \
        if (NEXTCONV) { int w_, nw_; if (tail_slot(c, 4 * __builtin_amdgcn_readfirstlane(*(const LAS int*)(ldsr + pg8::MOE_TAB + 768 * 4)), w_, nw_, vbid)) { conv_moe_items(c, p, (L) + 1, 32 * 256, 48 * 256, w_, nw_); \
             } } })); \
    PHASE(K5, { RP_M5D(moe_combine(c, p, L, OUTP, true)); moe_combine(c, p, L, OUTP); });
    MOE_BLOCK(0, PH_M1_0, PH_M3_0, PH_M4_0, PH_M5_0, nullptr, true)
    PHASE(PH_G1, GEMM_DENSE(WS_HB, WS_GM_IN, 2048, 1024, pg8::EpiBf16X<2>, (bf16*)(ws + WS_Z), 2048, p.in[I_GM_BIN], 0, 0, 1.f));
    PHASE(PH_G2, RP_G2(gmlp_spatial(c, p)));
    PHASE(PH_G3, GEMM_DENSE(WS_YG, WS_GM_OUT, 1024, 1024, pg8::EpiResid, (bf16*)(ws + WS_HB), ALPHA));
    MOE_BLOCK(1, PH_M1_1, PH_M3_1, PH_M4_1, PH_M5_1, nullptr, true)
    PHASE(PH_S1, GEMM_DENSE(WS_HB, WS_SB_IN, 3072, 1024, pg8::EpiBf16X<0>, (bf16*)(ws + WS_Q), 1024, nullptr, 1024, (size_t)T * 1024, C2));
    PHASE(PH_S2, RP_S2({ const attn_body::AttnTensors AT{(const attn_body::bf16*)(ws + WS_Q), (const attn_body::bf16*)(ws + WS_K), (const attn_body::bf16*)(ws + WS_V), (attn_body::bf16*)(ws + WS_O), nullptr, nullptr};
        const attn_body::SbOrder S(G, bid); attn_body::sb_phase<attn_body::SbOrder>((char*)lds, AT, S); }));
    PHASE(PH_S3, GEMM_DENSE(WS_O, WS_SB_OUT, 1024, 1024, pg8::EpiResid, (bf16*)(ws + WS_HB), ALPHA));
    MOE_BLOCK(2, PH_M1_2, PH_M3_2, PH_M4_2, PH_M5_2, nullptr, true)
    PHASE(PH_R0, rwkv_mix(c, p));
    PHASE(PH_R1, { pg8::Gemm g{(const bf16*)(ws + WS_HM), (const bf16*)(ws + WS_RKV), 6 * T, 15 * 256, 1024, nullptr}; pg8::Rw1Order S{G, vbid};
        pg8::EpiRw1 E{(bf16*)(ws + WS_RR), (bf16*)(ws + WS_L1), T}; pg8::gemm_phase<pg8::EpiRw1, pg8::Rw1Order, true, true>(ldsr, g, S, E); });
    PHASE(PH_R2, { pg8::Gemm g{(const bf16*)(ws + WS_L1), (const bf16*)(ws + WS_LORA2), 3 * T, 3 * 1024, 128, nullptr}; pg8::Rw2Order S{G, vbid};
        pg8::EpiRw2 E{(float*)(ws + WS_WDEC), (bf16*)(ws + WS_RA), (bf16*)(ws + WS_RG), p.in[I_RW_W0], p.in[I_RW_A0]}; pg8::gemm_phase<pg8::EpiRw2, pg8::Rw2Order, true, true>(ldsr, g, S, E); });
    const bool split_ok = G >= 128;
#define RW_STAGE(K, ST, C0, NCH, NC0, NNCH) PHASE(K, { if (split_ok) { if (bid < 64) rwc::rwc_scan(c, p, ST, C0, NCH); else rwc::rwc_prep(c, p, (ST) + 1, NC0, NNCH, 64, G - 64); } \
        else { rwc::rwc_scan(c, p, ST, C0, NCH); __syncthreads(); rwc::rwc_prep(c, p, (ST) + 1, NC0, NNCH, 0, G); } });
    PHASE(PH_RC0, rwc::rwc_prep(c, p, 0, 0, 32, 0, G));
    RW_STAGE(PH_RC1, 0, 0, 32, 32, 24)
    RW_STAGE(PH_RC2, 1, 32, 24, 56, 24)
    RW_STAGE(PH_RC3, 2, 56, 24, 80, 24)
    RW_STAGE(PH_RC4, 3, 80, 24, 104, 24)
#undef RW_STAGE
    PHASE(PH_RC5, { if (split_ok) { if (bid < 64) rwc::rwc_scan(c, p, 4, 104, 24); else rwkv_post(c, p, 0, 64, G - 64); } else { rwc::rwc_scan(c, p, 4, 104, 24); __syncthreads(); rwkv_post(c, p, 0, 0, G); } });
    PHASE(PH_R4B, rwkv_post(c, p, 1, 0, G));
    PHASE(PH_R5, GEMM_DENSE(WS_RYG, WS_RW_OUT, 1024, 1024, pg8::EpiResid, (bf16*)(ws + WS_HB), ALPHA));
    MOE_BLOCK(3, PH_M1_3, PH_M3_3, PH_M4_3, PH_M5_3, p.out, false)
#undef PHASE
}

#ifndef N_LAUNCH_MODE
#define N_LAUNCH_MODE 1
#endif
extern "C" void kernel_launch(void* const* d_in, const int* in_sizes, int n_in, void* d_out, int out_size, void* d_ws, size_t ws_size, hipStream_t stream) {
    static int grid = 0;
    if (grid == 0) {
        if (n_in != 38 || in_sizes[0] != T * D || out_size != T * D || ws_size < WS_END) { fprintf(stderr, "kernel_launch: unexpected shapes (n_in %d, ws %zu)\n", n_in, ws_size); grid = -1; return; }
        int dev = 0, cus = 0;
        if (hipGetDevice(&dev) != hipSuccess || hipDeviceGetAttribute(&cus, hipDeviceAttributeMultiprocessorCount, dev) != hipSuccess) { grid = -1; return; }
        if (hipFuncSetAttribute((const void*)fwd_kernel, hipFuncAttributeMaxDynamicSharedMemorySize, LDS_BYTES) != hipSuccess) { fprintf(stderr, "kernel_launch: hipFuncSetAttribute failed\n"); grid = -1; return; }
        int per_cu = 0; (void)hipOccupancyMaxActiveBlocksPerMultiprocessor(&per_cu, (const void*)fwd_kernel, NTHR, LDS_BYTES); (void)hipGetLastError();
        grid = cus > 0 ? cus : 256;
    }
    if (grid < 0) return;
    (void)hipMemsetAsync((char*)d_ws + WS_CTL, 0, CTL_BYTES, stream);
    Params a{};
    for (int i = 0; i < 38; ++i) a.in[i] = (const float*)d_in[i];
    a.out = (float*)d_out; a.ws = (unsigned char*)d_ws; a.pad = 0;
    if (N_LAUNCH_MODE == 1) { a.ph_lo = 0; a.ph_hi = NPHASE; a.li = 0; hipLaunchKernelGGL(fwd_kernel, dim3(grid), dim3(NTHR), LDS_BYTES, stream, a); }
    else for (int k = 0; k < NPHASE; ++k) { a.ph_lo = k; a.ph_hi = k + 1; a.li = k; hipLaunchKernelGGL(fwd_kernel, dim3(grid), dim3(NTHR), LDS_BYTES, stream, a); }
}
```

```cpp
#include <hip/hip_runtime.h>
#include <cstdio>
#include <cstdint>
#include <hip/hip_bf16.h>
#include <cmath>

#define LAS __attribute__((address_space(3)))
typedef unsigned short bf16;
typedef unsigned u32x4 __attribute__((ext_vector_type(4)));
typedef float f32x4 __attribute__((ext_vector_type(4)));

constexpr int D = 1024, BATCH = 4, SEQ = 4096, T = BATCH * SEQ, NH = 16, HD = 64;
constexpr int NEXP = 16, DEXP = 512;
constexpr float ALPHA = 1.6817928305074290f;
constexpr float LN_EPS = 1e-5f, GN_EPS = 64e-5f;
constexpr float LOG2E = 1.4426950408889634f;
constexpr float C2 = 0.125f * LOG2E;
constexpr int NW = 8, NTHR = 512;
constexpr int MPAD_MAX = 36864;

constexpr size_t MiB = 1u << 20;
constexpr size_t WS_CTL = 0, CTL_BYTES = 1 * MiB;
constexpr size_t WS_FOX_IN = 2 * MiB, WS_FOX_OUT = 10 * MiB, WS_GM_IN = 12 * MiB, WS_GM_OUT = 16 * MiB, WS_GM_WS = 18 * MiB;
constexpr size_t WS_SB_IN = 19 * MiB, WS_SB_OUT = 25 * MiB, WS_RKV = 27 * MiB, WS_LORA1 = 33 * MiB, WS_LORA2 = 35 * MiB, WS_RW_OUT = 134 * MiB;
constexpr size_t WS_GU = 38 * MiB, WS_DOWN = 70 * MiB, WS_MOE_ALT = 48 * MiB;
constexpr size_t WS_HF = 86 * MiB, WS_HB = 150 * MiB;
constexpr size_t WS_TOKE = 182 * MiB, WS_TOKG = WS_TOKE + 128 * 1024, WS_TOKP = WS_TOKG + 128 * 1024, WS_ROWG = WS_TOKP + 128 * 1024, WS_TILEE = WS_ROWG + 256 * 1024, WS_BLKB = WS_TILEE + 4096, WS_TOKQ = WS_BLKB + 32768, WS_P2T = WS_TOKQ + 128 * 1024;
constexpr size_t WS_FL = 184 * MiB, WS_CB = 185 * MiB;
constexpr int ECAP = 16384;
constexpr size_t WS_P2TE = 140 * MiB, WS_ROWGE = 141 * MiB;
constexpr size_t WS_ACT = 186 * MiB;
constexpr size_t WS_Q = WS_ACT, WS_K = WS_ACT + 32 * MiB, WS_V = WS_ACT + 64 * MiB, WS_OG = WS_ACT + 96 * MiB, WS_O = WS_ACT + 128 * MiB;
constexpr size_t WS_Z = WS_ACT, WS_YG = WS_ACT + 64 * MiB;
constexpr size_t WS_HM = WS_ACT, WS_RR = WS_ACT + 192 * MiB, WS_RK = WS_RR + 32 * MiB, WS_RV = WS_RK + 32 * MiB, WS_L1 = WS_RV + 32 * MiB;
constexpr size_t WS_WDEC = WS_ACT, WS_RA = WS_ACT + 64 * MiB, WS_RG = WS_ACT + 96 * MiB, WS_YSC = WS_ACT + 128 * MiB  , WS_RYG = WS_ACT  ;
constexpr size_t WS_XS = WS_ACT, WS_H1 = WS_ACT + 72 * MiB, WS_YD = WS_ACT + 108 * MiB;
constexpr size_t WS_CD0 = 2 * MiB, WS_CD1 = WS_ACT + 128 * MiB;
constexpr size_t WS_WLG = 136 * MiB;
constexpr size_t WS_SIG = 138 * MiB;
constexpr size_t WS_Y2 = WS_L1;
constexpr size_t WS_END = WS_Y2 + 32 * MiB;
constexpr int CW_BAR = 4096;
constexpr int CW_CNT = 200000;

constexpr int LDS_BYTES = 147456;
constexpr int MISC_OFF = LDS_BYTES - 256;

__device__ __forceinline__ float bf2f(unsigned b) { return __uint_as_float(b << 16); }
__device__ __forceinline__ unsigned f2bf(float f) { unsigned u = __float_as_uint(f); return (u + 0x7fffu + ((u >> 16) & 1u)) >> 16; }
typedef float f32x2_hw __attribute__((ext_vector_type(2))); typedef __bf16 bf16x2_hw __attribute__((ext_vector_type(2)));
__device__ __forceinline__ unsigned pk2(float lo, float hi) { f32x2_hw v = {lo, hi}; bf16x2_hw b = __builtin_convertvector(v, bf16x2_hw); return __builtin_bit_cast(unsigned, b); }
template <int CTRL> __device__ __forceinline__ float dppf(float v) { return __int_as_float(__builtin_amdgcn_update_dpp(0, __float_as_int(v), CTRL, 0xf, 0xf, true)); }
__device__ __forceinline__ float red16(float x) { x += dppf<0xB1>(x); x += dppf<0x4E>(x); x += dppf<0x141>(x); x += dppf<0x140>(x); return x; }
__device__ __forceinline__ float wave_sum(float v) {
    v = red16(v);
    return (__uint_as_float(__builtin_amdgcn_readlane(__float_as_uint(v), 0)) + __uint_as_float(__builtin_amdgcn_readlane(__float_as_uint(v), 16)))
         + (__uint_as_float(__builtin_amdgcn_readlane(__float_as_uint(v), 32)) + __uint_as_float(__builtin_amdgcn_readlane(__float_as_uint(v), 48)));
}
__device__ __forceinline__ float wave_max(float v) {
#pragma unroll
    for (int o = 1; o < 64; o <<= 1) v = fmaxf(v, __shfl_xor(v, o));
    return v;
}
__device__ __forceinline__ float wave_incl_scan(float v, int lane) {
#pragma unroll
    for (int o = 1; o < 64; o <<= 1) { float t = __shfl_up(v, o); if (lane >= o) v += t; }
    return v;
}
__device__ __forceinline__ float rdlane(float v, int l) { return __uint_as_float(__builtin_amdgcn_readlane(__float_as_uint(v), l)); }
__device__ __forceinline__ float sigmoidf_(float x) { return 1.0f / (1.0f + expf(-x)); }
__device__ __forceinline__ float softplusf_(float x) { return fmaxf(x, 0.f) + log1pf(expf(-fabsf(x))); }
#define LDS_WAIT() asm volatile("s_waitcnt lgkmcnt(0)" ::: "memory")

#define XB_TMO      128
#define XB_XCNT(j)  (256  + 64 * (j))
#define XB_XSUB(j)  (1280 + 64 * (j))
#define XB_XGEN(j)  (2304 + 64 * (j))
#define XB_TOP      3328
#define XB_TOPGEN   3392
#define XCD_BAR_WORDS 3456
#define XB_SPIN_CAP (1u << 24)
__device__ __forceinline__ unsigned xb_ld(unsigned* p)              { return __hip_atomic_load(p, __ATOMIC_RELAXED, __HIP_MEMORY_SCOPE_AGENT); }
__device__ __forceinline__ unsigned xb_add(unsigned* p, unsigned v) { return __hip_atomic_fetch_add(p, v, __ATOMIC_RELAXED, __HIP_MEMORY_SCOPE_AGENT); }
__device__ __forceinline__ unsigned xb_xcc_id() { return (unsigned)__builtin_amdgcn_s_getreg((3 << 11) | 20) & 0xFu; }
#define XB_SPIN(cond, bar) do { unsigned _sp = 0; while (cond) { __builtin_amdgcn_s_sleep(1); \
    if ((++_sp & 255u) == 0u) { if (xb_ld(&(bar)[XB_TMO])) break; if (_sp > XB_SPIN_CAP) { atomicAdd(&(bar)[XB_TMO], 1u); break; } } } } while (0)
struct XcdBarrier { unsigned* bar; unsigned x; volatile LAS unsigned* st; };
__device__ __forceinline__ XcdBarrier xcd_barrier_post(unsigned* bar, volatile LAS unsigned* st) {
    XcdBarrier b; b.bar = bar; b.x = xb_xcc_id(); b.st = st;
    if (threadIdx.x == 0) (void)xb_add(&bar[XB_XCNT(b.x)], 1u);
    return b;
}
__device__ __forceinline__ void xcd_barrier_complete(unsigned* bar, unsigned x, unsigned& nloc, unsigned& nx) {
    const unsigned G = gridDim.x * gridDim.y * gridDim.z;
    unsigned sum, cnt, mine, sp = 0u;
    for (;;) {
        sum = 0u; cnt = 0u; mine = 0u;
#pragma unroll
        for (unsigned j = 0; j < 16; ++j) { const unsigned c = xb_ld(&bar[XB_XCNT(j)]); sum += c; cnt += (c > 0u) ? 1u : 0u; mine = (j == x) ? c : mine; }
        if (sum == G) break;
        __builtin_amdgcn_s_sleep(1);
        if ((++sp & 255u) == 0u) { if (xb_ld(&bar[XB_TMO])) break; if (sp > XB_SPIN_CAP) { atomicAdd(&bar[XB_TMO], 1u); break; } }
    }
    nloc = mine > 0u ? mine : 1u; nx = cnt > 0u ? cnt : 1u;
}
__device__ __forceinline__ void xcd_barrier(const XcdBarrier& b) {
    asm volatile("s_waitcnt vmcnt(0)" ::: "memory");
    __syncthreads();
    if (threadIdx.x == 0) {
        unsigned* bar = b.bar;
        __builtin_amdgcn_s_waitcnt(0);
        unsigned nloc = b.st[0], nx = b.st[1];
        if (nloc == 0u) { xcd_barrier_complete(bar, b.x, nloc, nx); b.st[0] = nloc; b.st[1] = nx; }
        const unsigned old = xb_add(&bar[XB_XSUB(b.x)], 1u);
        const unsigned gen = old / nloc;
        if (old + 1u == (gen + 1u) * nloc) {
            __builtin_amdgcn_fence(__ATOMIC_RELEASE, "agent");
            asm volatile("s_waitcnt vmcnt(0)" ::: "memory");
            const unsigned og = xb_add(&bar[XB_TOP], 1u);
            const unsigned tg = og / nx;
            if (og + 1u == (tg + 1u) * nx) xb_add(&bar[XB_TOPGEN], 1u);
            else XB_SPIN(xb_ld(&bar[XB_TOPGEN]) == tg, bar);
            __builtin_amdgcn_fence(__ATOMIC_ACQUIRE, "agent");
            xb_add(&bar[XB_XGEN(b.x)], 1u);
            asm volatile("s_waitcnt vmcnt(0)" ::: "memory");
        } else {
            XB_SPIN(xb_ld(&bar[XB_XGEN(b.x)]) == gen, bar);
            __builtin_amdgcn_fence(__ATOMIC_ACQUIRE, "agent");
            asm volatile("s_waitcnt vmcnt(0)" ::: "memory");
        }
    }
    __syncthreads();
}

namespace pg8 {
#define PG8_LAS __attribute__((address_space(3)))
typedef unsigned short bf16_t;
typedef short bf16x8 __attribute__((ext_vector_type(8)));
typedef float f32x4 __attribute__((ext_vector_type(4)));
typedef unsigned u32x4 __attribute__((ext_vector_type(4)));
constexpr int BM = 256, BK = 64, HALF = 128, HTB = HALF * BK * 2  , STAGE_BYTES = 8 * HTB, NXCD = 8, WGM = 8;

__host__ __device__ __forceinline__ int lds_byte(int r, int c) { const int st = (r >> 4) * 2 + (c >> 5), rr = r & 15, cc = c & 31, ob = rr * 64 + cc * 2; return st * 1024 + (ob ^ (((ob >> 9) & 1) << 5)); }
__host__ __device__ __forceinline__ void stage_rc(int b, int& R, int& C) { const int st = b / 1024, sb = b % 1024, swz = sb ^ (((sb >> 9) & 1) << 5); R = (st >> 1) * 16 + swz / 64; C = (st & 1) * 32 + (swz % 64) / 2; }
__host__ __device__ __forceinline__ int perm32(int rho) { const int n = rho >> 4, i = rho & 15; return 8 * (i >> 2) + 4 * n + (i & 3); }

struct Unit { int pm, pn, rt, nv; };
struct Gemm { const bf16_t* A; const bf16_t* Bt; int M, N, K; const int* rowtok; };

struct StaticOrder {
    int nM, nN, nwg, G, c;
    __host__ __device__ void init(int M, int N, int G_, int c_) { nM = M / BM; nN = N / BM; nwg = nM * nN; G = G_; c = c_; }
    __host__ __device__ bool next(int i, Unit& u) const {
        const long L = (long)i * G + c; if (L >= nwg) return false;
        int wgid = (int)L; { const int q = nwg / NXCD, r = nwg % NXCD, xcd = wgid % NXCD, off = wgid / NXCD; wgid = (xcd < r ? xcd * (q + 1) : r * (q + 1) + (xcd - r) * q) + off; }
        const int nig = WGM * nN, gid = wgid / nig, fm = gid * WGM, gsz = (nM - fm) < WGM ? (nM - fm) : WGM;
        u.pm = fm + ((wgid % nig) % gsz); u.pn = (wgid % nig) / gsz; return true;
    }
    __device__ __forceinline__ void a_ready(const Unit&) const {}
    __device__ __forceinline__ void done(const Unit&) const {}
};

__device__ __forceinline__ unsigned cvt_pk_bf16(float lo, float hi) { unsigned r; asm volatile("v_cvt_pk_bf16_f32 %0, %1, %2" : "=v"(r) : "v"(lo), "v"(hi)); return r; }
typedef float f32x2 __attribute__((ext_vector_type(2)));
__device__ __forceinline__ f32x2 gelu_pk(f32x2 v) {
    const f32x2 av = __builtin_elementwise_abs(v), d = av * 0.2316418882f + 1.0f;
    f32x2 t; t.x = __builtin_amdgcn_rcpf(d.x); t.y = __builtin_amdgcn_rcpf(d.y);
    f32x2 q = t * 0.5307027145f + (-0.7265760135f); q = q * t + 0.7107068705f; q = q * t + (-0.142248368f); q = q * t + 0.127414796f; q = q * t;
    const f32x2 s = (v * v) * (-0.72134752044f);
    f32x2 e; e.x = __builtin_amdgcn_exp2f(s.x); e.y = __builtin_amdgcn_exp2f(s.y);
    const f32x2 m = v * (q * e), r = v - m;
    f32x2 o; o.x = v.x < 0.f ? m.x : r.x; o.y = v.y < 0.f ? m.y : r.y; return o;
}

template <int ACT  > struct EpiBf16 {
    static constexpr bool PERM = true, AFTER_DRAIN = false; static_assert(ACT == 0 || ACT == 1, "EpiBf16: ACT is 0 (none) or 1 (gelu_pk)");
    bf16_t* O; int ldc; const float* bias; int split_cols; size_t split_stride; float scale0;
    __device__ __forceinline__ void operator()(const f32x4 (&acc)[2][2][4][2], const Unit& u, int wr, int wc, int fr, int fq) const {
        const int row0 = u.pm * BM + wr * 64 + fr; int colt = u.pn * BM; bf16_t* base = O;
        float sc = 1.f; if (split_cols) { const int t = colt / split_cols; base += (size_t)t * split_stride; colt -= t * split_cols; if (t == 0) sc = scale0; }
        const int col0 = colt + wc * 32 + 8 * fq, bcol0 = u.pn * BM + wc * 32 + 8 * fq;
        f32x4 bv[2][2];
#pragma unroll
        for (int bj = 0; bj < 2; ++bj)
#pragma unroll
            for (int n = 0; n < 2; ++n) bv[bj][n] = bias ? *(const f32x4*)(bias + bcol0 + bj * HALF + 4 * n) : (f32x4){0.f, 0.f, 0.f, 0.f};
#pragma unroll
        for (int ai = 0; ai < 2; ++ai)
#pragma unroll
            for (int m = 0; m < 4; ++m) { bf16_t* rowp = base + (size_t)(row0 + ai * HALF + m * 16) * ldc + col0;
#pragma unroll
                for (int bj = 0; bj < 2; ++bj) { f32x4 v0 = acc[ai][bj][m][0] + bv[bj][0], v1 = acc[ai][bj][m][1] + bv[bj][1];
                    if (ACT == 1) { f32x2 a = gelu_pk((f32x2){v0[0], v0[1]}), b = gelu_pk((f32x2){v0[2], v0[3]}), c = gelu_pk((f32x2){v1[0], v1[1]}), d = gelu_pk((f32x2){v1[2], v1[3]});
                        v0 = (f32x4){a.x, a.y, b.x, b.y}; v1 = (f32x4){c.x, c.y, d.x, d.y}; }
                    v0 = v0 * sc; v1 = v1 * sc; u32x4 w; w.x = cvt_pk_bf16(v0[0], v0[1]); w.y = cvt_pk_bf16(v0[2], v0[3]); w.z = cvt_pk_bf16(v1[0], v1[1]); w.w = cvt_pk_bf16(v1[2], v1[3]);
                    *(u32x4*)(rowp + bj * HALF) = w; } }
    }
};


template <class Epi, class Sched, bool ALIGN_EPI = false, bool SP2 = false, bool GATH = false>
__device__ __forceinline__ void gemm_phase(PG8_LAS unsigned char* lds, const Gemm g, const Sched& S, const Epi& E) {
    const int tid = threadIdx.x, wid = __builtin_amdgcn_readfirstlane(tid >> 6), lane = tid & 63, wr = wid >> 2, wc = wid & 3, fr = lane & 15, fq = lane >> 4;
    const int K = g.K, nt = K / BK;
    unsigned voffA[2], voffB[2];
#pragma unroll
    for (int i = 0; i < 2; ++i) { int R, C; stage_rc(tid * 16 + i * 8192, R, C); const int Rb = Epi::PERM ? ((R & ~31) + perm32(R & 31)) : R;
        voffA[i] = (unsigned)(R * K + C) * 2u; voffB[i] = (unsigned)(Rb * K + C) * 2u; }
    static_assert(!GATH || SP2, "GATH is implemented for the SP2 loop only");
    int gR[2]; unsigned gC[2]; unsigned ogC[2][2], ogN[2][2];
    if constexpr (GATH) {
#pragma unroll
        for (int i = 0; i < 2; ++i) { int R, C; stage_rc(tid * 16 + i * 8192, R, C); gR[i] = R; gC[i] = (unsigned)C * 2u; }
    }
#define PG8_OG(og, U_) do { _Pragma("unroll") for (int h_ = 0; h_ < 2; ++h_) _Pragma("unroll") for (int i_ = 0; i_ < 2; ++i_) { const int rr_ = h_ * HALF + gR[i_]; \
        og[h_][i_] = (unsigned)(rr_ < (U_).nv ? g.rowtok[(U_).rt * BM + rr_] : 0) * (unsigned)(K * 2) + gC[i_]; } } while (0)
    const size_t kstep = (size_t)(BK * 2);
    const size_t hstep = (size_t)HALF * K * 2;
    const size_t tstep = 2 * hstep;
    const unsigned ldsw = (unsigned)wid * 1024u;
    const int aoff = lds_byte(wr * 64 + fr, fq * 8), boff = lds_byte(wc * 32 + fr, fq * 8);
#define PG8_SA(b, h) (((b) * 2 + (h)) * HTB)
#define PG8_SB(b, h) ((4 + (b) * 2 + (h)) * HTB)
#define PG8_STAGE(bufoff, gbase, voff) do { _Pragma("unroll") for (int _i = 0; _i < 2; ++_i) \
        __builtin_amdgcn_global_load_lds((const unsigned*)((const char*)(gbase) + (voff)[_i]), (PG8_LAS unsigned*)(lds + (bufoff) + ldsw + _i * 8192), 16, 0, 0); } while (0)
#define PG8_STAGE_G(bufoff, kptr, og) do { _Pragma("unroll") for (int _i = 0; _i < 2; ++_i) \
        __builtin_amdgcn_global_load_lds((const unsigned*)((const char*)(kptr) + (og)[_i]), (PG8_LAS unsigned*)(lds + (bufoff) + ldsw + _i * 8192), 16, 0, 0); } while (0)
#define PG8_STAGE_A(bufoff, tp, kp, h, sel) do { if constexpr (GATH) { unsigned og_[2] = {(sel) ? ogN[h][0] : ogC[h][0], (sel) ? ogN[h][1] : ogC[h][1]}; PG8_STAGE_G(bufoff, kp, og_); } \
        else { PG8_STAGE(bufoff, (tp) + (h) * hstep, voffA); } } while (0)
#define PG8_LDA(dst, b, h) do { _Pragma("unroll") for (int m = 0; m < 4; ++m) _Pragma("unroll") for (int k = 0; k < 2; ++k) dst[m][k] = *(const PG8_LAS bf16x8*)(lds + PG8_SA(b, h) + aoff + m * 2048 + k * 1024); } while (0)
#define PG8_LDB(dst, b, h) do { _Pragma("unroll") for (int n = 0; n < 2; ++n) _Pragma("unroll") for (int k = 0; k < 2; ++k) dst[n][k] = *(const PG8_LAS bf16x8*)(lds + PG8_SB(b, h) + boff + n * 2048 + k * 1024); } while (0)
#define PG8_MMA(ai, bj, At, Bt) do { __builtin_amdgcn_s_setprio(1); _Pragma("unroll") for (int m = 0; m < 4; ++m) _Pragma("unroll") for (int n = 0; n < 2; ++n) _Pragma("unroll") for (int k = 0; k < 2; ++k) \
        acc[ai][bj][m][n] = __builtin_amdgcn_mfma_f32_16x16x32_bf16(Bt[n][k], At[m][k], acc[ai][bj][m][n], 0, 0, 0); __builtin_amdgcn_s_setprio(0); } while (0)
#define PG8_WAIT_V(n) asm volatile("s_waitcnt vmcnt(" #n ")" ::: "memory")
#define PG8_WAIT_L(n) asm volatile("s_waitcnt lgkmcnt(" #n ")" ::: "memory")
#define PG8_BAR __builtin_amdgcn_s_barrier()
#define PG8_SCHED __builtin_amdgcn_sched_barrier(0)
    Unit cur, nxt; int ui = 0;
    if (!S.next(0, cur)) return;
    f32x4 acc[2][2][4][2];
#pragma unroll
    for (int a = 0; a < 2; ++a)
#pragma unroll
        for (int b = 0; b < 2; ++b)
#pragma unroll
            for (int m = 0; m < 4; ++m)
#pragma unroll
                for (int n = 0; n < 2; ++n) acc[a][b][m][n] = (f32x4){0.f, 0.f, 0.f, 0.f};
    bf16x8 At[4][2], B0[2][2], B1[2][2];
    const char* cA = (const char*)g.A + (size_t)cur.pm * tstep; const char* cB = (const char*)g.Bt + (size_t)cur.pn * tstep;
    const char* const gA = (const char*)g.A;
    if constexpr (GATH) { PG8_OG(ogC, cur); }
    S.a_ready(cur);
    if constexpr (SP2) {
        PG8_STAGE(PG8_SB(0, 0), cB, voffB); PG8_STAGE(PG8_SB(0, 1), cB + hstep, voffB); PG8_STAGE_A(PG8_SA(0, 0), cA, gA, 0, false); PG8_STAGE_A(PG8_SA(0, 1), cA, gA, 1, false);
        if (wr == 1) PG8_BAR;
        PG8_WAIT_V(2); PG8_BAR;
        PG8_STAGE(PG8_SB(1, 0), cB + kstep, voffB); PG8_STAGE_A(PG8_SA(1, 0), cA + kstep, gA + kstep, 0, false); PG8_STAGE(PG8_SB(1, 1), cB + hstep + kstep, voffB);
        PG8_WAIT_V(6); PG8_BAR;
    } else {
        PG8_STAGE(PG8_SB(0, 0), cB, voffB); PG8_STAGE(PG8_SA(0, 0), cA, voffA); PG8_STAGE(PG8_SB(0, 1), cB + hstep, voffB); PG8_STAGE(PG8_SA(0, 1), cA + hstep, voffA);
        if (wr == 1) PG8_BAR;
        PG8_WAIT_V(4); PG8_BAR;
        PG8_STAGE(PG8_SB(1, 0), cB + kstep, voffB); PG8_STAGE(PG8_SA(1, 0), cA + kstep, voffA); PG8_STAGE(PG8_SB(1, 1), cB + hstep + kstep, voffB);
        PG8_WAIT_V(6); PG8_BAR;
    }
    for (;;) {
        const bool has_next = S.next(ui + 1, nxt);
        if constexpr (GATH) { if (has_next) { PG8_OG(ogN, nxt); } }
        const char* nA = has_next ? (const char*)g.A + (size_t)nxt.pm * tstep : cA; const char* nB = has_next ? (const char*)g.Bt + (size_t)nxt.pn * tstep : cB;
        for (int t = 0; t < nt; t += 2) {
            const bool last = (t == nt - 2);
            const char* a1 = cA + (size_t)(t + 1) * kstep;
            const char* a2 = last ? nA : cA + (size_t)(t + 2) * kstep; const char* b2 = last ? nB : cB + (size_t)(t + 2) * kstep;
            const char* a3 = a2 + kstep; const char* b3 = b2 + kstep;
            const bool gsel = last && has_next; const char* ga1 = gA + (size_t)(t + 1) * kstep; const char* ga2 = last ? gA : gA + (size_t)(t + 2) * kstep; const char* ga3 = ga2 + kstep;
            if (last && has_next) S.a_ready(nxt);
            if constexpr (SP2) {
            PG8_LDB(B0, 0, 0); PG8_LDB(B1, 0, 1); PG8_SCHED; PG8_LDA(At, 0, 0); PG8_STAGE_A(PG8_SA(1, 1), a1, ga1, 1, false);
            PG8_WAIT_V(8); PG8_WAIT_L(0); PG8_BAR; PG8_MMA(0, 0, At, B0); PG8_MMA(0, 1, At, B1); PG8_BAR; PG8_SCHED;
            PG8_LDA(At, 0, 1); PG8_STAGE(PG8_SB(0, 0), b2, voffB); PG8_STAGE(PG8_SB(0, 1), b2 + hstep, voffB); PG8_STAGE_A(PG8_SA(0, 0), a2, ga2, 0, gsel);
            PG8_WAIT_V(8); PG8_WAIT_L(0); PG8_BAR; PG8_MMA(1, 0, At, B0); PG8_MMA(1, 1, At, B1); PG8_BAR; PG8_SCHED;
            PG8_LDB(B0, 1, 0); PG8_LDB(B1, 1, 1); PG8_SCHED; PG8_LDA(At, 1, 0); PG8_STAGE_A(PG8_SA(0, 1), a2, ga2, 1, gsel);
            PG8_WAIT_V(8); PG8_WAIT_L(0); PG8_BAR; PG8_MMA(0, 0, At, B0); PG8_MMA(0, 1, At, B1); PG8_BAR; PG8_SCHED;
            PG8_LDA(At, 1, 1); PG8_STAGE(PG8_SB(1, 0), b3, voffB); PG8_STAGE(PG8_SB(1, 1), b3 + hstep, voffB); PG8_STAGE_A(PG8_SA(1, 0), a3, ga3, 0, gsel);
            PG8_WAIT_V(8); PG8_WAIT_L(0); PG8_BAR; PG8_MMA(1, 0, At, B0); PG8_MMA(1, 1, At, B1); PG8_BAR; PG8_SCHED;
            } else {
            PG8_LDB(B0, 0, 0); PG8_SCHED; PG8_LDA(At, 0, 0); PG8_STAGE(PG8_SA(1, 1), a1 + hstep, voffA);
            PG8_WAIT_L(8); PG8_BAR; PG8_WAIT_L(0); PG8_MMA(0, 0, At, B0); PG8_BAR; PG8_SCHED;
            PG8_LDB(B1, 0, 1); PG8_STAGE(PG8_SB(0, 0), b2, voffB);
            PG8_BAR; PG8_WAIT_L(0); PG8_MMA(0, 1, At, B1); PG8_BAR;
            PG8_LDA(At, 0, 1); PG8_STAGE(PG8_SA(0, 0), a2, voffA);
            PG8_BAR; PG8_WAIT_L(0); PG8_MMA(1, 0, At, B0); PG8_BAR; PG8_SCHED;
            PG8_STAGE(PG8_SB(0, 1), b2 + hstep, voffB);
            PG8_WAIT_V(6); PG8_BAR; PG8_MMA(1, 1, At, B1); PG8_BAR;
            PG8_LDB(B0, 1, 0); PG8_SCHED; PG8_LDA(At, 1, 0); PG8_STAGE(PG8_SA(0, 1), a2 + hstep, voffA);
            PG8_WAIT_L(8); PG8_BAR; PG8_WAIT_L(0); PG8_MMA(0, 0, At, B0); PG8_BAR; PG8_SCHED;
            PG8_LDB(B1, 1, 1); PG8_STAGE(PG8_SB(1, 0), b3, voffB);
            PG8_BAR; PG8_WAIT_L(0); PG8_MMA(0, 1, At, B1); PG8_BAR;
            PG8_LDA(At, 1, 1); PG8_STAGE(PG8_SA(1, 0), a3, voffA);
            PG8_BAR; PG8_WAIT_L(0); PG8_MMA(1, 0, At, B0); PG8_BAR; PG8_SCHED;
            PG8_STAGE(PG8_SB(1, 1), b3 + hstep, voffB);
            PG8_WAIT_V(6); PG8_BAR; PG8_MMA(1, 1, At, B1); PG8_BAR;
            }
        }
        if constexpr (ALIGN_EPI) { if (wr == 0) PG8_BAR; }
        if constexpr (!Epi::AFTER_DRAIN) { E(acc, cur, wr, wc, fr, fq); S.done(cur); }
        if (!has_next) break;
#pragma unroll
        for (int a = 0; a < 2; ++a)
#pragma unroll
            for (int b = 0; b < 2; ++b)
#pragma unroll
                for (int m = 0; m < 4; ++m)
#pragma unroll
                    for (int n = 0; n < 2; ++n) acc[a][b][m][n] = (f32x4){0.f, 0.f, 0.f, 0.f};
        cur = nxt; cA = nA; cB = nB; ++ui;
        if constexpr (GATH) { ogC[0][0] = ogN[0][0]; ogC[0][1] = ogN[0][1]; ogC[1][0] = ogN[1][0]; ogC[1][1] = ogN[1][1]; }
        if constexpr (ALIGN_EPI) { if (wr == 1) PG8_BAR; }
    }
    PG8_WAIT_V(0);
    if constexpr (!ALIGN_EPI) { if (wr == 0) PG8_BAR; }
    PG8_BAR;
    if constexpr (Epi::AFTER_DRAIN) { E.fused(acc, cur, wr, wc, fr, fq, lds, wid, lane); S.done(cur); }
#undef PG8_SA
#undef PG8_SB
#undef PG8_STAGE
#undef PG8_LDA
#undef PG8_STAGE_G
#undef PG8_STAGE_A
#undef PG8_OG
#undef PG8_LDB
#undef PG8_MMA
#undef PG8_WAIT_V
#undef PG8_WAIT_L
#undef PG8_BAR
#undef PG8_SCHED
}

__device__ __forceinline__ float gelu_tanh_f(float x) { const float t = x + 0.044715f * x * x * x; return x * __builtin_amdgcn_rcpf(1.0f + __builtin_amdgcn_exp2f(-2.302208198f * t)); }
__device__ __forceinline__ float silu_f(float x) { return x * __builtin_amdgcn_rcpf(1.0f + __builtin_amdgcn_exp2f(-1.4426950408889634f * x)); }
__device__ __forceinline__ float sigm_f(float x) { return __builtin_amdgcn_rcpf(1.0f + __builtin_amdgcn_exp2f(-1.4426950408889634f * x)); }
template <int ACT  > struct EpiBf16X {
    static constexpr bool PERM = true, AFTER_DRAIN = false;
    bf16_t* O; int ldc; const float* bias; int split_cols; size_t split_stride; float scale0;
    __device__ __forceinline__ void operator()(const f32x4 (&acc)[2][2][4][2], const Unit& u, int wr, int wc, int fr, int fq) const {
        const int row0 = u.pm * BM + wr * 64 + fr; int colt = u.pn * BM; bf16_t* base = O;
        float sc = 1.f; if (split_cols) { const int t = colt / split_cols; base += (size_t)t * split_stride; colt -= t * split_cols; if (t == 0) sc = scale0; }
        const int col0 = colt + wc * 32 + 8 * fq, bcol0 = u.pn * BM + wc * 32 + 8 * fq;
        f32x4 bv[2][2];
#pragma unroll
        for (int bj = 0; bj < 2; ++bj)
#pragma unroll
            for (int n = 0; n < 2; ++n) bv[bj][n] = bias ? *(const f32x4*)(bias + bcol0 + bj * HALF + 4 * n) : (f32x4){0.f, 0.f, 0.f, 0.f};
#pragma unroll
        for (int ai = 0; ai < 2; ++ai)
#pragma unroll
            for (int m = 0; m < 4; ++m) { bf16_t* rowp = base + (size_t)(row0 + ai * HALF + m * 16) * ldc + col0;
#pragma unroll
                for (int bj = 0; bj < 2; ++bj) { f32x4 v0 = acc[ai][bj][m][0] + bv[bj][0], v1 = acc[ai][bj][m][1] + bv[bj][1];
                    if (ACT == 2) {
#pragma unroll
                        for (int i = 0; i < 4; ++i) { v0[i] = gelu_tanh_f(v0[i]); v1[i] = gelu_tanh_f(v1[i]); } }
                    v0 = v0 * sc; v1 = v1 * sc; u32x4 w; w.x = cvt_pk_bf16(v0[0], v0[1]); w.y = cvt_pk_bf16(v0[2], v0[3]); w.z = cvt_pk_bf16(v1[0], v1[1]); w.w = cvt_pk_bf16(v1[2], v1[3]);
                    *(u32x4*)(rowp + bj * HALF) = w; } }
    }
};
struct EpiResid {
    static constexpr bool PERM = true, AFTER_DRAIN = false;
    bf16_t* H; float alpha;
    __device__ __forceinline__ void operator()(const f32x4 (&acc)[2][2][4][2], const Unit& u, int wr, int wc, int fr, int fq) const {
        const int row0 = u.pm * BM + wr * 64 + fr, col0 = u.pn * BM + wc * 32 + 8 * fq;
#pragma unroll
        for (int ai = 0; ai < 2; ++ai) {
            u32x4 hres[4][2];
#pragma unroll
            for (int m = 0; m < 4; ++m)
#pragma unroll
                for (int bj = 0; bj < 2; ++bj) hres[m][bj] = *(const u32x4*)(H + (size_t)(row0 + ai * HALF + m * 16) * 1024 + col0 + bj * HALF);
#pragma unroll
            for (int m = 0; m < 4; ++m) { bf16_t* rowp = H + (size_t)(row0 + ai * HALF + m * 16) * 1024 + col0;
#pragma unroll
                for (int bj = 0; bj < 2; ++bj) { const u32x4 h = hres[m][bj]; const f32x4 a0 = acc[ai][bj][m][0], a1 = acc[ai][bj][m][1]; u32x4 w;
                    w.x = cvt_pk_bf16(alpha * __uint_as_float(h.x << 16) + a0[0], alpha * __uint_as_float(h.x & 0xffff0000u) + a0[1]);
                    w.y = cvt_pk_bf16(alpha * __uint_as_float(h.y << 16) + a0[2], alpha * __uint_as_float(h.y & 0xffff0000u) + a0[3]);
                    w.z = cvt_pk_bf16(alpha * __uint_as_float(h.z << 16) + a1[0], alpha * __uint_as_float(h.z & 0xffff0000u) + a1[1]);
                    w.w = cvt_pk_bf16(alpha * __uint_as_float(h.w << 16) + a1[2], alpha * __uint_as_float(h.w & 0xffff0000u) + a1[3]);
                    *(u32x4*)(rowp + bj * HALF) = w; } }
        }
    }
};
struct EpiSwiglu {
    static constexpr bool PERM = true, AFTER_DRAIN = false;
    bf16_t* H1;
    __device__ __forceinline__ void operator()(const f32x4 (&acc)[2][2][4][2], const Unit& u, int wr, int wc, int fr, int fq) const {
        const int row0 = u.pm * BM + wr * 64 + fr, col0 = (u.pn & 3) * 128 + wc * 32 + 8 * fq;
#pragma unroll
        for (int ai = 0; ai < 2; ++ai)
#pragma unroll
            for (int m = 0; m < 4; ++m) { bf16_t* rowp = H1 + (size_t)(row0 + ai * HALF + m * 16) * 512 + col0;
                f32x4 h0, h1;
#pragma unroll
                for (int i = 0; i < 4; ++i) { h0[i] = silu_f(acc[ai][0][m][0][i]) * acc[ai][1][m][0][i]; h1[i] = silu_f(acc[ai][0][m][1][i]) * acc[ai][1][m][1][i]; }
                u32x4 w; w.x = cvt_pk_bf16(h0[0], h0[1]); w.y = cvt_pk_bf16(h0[2], h0[3]); w.z = cvt_pk_bf16(h1[0], h1[1]); w.w = cvt_pk_bf16(h1[2], h1[3]);
                *(u32x4*)rowp = w; }
    }
};
struct EpiDown {
    static constexpr bool PERM = true, AFTER_DRAIN = false;
    bf16_t* Yd; const float* rowg;
    __device__ __forceinline__ void operator()(const f32x4 (&acc)[2][2][4][2], const Unit& u, int wr, int wc, int fr, int fq) const {
        const int row0 = u.pm * BM + wr * 64 + fr, col0 = (u.pn & 3) * BM + wc * 32 + 8 * fq;
        float scv[2][4];
#pragma unroll
        for (int ai = 0; ai < 2; ++ai)
#pragma unroll
            for (int m = 0; m < 4; ++m) scv[ai][m] = rowg[u.rt * BM + wr * 64 + fr + ai * HALF + m * 16];
#pragma unroll
        for (int ai = 0; ai < 2; ++ai)
#pragma unroll
            for (int m = 0; m < 4; ++m) { const int row = row0 + ai * HALF + m * 16; const float sc = scv[ai][m]; bf16_t* rowp = Yd + (size_t)row * 1024 + col0;
#pragma unroll
                for (int bj = 0; bj < 2; ++bj) { const f32x4 v0 = acc[ai][bj][m][0] * sc, v1 = acc[ai][bj][m][1] * sc;
                    u32x4 w; w.x = cvt_pk_bf16(v0[0], v0[1]); w.y = cvt_pk_bf16(v0[2], v0[3]); w.z = cvt_pk_bf16(v1[0], v1[1]); w.w = cvt_pk_bf16(v1[2], v1[3]);
                    *(u32x4*)(rowp + bj * HALF) = w; } }
    }
};
struct EpiRw1 {
    static constexpr bool PERM = true, AFTER_DRAIN = false;
    bf16_t* RKV; bf16_t* L1; int Trows;
    __device__ __forceinline__ void operator()(const f32x4 (&acc)[2][2][4][2], const Unit& u, int wr, int wc, int fr, int fq) const {
        const int t0 = (u.pm & 63) * BM + wr * 64 + fr;
        if (u.pn < 12) { const int cc = u.pn >> 2, col0 = (u.pn & 3) * BM + wc * 32 + 8 * fq;
#pragma unroll
            for (int ai = 0; ai < 2; ++ai)
#pragma unroll
                for (int m = 0; m < 4; ++m) { bf16_t* rowp = RKV + (size_t)cc * Trows * 1024 + (size_t)(t0 + ai * HALF + m * 16) * 1024 + col0;
#pragma unroll
                    for (int bj = 0; bj < 2; ++bj) { const f32x4 v0 = acc[ai][bj][m][0], v1 = acc[ai][bj][m][1];
                        u32x4 w; w.x = cvt_pk_bf16(v0[0], v0[1]); w.y = cvt_pk_bf16(v0[2], v0[3]); w.z = cvt_pk_bf16(v1[0], v1[1]); w.w = cvt_pk_bf16(v1[2], v1[3]);
                        *(u32x4*)(rowp + bj * HALF) = w; } }
        } else { const int j = u.pn - 12, col0 = wc * 32 + 8 * fq;
#pragma unroll
            for (int ai = 0; ai < 2; ++ai)
#pragma unroll
                for (int m = 0; m < 4; ++m) { bf16_t* rowp = L1 + (size_t)j * Trows * 128 + (size_t)(t0 + ai * HALF + m * 16) * 128 + col0;
                    f32x4 v0 = acc[ai][0][m][0], v1 = acc[ai][0][m][1];
#pragma unroll
                    for (int i = 0; i < 4; ++i) { if (j == 0) { v0[i] = 2.f * sigm_f(2.f * v0[i]) - 1.f; v1[i] = 2.f * sigm_f(2.f * v1[i]) - 1.f; } else if (j == 2) { v0[i] = sigm_f(v0[i]); v1[i] = sigm_f(v1[i]); } }
                    u32x4 w; w.x = cvt_pk_bf16(v0[0], v0[1]); w.y = cvt_pk_bf16(v0[2], v0[3]); w.z = cvt_pk_bf16(v1[0], v1[1]); w.w = cvt_pk_bf16(v1[2], v1[3]);
                    *(u32x4*)rowp = w; }
        }
    }
};
struct EpiRw2 {
    static constexpr bool PERM = true, AFTER_DRAIN = false;
    float* Wdec; bf16_t* A; bf16_t* G; const float* w0; const float* a0;
    __device__ __forceinline__ void operator()(const f32x4 (&acc)[2][2][4][2], const Unit& u, int wr, int wc, int fr, int fq) const {
        const int j = u.pn >> 2, t0 = (u.pm & 63) * BM + wr * 64 + fr, col0 = (u.pn & 3) * BM + wc * 32 + 8 * fq;
#pragma unroll
        for (int ai = 0; ai < 2; ++ai)
#pragma unroll
            for (int m = 0; m < 4; ++m) { const size_t ro = (size_t)(t0 + ai * HALF + m * 16) * 1024 + col0;
#pragma unroll
                for (int bj = 0; bj < 2; ++bj) { f32x4 v0 = acc[ai][bj][m][0], v1 = acc[ai][bj][m][1]; const size_t o = ro + bj * HALF;
                    if (j == 0) { const f32x4 b0 = __builtin_bit_cast(f32x4, *(const u32x4*)(w0 + col0 + bj * HALF)), b1 = __builtin_bit_cast(f32x4, *(const u32x4*)(w0 + col0 + bj * HALF + 4));
#pragma unroll
                        for (int i = 0; i < 4; ++i) { v0[i] = -0.8750387749f * sigm_f(v0[i] + b0[i]); v1[i] = -0.8750387749f * sigm_f(v1[i] + b1[i]); }
                        *(f32x4*)(Wdec + o) = v0; *(f32x4*)(Wdec + o + 4) = v1;
                    } else { if (j == 1) { const f32x4 b0 = __builtin_bit_cast(f32x4, *(const u32x4*)(a0 + col0 + bj * HALF)), b1 = __builtin_bit_cast(f32x4, *(const u32x4*)(a0 + col0 + bj * HALF + 4));
#pragma unroll
                            for (int i = 0; i < 4; ++i) { v0[i] = sigm_f(v0[i] + b0[i]); v1[i] = sigm_f(v1[i] + b1[i]); } }
                        u32x4 w; w.x = cvt_pk_bf16(v0[0], v0[1]); w.y = cvt_pk_bf16(v0[2], v0[3]); w.z = cvt_pk_bf16(v1[0], v1[1]); w.w = cvt_pk_bf16(v1[2], v1[3]);
                        if (j == 1) *(u32x4*)(A + o) = w; else *(u32x4*)(G + o) = w; } } }
    }
};
struct Rw1Order { int G, c;
    __device__ __forceinline__ bool next(int i, Unit& u) const { const int L = i * G + c; if (L >= 960) return false;
        if (L < 768) { const int cc = L >> 8, mt = (L & 255) >> 2, pn = L & 3; u.pm = cc * 64 + mt; u.pn = cc * 4 + pn; } else { const int L2 = L - 768, cc = 3 + (L2 >> 6), mt = L2 & 63; u.pm = cc * 64 + mt; u.pn = 9 + cc; }
        return true; }
    __device__ __forceinline__ void a_ready(const Unit&) const {}
    __device__ __forceinline__ void done(const Unit&) const {} };
struct Rw2Order { int G, c;
    __device__ __forceinline__ bool next(int i, Unit& u) const { const int L = i * G + c; if (L >= 768) return false; const int j = L >> 8, mt = (L & 255) >> 2, pn = L & 3; u.pm = j * 64 + mt; u.pn = j * 4 + pn; return true; }
    __device__ __forceinline__ void a_ready(const Unit&) const {}
    __device__ __forceinline__ void done(const Unit&) const {} };
constexpr int MOE_TAB = 131072;
struct MoeOrder { const PG8_LAS int* tab; int G, c;
    __device__ __forceinline__ bool next(int i, Unit& u) const {
        const int nt = __builtin_amdgcn_readfirstlane(tab[768]);
        const int L = i * G + c; if (L >= nt * 4) return false; const int mt = L >> 2;
        const int e = __builtin_amdgcn_readfirstlane(tab[mt]), j = __builtin_amdgcn_readfirstlane(tab[256 + mt]);
        u.pm = mt; u.pn = e * 4 + (L & 3); u.rt = e * (ECAP / BM) + j; u.nv = __builtin_amdgcn_readfirstlane(tab[512 + mt]); return true; }
    __device__ __forceinline__ void a_ready(const Unit&) const {}
    __device__ __forceinline__ void done(const Unit&) const {} };
}

namespace attn_body {
using bf16=__hip_bfloat16;
using bf16x8=__attribute__((ext_vector_type(8)))short;
using s16x4=__attribute__((ext_vector_type(4)))short;
using f32x16=__attribute__((ext_vector_type(16)))float;
using u32x4=__attribute__((ext_vector_type(4)))unsigned;
using f32x4_t=__attribute__((ext_vector_type(4)))float;
constexpr int BATCH=4,NHEAD=16,SEQ=4096,D=64,DM=NHEAD*D;
constexpr int NW=8,QBLK=32,QB=QBLK*NW,KVBLK=64,NQB=SEQ/QB;
constexpr int ATTN_PITCH=DM, ATTN_UNIT_ROWS=QB;
__device__ __forceinline__ int crow(int r,int hi){return (r&3)+8*(r>>2)+4*hi;}
#define SBAR() __builtin_amdgcn_sched_barrier(0)
__device__ __forceinline__ void cmask(f32x16&p0,f32x16&p1,int jb,int qrel,int hi){
  const float NEG=-INFINITY; int kb=64*jb+4*hi;
  #pragma unroll
  for(int r=0;r<16;++r){int kv=kb+(r&3)+8*(r>>2); if(kv>qrel)p0[r]=NEG; if(kv+32>qrel)p1[r]=NEG;}
}

constexpr int NSLOT=3, SLOTB=8192;
constexpr int LDS_K=0, LDS_V=NSLOT*SLOTB, LDS_WS=2*NSLOT*SLOTB, LDS_OST=LDS_WS+NW*64*4, LDS_CB=LDS_OST+NW*4096, LDS_BYTES=LDS_CB+SEQ*8;
constexpr float C2=0.125f*1.4426950408889634f;
__device__ __forceinline__ void glds16(const void*gsrc,unsigned lds_dst){unsigned keep;
  asm volatile("s_mov_b32 %0, m0\n\ts_mov_b32 m0, %2\n\ts_nop 0\n\tglobal_load_lds_dwordx4 %1, off\n\ts_mov_b32 m0, %0":"=&s"(keep):"v"(gsrc),"s"(lds_dst):"memory");}
__device__ __forceinline__ void glds16s(unsigned voff,const void*sbase,unsigned lds_dst){unsigned keep;
  asm volatile("s_mov_b32 %0, m0\n\ts_mov_b32 m0, %2\n\ts_nop 2\n\tglobal_load_lds_dwordx4 %1, %3\n\ts_mov_b32 m0, %0":"=&s"(keep):"v"(voff),"s"(lds_dst),"s"(sbase):"memory");}
__device__ __forceinline__ float max3f(float a,float b,float c){float r;asm("v_max3_f32 %0, %1, %2, %3":"=v"(r):"v"(a),"v"(b),"v"(c));return r;}
__device__ __forceinline__ float max2f(float a,float b){float r;asm("v_max_f32_e32 %0, %1, %2":"=v"(r):"v"(a),"v"(b));return r;}
__device__ __forceinline__ float fadd_s(float a,float b){float r;asm("v_add_f32_e32 %0, %1, %2":"=v"(r):"v"(a),"v"(b));return r;}
__device__ __forceinline__ float fsub_s(float a,float b){float r;asm("v_sub_f32_e32 %0, %1, %2":"=v"(r):"v"(a),"v"(b));return r;}
typedef float f32x2_t __attribute__((ext_vector_type(2))); typedef __bf16 bf16x2_t __attribute__((ext_vector_type(2)));
__device__ __forceinline__ unsigned cvtpk_s(float lo,float hi){f32x2_t v={lo,hi};bf16x2_t b=__builtin_convertvector(v,bf16x2_t);return __builtin_bit_cast(unsigned,b);}
#define WAIT_BAR(N) asm volatile("s_waitcnt vmcnt(" #N ") lgkmcnt(0)\n\ts_barrier":::"memory")
typedef unsigned u32x2_t __attribute__((ext_vector_type(2)));
__device__ __forceinline__ unsigned bfr_(float x){unsigned u=__float_as_uint(x);return (u+0x7fffu+((u>>16)&1u))>>16;}
__device__ __forceinline__ void split3(float v,unsigned&h1,unsigned&h2,unsigned&h3){h1=bfr_(v);const float r1=v-__uint_as_float(h1<<16);h2=bfr_(r1);const float r2=r1-__uint_as_float(h2<<16);h3=bfr_(r2);}

__device__ __forceinline__ void qkt(f32x16&p0,f32x16&p1,const char*Kslot,const bf16x8*qr,const f32x16&negm,int r32,int hi){
  const char*kb=Kslot+hi*1024+r32*16;
  #pragma unroll
  for(int d0=0;d0<4;++d0){
    const bf16x8 b0=*reinterpret_cast<const bf16x8*>(kb+d0*2048);
    const bf16x8 b1=*reinterpret_cast<const bf16x8*>(kb+d0*2048+512);
    if(d0==0){p0=__builtin_amdgcn_mfma_f32_32x32x16_bf16(b0,qr[0],negm,0,0,0);p1=__builtin_amdgcn_mfma_f32_32x32x16_bf16(b1,qr[0],negm,0,0,0);}
    else{p0=__builtin_amdgcn_mfma_f32_32x32x16_bf16(b0,qr[d0],p0,0,0,0);p1=__builtin_amdgcn_mfma_f32_32x32x16_bf16(b1,qr[d0],p1,0,0,0);}}
}
typedef __attribute__((address_space(3))) const char* lds_cptr;
typedef short v4i16_t __attribute__((ext_vector_type(4)));
__device__ __forceinline__ void kload8(bf16x8*kf,lds_cptr kp){
  kf[0]=*(const __attribute__((address_space(3))) bf16x8*)(kp);      kf[1]=*(const __attribute__((address_space(3))) bf16x8*)(kp+512);
  kf[2]=*(const __attribute__((address_space(3))) bf16x8*)(kp+2048); kf[3]=*(const __attribute__((address_space(3))) bf16x8*)(kp+2560);
  kf[4]=*(const __attribute__((address_space(3))) bf16x8*)(kp+4096); kf[5]=*(const __attribute__((address_space(3))) bf16x8*)(kp+4608);
  kf[6]=*(const __attribute__((address_space(3))) bf16x8*)(kp+6144); kf[7]=*(const __attribute__((address_space(3))) bf16x8*)(kp+6656);
}
__device__ __forceinline__ void kload2(bf16x8*kf,lds_cptr kp,int j){ kf[2*j]=*(const __attribute__((address_space(3))) bf16x8*)(kp+j*2048); kf[2*j+1]=*(const __attribute__((address_space(3))) bf16x8*)(kp+j*2048+512); }
__device__ __forceinline__ s16x4 vtr(lds_cptr p){ return __builtin_bit_cast(s16x4,__builtin_amdgcn_ds_read_tr16_b64_v4i16((__attribute__((address_space(3))) v4i16_t*)p)); }
__device__ __forceinline__ float rowmax(const f32x16&p0,const f32x16&p1){
  float a=max3f(p0[0],p0[1],p1[0]),b=max3f(p0[2],p0[3],p1[1]);a=max3f(a,p1[2],p1[3]);
  #pragma unroll
  for(int r=4;r<16;r+=4){a=max3f(a,p0[r],p0[r+1]);b=max3f(b,p0[r+2],p0[r+3]);a=max3f(a,p1[r],p1[r+1]);b=max3f(b,p1[r+2],p1[r+3]);}
  const float m=max2f(a,b);
  auto rr=__builtin_amdgcn_permlane32_swap(__float_as_uint(m),__float_as_uint(m),false,false);
  return max2f(__uint_as_float(rr[0]),__uint_as_float(rr[1]));
}
__device__ __forceinline__ void pv(f32x16*o,int vb,bf16x8 pa0,bf16x8 pa1,bf16x8 pa2,bf16x8 pa3){
  #pragma unroll
  for(int d0=0;d0<2;++d0){s16x4 lo[4],hi[4];
    #pragma unroll
    for(int ks=0;ks<4;++ks){
      asm volatile("ds_read_b64_tr_b16 %0,%1 offset:%c2":"=&v"(lo[ks]):"v"(vb),"i"(d0*4096+ks*1024):"memory");
      asm volatile("ds_read_b64_tr_b16 %0,%1 offset:%c2":"=&v"(hi[ks]):"v"(vb),"i"(d0*4096+ks*1024+512):"memory");}
    asm volatile("s_waitcnt lgkmcnt(0)":::"memory");SBAR();
    #define PK(k) (bf16x8){lo[k][0],lo[k][1],lo[k][2],lo[k][3],hi[k][0],hi[k][1],hi[k][2],hi[k][3]}
    o[d0]=__builtin_amdgcn_mfma_f32_32x32x16_bf16(pa0,PK(0),o[d0],0,0,0);
    o[d0]=__builtin_amdgcn_mfma_f32_32x32x16_bf16(pa1,PK(1),o[d0],0,0,0);
    o[d0]=__builtin_amdgcn_mfma_f32_32x32x16_bf16(pa2,PK(2),o[d0],0,0,0);
    o[d0]=__builtin_amdgcn_mfma_f32_32x32x16_bf16(pa3,PK(3),o[d0],0,0,0);
    #undef PK
  }
}

#ifndef ATTN_STORE16
#define ATTN_STORE16(p,v) (*(u32x4*)(p)=(v))
#endif
template<int THRL> __device__ __forceinline__ void attn_unit(int b,int h,int qb,const bf16*Q,const bf16*__restrict__ K,const bf16*__restrict__ V,bf16*O,const float*CBg,const bf16*OGg,bool loadcb,float bnd2,char*shm){
  const int tid=threadIdx.x,lane=tid&63,r32=lane&31,hi=lane>>5; const int wid=__builtin_amdgcn_readfirstlane(tid>>6);
  const long rowbase=(long)b*SEQ; const int q0=qb*QB;
  const bf16*Qw=Q+(rowbase+q0+wid*QBLK)*DM+h*D;
  const bf16*Kh=K+rowbase*DM+h*D,*Vh=V+rowbase*DM+h*D;
  const unsigned lds0=(unsigned)(uintptr_t)shm;
  float*wsf=(float*)(shm+LDS_WS)+wid*64;
  int ln2_=lane; asm volatile("":"+v"(ln2_));
  const unsigned koff=(unsigned)(ln2_*DM+wid*8)*2u;
  const unsigned voff=(unsigned)((16*(wid&3)+(ln2_>>2))*DM+(wid>>2)*32+(ln2_&3)*8)*2u;
  const unsigned kdst=lds0+LDS_K+wid*1024, vdst=lds0+LDS_V+wid*1024;
  #define DMA_K(t,slot) glds16s(koff,Kh+(long)(t)*KVBLK*DM,(unsigned)__builtin_amdgcn_readfirstlane(kdst+(slot)))
  #define DMA_V(t,slot) glds16s(voff,Vh+(long)(t)*KVBLK*DM,(unsigned)__builtin_amdgcn_readfirstlane(vdst+(slot)))
  const int vb0=(int)(lds0+LDS_V)+((lane>>4)&1)*32+(lane&3)*8+(4*hi+((lane&15)>>2))*64;
  const char*Kbase=shm+LDS_K; bf16x8 kf[8];
  const lds_cptr shm3=(lds_cptr)shm; const lds_cptr kp0=shm3+LDS_K+hi*1024+r32*16; const lds_cptr vp0=shm3+LDS_V+((lane>>4)&1)*32+(lane&3)*8+(4*hi+((lane&15)>>2))*64;
  int NT=(q0+QB)/KVBLK;
  typedef __attribute__((address_space(3))) const u32x2_t* lds_u2p; lds_u2p bt=(lds_u2p)(shm3+LDS_CB)+r32;
  if(loadcb){ const float*src=CBg+(long)(b*NHEAD+h)*SEQ; u32x2_t*dst=(u32x2_t*)(shm+LDS_CB);
    #pragma unroll
    for(int i=0;i<8;++i){ const int kv=tid+512*i; unsigned h1,h2,h3; split3(src[kv],h1,h2,h3); dst[kv]=(u32x2_t){h1|(h2<<16),h3|0x3F800000u}; }
    asm volatile("s_waitcnt vmcnt(0) lgkmcnt(0)\n\ts_barrier":::"memory"); }
  { const lds_u2p b0_=(lds_u2p)(shm3+LDS_CB);
    #define BTV(kv) ({ const u32x2_t e_=b0_[kv]; __uint_as_float(e_.x<<16)+__uint_as_float(e_.x&0xffff0000u)+__uint_as_float(e_.y<<16); })
    const float bq0_=BTV(q0); int cand_=NT-4;
    while(cand_>=2){ const float d_=bq0_-BTV(64*cand_-1); if(__builtin_amdgcn_readfirstlane(d_>=bnd2?1:0))break; cand_-=2; }
    #undef BTV
    const int T0_=cand_>=2?cand_:0; Kh+=(long)T0_*KVBLK*DM; Vh+=(long)T0_*KVBLK*DM; bt+=64*T0_; NT-=T0_; }
  u32x4 Bq; const unsigned hm_=hi?0u:0xffffffffu;
  #define SETBQ(mh) do{ unsigned h1_,h2_,h3_; split3(-(mh),h1_,h2_,h3_); Bq.x=0x3F803F80u&hm_; Bq.y=(0x3F80u|(h1_<<16))&hm_; Bq.z=(h2_|(h3_<<16))&hm_; Bq.w=0u; }while(0)
  #define BIASM(P0,P1,t) do{ const u32x2_t a0_=bt[64*(t)],a1_=bt[64*(t)+32]; \
      P0=__builtin_amdgcn_mfma_f32_32x32x16_bf16(__builtin_bit_cast(bf16x8,(u32x4){a0_.x,a0_.y,0x3F803F80u,0u}),__builtin_bit_cast(bf16x8,Bq),P0,0,0,0); \
      P1=__builtin_amdgcn_mfma_f32_32x32x16_bf16(__builtin_bit_cast(bf16x8,(u32x4){a1_.x,a1_.y,0x3F803F80u,0u}),__builtin_bit_cast(bf16x8,Bq),P1,0,0,0); }while(0)
  SETBQ(0.f);
  DMA_K(0,0);DMA_V(0,0);DMA_K(1,SLOTB);
  bf16x8 qr[4];
  #pragma unroll
  for(int d0=0;d0<4;++d0)qr[d0]=*reinterpret_cast<const bf16x8*>(&Qw[(long)r32*DM+d0*16+hi*8]);
  float mhat=0.f,l_reg=0.f;f32x16 o[2];o[0]=f32x16{};o[1]=f32x16{};const f32x16 zero16=f32x16{};
  const int qrel=wid*QBLK+r32;
  #define CMASK(P0,P1,t) do{int jb_=(t)-(NT-4); if(jb_>=0)cmask(P0,P1,jb_,qrel,hi);}while(0)
  bool resc=false;
  #define START(P0,P1) do{ const float rm=rowmax(P0,P1); resc=false; \
    { const float dl=rm; mhat=fadd_s(mhat,dl); \
      _Pragma("unroll") for(int r=0;r<16;++r){P0[r]=fsub_s(P0[r],dl);P1[r]=fsub_s(P1[r],dl);} \
      SETBQ(mhat); } \
    _Pragma("unroll") for(int r=0;r<16;++r)P0[r]=__builtin_amdgcn_exp2f(P0[r]); }while(0)
  #define RESC() do{ if(resc){ asm volatile("s_waitcnt lgkmcnt(0)":::"memory"); \
      _Pragma("unroll") for(int d_=0;d_<2;++d_) _Pragma("unroll") for(int r=0;r<16;++r)o[d_][r]*=wsf[crow(r,hi)]; } }while(0)
  f32x16 pA0,pA1,pB0,pB1;
  int sl_prev=0,sl_cur=0,sl_next=SLOTB;
  #define ROT() do{sl_prev=sl_cur;sl_cur=sl_next;sl_next=(sl_next==(NSLOT-1)*SLOTB)?0:sl_next+SLOTB;}while(0)
  DMA_K(2,2*SLOTB);
  WAIT_BAR(3);
  qkt(pA0,pA1,Kbase,qr,zero16,r32,hi);BIASM(pA0,pA1,0);asm volatile("s_nop 15\n\ts_nop 7":"+v"(pA0),"+v"(pA1));CMASK(pA0,pA1,0);
  START(pA0,pA1);
  _Pragma("unroll") for(int r=0;r<16;++r)pA1[r]=__builtin_amdgcn_exp2f(pA1[r]);
  WAIT_BAR(0);
  DMA_K(3,0);DMA_V(1,SLOTB);
  ROT();
  kload8(kf,kp0+sl_cur);
  WAIT_BAR(2);
  s16x4 vlo[8],vhi[8]; u32x4 pw0,pw1,pw2,pw3;
  #define PKW(P,B) cvtpk_s(P[B],P[B+1])
  #define PAF(k) __builtin_bit_cast(bf16x8,pw##k)
  #define VFR(i) (bf16x8){vlo[i][0],vlo[i][1],vlo[i][2],vlo[i][3],vhi[i][0],vhi[i][1],vhi[i][2],vhi[i][3]}
  #define PIN(x) asm volatile("":"+v"(x))
  #define MX3(a,b,c) __builtin_fmaxf(__builtin_fmaxf((a),(b)),(c))
  #define GAPA(MF,A0,A1,A2,A3,W0,W1,PW) do{ MF; sacc+=A0; sacc+=A1; sacc+=A2; sacc+=A3; PIN(sacc); W0; W1; PIN(PW); SBAR(); }while(0)
  #define EX(v) __builtin_amdgcn_exp2f(v)
  #define GAPB(MF,X,B) do{ MF; X[B]=EX(X[B]); X[B+1]=EX(X[B+1]); X[B+2]=EX(X[B+2]); X[B+3]=EX(X[B+3]); PIN(X); SBAR(); }while(0)
  #define VRD(i) do{ vlo[i]=vtr(vp_+(((i)>>2)*4096+((i)&3)*1024)); vhi[i]=vtr(vp_+(((i)>>2)*4096+((i)&3)*1024+512)); }while(0)
  #define KRD(G,j) do{ if(G){ kload2(kf,kp0+sl_next,j); SBAR(); } }while(0)
  #define STEP(C0,C1,P0,P1,t,GK,GV,GL) do{ SBAR(); \
    const lds_cptr vp_=vp0+sl_prev; \
    VRD(0); SBAR(); float sacc=(P0[0]+P0[1]); \
    GAPA(C0=__builtin_amdgcn_mfma_f32_32x32x16_bf16(kf[0],qr[0],zero16,0,0,0), P0[2],P0[3],P0[4],P0[5],     pw0[0]=PKW(P0,0), pw0[1]=PKW(P0,2), pw0); \
    VRD(4); SBAR(); GAPA(C1=__builtin_amdgcn_mfma_f32_32x32x16_bf16(kf[1],qr[0],zero16,0,0,0), P0[6],P0[7],P0[8],P0[9],     pw0[2]=PKW(P0,4), pw0[3]=PKW(P0,6), pw0); \
    VRD(1); SBAR(); GAPA(C0=__builtin_amdgcn_mfma_f32_32x32x16_bf16(kf[2],qr[1],C0,0,0,0),   P0[10],P0[11],P0[12],P0[13], pw1[0]=PKW(P0,8), pw1[1]=PKW(P0,10), pw1); \
    VRD(5); SBAR(); GAPA(C1=__builtin_amdgcn_mfma_f32_32x32x16_bf16(kf[3],qr[1],C1,0,0,0),   P0[14],P0[15],P1[0],P1[1],   pw1[2]=PKW(P0,12),pw1[3]=PKW(P0,14), pw1); \
    VRD(2); SBAR(); GAPA(C0=__builtin_amdgcn_mfma_f32_32x32x16_bf16(kf[4],qr[2],C0,0,0,0),   P1[2],P1[3],P1[4],P1[5],     pw2[0]=PKW(P1,0), pw2[1]=PKW(P1,2), pw2); \
    VRD(6); SBAR(); GAPA(C1=__builtin_amdgcn_mfma_f32_32x32x16_bf16(kf[5],qr[2],C1,0,0,0),   P1[6],P1[7],P1[8],P1[9],     pw2[2]=PKW(P1,4), pw2[3]=PKW(P1,6), pw2); \
    VRD(3); SBAR(); GAPA(C0=__builtin_amdgcn_mfma_f32_32x32x16_bf16(kf[6],qr[3],C0,0,0,0),   P1[10],P1[11],P1[12],P1[13], pw3[0]=PKW(P1,8), pw3[1]=PKW(P1,10), pw3); \
    VRD(7); SBAR(); GAPA(C1=__builtin_amdgcn_mfma_f32_32x32x16_bf16(kf[7],qr[3],C1,0,0,0),   P1[14],P1[15],0.f,0.f,       pw3[2]=PKW(P1,12),pw3[3]=PKW(P1,14), pw3); \
    l_reg+=sacc; \
    if(GK){DMA_K((t)+3,sl_cur);} if(GV){DMA_V((t)+1,sl_next);} \
    BIASM(C0,C1,t); CMASK(C0,C1,t); \
    { float a=MX3(C0[0],C0[1],C1[0]),b=MX3(C0[2],C0[3],C1[1]); a=MX3(a,C1[2],C1[3]); \
      _Pragma("unroll") for(int r=4;r<16;r+=4){a=MX3(a,C0[r],C0[r+1]);b=MX3(b,C0[r+2],C0[r+3]);a=MX3(a,C1[r],C1[r+1]);b=MX3(b,C1[r+2],C1[r+3]);} \
      float rm=__builtin_fmaxf(a,b); { auto rr=__builtin_amdgcn_permlane32_swap(__float_as_uint(rm),__float_as_uint(rm),false,false); rm=__builtin_fmaxf(__uint_as_float(rr[0]),__uint_as_float(rr[1])); } \
      resc=false; \
      if(__builtin_expect(__any(rm>(float)THRL),0)){ const float dl=__builtin_fmaxf(rm,0.f); mhat+=dl; \
        _Pragma("unroll") for(int r=0;r<16;++r){C0[r]-=dl;C1[r]-=dl;} \
        SETBQ(mhat); \
        const float f=__builtin_amdgcn_exp2f(-dl); l_reg*=f; if(hi==0)wsf[r32]=f; resc=true; } } \
    SBAR(); \
    GAPB(o[0]=__builtin_amdgcn_mfma_f32_32x32x16_bf16(PAF(0),VFR(0),o[0],0,0,0), C0,0); \
    GAPB(o[1]=__builtin_amdgcn_mfma_f32_32x32x16_bf16(PAF(0),VFR(4),o[1],0,0,0), C0,4); \
    KRD(GL,0); GAPB(o[0]=__builtin_amdgcn_mfma_f32_32x32x16_bf16(PAF(1),VFR(1),o[0],0,0,0), C0,8); \
    KRD(GL,1); GAPB(o[1]=__builtin_amdgcn_mfma_f32_32x32x16_bf16(PAF(1),VFR(5),o[1],0,0,0), C0,12); \
    KRD(GL,2); GAPB(o[0]=__builtin_amdgcn_mfma_f32_32x32x16_bf16(PAF(2),VFR(2),o[0],0,0,0), C1,0); \
    KRD(GL,3); GAPB(o[1]=__builtin_amdgcn_mfma_f32_32x32x16_bf16(PAF(2),VFR(6),o[1],0,0,0), C1,4); \
    GAPB(o[0]=__builtin_amdgcn_mfma_f32_32x32x16_bf16(PAF(3),VFR(3),o[0],0,0,0), C1,8); \
    GAPB(o[1]=__builtin_amdgcn_mfma_f32_32x32x16_bf16(PAF(3),VFR(7),o[1],0,0,0), C1,12); \
    }while(0)
  int t=1;
  #undef CMASK
  #define CMASK(P0,P1,t) do{}while(0)
  for(;t+5<NT;t+=2){
    STEP(pB0,pB1,pA0,pA1,t,true,true,true);     WAIT_BAR(2); RESC(); ROT();
    STEP(pA0,pA1,pB0,pB1,t+1,true,true,true);   WAIT_BAR(2); RESC(); ROT();
  }
  #undef CMASK
  #define CMASK(P0,P1,t) do{int jb_=(t)-(NT-4); if(jb_>=0)cmask(P0,P1,jb_,qrel,hi);}while(0)
  #define ENDW(tt) do{ if((tt)+3<NT){WAIT_BAR(2);} else if((tt)+2<NT){WAIT_BAR(1);} else {WAIT_BAR(0);} }while(0)
  for(;t+1<NT;t+=2){
    STEP(pB0,pB1,pA0,pA1,t,(t+3<NT),(t+1<NT),(t+1<NT));       ENDW(t);   RESC(); ROT();
    STEP(pA0,pA1,pB0,pB1,t+1,(t+4<NT),(t+2<NT),(t+2<NT));     ENDW(t+1); RESC(); ROT();
  }
  STEP(pB0,pB1,pA0,pA1,NT-1,false,false,false); RESC();
  { float sacc=pB0[0]+pB0[1]; _Pragma("unroll") for(int r=2;r<16;++r)sacc+=pB0[r]; _Pragma("unroll") for(int r=0;r<16;++r)sacc+=pB1[r]; l_reg+=sacc;
    pw0=(u32x4){PKW(pB0,0),PKW(pB0,2),PKW(pB0,4),PKW(pB0,6)};pw1=(u32x4){PKW(pB0,8),PKW(pB0,10),PKW(pB0,12),PKW(pB0,14)};pw2=(u32x4){PKW(pB1,0),PKW(pB1,2),PKW(pB1,4),PKW(pB1,6)};pw3=(u32x4){PKW(pB1,8),PKW(pB1,10),PKW(pB1,12),PKW(pB1,14)};
    SBAR(); pv(o,vb0+sl_cur,PAF(0),PAF(1),PAF(2),PAF(3)); }
  #undef PKW
  #undef PAF
  #undef VFR
  #undef PIN
  #undef MX3
  #undef GAPA
  #undef GAPB
  #undef EX
  #undef VRD
  #undef KRD
  #undef STEP
  #undef ENDW
  {auto rr=__builtin_amdgcn_permlane32_swap(__float_as_uint(l_reg),__float_as_uint(l_reg),false,false);l_reg=__uint_as_float(rr[0])+__uint_as_float(rr[1]);}
  if(hi==0)wsf[32+r32]=l_reg;asm volatile("s_waitcnt lgkmcnt(0)":::"memory");
  float rli[16];
  #pragma unroll
  for(int r=0;r<16;++r)rli[r]=__builtin_amdgcn_rcpf(wsf[32+crow(r,hi)]);
  bf16*Ow=O+(rowbase+q0+wid*QBLK)*DM+h*D;
  { bf16*stg=(bf16*)(shm+LDS_OST)+wid*2048;
    #pragma unroll
    for(int r=0;r<16;++r){const int orow=crow(r,hi);
      #pragma unroll
      for(int d0=0;d0<2;++d0)stg[orow*64+d0*32+r32]=__float2bfloat16(o[d0][r]*rli[r]);}
    asm volatile("s_waitcnt lgkmcnt(0)":::"memory");
    int ln_=lane; asm volatile("":"+v"(ln_));
    #pragma unroll
    for(int i=0;i<4;++i){const int row=i*8+(ln_>>3),ch=ln_&7; u32x4 v=*(const u32x4*)(stg+row*64+ch*8);
      if(OGg){ const u32x4 gt=*(const u32x4*)(OGg+(rowbase+q0+wid*QBLK+row)*DM+h*D+ch*8);
        _Pragma("unroll") for(int e=0;e<4;++e){ const float a0=__uint_as_float(v[e]<<16)*__builtin_amdgcn_rcpf(1.f+__builtin_amdgcn_exp2f(-1.4426950408889634f*__uint_as_float(gt[e]<<16)));
          const float a1=__uint_as_float(v[e]&0xffff0000u)*__builtin_amdgcn_rcpf(1.f+__builtin_amdgcn_exp2f(-1.4426950408889634f*__uint_as_float(gt[e]&0xffff0000u))); v[e]=cvtpk_s(a0,a1); } }
      ATTN_STORE16(Ow+(long)row*DM+ch*8,v);} }
  asm volatile("s_waitcnt lgkmcnt(0)\n\ts_barrier":::"memory");
  #undef BIASM
  #undef SETBQ
  #undef DMA_K
  #undef DMA_V
  #undef CMASK
  #undef START
  #undef RESC
  #undef ROT
}
constexpr int ATTN_LDS_BYTES=LDS_BYTES;
struct AttnTensors { const bf16* Q; const bf16* K; const bf16* V; bf16* O; const float* CB; const bf16* OG; };
struct AttnUnit { int bh; int qb; };
struct StaticOrder {
  int vcu,G;
  __device__ __forceinline__ explicit StaticOrder(int grid,int block):vcu((grid%8==0)?(block%8)*(grid/8)+block/8:block),G(grid){}
  __device__ __forceinline__ bool next(int i,AttnUnit&u)const{ const int vc=vcu+(i>>2)*G; if(vc>=256)return false; const int s=vc&3,k=i&3; u.bh=vc>>2; u.qb=(k==0)?s:(k==1)?7-s:(k==2)?8+s:15-s; return true; }
  __device__ __forceinline__ void a_ready(const AttnUnit&)const{}
  __device__ __forceinline__ void done(const AttnUnit&)const{}
};
template<class Sched,int THRL=60> __device__ __forceinline__ void attn_phase(char*lds,const AttnTensors&T,const Sched&S){
  AttnUnit u;
  int prev=-1; float bnd2=1e30f;
  for(int i=0;S.next(i,u);++i){ S.a_ready(u);
    if(u.bh!=prev){
      int tid=threadIdx.x; asm volatile("":"+v"(tid)); const int lane=tid&63,wid=tid>>6; const long rb=(long)(u.bh/NHEAD)*SEQ*DM+(u.bh%NHEAD)*D; float mq=0.f,mk=0.f;
      for(int r=tid;r<SEQ;r+=512){ float sq=0.f,sk=0.f;
        #pragma unroll
        for(int cch=0;cch<8;++cch){ const u32x4 a=*(const u32x4*)(T.Q+rb+(long)r*DM+cch*8), c=*(const u32x4*)(T.K+rb+(long)r*DM+cch*8);
          #pragma unroll
          for(int e=0;e<4;++e){ const float a0=__uint_as_float(a[e]<<16),a1=__uint_as_float(a[e]&0xffff0000u),c0=__uint_as_float(c[e]<<16),c1=__uint_as_float(c[e]&0xffff0000u); sq+=a0*a0+a1*a1; sk+=c0*c0+c1*c1; } }
        mq=fmaxf(mq,sq); mk=fmaxf(mk,sk); }
      #pragma unroll
      for(int o=1;o<64;o<<=1){ mq=fmaxf(mq,__shfl_xor(mq,o)); mk=fmaxf(mk,__shfl_xor(mk,o)); }
      float*red=(float*)(lds+LDS_WS);
      if(lane==0){ red[wid*2]=mq; red[wid*2+1]=mk; }
      asm volatile("s_waitcnt lgkmcnt(0)\n\ts_barrier":::"memory");
      float aq=0.f,ak=0.f;
      #pragma unroll
      for(int w=0;w<NW;++w){ aq=fmaxf(aq,red[w*2]); ak=fmaxf(ak,red[w*2+1]); }
      asm volatile("s_waitcnt lgkmcnt(0)\n\ts_barrier":::"memory");
      bnd2=__uint_as_float((unsigned)__builtin_amdgcn_readfirstlane((int)__float_as_uint(2.f*sqrtf(aq*ak)*1.01f+48.f))); }
    attn_unit<THRL>(u.bh/NHEAD,u.bh%NHEAD,u.qb,T.Q,T.K,T.V,T.O,T.CB,T.OG,u.bh!=prev,bnd2,lds); prev=u.bh; S.done(u); }
}

constexpr int SB_K=0, SB_V=2*SLOTB, SB_FLAG=4*SLOTB, SB_OST=SB_FLAG+256, SB_BYTES=SB_OST+NW*4096;
constexpr float SB_THR=48.0f;
__device__ __forceinline__ void sb_unit(int b,int h,int qb,const bf16*Q,const bf16*__restrict__ K,const bf16*__restrict__ V,bf16*O,char*shm){
  const int tid=threadIdx.x,lane=tid&63,r32=lane&31,hi=lane>>5; const int wid=__builtin_amdgcn_readfirstlane(tid>>6);
  const long rowbase=(long)b*SEQ; const int q0=qb*QB;
  const bf16*Qw=Q+(rowbase+q0+wid*QBLK)*DM+h*D;
  const bf16*Kh=K+rowbase*DM+h*D,*Vh=V+rowbase*DM+h*D;
  const unsigned lds0=(unsigned)(uintptr_t)shm;
  const unsigned koff=(unsigned)(lane*DM+wid*8)*2u;
  const unsigned voff=(unsigned)((16*(wid&3)+(lane>>2))*DM+(wid>>2)*32+(lane&3)*8)*2u;
  const unsigned kdst=lds0+SB_K+wid*1024, vdst=lds0+SB_V+wid*1024;
  #define SB_DMA_K(t,slot) glds16s(koff,Kh+(long)(t)*KVBLK*DM,(unsigned)__builtin_amdgcn_readfirstlane(kdst+(slot)))
  #define SB_DMA_V(t,slot) glds16s(voff,Vh+(long)(t)*KVBLK*DM,(unsigned)__builtin_amdgcn_readfirstlane(vdst+(slot)))
  const int vb0=(int)(lds0+SB_V)+((lane>>4)&1)*32+(lane&3)*8+(4*hi+((lane&15)>>2))*64;
  volatile unsigned*flag=(volatile unsigned*)(shm+SB_FLAG);
  int j=(q0+QB)/KVBLK-1;
  SB_DMA_K(j,0);SB_DMA_V(j,0);
  bf16x8 qr[4];
  #pragma unroll
  for(int d0=0;d0<4;++d0)qr[d0]=*reinterpret_cast<const bf16x8*>(&Qw[(long)r32*DM+d0*16+hi*8]);
  f32x16 o[2];o[0]=f32x16{};o[1]=f32x16{};
  const f32x16 zero16=f32x16{};
  float carry=0.f; bool mydone=false;
  const int qw0=q0+wid*QBLK, tq=qw0+r32;
  int slot=0;
  for(int it=0;j>=0;--j,++it){
    WAIT_BAR(0);
    if(it>0){ unsigned all=1u;
      #pragma unroll
      for(int w=0;w<NW;++w)all&=flag[((it-1)&1)*8+w];
      if(__builtin_amdgcn_readfirstlane(all))break; }
    if(j>0){SB_DMA_K(j-1,slot^SLOTB);SB_DMA_V(j-1,slot^SLOTB);}
    if(64*j<=qw0+30&&!mydone){
      f32x16 p0,p1;
      qkt(p0,p1,shm+SB_K+slot,qr,zero16,r32,hi);
      if(64*j+64>qw0){ const int kb=64*j+4*hi;
        #pragma unroll
        for(int r=0;r<16;++r){const int kv=kb+(r&3)+8*(r>>2); if(!(kv<tq))p0[r]=-INFINITY; if(!(kv+32<tq))p1[r]=-INFINITY;} }
      f32x16 s0,s1;
      #pragma unroll
      for(int r=0;r<16;++r){ s0[r]=__builtin_fmaxf(p0[r],0.f)+__builtin_amdgcn_logf(1.f+__builtin_amdgcn_exp2f(-__builtin_fabsf(p0[r])));
                             s1[r]=__builtin_fmaxf(p1[r],0.f)+__builtin_amdgcn_logf(1.f+__builtin_amdgcn_exp2f(-__builtin_fabsf(p1[r]))); }
      float w1[2][4],w0[2][4],gl[2][4],gh[2][4];
      #pragma unroll
      for(int g=0;g<4;++g){ w1[0][g]=s0[4*g+3]+s0[4*g+2]; w0[0][g]=w1[0][g]+s0[4*g+1]; const float gs0=w0[0][g]+s0[4*g];
                            w1[1][g]=s1[4*g+3]+s1[4*g+2]; w0[1][g]=w1[1][g]+s1[4*g+1]; const float gs1=w0[1][g]+s1[4*g];
        auto ra=__builtin_amdgcn_permlane32_swap(__float_as_uint(gs0),__float_as_uint(gs0),false,false); gl[0][g]=__uint_as_float(ra[0]); gh[0][g]=__uint_as_float(ra[1]);
        auto rb=__builtin_amdgcn_permlane32_swap(__float_as_uint(gs1),__float_as_uint(gs1),false,false); gl[1][g]=__uint_as_float(rb[0]); gh[1][g]=__uint_as_float(rb[1]); }
      float run=carry, base[2][4];
      #pragma unroll
      for(int blk=1;blk>=0;--blk)
        #pragma unroll
        for(int g=3;g>=0;--g){ const float eh=run; run+=gh[blk][g]; const float el=run; run+=gl[blk][g]; base[blk][g]=hi?eh:el; }
      carry=run;
      #pragma unroll
      for(int g=0;g<4;++g){
        p0[4*g+3]=__builtin_amdgcn_exp2f(p0[4*g+3]-s0[4*g+3]-base[0][g]);
        p0[4*g+2]=__builtin_amdgcn_exp2f(p0[4*g+2]-s0[4*g+2]-base[0][g]-s0[4*g+3]);
        p0[4*g+1]=__builtin_amdgcn_exp2f(p0[4*g+1]-s0[4*g+1]-base[0][g]-w1[0][g]);
        p0[4*g  ]=__builtin_amdgcn_exp2f(p0[4*g  ]-s0[4*g  ]-base[0][g]-w0[0][g]);
        p1[4*g+3]=__builtin_amdgcn_exp2f(p1[4*g+3]-s1[4*g+3]-base[1][g]);
        p1[4*g+2]=__builtin_amdgcn_exp2f(p1[4*g+2]-s1[4*g+2]-base[1][g]-s1[4*g+3]);
        p1[4*g+1]=__builtin_amdgcn_exp2f(p1[4*g+1]-s1[4*g+1]-base[1][g]-w1[1][g]);
        p1[4*g  ]=__builtin_amdgcn_exp2f(p1[4*g  ]-s1[4*g  ]-base[1][g]-w0[1][g]); }
      u32x4 pw0,pw1,pw2,pw3;
      pw0=(u32x4){cvtpk_s(p0[0],p0[1]),cvtpk_s(p0[2],p0[3]),cvtpk_s(p0[4],p0[5]),cvtpk_s(p0[6],p0[7])};
      pw1=(u32x4){cvtpk_s(p0[8],p0[9]),cvtpk_s(p0[10],p0[11]),cvtpk_s(p0[12],p0[13]),cvtpk_s(p0[14],p0[15])};
      pw2=(u32x4){cvtpk_s(p1[0],p1[1]),cvtpk_s(p1[2],p1[3]),cvtpk_s(p1[4],p1[5]),cvtpk_s(p1[6],p1[7])};
      pw3=(u32x4){cvtpk_s(p1[8],p1[9]),cvtpk_s(p1[10],p1[11]),cvtpk_s(p1[12],p1[13]),cvtpk_s(p1[14],p1[15])};
      SBAR(); pv(o,vb0+slot,__builtin_bit_cast(bf16x8,pw0),__builtin_bit_cast(bf16x8,pw1),__builtin_bit_cast(bf16x8,pw2),__builtin_bit_cast(bf16x8,pw3));
      mydone=__all(carry>SB_THR)!=0;
    }
    if(lane==0)flag[(it&1)*8+wid]=mydone?1u:0u;
    slot^=SLOTB;
  }
  bf16*Ow=O+(rowbase+q0+wid*QBLK)*DM+h*D;
  { bf16*stg=(bf16*)(shm+SB_OST)+wid*2048;
    #pragma unroll
    for(int r=0;r<16;++r){const int orow=crow(r,hi);
      #pragma unroll
      for(int d0=0;d0<2;++d0)stg[orow*64+d0*32+r32]=__float2bfloat16(o[d0][r]);}
    asm volatile("s_waitcnt lgkmcnt(0)":::"memory");
    #pragma unroll
    for(int i=0;i<4;++i){const int row=i*8+(lane>>3),ch=lane&7; const u32x4 v=*(const u32x4*)(stg+row*64+ch*8); *(u32x4*)(Ow+(long)row*DM+ch*8)=v;} }
  asm volatile("s_waitcnt vmcnt(0) lgkmcnt(0)\n\ts_barrier":::"memory");
  #undef SB_DMA_K
  #undef SB_DMA_V
}
struct SbOrder {
  int vcu,G;
  __device__ __forceinline__ explicit SbOrder(int grid,int block):vcu((grid%8==0)?(block%8)*(grid/8)+block/8:block),G(grid){}
  __device__ __forceinline__ bool next(int i,AttnUnit&u)const{ const int L=(vcu+(i>>2)*G)*4+(i&3); if(L>=BATCH*NHEAD*NQB)return false; u.bh=L/NQB; u.qb=L%NQB; return true; }
};
template<class Sched> __device__ __forceinline__ void sb_phase(char*lds,const AttnTensors&T,const Sched&S){
  AttnUnit u;
  for(int i=0;S.next(i,u);++i) sb_unit(u.bh/NHEAD,u.bh%NHEAD,u.qb,T.Q,T.K,T.V,T.O,lds);
}
#undef SBAR
#undef WAIT_BAR
}

struct Params {
    const float* in[38];
    float* out; unsigned char* ws;
    int ph_lo, ph_hi, li, pad;
};
enum { I_X = 0, I_LN1G, I_LN1B, I_LN2G, I_LN2B, I_FOX_WIN, I_FOX_BF, I_FOX_WOUT, I_GM_WIN, I_GM_BIN, I_GM_LNG, I_GM_LNB, I_GM_WS, I_GM_BS, I_GM_WOUT,
       I_SB_WIN, I_SB_WOUT, I_RW_MU, I_RW_WRKV, I_RW_W0, I_RW_W1, I_RW_W2, I_RW_A0, I_RW_A1, I_RW_A2, I_RW_G1, I_RW_G2, I_RW_KK, I_RW_KA, I_RW_RK,
       I_RW_GNG, I_RW_GNB, I_RW_WOUT, I_ROUTER_W, I_ROUTER_B, I_MOE_G, I_MOE_U, I_MOE_D };

struct Ctx { int tid, lane, wave, gw, ngw; unsigned char* lds; };

__device__ __forceinline__ void tr_tile(const float* src, int ld, bf16* dst, int ldt, float* scr, int lane) {
    float tv[32];
#pragma unroll
    for (int i = 0; i < 32; ++i) tv[i] = src[(size_t)(2 * i + (lane >> 5)) * ld + (lane & 31)];
#pragma unroll
    for (int i = 0; i < 32; ++i) scr[(2 * i + (lane >> 5)) * 33 + (lane & 31)] = tv[i];
    LDS_WAIT();
    const int c = lane & 7;
#pragma unroll
    for (int j = 0; j < 4; ++j) { const int n = (lane >> 3) + 8 * j; const float* s = scr + (8 * c) * 33 + n;
        u32x4 o; o.x = pk2(s[0 * 33], s[1 * 33]); o.y = pk2(s[2 * 33], s[3 * 33]); o.z = pk2(s[4 * 33], s[5 * 33]); o.w = pk2(s[6 * 33], s[7 * 33]);
        *(u32x4*)(dst + (size_t)n * ldt + 8 * c) = o; }
    LDS_WAIT();
}
__device__ __forceinline__ void conv_matrix(const Ctx& c, const float* W, int ld, int K, int ncols, bf16* WT, int ldt, int mode) {
    float* scr = (float*)(c.lds + c.wave * 16384);
    const int nblk = ncols / 32, nit = (K / 64) * nblk;
    for (int it = c.gw; it < nit; it += c.ngw) {
        const int kb = it / nblk, nb = it % nblk, n0 = nb * 32, k0 = kb * 64;
        int orow = n0; if (mode) orow = (n0 >> 7) * 256 + (n0 & 127) + (mode == 2 ? 128 : 0);
        tr_tile(W + (size_t)k0 * ld + n0, ld, WT + (size_t)orow * ldt + k0, ldt, scr, c.lane);
    }
}
__device__ __forceinline__ void conv_moe_items(const Ctx& c, const Params& p, int l, int it0, int it1, int w, int nw) {
    float* scr = (float*)(c.lds + c.wave * 16384);
    bf16* gu = (bf16*)(p.ws + WS_GU + (size_t)(l & 1) * WS_MOE_ALT); bf16* dn = (bf16*)(p.ws + WS_DOWN + (size_t)(l & 1) * WS_MOE_ALT);
    for (int it = it0 + w; it < it1; it += nw) {
        const int mtx = it >> 8, sub = it & 255, kind = mtx / 16, e = mtx % 16;
        if (kind < 2) {
            const float* W = p.in[kind == 0 ? I_MOE_G : I_MOE_U] + (size_t)(l * 16 + e) * 1024 * 512;
            const int kb = sub / 16, nb = sub % 16, n0 = nb * 32, k0 = kb * 64;
            const int orow = (n0 >> 7) * 256 + (n0 & 127) + (kind == 1 ? 128 : 0);
            tr_tile(W + (size_t)k0 * 512 + n0, 512, gu + (size_t)e * 1024 * 1024 + (size_t)orow * 1024 + k0, 1024, scr, c.lane);
        } else {
            const float* W = p.in[I_MOE_D] + (size_t)(l * 16 + e) * 512 * 1024;
            const int kb = sub / 32, nb = sub % 32, n0 = nb * 32, k0 = kb * 64;
            tr_tile(W + (size_t)k0 * 1024 + n0, 1024, dn + (size_t)e * 1024 * 512 + (size_t)n0 * 512 + k0, 512, scr, c.lane);
        }
    }
}
struct ConvDesc { int in_idx, src_off, ld, K, ncols; unsigned dst; int ldt; };
__device__ __forceinline__ void conv_list(const Ctx& c, const Params& p, const ConvDesc* tab, int n, int w, int nw) {
    float* scr = (float*)(c.lds + c.wave * 16384);
    int total = 0;
    for (int i = 0; i < n; ++i) total += (tab[i].K / 64) * (tab[i].ncols / 32);
    for (int it = w; it < total; it += nw) {
        int r = it, i = 0;
        for (; i < n - 1; ++i) { const int ni = (tab[i].K / 64) * (tab[i].ncols / 32); if (r < ni) break; r -= ni; }
        const ConvDesc d = tab[i]; const int nblk = d.ncols / 32, kb = r / nblk, nb = r % nblk;
        const float* src = p.in[I_FOX_WIN];
#define CSEL(ix) if (d.in_idx == ix) src = p.in[ix];
        CSEL(I_FOX_WOUT) CSEL(I_GM_WIN) CSEL(I_GM_WOUT) CSEL(I_SB_WIN) CSEL(I_SB_WOUT) CSEL(I_RW_WRKV) CSEL(I_RW_W1) CSEL(I_RW_A1) CSEL(I_RW_G1) CSEL(I_RW_W2) CSEL(I_RW_A2) CSEL(I_RW_G2) CSEL(I_RW_WOUT)
#undef CSEL
        tr_tile(src + d.src_off + (size_t)(kb * 64) * d.ld + nb * 32, d.ld, (bf16*)(p.ws + d.dst) + (size_t)(nb * 32) * d.ldt + kb * 64, d.ldt, scr, c.lane);
    }
}
__device__ const ConvDesc CONV_FOX[3] = { {I_FOX_WIN, 0, 4112, 1024, 3072, (unsigned)WS_FOX_IN, 1024}, {I_FOX_WIN, 3088, 4112, 1024, 1024, (unsigned)(WS_FOX_IN + 3072 * 1024 * 2), 1024}, {I_FOX_WOUT, 0, 1024, 1024, 1024, (unsigned)WS_FOX_OUT, 1024} };
__device__ const ConvDesc CONV_GM[2] = { {I_GM_WIN, 0, 2048, 1024, 2048, (unsigned)WS_GM_IN, 1024}, {I_GM_WOUT, 0, 1024, 1024, 1024, (unsigned)WS_GM_OUT, 1024} };
__device__ const ConvDesc CONV_SB[2] = { {I_SB_WIN, 0, 3072, 1024, 3072, (unsigned)WS_SB_IN, 1024}, {I_SB_WOUT, 0, 1024, 1024, 1024, (unsigned)WS_SB_OUT, 1024} };
__device__ const ConvDesc CONV_RW[10] = { {I_RW_WRKV, 0, 1024, 1024, 1024, (unsigned)WS_RKV, 1024}, {I_RW_WRKV, 1024 * 1024, 1024, 1024, 1024, (unsigned)(WS_RKV + 2 * MiB), 1024}, {I_RW_WRKV, 2 * 1024 * 1024, 1024, 1024, 1024, (unsigned)(WS_RKV + 4 * MiB), 1024},
    {I_RW_W1, 0, 64, 1024, 64, (unsigned)WS_LORA1, 1024}, {I_RW_A1, 0, 64, 1024, 64, (unsigned)(WS_LORA1 + 256 * 1024 * 2), 1024}, {I_RW_G1, 0, 128, 1024, 128, (unsigned)(WS_LORA1 + 512 * 1024 * 2), 1024},
    {I_RW_W2, 0, 1024, 64, 1024, (unsigned)WS_LORA2, 128}, {I_RW_A2, 0, 1024, 64, 1024, (unsigned)(WS_LORA2 + 1024 * 128 * 2), 128}, {I_RW_G2, 0, 1024, 128, 1024, (unsigned)(WS_LORA2 + 2048 * 128 * 2), 128},
    {I_RW_WOUT, 0, 1024, 1024, 1024, (unsigned)WS_RW_OUT, 1024} };
__device__ __forceinline__ bool tail_slot(const Ctx& c, int nunits, int& w, int& nw, int bid) {
    const int G = gridDim.x, rem = nunits % G;
    if (rem == 0 || (G - rem) * 2 < G) { w = bid * NW + c.wave; nw = G * NW; return true; }
    if (bid < rem) return false;
    w = (bid - rem) * NW + c.wave; nw = (G - rem) * NW; return true;
}

struct Row { f32x4 v[4]; };
__device__ __forceinline__ Row row_load(const float* r, int lane) { Row x; const f32x4* p = (const f32x4*)r + lane;
#pragma unroll
    for (int j = 0; j < 4; ++j) x.v[j] = p[64 * j]; return x; }
__device__ __forceinline__ Row row_load_bf(const bf16* r, int lane) { Row x; const unsigned long long* p = (const unsigned long long*)r + lane;
#pragma unroll
    for (int j = 0; j < 4; ++j) { const unsigned long long a = p[64 * j]; x.v[j][0] = bf2f((unsigned)a & 0xffffu); x.v[j][1] = bf2f((unsigned)a >> 16); x.v[j][2] = bf2f((unsigned)(a >> 32) & 0xffffu); x.v[j][3] = bf2f((unsigned)(a >> 48)); } return x; }
__device__ __forceinline__ void row_store(float* r, int lane, const Row& x) { f32x4* p = (f32x4*)r + lane;
#pragma unroll
    for (int j = 0; j < 4; ++j) p[64 * j] = x.v[j]; }
__device__ __forceinline__ void row_store_bf(bf16* r, int lane, const Row& x) { unsigned long long* p = (unsigned long long*)r + lane;
#pragma unroll
    for (int j = 0; j < 4; ++j) p[64 * j] = (unsigned long long)pk2(x.v[j].x, x.v[j].y) | ((unsigned long long)pk2(x.v[j].z, x.v[j].w) << 32); }
__device__ __forceinline__ Row row_ln(const Row& x, const float* g, const float* b, int lane) {
    float s = 0.f;
#pragma unroll
    for (int j = 0; j < 4; ++j) s += (x.v[j].x + x.v[j].y) + (x.v[j].z + x.v[j].w);
    const float mean = wave_sum(s) * (1.f / D); float s2 = 0.f; Row y;
#pragma unroll
    for (int j = 0; j < 4; ++j) { y.v[j] = x.v[j] - mean; s2 += (y.v[j].x * y.v[j].x + y.v[j].y * y.v[j].y) + (y.v[j].z * y.v[j].z + y.v[j].w * y.v[j].w); }
    const float rstd = 1.0f / sqrtf(wave_sum(s2) * (1.f / D) + LN_EPS);
    const f32x4* gp = (const f32x4*)g + lane; const f32x4* bp = (const f32x4*)b + lane;
#pragma unroll
    for (int j = 0; j < 4; ++j) y.v[j] = y.v[j] * rstd * gp[64 * j] + bp[64 * j];
    return y;
}
__device__ __forceinline__ void stage_w16(const Ctx& c, const float* W, int ld, float* tab) {
    for (int i = c.tid; i < 1024 * 4; i += NTHR) { const int col = i >> 2, e4 = i & 3; const f32x4 w = *(const f32x4*)(W + (size_t)col * ld + e4 * 4);
        tab[(e4 * 4 + 0) * 1024 + col] = w.x; tab[(e4 * 4 + 1) * 1024 + col] = w.y; tab[(e4 * 4 + 2) * 1024 + col] = w.z; tab[(e4 * 4 + 3) * 1024 + col] = w.w; }
}
__device__ __forceinline__ void row_dot16(const Row& x, const float* tab, int lane, float (&out)[16]) {
    const LAS f32x4* tp = (const LAS f32x4*)(LAS const float*)tab + lane;
#pragma unroll
    for (int e = 0; e < 16; ++e) {
        f32x4 a = x.v[0] * tp[e * 256]; a += x.v[1] * tp[e * 256 + 64]; a += x.v[2] * tp[e * 256 + 128]; a += x.v[3] * tp[e * 256 + 192];
        out[e] = (a.x + a.y) + (a.z + a.w);
        if ((e & 3) == 3) asm volatile("" ::: "memory");
    }
    float b8[8], c4[4];
#pragma unroll
    for (int k = 0; k < 8; ++k) { auto r = __builtin_amdgcn_permlane32_swap(__float_as_uint(out[k]), __float_as_uint(out[k + 8]), false, false); b8[k] = __uint_as_float(r[0]) + __uint_as_float(r[1]); }
#pragma unroll
    for (int k = 0; k < 4; ++k) { auto r = __builtin_amdgcn_permlane16_swap(__float_as_uint(b8[k]), __float_as_uint(b8[k + 4]), false, false); c4[k] = red16(__uint_as_float(r[0]) + __uint_as_float(r[1])); }
#pragma unroll
    for (int rho = 0; rho < 4; ++rho)
#pragma unroll
        for (int k = 0; k < 4; ++k) out[4 * rho + k] = rdlane(c4[k], 16 * rho);
}

__device__ __forceinline__ void phase_p0(const Ctx& c, const Params& p) {
    unsigned char* ws = p.ws;
    conv_list(c, p, CONV_FOX, 3, c.gw, c.ngw); conv_list(c, p, CONV_GM, 2, c.gw, c.ngw); conv_list(c, p, CONV_SB, 2, c.gw, c.ngw); conv_list(c, p, CONV_RW, 10, c.gw, c.ngw);
    {
        const int gt = c.gw * 64 + c.lane, ngt = c.ngw * 64;
        u32x4 z = {0u, 0u, 0u, 0u};
        u32x4* l1 = (u32x4*)(ws + WS_LORA1);
        for (int i = gt; i < 768 * 128; i += ngt) { const int row = i >> 7, blk = row >> 8, r = row & 255; if (r >= (blk == 2 ? 128 : 64)) l1[i] = z; }
        u32x4* l2 = (u32x4*)(ws + WS_LORA2);
        for (int i = gt; i < 2048 * 16; i += ngt) { if ((i & 15) >= 8) l2[i] = z; }
        const float* wsrc = p.in[I_GM_WS]; bf16* wd = (bf16*)(ws + WS_GM_WS);
        for (int i = gt; i < 8 * 128 * 128; i += ngt) { const int s = i & 127, t = (i >> 7) & 127; wd[i] = (bf16)f2bf(s <= t ? wsrc[i] : 0.f); }
    }
    conv_moe_items(c, p, 0, 0, 48 * 256, c.gw, c.ngw);
    bf16* Hb = (bf16*)(ws + WS_HB); float* FL = (float*)(ws + WS_FL);
    __syncthreads(); float* tab = (float*)c.lds; stage_w16(c, p.in[I_FOX_WIN] + 3072, 4112, tab); __syncthreads();
    for (int m = c.gw; m < T; m += c.ngw) {
        Row x = row_load(p.in[I_X] + (size_t)m * D, c.lane);
        row_store_bf(Hb + (size_t)m * D, c.lane, x);
        float fl[16]; row_dot16(x, tab, c.lane, fl);
        if (c.lane < 16) { float v = fl[0];
#pragma unroll
            for (int e = 1; e < 16; ++e) v = (c.lane == e) ? fl[e] : v;
            FL[(size_t)m * 16 + c.lane] = v; }
    }
}

struct GDesc { int arow0, brow0, pm, pn; };
template <class Sched, class Epi>
__device__ __forceinline__ void gemm_naive(const Ctx& c, const bf16* A, int lda, const bf16* Bt, int ldb, int K, const Sched& S, const Epi& E) {
    float* As = (float*)c.lds;
    float* Bs = As + 32 * 132;
    const int tid = c.tid, ty = tid >> 4, tx = tid & 15;
    for (int ui = blockIdx.x;; ui += gridDim.x) {
        GDesc d; if (!S.get(ui, d)) break;
        float acc[4][16];
#pragma unroll
        for (int i = 0; i < 4; ++i)
#pragma unroll
            for (int j = 0; j < 16; ++j) acc[i][j] = 0.f;
        for (int k0 = 0; k0 < K; k0 += 32) {
            { const int r = tid >> 2, kc = (tid & 3) * 8;
              const u32x4 v = *(const u32x4*)(A + (size_t)(d.arow0 + r) * lda + k0 + kc);
              As[(kc + 0) * 132 + r] = bf2f(v.x & 0xffffu); As[(kc + 1) * 132 + r] = bf2f(v.x >> 16);
              As[(kc + 2) * 132 + r] = bf2f(v.y & 0xffffu); As[(kc + 3) * 132 + r] = bf2f(v.y >> 16);
              As[(kc + 4) * 132 + r] = bf2f(v.z & 0xffffu); As[(kc + 5) * 132 + r] = bf2f(v.z >> 16);
              As[(kc + 6) * 132 + r] = bf2f(v.w & 0xffffu); As[(kc + 7) * 132 + r] = bf2f(v.w >> 16); }
#pragma unroll
            for (int jj = 0; jj < 2; ++jj) { const int idx = tid + 512 * jj, r = idx >> 2, kc = (idx & 3) * 8;
              const u32x4 v = *(const u32x4*)(Bt + (size_t)(d.brow0 + r) * ldb + k0 + kc);
              Bs[(kc + 0) * 260 + r] = bf2f(v.x & 0xffffu); Bs[(kc + 1) * 260 + r] = bf2f(v.x >> 16);
              Bs[(kc + 2) * 260 + r] = bf2f(v.y & 0xffffu); Bs[(kc + 3) * 260 + r] = bf2f(v.y >> 16);
              Bs[(kc + 4) * 260 + r] = bf2f(v.z & 0xffffu); Bs[(kc + 5) * 260 + r] = bf2f(v.z >> 16);
              Bs[(kc + 6) * 260 + r] = bf2f(v.w & 0xffffu); Bs[(kc + 7) * 260 + r] = bf2f(v.w >> 16); }
            __syncthreads();
#pragma unroll 4
            for (int k = 0; k < 32; ++k) {
                const f32x4 a = *(const f32x4*)&As[k * 132 + ty * 4];
#pragma unroll
                for (int q = 0; q < 4; ++q) { const f32x4 b = *(const f32x4*)&Bs[k * 260 + q * 64 + tx * 4];
#pragma unroll
                    for (int i = 0; i < 4; ++i) { acc[i][q * 4 + 0] += a[i] * b.x; acc[i][q * 4 + 1] += a[i] * b.y; acc[i][q * 4 + 2] += a[i] * b.z; acc[i][q * 4 + 3] += a[i] * b.w; } }
            }
            __syncthreads();
        }
#pragma unroll
        for (int i = 0; i < 4; ++i)
#pragma unroll
            for (int q = 0; q < 4; ++q)
#pragma unroll
                for (int j = 0; j < 4; ++j) E(d.pm * 128 + ty * 4 + i, d.pn * 256 + q * 64 + tx * 4 + j, acc[i][q * 4 + j], acc[i][(q ^ 2) * 4 + j]);
    }
}
struct DenseSched { int nM, nN;
    __device__ __forceinline__ bool get(int ui, GDesc& d) const { if (ui >= nM * nN) return false; d.pm = ui / nN; d.pn = ui % nN; d.arow0 = d.pm * 128; d.brow0 = d.pn * 256; return true; } };

struct EpiSplitBf16 {
    bf16* O0; size_t stride; float scale0;
    __device__ __forceinline__ void operator()(int row, int col, float v, float) const { const int t = col >> 10; if (t == 0) v *= scale0; O0[(size_t)t * stride + (size_t)row * 1024 + (col & 1023)] = (bf16)f2bf(v); } };
struct EpiResid {
    float* Hf;
    __device__ __forceinline__ void operator()(int row, int col, float v, float) const { float* q = Hf + (size_t)row * 1024 + col; *q = ALPHA * *q + v; } };
struct EpiGelu {
    bf16* Z; const float* bias;
    __device__ __forceinline__ void operator()(int row, int col, float v, float) const { const float x = v + bias[col];
        const float g = 0.5f * x * (1.f + tanhf(0.7978845608028654f * (x + 0.044715f * x * x * x))); Z[(size_t)row * 2048 + col] = (bf16)f2bf(g); } };
struct EpiRw1 {
    bf16* R; bf16* L1;
    __device__ __forceinline__ void operator()(int vrow, int col, float v, float) const { const int cc = vrow >> 14, t = vrow & (T - 1);
        if (cc < 3) R[(size_t)cc * T * 1024 + (size_t)t * 1024 + col] = (bf16)f2bf(v);
        else if (col < 128) { float o = v; if (cc == 3) o = tanhf(v); else if (cc == 5) o = sigmoidf_(v); L1[(size_t)(cc - 3) * T * 128 + (size_t)t * 128 + col] = (bf16)f2bf(o); } } };
struct Rw1Sched {
    __device__ __forceinline__ bool get(int ui, GDesc& d) const { if (ui >= 3 * 512 + 3 * 128) return false;
        int cc, mt, pn; if (ui < 1536) { cc = ui / 512; mt = (ui % 512) / 4; pn = ui % 4; d.brow0 = cc * 1024 + pn * 256; } else { const int u2 = ui - 1536; cc = 3 + u2 / 128; mt = u2 % 128; pn = 0; d.brow0 = 3072 + (cc - 3) * 256; }
        d.pm = cc * 128 + mt; d.pn = pn; d.arow0 = d.pm * 128; return true; } };
struct EpiRw2 {
    float* Wdec; bf16* A; bf16* G; const float* w0; const float* a0;
    __device__ __forceinline__ void operator()(int vrow, int col, float v, float) const { const int j = vrow >> 14, t = vrow & (T - 1); const size_t o = (size_t)t * 1024 + col;
        if (j == 0) Wdec[o] = expf(-0.6065306597126334f * sigmoidf_(w0[col] + v));
        else if (j == 1) A[o] = (bf16)f2bf(sigmoidf_(a0[col] + v)); else G[o] = (bf16)f2bf(v); } };
struct Rw2Sched { __device__ __forceinline__ bool get(int ui, GDesc& d) const { if (ui >= 3 * 512) return false; const int j = ui / 512, mt = (ui % 512) / 4, pn = ui % 4;
        d.pm = j * 128 + mt; d.pn = pn; d.arow0 = d.pm * 128; d.brow0 = j * 1024 + pn * 256; return true; } };
struct MoeSched {
    const int* tile_e; int nN, rowsB;
    __device__ __forceinline__ bool get(int ui, GDesc& d) const { const int ntile = tile_e[255] * 2; if (ui >= ntile * nN) return false;
        const int mt = ui / nN, pn = ui % nN, e = tile_e[mt >> 1]; d.pm = mt; d.pn = pn; d.arow0 = mt * 128; d.brow0 = e * rowsB + pn * 256; return true; } };
struct EpiSwiglu { bf16* H1;
    __device__ __forceinline__ void operator()(int row, int col, float v, float vp) const { const int x = col & 255; if (x < 128) { const float s = v / (1.f + expf(-v)); H1[(size_t)row * 512 + (col >> 8) * 128 + x] = (bf16)f2bf(s * vp); } } };
struct EpiDown { bf16* Yd; const float* rowg;
    __device__ __forceinline__ void operator()(int row, int col, float v, float) const { Yd[(size_t)row * 1024 + col] = (bf16)f2bf(v * rowg[row]); } };

__device__ __forceinline__ void fox_cumsum(const Ctx& c, const Params& p) {
    const float* FL = (const float*)(p.ws + WS_FL); float* CB = (float*)(p.ws + WS_CB); float* red = (float*)c.lds;
    for (int bh = blockIdx.x; bh < BATCH * NH; bh += gridDim.x) {
        const int b = bh / NH, h = bh % NH; const float bf = p.in[I_FOX_BF][h];
        float v[8], run = 0.f;
#pragma unroll
        for (int i = 0; i < 8; ++i) { const int s = c.tid * 8 + i; const float x = FL[(size_t)(b * SEQ + s) * 16 + h] + bf; run += -softplusf_(-x); v[i] = run; }
        const float incl = wave_incl_scan(run, c.lane);
        __syncthreads();
        if (c.lane == 63) red[c.wave] = incl;
        __syncthreads();
        float base = incl - run;
        for (int w = 0; w < c.wave; ++w) base += red[w];
#pragma unroll
        for (int i = 0; i < 8; ++i) CB[(size_t)bh * SEQ + c.tid * 8 + i] = -LOG2E * (base + v[i]);
    }
}
__device__ __forceinline__ void fox_attn_naive(const Ctx& c, const Params& p) {
    bf16* Q = (bf16*)(p.ws + WS_Q); const bf16* K = (const bf16*)(p.ws + WS_K); const bf16* V = (const bf16*)(p.ws + WS_V); const bf16* OG = (const bf16*)(p.ws + WS_OG);
    const float* CB = (const float*)(p.ws + WS_CB);
    float* qs = (float*)c.lds + c.wave * 64;
    for (int row = c.gw; row < BATCH * NH * SEQ; row += c.ngw) {
        const int bh = row / SEQ, t = row % SEQ, b = bh / NH, h = bh % NH;
        const size_t qoff = (size_t)(b * SEQ + t) * 1024 + h * 64 + c.lane;
        LDS_WAIT(); qs[c.lane] = bf2f(Q[qoff]); LDS_WAIT();
        float m = -INFINITY, l = 0.f, o = 0.f;
        for (int s0 = 0; s0 <= t; s0 += 64) {
            const int s = s0 + c.lane; const bool valid = s <= t;
            const u32x4* kp = (const u32x4*)(K + (size_t)(b * SEQ + s) * 1024 + h * 64);
            float z = 0.f;
#pragma unroll
            for (int cc = 0; cc < 8; ++cc) { const u32x4 kv = kp[cc];
                z += qs[cc * 8 + 0] * bf2f(kv.x & 0xffffu) + qs[cc * 8 + 1] * bf2f(kv.x >> 16) + qs[cc * 8 + 2] * bf2f(kv.y & 0xffffu) + qs[cc * 8 + 3] * bf2f(kv.y >> 16)
                   + qs[cc * 8 + 4] * bf2f(kv.z & 0xffffu) + qs[cc * 8 + 5] * bf2f(kv.z >> 16) + qs[cc * 8 + 6] * bf2f(kv.w & 0xffffu) + qs[cc * 8 + 7] * bf2f(kv.w >> 16); }
            z += CB[(size_t)bh * SEQ + s]; z = valid ? z : -INFINITY;
            const float mn = fmaxf(m, wave_max(z)); const float f = exp2f(m - mn); const float pe = valid ? exp2f(z - mn) : 0.f;
            l = l * f + pe; o *= f; m = mn;
#pragma unroll 8
            for (int k = 0; k < 64; ++k) { const float pk = rdlane(pe, k); o += pk * bf2f(V[(size_t)(b * SEQ + s0 + k) * 1024 + h * 64 + c.lane]); }
        }
        const float L = wave_sum(l);
        Q[qoff] = (bf16)f2bf(o / L * sigmoidf_(bf2f(OG[qoff])));
    }
}

__device__ __forceinline__ void sb_attn_naive(const Ctx& c, const Params& p) {
    bf16* Q = (bf16*)(p.ws + WS_Q); const bf16* K = (const bf16*)(p.ws + WS_K); const bf16* V = (const bf16*)(p.ws + WS_V);
    float* qs = (float*)c.lds + c.wave * 64;
    for (int row = c.gw; row < BATCH * NH * SEQ; row += c.ngw) {
        const int bh = row / SEQ, t = row % SEQ, b = bh / NH, h = bh % NH;
        const size_t qoff = (size_t)(b * SEQ + t) * 1024 + h * 64 + c.lane;
        LDS_WAIT(); qs[c.lane] = bf2f(Q[qoff]); LDS_WAIT();
        float carry = 0.f, o = 0.f;
        for (int c0 = 0; c0 < t; c0 += 64) {
            const int s = t - 1 - c0 - c.lane; const bool valid = s >= 0; const int sc = valid ? s : 0;
            const u32x4* kp = (const u32x4*)(K + (size_t)(b * SEQ + sc) * 1024 + h * 64);
            float z = 0.f;
#pragma unroll
            for (int cc = 0; cc < 8; ++cc) { const u32x4 kv = kp[cc];
                z += qs[cc * 8 + 0] * bf2f(kv.x & 0xffffu) + qs[cc * 8 + 1] * bf2f(kv.x >> 16) + qs[cc * 8 + 2] * bf2f(kv.y & 0xffffu) + qs[cc * 8 + 3] * bf2f(kv.y >> 16)
                   + qs[cc * 8 + 4] * bf2f(kv.z & 0xffffu) + qs[cc * 8 + 5] * bf2f(kv.z >> 16) + qs[cc * 8 + 6] * bf2f(kv.w & 0xffffu) + qs[cc * 8 + 7] * bf2f(kv.w >> 16); }
            const float sp = valid ? softplusf_(z) : 0.f;
            const float incl = wave_incl_scan(sp, c.lane);
            const float a = valid ? expf(z - incl - carry) : 0.f;
            carry += rdlane(incl, 63);
#pragma unroll 8
            for (int k = 0; k < 64; ++k) { const float ak = rdlane(a, k); int sk = t - 1 - c0 - k; sk = sk < 0 ? 0 : sk; o += ak * bf2f(V[(size_t)(b * SEQ + sk) * 1024 + h * 64 + c.lane]); }
        }
        Q[qoff] = (bf16)f2bf(o);
    }
}

__device__ __forceinline__ void gmlp_spatial_naive(const Ctx& c, const Params& p) {
    const bf16* Z = (const bf16*)(p.ws + WS_Z); bf16* Yg = (bf16*)(p.ws + WS_YG); const bf16* Wt = (const bf16*)(p.ws + WS_GM_WS);
    float* vn = (float*)c.lds;
    float* Ws = vn + 128 * 128;
    float* st = Ws + 128 * 129;
    for (int u = blockIdx.x; u < 128 * 8; u += gridDim.x) {
        const int n = u >> 3, g = u & 7;
        __syncthreads();
        for (int r = c.wave * 16; r < c.wave * 16 + 16; ++r) {
            const bf16* zr = Z + (size_t)(n * 128 + r) * 2048 + 1024;
            float x[16];
#pragma unroll
            for (int jj = 0; jj < 2; ++jj) { const u32x4 v = *(const u32x4*)(zr + c.lane * 8 + 512 * jj);
                x[jj * 8 + 0] = bf2f(v.x & 0xffffu); x[jj * 8 + 1] = bf2f(v.x >> 16); x[jj * 8 + 2] = bf2f(v.y & 0xffffu); x[jj * 8 + 3] = bf2f(v.y >> 16);
                x[jj * 8 + 4] = bf2f(v.z & 0xffffu); x[jj * 8 + 5] = bf2f(v.z >> 16); x[jj * 8 + 6] = bf2f(v.w & 0xffffu); x[jj * 8 + 7] = bf2f(v.w >> 16); }
            float s = 0.f;
#pragma unroll
            for (int i = 0; i < 16; ++i) s += x[i];
            const float mean = wave_sum(s) * (1.f / 1024.f); float s2 = 0.f;
#pragma unroll
            for (int i = 0; i < 16; ++i) { const float dd = x[i] - mean; s2 += dd * dd; }
            const float rstd = 1.0f / sqrtf(wave_sum(s2) * (1.f / 1024.f) + LN_EPS);
            if (c.lane == 0) { st[r * 2] = mean; st[r * 2 + 1] = rstd; }
        }
        __syncthreads();
        { const int s = c.tid >> 2, cb = (c.tid & 3) * 32; const float mean = st[s * 2], rstd = st[s * 2 + 1];
          const bf16* zr = Z + (size_t)(n * 128 + s) * 2048 + 1024 + g * 128 + cb;
          for (int i = 0; i < 32; ++i) { const int gc = g * 128 + cb + i; vn[s * 128 + cb + i] = (bf2f(zr[i]) - mean) * rstd * p.in[I_GM_LNG][gc] + p.in[I_GM_LNB][gc]; }
          for (int i = c.tid; i < 128 * 128; i += NTHR) Ws[(i >> 7) * 129 + (i & 127)] = bf2f(Wt[(size_t)g * 16384 + i]); }
        __syncthreads();
        { const int t = c.tid >> 2, cb = (c.tid & 3) * 32;
          float acc[32];
#pragma unroll
          for (int i = 0; i < 32; ++i) acc[i] = 0.f;
          for (int s = 0; s < 128; ++s) { const float w = Ws[t * 129 + s];
#pragma unroll
              for (int i = 0; i < 8; ++i) { const f32x4 x = *(const f32x4*)&vn[s * 128 + cb + 4 * i]; acc[4 * i] += w * x.x; acc[4 * i + 1] += w * x.y; acc[4 * i + 2] += w * x.z; acc[4 * i + 3] += w * x.w; } }
          const float bs = p.in[I_GM_BS][g * 128 + t];
          const bf16* ur = Z + (size_t)(n * 128 + t) * 2048 + g * 128 + cb; bf16* yr = Yg + (size_t)(n * 128 + t) * 1024 + g * 128 + cb;
#pragma unroll
          for (int i = 0; i < 32; ++i) yr[i] = (bf16)f2bf(bf2f(ur[i]) * (acc[i] + bs)); }
    }
}


constexpr int GM_SLD = 528;
constexpr int GM_LD = 272;
typedef float f32x16_t __attribute__((ext_vector_type(16)));
typedef short bf16x8_t __attribute__((ext_vector_type(8)));
__device__ __forceinline__ void gmlp_spatial(const Ctx& c, const Params& p) {
    const bf16* Z = (const bf16*)(p.ws + WS_Z); bf16* Yg = (bf16*)(p.ws + WS_YG); const bf16* Wt = (const bf16*)(p.ws + WS_GM_WS);
    unsigned char* Wl = c.lds; unsigned char* Vl = c.lds + 128 * GM_LD; float* st = (float*)(c.lds + 2 * 128 * GM_LD); unsigned char* Sl = c.lds + 2 * 128 * GM_LD + 1024;
    const int lane = c.lane, r32 = lane & 31, hi = lane >> 5, wid = c.wave;
    for (int u = blockIdx.x; u < 256; u += gridDim.x) {
        const int n = u >> 1, g0 = (u & 1) * 4;
        __syncthreads();
#pragma unroll
        for (int rb = 0; rb < 2; ++rb) {
            u32x4 zv[8][2];
#pragma unroll
            for (int i = 0; i < 8; ++i) { const bf16* zr = Z + (size_t)(n * 128 + wid * 16 + rb * 8 + i) * 2048 + 1024; zv[i][0] = *(const u32x4*)(zr + lane * 8); zv[i][1] = *(const u32x4*)(zr + lane * 8 + 512); }
#pragma unroll
            for (int i = 0; i < 8; ++i) { float s1 = 0.f, s2 = 0.f;
#pragma unroll
                for (int jj = 0; jj < 2; ++jj)
#pragma unroll
                    for (int e = 0; e < 4; ++e) { const float a = bf2f(zv[i][jj][e] & 0xffffu), b = bf2f(zv[i][jj][e] >> 16); s1 += a + b; s2 += a * a + b * b; }
                s1 = red16(s1); s2 = red16(s2);
                const float t1 = (rdlane(s1, 0) + rdlane(s1, 16)) + (rdlane(s1, 32) + rdlane(s1, 48)), t2 = (rdlane(s2, 0) + rdlane(s2, 16)) + (rdlane(s2, 32) + rdlane(s2, 48));
                const float mean = t1 * (1.f / 1024.f), var = fmaxf(t2 * (1.f / 1024.f) - mean * mean, 0.f);
                if (lane == 0) { const int r = wid * 16 + rb * 8 + i; st[r * 2] = mean; st[r * 2 + 1] = 1.0f / sqrtf(var + LN_EPS); } }
        }
        for (int gi = 0; gi < 4; ++gi) {
            const int g = g0 + gi;
            __syncthreads();
            { u32x4 wv[4];
#pragma unroll
              for (int k = 0; k < 4; ++k) wv[k] = *(const u32x4*)(Wt + (size_t)g * 16384 + (size_t)(c.tid + NTHR * k) * 8);
#pragma unroll
              for (int k = 0; k < 4; ++k) { const int i = c.tid + NTHR * k, t = i >> 4, ch = i & 15; *(LAS u32x4*)((LAS unsigned char*)Wl + t * GM_LD + ch * 16) = wv[k]; } }
            { const int sp = lane, cb = wid * 16;
              const float mean0 = st[4 * sp], rstd0 = st[4 * sp + 1], mean1 = st[4 * sp + 2], rstd1 = st[4 * sp + 3];
              const bf16* z0 = Z + (size_t)(n * 128 + 2 * sp) * 2048 + 1024 + g * 128 + cb;
              const u32x4 a0 = *(const u32x4*)z0, a1 = *(const u32x4*)(z0 + 8), b0 = *(const u32x4*)(z0 + 2048), b1 = *(const u32x4*)(z0 + 2048 + 8);
              const float* gp = p.in[I_GM_LNG] + g * 128 + cb; const float* bp = p.in[I_GM_LNB] + g * 128 + cb;
#pragma unroll
              for (int j = 0; j < 16; ++j) { const unsigned wa = j < 8 ? a0[(j & 7) >> 1] : a1[(j & 7) >> 1], wb = j < 8 ? b0[(j & 7) >> 1] : b1[(j & 7) >> 1];
                  const float xa = (j & 1) ? __uint_as_float(wa & 0xffff0000u) : __uint_as_float(wa << 16), xb = (j & 1) ? __uint_as_float(wb & 0xffff0000u) : __uint_as_float(wb << 16);
                  const float gn = gp[j], bs_ = bp[j];
                  *(unsigned*)(Vl + (cb + j) * GM_LD + sp * 4) = pk2((xa - mean0) * rstd0 * gn + bs_, (xb - mean1) * rstd1 * gn + bs_); } }
            __syncthreads();
            const int cb32 = wid >> 1, tb0 = 2 * (wid & 1);
            f32x16_t acc0 = {}, acc1 = {};
#pragma unroll
            for (int ks = 0; ks < 8; ++ks) {
                const bf16x8_t a = *(const bf16x8_t*)(Vl + (cb32 * 32 + r32) * GM_LD + (16 * ks + 8 * hi) * 2);
                const bf16x8_t b0 = *(const bf16x8_t*)(Wl + (tb0 * 32 + r32) * GM_LD + (16 * ks + 8 * hi) * 2);
                const bf16x8_t b1 = *(const bf16x8_t*)(Wl + ((tb0 + 1) * 32 + r32) * GM_LD + (16 * ks + 8 * hi) * 2);
                acc0 = __builtin_amdgcn_mfma_f32_32x32x16_bf16(a, b0, acc0, 0, 0, 0);
                acc1 = __builtin_amdgcn_mfma_f32_32x32x16_bf16(a, b1, acc1, 0, 0, 0);
            }
#pragma unroll
            for (int tt = 0; tt < 2; ++tt) { const f32x16_t& acc = tt ? acc1 : acc0; const int t = (tb0 + tt) * 32 + r32; const float bs = p.in[I_GM_BS][g * 128 + t];
#pragma unroll
                for (int q = 0; q < 4; ++q) *(f32x4*)(Sl + t * GM_SLD + (cb32 * 32 + 8 * q + 4 * hi) * 4) = (f32x4){acc[4 * q] + bs, acc[4 * q + 1] + bs, acc[4 * q + 2] + bs, acc[4 * q + 3] + bs}; }
            __syncthreads();
            u32x4 uvv[4];
#pragma unroll
            for (int k = 0; k < 4; ++k) { const int i = c.tid + NTHR * k, t = i >> 4, ch8 = (i & 15) * 8; uvv[k] = *(const u32x4*)(Z + (size_t)(n * 128 + t) * 2048 + g * 128 + ch8); }
#pragma unroll
            for (int k = 0; k < 4; ++k) { const int i = c.tid + NTHR * k, t = i >> 4, ch8 = (i & 15) * 8;
                const u32x4 uv = uvv[k];
                const f32x4 s0 = *(const f32x4*)(Sl + t * GM_SLD + ch8 * 4), s1 = *(const f32x4*)(Sl + t * GM_SLD + ch8 * 4 + 16);
                u32x4 o; o.x = pk2(__uint_as_float(uv.x << 16) * s0[0], __uint_as_float(uv.x & 0xffff0000u) * s0[1]); o.y = pk2(__uint_as_float(uv.y << 16) * s0[2], __uint_as_float(uv.y & 0xffff0000u) * s0[3]);
                o.z = pk2(__uint_as_float(uv.z << 16) * s1[0], __uint_as_float(uv.z & 0xffff0000u) * s1[1]); o.w = pk2(__uint_as_float(uv.w << 16) * s1[2], __uint_as_float(uv.w & 0xffff0000u) * s1[3]);
                *(u32x4*)(Yg + (size_t)(n * 128 + t) * 1024 + g * 128 + ch8) = o; }
        }
    }
}

__device__ __forceinline__ void rwkv_mix(const Ctx& c, const Params& p) {
    const bf16* Hb = (const bf16*)(p.ws + WS_HB); bf16* HM = (bf16*)(p.ws + WS_HM); const float* mu = p.in[I_RW_MU];
    f32x4 mv[6][2][2];
#pragma unroll
    for (int cc = 0; cc < 6; ++cc)
#pragma unroll
        for (int jj = 0; jj < 2; ++jj) { mv[cc][jj][0] = *(const f32x4*)(mu + cc * 1024 + 512 * jj + 8 * c.lane); mv[cc][jj][1] = *(const f32x4*)(mu + cc * 1024 + 512 * jj + 8 * c.lane + 4); }
    int m = c.gw; const u32x4 z4 = {0u, 0u, 0u, 0u};
    u32x4 h[2], hp[2];
#pragma unroll
    for (int jj = 0; jj < 2; ++jj) { h[jj] = (m < T) ? *(const u32x4*)(Hb + (size_t)m * D + 512 * jj + 8 * c.lane) : z4; hp[jj] = (m < T && (m & (SEQ - 1))) ? *(const u32x4*)(Hb + (size_t)(m - 1) * D + 512 * jj + 8 * c.lane) : z4; }
    for (; m < T; m += c.ngw) {
        u32x4 hc[2] = {h[0], h[1]}, hq[2] = {hp[0], hp[1]}; const int mn = m + c.ngw;
        if (mn < T) {
#pragma unroll
            for (int jj = 0; jj < 2; ++jj) { h[jj] = *(const u32x4*)(Hb + (size_t)mn * D + 512 * jj + 8 * c.lane); hp[jj] = (mn & (SEQ - 1)) ? *(const u32x4*)(Hb + (size_t)(mn - 1) * D + 512 * jj + 8 * c.lane) : z4; }
        }
#pragma unroll
        for (int jj = 0; jj < 2; ++jj) {
            f32x4 a0, a1, d0, d1;
#pragma unroll
            for (int e = 0; e < 2; ++e) { a0[2 * e] = bf2f(hc[jj][e] & 0xffffu); a0[2 * e + 1] = bf2f(hc[jj][e] >> 16); a1[2 * e] = bf2f(hc[jj][e + 2] & 0xffffu); a1[2 * e + 1] = bf2f(hc[jj][e + 2] >> 16);
                d0[2 * e] = bf2f(hq[jj][e] & 0xffffu) - a0[2 * e]; d0[2 * e + 1] = bf2f(hq[jj][e] >> 16) - a0[2 * e + 1]; d1[2 * e] = bf2f(hq[jj][e + 2] & 0xffffu) - a1[2 * e]; d1[2 * e + 1] = bf2f(hq[jj][e + 2] >> 16) - a1[2 * e + 1]; }
#pragma unroll
            for (int cc = 0; cc < 6; ++cc) { const f32x4 o0 = a0 + d0 * mv[cc][jj][0], o1 = a1 + d1 * mv[cc][jj][1];
                u32x4 w; w.x = pk2(o0[0], o0[1]); w.y = pk2(o0[2], o0[3]); w.z = pk2(o1[0], o1[1]); w.w = pk2(o1[2], o1[3]);
                *(u32x4*)(HM + (size_t)cc * T * 1024 + (size_t)m * 1024 + 512 * jj + 8 * c.lane) = w; }
        }
    }
}
struct RwIn { float r, k, v, w, a, g; };
__device__ __forceinline__ RwIn rw_load(const Params& p, size_t off) { RwIn x;
    x.r = bf2f(((const bf16*)(p.ws + WS_RR))[off]); x.k = bf2f(((const bf16*)(p.ws + WS_RK))[off]); x.v = bf2f(((const bf16*)(p.ws + WS_RV))[off]);
    x.w = ((const float*)(p.ws + WS_WDEC))[off]; x.a = bf2f(((const bf16*)(p.ws + WS_RA))[off]); x.g = bf2f(((const bf16*)(p.ws + WS_RG))[off]); return x; }
__device__ __forceinline__ void rwkv_scan_naive(const Ctx& c, const Params& p) {
    bf16* YG = (bf16*)(p.ws + WS_RYG);
    for (int bh = c.gw; bh < BATCH * NH; bh += c.ngw) {
        const int b = bh / NH, h = bh % NH, ch = h * 64 + c.lane;
        const float k_k = p.in[I_RW_KK][ch], k_a = p.in[I_RW_KA][ch], r_k = p.in[I_RW_RK][ch], gn_g = p.in[I_RW_GNG][ch], gn_b = p.in[I_RW_GNB][ch];
        float S[64];
#pragma unroll
        for (int j = 0; j < 64; ++j) S[j] = 0.f;
        RwIn nx = rw_load(p, (size_t)(b * SEQ) * 1024 + ch);
        for (int t = 0; t < SEQ; ++t) {
            const RwIn x = nx; const size_t off = (size_t)(b * SEQ + t) * 1024 + ch;
            if (t + 1 < SEQ) nx = rw_load(p, off + 1024);
            float kk = x.k * k_k; const float nrm = sqrtf(wave_sum(kk * kk)); kk = kk / fmaxf(nrm, 1e-12f);
            const float kt = x.k * (1.f + (x.a - 1.f) * k_a), bv = kk * x.a;
            float sa = 0.f;
#pragma unroll
            for (int j = 0; j < 64; ++j) sa -= S[j] * rdlane(kk, j);
            float y = 0.f;
#pragma unroll
            for (int j = 0; j < 64; ++j) { S[j] = S[j] * rdlane(x.w, j) + sa * rdlane(bv, j) + x.v * rdlane(kt, j); y += S[j] * rdlane(x.r, j); }
            const float mean = wave_sum(y) * (1.f / 64.f); const float dy = y - mean; const float var = wave_sum(dy * dy) * (1.f / 64.f);
            const float yn = dy * (1.0f / sqrtf(var + GN_EPS)) * gn_g + gn_b;
            const float bonus = wave_sum(x.r * kt * r_k) * x.v;
            YG[off] = (bf16)f2bf((yn + bonus) * x.g);
        }
    }
}


constexpr int RW_CH = 32, RW_RING = RW_CH * 6 * 64 * 4  , RW_YB = 2 * RW_RING, RW_YBB = RW_CH * 16 * 4;
#define RAW_BAR() asm volatile("s_waitcnt lgkmcnt(0)\n\ts_barrier" ::: "memory")
__device__ __forceinline__ void rwkv_scan(const Ctx& c, const Params& p) {
    const bf16* Rg = (const bf16*)(p.ws + WS_RR); const bf16* Kg = (const bf16*)(p.ws + WS_RK); const bf16* Vg = (const bf16*)(p.ws + WS_RV);
    const float* Wg = (const float*)(p.ws + WS_WDEC); const bf16* Ag = (const bf16*)(p.ws + WS_RA); float* Ysc = (float*)(p.ws + WS_YSC);
    float* ring = (float*)c.lds; float* ybuf = (float*)(c.lds + RW_YB);
    const int lane = c.lane, wid = c.wave;
    for (int u = blockIdx.x; u < BATCH * NH * 4; u += gridDim.x) {
        const int bh = u >> 2, qr = u & 3, b = bh / NH, h = bh % NH;
        const size_t gbase = (size_t)(b * SEQ) * 1024 + h * 64;
        if (wid >= 4) {
            const int pw = wid - 4; const int ch = h * 64 + lane;
            const float k_k = p.in[I_RW_KK][ch], k_a = p.in[I_RW_KA][ch];
            unsigned rr[8], rk[8], rv[8], ra[8]; float rw[8];
#define RW_LOAD(cc) _Pragma("unroll") for (int i = 0; i < 8; ++i) { const size_t o = gbase + (size_t)((cc) * RW_CH + pw + 4 * i) * 1024 + lane; rr[i] = Rg[o]; rk[i] = Kg[o]; rv[i] = Vg[o]; ra[i] = Ag[o]; rw[i] = Wg[o]; }
#define RW_PROC(cc) _Pragma("unroll") for (int i = 0; i < 8; ++i) { float* dst = ring + ((cc) & 1) * (RW_RING / 4) + (pw + 4 * i) * 384 + lane; \
                const float kf = bf2f(rk[i]), af = bf2f(ra[i]); float kk = kf * k_k; float n2 = red16(kk * kk); n2 = rdlane(n2, 0) + rdlane(n2, 16) + rdlane(n2, 32) + rdlane(n2, 48); \
                kk = kk * __builtin_amdgcn_rsqf(fmaxf(n2, 1e-24f)); dst[0] = bf2f(rr[i]); dst[64] = kf * (1.f + (af - 1.f) * k_a); dst[128] = __builtin_amdgcn_exp2f(rw[i]); dst[192] = kk * af; dst[256] = kk; dst[320] = bf2f(rv[i]); }
#define RW_FLUSH(cc) _Pragma("unroll") for (int i2 = 0; i2 < 2; ++i2) { const int st = pw + 4 * (i2 * 4 + (lane >> 4)); \
                Ysc[gbase + (size_t)((cc) * RW_CH + st) * 1024 + qr * 16 + (lane & 15)] = ybuf[((cc) & 1) * (RW_YBB / 4) + st * 16 + (lane & 15)]; }
            RW_LOAD(0); RW_PROC(0); RW_LOAD(1);
            RAW_BAR();
            for (int cc = 0; cc < SEQ / RW_CH; ++cc) {
                if (cc + 1 < SEQ / RW_CH) { RW_PROC(cc + 1); }
                if (cc + 2 < SEQ / RW_CH) { RW_LOAD(cc + 2); }
                if (cc > 0) { RW_FLUSH(cc - 1); }
                RAW_BAR();
            }
            RW_FLUSH(SEQ / RW_CH - 1);
#undef RW_LOAD
#undef RW_PROC
#undef RW_FLUSH
        } else {
            const int rg = lane >> 4, c4 = (lane & 15) * 4, row = wid * 4 + rg;
            float S0 = 0.f, S1 = 0.f, S2 = 0.f, S3 = 0.f;
            RAW_BAR();
            for (int cc = 0; cc < SEQ / RW_CH; ++cc) {
                const float* base = ring + (cc & 1) * (RW_RING / 4); float* yb = ybuf + (cc & 1) * (RW_YBB / 4);
                const float* sp0 = base + c4; const float* vp0 = base + 320 + qr * 16 + row;
                f32x4 r4 = *(const f32x4*)(sp0), kt4 = *(const f32x4*)(sp0 + 64), w4 = *(const f32x4*)(sp0 + 128), b4 = *(const f32x4*)(sp0 + 192), kk4 = *(const f32x4*)(sp0 + 256); float vi = vp0[0];
#pragma unroll 8
                for (int st = 0; st < RW_CH; ++st) {
                    const int sn = (st + 1 < RW_CH) ? st + 1 : st;
                    const f32x4 nr4 = *(const f32x4*)(sp0 + sn * 384), nkt4 = *(const f32x4*)(sp0 + sn * 384 + 64), nw4 = *(const f32x4*)(sp0 + sn * 384 + 128), nb4 = *(const f32x4*)(sp0 + sn * 384 + 192), nkk4 = *(const f32x4*)(sp0 + sn * 384 + 256);
                    const float nvi = vp0[sn * 384];
                    float pd = S0 * kk4.x; pd = fmaf(S1, kk4.y, pd); pd = fmaf(S2, kk4.z, pd); pd = fmaf(S3, kk4.w, pd);
                    pd = red16(pd);
                    S0 = fmaf(S0, w4.x, fmaf(-pd, b4.x, vi * kt4.x)); S1 = fmaf(S1, w4.y, fmaf(-pd, b4.y, vi * kt4.y));
                    S2 = fmaf(S2, w4.z, fmaf(-pd, b4.z, vi * kt4.z)); S3 = fmaf(S3, w4.w, fmaf(-pd, b4.w, vi * kt4.w));
                    float y = S0 * r4.x; y = fmaf(S1, r4.y, y); y = fmaf(S2, r4.z, y); y = fmaf(S3, r4.w, y);
                    y = red16(y);
                    yb[st * 16 + row] = y;
                    r4 = nr4; kt4 = nkt4; w4 = nw4; b4 = nb4; kk4 = nkk4; vi = nvi;
                }
                RAW_BAR();
            }
        }
        RAW_BAR();
    }
}

namespace rwc {
typedef float f32x16 __attribute__((ext_vector_type(16)));
typedef short bf16x8 __attribute__((ext_vector_type(8)));
__device__ __forceinline__ bf16 hbf(float x) { return (bf16)(pk2(x, 0.f) & 0xffffu); }
constexpr int L = 32, NCHH = 32  , NQ = 4, REC = 30720;
constexpr int O_P1T = 0, O_RBT = 4096, O_BBP = 8192, O_MBRT = 12288, O_VP2T = 14336, O_VMKRT = 18432, O_VKTP = 22528;
constexpr int A_ABT = 0, A_BBT = 4096, A_KBT = 8192, A_RBT = 12288, A_WAVE = 16384;
constexpr int A_MBB = A_BBT  , A_TT = A_KBT  , A_MKB = A_KBT + 2048, A_MKRT = A_RBT, A_P2T = A_RBT + 2048;
__device__ __forceinline__ int crow(int r, int hi) { return (r & 3) + 8 * (r >> 2) + 4 * hi; }
__device__ __forceinline__ int ppos(int k) { return (k & ~15) + 8 * ((k >> 2) & 1) + 4 * ((k >> 3) & 1) + (k & 3); }
__device__ __forceinline__ bf16x8 ldf(const unsigned char* base, int row, int rowbytes, int kb) { return *(const bf16x8*)(base + row * rowbytes + kb); }
__device__ __forceinline__ f32x16 mm(bf16x8 a, bf16x8 b, f32x16 c) { return __builtin_amdgcn_mfma_f32_32x32x16_bf16(a, b, c, 0, 0, 0); }
__device__ __forceinline__ unsigned char* rec_ptr(unsigned char* ws, int qr, int head, int cl) { return ws + ((qr & 1) ? WS_CD1 : WS_CD0) + (size_t)(head * NCHH + cl) * REC; }
#define RWC_FENCE() asm volatile("s_waitcnt lgkmcnt(0)" ::: "memory")

template <int TAU, int TP> struct TriDot { static __device__ __forceinline__ void run(const float (&x)[32], const f32x4 (&m)[8], float (&acc)[4]) { acc[TP & 3] = fmaf(m[TP >> 2][TP & 3], x[TP], acc[TP & 3]); TriDot<TAU, TP + 1>::run(x, m, acc); } };
template <int TAU> struct TriDot<TAU, 32> { static __device__ __forceinline__ void run(const float (&)[32], const f32x4 (&)[8], float (&)[4]) {} };
template <int TAU> struct TriSolve { static __device__ __forceinline__ void run(float (&x)[32], const unsigned char* mb, int col) {
    f32x4 m[8];
#pragma unroll
    for (int g = 0; g < 8; ++g) m[g] = *(const f32x4*)(mb + (TAU * 32 + 4 * g) * 4);
    float a4[4] = {0.f, 0.f, 0.f, 0.f};
    TriDot<TAU, TAU + 1>::run(x, m, a4);
    float acc = (a4[0] + a4[1]) + (a4[2] + a4[3]);
    asm volatile("" : "+v"(acc) :: "memory");
    x[TAU] = (TAU < col) ? acc : x[TAU];
    TriSolve<TAU - 1>::run(x, mb, col); } };
template <> struct TriSolve<-1> { static __device__ __forceinline__ void run(float (&)[32], const unsigned char*, int) {} };
__device__ __forceinline__ void rwc_prep(const Ctx& c, const Params& p, int half, int c0, int nch, int blk0, int nblk) {
    if ((int)blockIdx.x < blk0) return;
    unsigned char* wl = c.lds + c.wave * A_WAVE;
    const bf16* Rg = (const bf16*)(p.ws + WS_RR); const bf16* Kg = (const bf16*)(p.ws + WS_RK); const bf16* Vg = (const bf16*)(p.ws + WS_RV);
    const float* LWg = (const float*)(p.ws + WS_WDEC); const bf16* Ag = (const bf16*)(p.ws + WS_RA); float* WLg = (float*)(p.ws + WS_WLG);
    const int lane0 = c.lane;
    int lane = lane0;
    unsigned ra_[8], rb_[8], rd_[8]; float re_[8];
#define RWC_GB(q_) ((size_t)((((q_) & 63) / NH) * SEQ + (c0 + ((q_) >> 6)) * L) * 1024 + (((q_) & 63) % NH) * 64)
#define RWC_LD8(gb_, tb_) _Pragma("unroll") for (int i = 0; i < 8; ++i) { const int o = ((tb_) + i) * 1024 + lane; ra_[i] = (Rg + (gb_))[o]; rb_[i] = (Kg + (gb_))[o]; rd_[i] = (Ag + (gb_))[o]; re_[i] = (LWg + (gb_))[o]; }
    const int q0 = ((int)blockIdx.x - blk0) * NW + c.wave, qs = nblk * NW, qn = BATCH * NH * nch;
    if (q0 < qn) { const size_t g0 = RWC_GB(q0); RWC_LD8(g0, 0) }
    for (int q = q0; q < qn; q += qs) {
        lane = lane0; asm volatile("" : "+v"(lane)); const int r32 = lane & 31, hi = lane >> 5, pl = ppos(lane);
        const int head = q & 63, cl = q >> 6, b = head / NH, h = head % NH, ch = h * 64 + lane;
        const size_t gbase = (size_t)(b * SEQ + (c0 + cl) * L) * 1024 + h * 64;
        unsigned char* rec = rec_ptr(p.ws, half, head, cl);
        const float k_k = p.in[I_RW_KK][ch], k_a = p.in[I_RW_KA][ch];
        float run = 0.f, wprev = 1.f;
        RWC_FENCE();
#pragma unroll 1
        for (int tb = 0; tb < L; tb += 8) {
            unsigned rr[8], rk[8], ra[8]; float rl[8];
#pragma unroll
            for (int i = 0; i < 8; ++i) { rr[i] = ra_[i]; rk[i] = rb_[i]; ra[i] = rd_[i]; rl[i] = re_[i]; }
            if (tb + 8 < L) { RWC_LD8(gbase, tb + 8) }
#pragma unroll
            for (int i = 0; i < 8; ++i) { const int t = tb + i;
                const float kf = bf2f(rk[i]), af = bf2f(ra[i]); float kk = kf * k_k; kk = kk * __builtin_amdgcn_rsqf(fmaxf(wave_sum(kk * kk), 1e-24f));
                const float ktv = kf * (1.f + (af - 1.f) * k_a), bv = kk * af; run += rl[i];
                const float ep = __builtin_amdgcn_exp2f(run), em = __builtin_amdgcn_exp2f(-run);
                *(bf16*)(wl + A_ABT + t * 128 + pl * 2) = hbf(-kk * wprev);
                *(bf16*)(wl + A_BBT + t * 128 + pl * 2) = hbf(bv * em); *(bf16*)(wl + A_KBT + t * 128 + pl * 2) = hbf(ktv * em);
                *(bf16*)(wl + A_RBT + t * 128 + pl * 2) = hbf(bf2f(rr[i]) * ep);
                wprev = ep; }
        }
        RWC_FENCE();
        f32x16 mbb = {}, mkb = {}, mbr = {}, mkr = {};
#pragma unroll
        for (int s_ = 0; s_ < 4; ++s_) { const int kb = (16 * s_ + 8 * hi) * 2;
            const bf16x8 ab_ = ldf(wl + A_BBT, r32, 128, kb), ak_ = ldf(wl + A_KBT, r32, 128, kb), ba_ = ldf(wl + A_ABT, r32, 128, kb), br_ = ldf(wl + A_RBT, r32, 128, kb);
            mbb = mm(ab_, ba_, mbb); mkb = mm(ak_, ba_, mkb); mbr = mm(ab_, br_, mbr); mkr = mm(ak_, br_, mkr); }
        RWC_FENCE();
        unsigned abr[16], vr[16], kpr[16], bpr[16];
        { const float wlj = __builtin_amdgcn_exp2f(run);
          WLg[(size_t)(head * 128 + c0 + cl) * 64 + lane] = wlj;
#pragma unroll
          for (int t = 0; t < L; ++t) { const int pt = (t & ~15) + 8 * ((t >> 2) & 1) + 4 * ((t >> 3) & 1) + (t & 3);
              const unsigned ab = *(const bf16*)(wl + A_ABT + t * 128 + pl * 2), kp = hbf(bf2f(*(const bf16*)(wl + A_KBT + t * 128 + pl * 2)) * wlj), bp = hbf(bf2f(*(const bf16*)(wl + A_BBT + t * 128 + pl * 2)) * wlj);
              const unsigned vv = (Vg + gbase)[t * 1024 + lane];
              if (t & 1) { abr[t >> 1] |= ab << 16; vr[t >> 1] |= vv << 16; kpr[t >> 1] |= kp << 16; bpr[pt >> 1] |= bp << 16; }
              else { abr[t >> 1] = ab; vr[t >> 1] = vv; kpr[t >> 1] = kp; bpr[pt >> 1] = bp; } } }
#pragma unroll
        for (int i = 0; i < 4; ++i) *(u32x4*)(rec + O_BBP + lane * 64 + i * 16) = (u32x4){bpr[4 * i], bpr[4 * i + 1], bpr[4 * i + 2], bpr[4 * i + 3]};
#pragma unroll
        for (int i = 0; i < 4; ++i) *(u32x4*)(rec + O_RBT + i * 1024 + lane * 16) = *(const u32x4*)(wl + A_RBT + i * 1024 + lane * 16);
        RWC_FENCE();
        { int r32 = lane & 31, hi = lane >> 5; asm volatile("" : "+v"(r32), "+v"(hi));
#pragma unroll
        for (int r = 0; r < 16; ++r) { const int tau = crow(r, hi), t = r32; const bool s1 = tau < t, s2 = tau <= t;
            *(float*)(wl + A_MBB + (tau * 32 + t) * 4) = s1 ? mbb[r] : 0.f;
            *(bf16*)(wl + A_MKB + (tau * 32 + t) * 2) = hbf(s1 ? mkb[r] : 0.f);
            *(bf16*)(wl + A_MKRT + (t * 32 + tau) * 2) = hbf(s2 ? mkr[r] : 0.f);
            *(bf16*)(wl + A_ABT + (t * 32 + ppos(tau)) * 2) = hbf(s2 ? mbr[r] : 0.f); } }
        RWC_FENCE();
#pragma unroll
        for (int i = 0; i < 2; ++i) *(u32x4*)(rec + O_MBRT + i * 1024 + lane * 16) = *(const u32x4*)(wl + A_ABT + i * 1024 + lane * 16);
        RWC_FENCE();
        if (q + qs < qn) { const size_t gn = RWC_GB(q + qs); RWC_LD8(gn, 0) }
        { float x[L]; int r32 = lane & 31; asm volatile("" : "+v"(r32));
#pragma unroll
          for (int tau = 0; tau < L; ++tau) x[tau] = (tau == r32) ? 1.f : 0.f;
          TriSolve<L - 2>::run(x, wl + A_MBB, r32);
          RWC_FENCE();
          if (hi == 0) {
#pragma unroll
              for (int i = 0; i < 4; ++i) *(u32x4*)(wl + A_TT + r32 * 64 + i * 16) = (u32x4){pk2(x[8 * i], x[8 * i + 1]), pk2(x[8 * i + 2], x[8 * i + 3]), pk2(x[8 * i + 4], x[8 * i + 5]), pk2(x[8 * i + 6], x[8 * i + 7])}; } }
#pragma unroll
        for (int i = 0; i < 4; ++i) *(u32x4*)(wl + A_BBT + lane * 64 + i * 16) = (u32x4){abr[4 * i], abr[4 * i + 1], abr[4 * i + 2], abr[4 * i + 3]};
        RWC_FENCE();
        { f32x16 p1a = {}, p1b = {}, p2 = {};
#pragma unroll
          for (int s_ = 0; s_ < 2; ++s_) { const int kb = (16 * s_ + 8 * hi) * 2; const bf16x8 tt = ldf(wl + A_TT, r32, 64, kb);
              p1a = mm(tt, ldf(wl + A_BBT, r32, 64, kb), p1a); p1b = mm(tt, ldf(wl + A_BBT, 32 + r32, 64, kb), p1b); p2 = mm(tt, ldf(wl + A_MKB, r32, 64, kb), p2); }
          RWC_FENCE();
          int r32 = lane & 31, hi = lane >> 5; asm volatile("" : "+v"(r32), "+v"(hi));
#pragma unroll
          for (int r = 0; r < 16; ++r) { const int t = crow(r, hi);
              *(bf16*)(wl + A_ABT + (t * 64 + ppos(r32)) * 2) = hbf(p1a[r]); *(bf16*)(wl + A_ABT + (t * 64 + 32 + ppos(r32)) * 2) = hbf(p1b[r]);
              *(bf16*)(wl + A_P2T + (t * 32 + r32) * 2) = hbf(p2[r]); } }
#pragma unroll
        for (int i = 0; i < 4; ++i) { *(u32x4*)(wl + A_BBT + lane * 64 + i * 16) = (u32x4){vr[4 * i], vr[4 * i + 1], vr[4 * i + 2], vr[4 * i + 3]};
                                      *(u32x4*)(wl + A_KBT + lane * 64 + i * 16) = (u32x4){kpr[4 * i], kpr[4 * i + 1], kpr[4 * i + 2], kpr[4 * i + 3]}; }
        RWC_FENCE();
#pragma unroll
        for (int i = 0; i < 4; ++i) *(u32x4*)(rec + O_P1T + i * 1024 + lane * 16) = *(const u32x4*)(wl + A_ABT + i * 1024 + lane * 16);
        RWC_FENCE();
#pragma unroll
        for (int ib = 0; ib < 2; ++ib) { f32x16 vp = {}, vm = {}, vk0 = {}, vk1 = {};
#pragma unroll
            for (int s_ = 0; s_ < 2; ++s_) { const int kb = (16 * s_ + 8 * hi) * 2; const bf16x8 vv = ldf(wl + A_BBT, ib * 32 + r32, 64, kb);
                vp = mm(ldf(wl + A_P2T, r32, 64, kb), vv, vp); vm = mm(ldf(wl + A_MKRT, r32, 64, kb), vv, vm);
                vk0 = mm(ldf(wl + A_KBT, r32, 64, kb), vv, vk0); vk1 = mm(ldf(wl + A_KBT, 32 + r32, 64, kb), vv, vk1); }
            int ln_ = lane; asm volatile("" : "+v"(ln_));
#define RWC_ST(acc, off) do { _Pragma("unroll") for (int i_ = 0; i_ < 2; ++i_) *(u32x4*)(rec + (off) + ln_ * 32 + i_ * 16) = (u32x4){pk2(acc[8 * i_], acc[8 * i_ + 1]), pk2(acc[8 * i_ + 2], acc[8 * i_ + 3]), pk2(acc[8 * i_ + 4], acc[8 * i_ + 5]), pk2(acc[8 * i_ + 6], acc[8 * i_ + 7])}; } while (0)
            RWC_ST(vp, O_VP2T + ib * 2048); RWC_ST(vm, O_VMKRT + ib * 2048); RWC_ST(vk0, O_VKTP + (ib * 2 + 0) * 2048); RWC_ST(vk1, O_VKTP + (ib * 2 + 1) * 2048);
#undef RWC_ST
        }
        RWC_FENCE();
    }
}
#undef RWC_LD8
#undef RWC_GB
__device__ __forceinline__ void rwc_scan(const Ctx& c, const Params& p, int half, int c0, int nch) {
    bf16* Y2 = (bf16*)(p.ws + WS_Y2); const float* WLg = (const float*)(p.ws + WS_WLG); float* SIG = (float*)(p.ws + WS_SIG);
    const int lane = c.lane, r32 = lane & 31, hi = lane >> 5, wid = c.wave;
    const unsigned lds0 = (unsigned)(uintptr_t)c.lds;
    for (int head = blockIdx.x; head < BATCH * NH; head += gridDim.x) {
        const int b = head / NH, h = head % NH;
        const unsigned char* rec0 = rec_ptr(p.ws, half, head, 0);
        asm volatile("s_waitcnt vmcnt(0) lgkmcnt(0)\n\ts_barrier" ::: "memory");
        if (wid >= 2) {
            const int lw = wid - 2;
#define RWC_DMA(cl) do { _Pragma("unroll") for (int k_ = 0; k_ < 5; ++k_) attn_body::glds16s((unsigned)((lw * 5 + k_) * 1024 + lane * 16), rec0 + (size_t)(cl) * REC, \
                    (unsigned)__builtin_amdgcn_readfirstlane(lds0 + ((cl) & 3) * REC + (lw * 5 + k_) * 1024)); } while (0)
            RWC_DMA(0); RWC_DMA(1); RWC_DMA(2);
            asm volatile("s_waitcnt vmcnt(10)\n\ts_barrier" ::: "memory");
            for (int cl = 0; cl < nch; ++cl) {
                if (cl + 3 < nch) { RWC_DMA(cl + 3); asm volatile("s_waitcnt vmcnt(10)\n\ts_barrier" ::: "memory"); }
                else if (cl + 3 == nch) { asm volatile("s_waitcnt vmcnt(5)\n\ts_barrier" ::: "memory"); }
                else { asm volatile("s_waitcnt vmcnt(0)\n\ts_barrier" ::: "memory"); }
            }
#undef RWC_DMA
        } else {
            const int ib = wid; f32x16 S0, S1;
            float* sg = SIG + ((size_t)(head * 2 + ib) * 2) * 1024 + lane * 16;
            if (c0 == 0) { S0 = f32x16{}; S1 = f32x16{}; }
            else {
#pragma unroll
                for (int r = 0; r < 16; ++r) { S0[r] = sg[r]; S1[r] = sg[1024 + r]; } }
            f32x4 wn0[4], wn1[4];
#pragma unroll
            for (int g = 0; g < 4; ++g) { wn0[g] = *(const f32x4*)(WLg + (size_t)(head * 128 + c0) * 64 + 8 * g + 4 * hi); wn1[g] = *(const f32x4*)(WLg + (size_t)(head * 128 + c0) * 64 + 32 + 8 * g + 4 * hi); }
            asm volatile("s_waitcnt lgkmcnt(0)\n\ts_barrier" ::: "memory");
            for (int cl = 0; cl < nch; ++cl) {
                const unsigned char* rl = c.lds + (cl & 3) * REC;
                f32x4 w0[4], w1[4];
#pragma unroll
                for (int g = 0; g < 4; ++g) { w0[g] = wn0[g]; w1[g] = wn1[g]; }
                { const float* wlp = WLg + (size_t)(head * 128 + c0 + (cl + 1 < nch ? cl + 1 : cl)) * 64;
#pragma unroll
                  for (int g = 0; g < 4; ++g) { wn0[g] = *(const f32x4*)(wlp + 8 * g + 4 * hi); wn1[g] = *(const f32x4*)(wlp + 32 + 8 * g + 4 * hi); } }
                bf16x8 sb[4];
#define RWC_CV(X, o) __builtin_bit_cast(bf16x8, (u32x4){pk2(X[o], X[o + 1]), pk2(X[o + 2], X[o + 3]), pk2(X[o + 4], X[o + 5]), pk2(X[o + 6], X[o + 7])})
                sb[0] = RWC_CV(S0, 0); sb[1] = RWC_CV(S0, 8); sb[2] = RWC_CV(S1, 0); sb[3] = RWC_CV(S1, 8);
                f32x16 ut, yt;
                { const u32x4 a0 = *(const u32x4*)(rl + O_VP2T + ib * 2048 + lane * 32), a1 = *(const u32x4*)(rl + O_VP2T + ib * 2048 + lane * 32 + 16);
                  const u32x4 b0 = *(const u32x4*)(rl + O_VMKRT + ib * 2048 + lane * 32), b1 = *(const u32x4*)(rl + O_VMKRT + ib * 2048 + lane * 32 + 16);
#pragma unroll
                  for (int e = 0; e < 4; ++e) { ut[2 * e] = bf2f(a0[e] & 0xffffu); ut[2 * e + 1] = bf2f(a0[e] >> 16); ut[8 + 2 * e] = bf2f(a1[e] & 0xffffu); ut[8 + 2 * e + 1] = bf2f(a1[e] >> 16);
                                                yt[2 * e] = bf2f(b0[e] & 0xffffu); yt[2 * e + 1] = bf2f(b0[e] >> 16); yt[8 + 2 * e] = bf2f(b1[e] & 0xffffu); yt[8 + 2 * e + 1] = bf2f(b1[e] >> 16); } }
#pragma unroll
                for (int s_ = 0; s_ < 4; ++s_) { const int kb = (16 * s_ + 8 * hi) * 2; ut = mm(ldf(rl + O_P1T, r32, 128, kb), sb[s_], ut); yt = mm(ldf(rl + O_RBT, r32, 128, kb), sb[s_], yt); }
                { const u32x4 c0 = *(const u32x4*)(rl + O_VKTP + (ib * 2 + 0) * 2048 + lane * 32), c1 = *(const u32x4*)(rl + O_VKTP + (ib * 2 + 0) * 2048 + lane * 32 + 16);
                  const u32x4 d0 = *(const u32x4*)(rl + O_VKTP + (ib * 2 + 1) * 2048 + lane * 32), d1 = *(const u32x4*)(rl + O_VKTP + (ib * 2 + 1) * 2048 + lane * 32 + 16);
#pragma unroll
                  for (int e = 0; e < 4; ++e) {
                      S0[2 * e] = fmaf(S0[2 * e], w0[(2 * e) >> 2][(2 * e) & 3], bf2f(c0[e] & 0xffffu)); S0[2 * e + 1] = fmaf(S0[2 * e + 1], w0[(2 * e + 1) >> 2][(2 * e + 1) & 3], bf2f(c0[e] >> 16));
                      S0[8 + 2 * e] = fmaf(S0[8 + 2 * e], w0[(8 + 2 * e) >> 2][(8 + 2 * e) & 3], bf2f(c1[e] & 0xffffu)); S0[8 + 2 * e + 1] = fmaf(S0[8 + 2 * e + 1], w0[(9 + 2 * e) >> 2][(9 + 2 * e) & 3], bf2f(c1[e] >> 16));
                      S1[2 * e] = fmaf(S1[2 * e], w1[(2 * e) >> 2][(2 * e) & 3], bf2f(d0[e] & 0xffffu)); S1[2 * e + 1] = fmaf(S1[2 * e + 1], w1[(2 * e + 1) >> 2][(2 * e + 1) & 3], bf2f(d0[e] >> 16));
                      S1[8 + 2 * e] = fmaf(S1[8 + 2 * e], w1[(8 + 2 * e) >> 2][(8 + 2 * e) & 3], bf2f(d1[e] & 0xffffu)); S1[8 + 2 * e + 1] = fmaf(S1[8 + 2 * e + 1], w1[(9 + 2 * e) >> 2][(9 + 2 * e) & 3], bf2f(d1[e] >> 16)); } }
                bf16x8 ub[2]; ub[0] = RWC_CV(ut, 0); ub[1] = RWC_CV(ut, 8);
#pragma unroll
                for (int s_ = 0; s_ < 2; ++s_) { const int kb = (16 * s_ + 8 * hi) * 2;
                    S0 = mm(ldf(rl + O_BBP, r32, 64, kb), ub[s_], S0); S1 = mm(ldf(rl + O_BBP, 32 + r32, 64, kb), ub[s_], S1); yt = mm(ldf(rl + O_MBRT, r32, 64, kb), ub[s_], yt); }
#undef RWC_CV
                { bf16* yo = Y2 + (size_t)(b * SEQ + (c0 + cl) * L) * 1024 + h * 64 + ib * 32 + r32;
#pragma unroll
                  for (int r = 0; r < 16; ++r) yo[(size_t)crow(r, hi) * 1024] = hbf(yt[r]); }
                asm volatile("s_waitcnt lgkmcnt(0)\n\ts_barrier" ::: "memory");
            }
            if (c0 + nch < SEQ / L) {
#pragma unroll
                for (int r = 0; r < 16; ++r) { sg[r] = S0[r]; sg[1024 + r] = S1[r]; } }
        }
    }
}
}


constexpr int CW_CHK = 210000;
__device__ __forceinline__ void rwc_check(const Ctx& c, const Params& p) {
    const float* Ysc = (const float*)(p.ws + WS_YSC); const bf16* Y2 = (const bf16*)(p.ws + WS_Y2); float* acc = (float*)((unsigned*)(p.ws + WS_CTL) + CW_CHK);
    float num = 0.f, den = 0.f;
    for (size_t i = (size_t)blockIdx.x * NTHR + c.tid; i < (size_t)T * D; i += (size_t)gridDim.x * NTHR) { const float a = Ysc[i], b = bf2f(Y2[i]); num += (a - b) * (a - b); den += a * a; }
    num = wave_sum(num); den = wave_sum(den);
    if (c.lane == 0) { atomicAdd(acc, num); atomicAdd(acc + 1, den); }
}

constexpr int RW_SPLIT = 104 * 32;
__device__ __forceinline__ void rwkv_post(const Ctx& c, const Params& p, int part, int blk0, int nblk) {
    const bf16* Y2 = (const bf16*)(p.ws + WS_Y2); const bf16* Rg = (const bf16*)(p.ws + WS_RR); const bf16* Kg = (const bf16*)(p.ws + WS_RK); const bf16* Vg = (const bf16*)(p.ws + WS_RV);
    const bf16* Ag = (const bf16*)(p.ws + WS_RA); const bf16* Gg = (const bf16*)(p.ws + WS_RG); bf16* YG = (bf16*)(p.ws + WS_RYG);
    if ((int)blockIdx.x < blk0) return;
    const int per = part ? SEQ - RW_SPLIT : RW_SPLIT, cnt = BATCH * per, step = nblk * NW;
    typedef unsigned long long u64;
    u64 ny[4], nr[4], nk[4], nv[4], na[4], ng[4];
#define RWP_ROW(i_) (((i_) / per) * SEQ + (part ? RW_SPLIT : 0) + (i_) % per)
#define RWP_LOAD(i_) { const size_t o_ = (size_t)RWP_ROW(i_) * D + 4 * c.lane; _Pragma("unroll") for (int j = 0; j < 4; ++j) { ny[j] = *(const u64*)(Y2 + o_ + 256 * j); nr[j] = *(const u64*)(Rg + o_ + 256 * j); \
        nk[j] = *(const u64*)(Kg + o_ + 256 * j); nv[j] = *(const u64*)(Vg + o_ + 256 * j); na[j] = *(const u64*)(Ag + o_ + 256 * j); ng[j] = *(const u64*)(Gg + o_ + 256 * j); } }
    int idx = ((int)blockIdx.x - blk0) * NW + c.wave;
    if (idx < cnt) RWP_LOAD(idx)
    for (; idx < cnt; idx += step) {
        const int m = RWP_ROW(idx);
        u64 cy[4], cr[4], ck[4], cv[4], ca[4], cg[4];
#pragma unroll
        for (int j = 0; j < 4; ++j) { cy[j] = ny[j]; cr[j] = nr[j]; ck[j] = nk[j]; cv[j] = nv[j]; ca[j] = na[j]; cg[j] = ng[j]; }
        if (idx + step < cnt) RWP_LOAD(idx + step)
        Row o;
#pragma unroll
        for (int j = 0; j < 4; ++j) {
            const int col = 4 * (c.lane + 64 * j);
            const u64 y8 = cy[j], r8 = cr[j], k8 = ck[j], v8 = cv[j], a8 = ca[j], g8 = cg[j];
            const f32x4 ka = *(const f32x4*)(p.in[I_RW_KA] + col), rk = *(const f32x4*)(p.in[I_RW_RK] + col), gg = *(const f32x4*)(p.in[I_RW_GNG] + col), gb = *(const f32x4*)(p.in[I_RW_GNB] + col);
            f32x4 r4, k4, v4, a4, g4, yv;
#pragma unroll
            for (int q = 0; q < 4; ++q) { r4[q] = bf2f((unsigned)(r8 >> (16 * q)) & 0xffffu); k4[q] = bf2f((unsigned)(k8 >> (16 * q)) & 0xffffu); v4[q] = bf2f((unsigned)(v8 >> (16 * q)) & 0xffffu);
                a4[q] = bf2f((unsigned)(a8 >> (16 * q)) & 0xffffu); g4[q] = bf2f((unsigned)(g8 >> (16 * q)) & 0xffffu); yv[q] = bf2f((unsigned)(y8 >> (16 * q)) & 0xffffu); }
            const float mean = red16((yv.x + yv.y) + (yv.z + yv.w)) * (1.f / 64.f);
            const f32x4 dy = yv - mean;
            const float var = red16((dy.x * dy.x + dy.y * dy.y) + (dy.z * dy.z + dy.w * dy.w)) * (1.f / 64.f);
            const float rstd = 1.0f / sqrtf(var + GN_EPS);
            f32x4 kt; float bs = 0.f;
#pragma unroll
            for (int q = 0; q < 4; ++q) { kt[q] = k4[q] * (1.f + (a4[q] - 1.f) * ka[q]); bs += r4[q] * kt[q] * rk[q]; }
            const float bonus = red16(bs);
#pragma unroll
            for (int q = 0; q < 4; ++q) o.v[j][q] = (dy[q] * rstd * gg[q] + gb[q] + bonus * v4[q]) * g4[q];
        }
        row_store_bf(YG + (size_t)m * D, c.lane, o);
    }
#undef RWP_LOAD
#undef RWP_ROW
}

__device__ __forceinline__ float allred4(float x) {
    auto r = __builtin_amdgcn_permlane16_swap(__float_as_uint(x), __float_as_uint(x), false, false); x = __uint_as_float(r[0]) + __uint_as_float(r[1]);
    auto q = __builtin_amdgcn_permlane32_swap(__float_as_uint(x), __float_as_uint(x), false, false); return __uint_as_float(q[0]) + __uint_as_float(q[1]);
}
__device__ __forceinline__ void moe_ln_route(const Ctx& c, const Params& p, int l, bool = false) {
    const bf16* Hbr = (const bf16*)(p.ws + WS_HB); bf16* Hb = (bf16*)(p.ws + WS_HB);
    int* P2TE = (int*)(p.ws + WS_P2TE); float* ROWGE = (float*)(p.ws + WS_ROWGE); int* TOKQ = (int*)(p.ws + WS_TOKQ);
    unsigned* cnt = (unsigned*)(p.ws + WS_CTL) + CW_CNT + l * 64;
    constexpr int L_WT = 0  , L_GB = 98304  , L_RED = L_GB + 256  , L_CNT = L_RED + 1024, L_LNG = L_CNT + 64, L_LNB = L_LNG + 4096,
                  L_GS = L_LNB + 4096  , L_REC = L_GS + 2048  , L_BLK = L_REC + 6144  ;
    LAS unsigned char* ldl = (LAS unsigned char*)c.lds;
    unsigned* lcnt = (unsigned*)(c.lds + L_CNT);
    const int fr = c.lane & 15, fq = c.lane >> 4;
    if (c.tid < 16) lcnt[c.tid] = 0u;
    const int rpb = (T + (int)gridDim.x - 1) / (int)gridDim.x, r0 = (int)blockIdx.x * rpb, r1 = (r0 + rpb < T) ? r0 + rpb : T, ng = (r1 - r0 + 15) >> 4;
    u32x4 xr[32];
#define M1_LOADX(gi_) { int mr_ = r0 + (gi_) * 16 + fr; mr_ = mr_ < r1 ? mr_ : r1 - 1; const u32x4* s_ = (const u32x4*)(Hbr + (size_t)mr_ * D) + fq; _Pragma("unroll") for (int s = 0; s < 32; ++s) xr[s] = s_[4 * s]; }
    int gi = c.wave;
    if (gi < ng) M1_LOADX(gi)
    {
        const float* lg = p.in[I_LN1G] + l * D; const float* lb = p.in[I_LN1B] + l * D; const float* Wr = p.in[I_ROUTER_W];
        const int e = c.tid & 15, q = c.tid >> 4;
        float gsum = 0.f, bsum = 0.f;
#pragma unroll
        for (int m = 0; m < 4; ++m) {
            const int ch = q + 32 * m, col0 = 8 * ch;
            const f32x4 g0 = *(const f32x4*)(lg + col0), g1 = *(const f32x4*)(lg + col0 + 4), b0 = *(const f32x4*)(lb + col0), b1 = *(const f32x4*)(lb + col0 + 4);
            unsigned h1[8], h2[8], h3[8];
#pragma unroll
            for (int i = 0; i < 8; ++i) { const float w = Wr[(col0 + i) * 16 + e], gv = i < 4 ? g0[i & 3] : g1[i & 3], bv = i < 4 ? b0[i & 3] : b1[i & 3], pr = gv * w;
                gsum += pr; bsum = fmaf(bv, w, bsum); attn_body::split3(pr, h1[i], h2[i], h3[i]); }
            const int slot = ((ch >> 2) * 64 + (ch & 3) * 16 + e) * 16;
            *(LAS u32x4*)(ldl + L_WT + slot) = (u32x4){h1[0] | (h1[1] << 16), h1[2] | (h1[3] << 16), h1[4] | (h1[5] << 16), h1[6] | (h1[7] << 16)};
            *(LAS u32x4*)(ldl + L_WT + 32768 + slot) = (u32x4){h2[0] | (h2[1] << 16), h2[2] | (h2[3] << 16), h2[4] | (h2[5] << 16), h2[6] | (h2[7] << 16)};
            *(LAS u32x4*)(ldl + L_WT + 65536 + slot) = (u32x4){h3[0] | (h3[1] << 16), h3[2] | (h3[3] << 16), h3[4] | (h3[5] << 16), h3[6] | (h3[7] << 16)};
        }
        gsum = allred4(gsum); bsum = allred4(bsum);
        if (c.lane < 16) { *(LAS float*)(ldl + L_RED + (c.wave * 32 + e) * 4) = gsum; *(LAS float*)(ldl + L_RED + (c.wave * 32 + 16 + e) * 4) = bsum; }
        for (int i = c.tid; i < 1024; i += NTHR) { *(LAS float*)(ldl + L_LNG + i * 4) = lg[i]; *(LAS float*)(ldl + L_LNB + i * 4) = lb[i]; }
        __syncthreads();
        if (c.tid < 32) { float a = 0.f;
#pragma unroll
            for (int w = 0; w < NW; ++w) a += *(LAS float*)(ldl + L_RED + (w * 32 + c.tid) * 4);
            *(LAS float*)(ldl + L_GB + c.tid * 4) = a; }
        else if (c.tid < 48) *(LAS float*)(ldl + L_GB + c.tid * 4) = p.in[I_ROUTER_B][c.tid - 32];
        __syncthreads();
    }
    const f32x4 Gv = *(LAS f32x4*)(ldl + L_GB + fq * 16), Bv = *(LAS f32x4*)(ldl + L_GB + 64 + fq * 16), Rv = *(LAS f32x4*)(ldl + L_GB + 128 + fq * 16);
    for (; gi < ng; gi += NW) {
        f32x4 acc = {0.f, 0.f, 0.f, 0.f};
        unsigned wb_ = (unsigned)c.lane * 16u, gb_ = (unsigned)fq * 32u + (unsigned)L_LNG; asm volatile("" : "+v"(wb_), "+v"(gb_));
        LAS unsigned char* wtl = ldl + wb_; LAS unsigned char* gbl = ldl + gb_;
#pragma unroll
        for (int s = 0; s < 32; ++s) {
            const pg8::bf16x8 xf = __builtin_bit_cast(pg8::bf16x8, xr[s]);
#pragma unroll
            for (int part = 0; part < 3; ++part)
                acc = __builtin_amdgcn_mfma_f32_16x16x32_bf16(*(LAS pg8::bf16x8*)(wtl + L_WT + part * 32768 + s * 1024), xf, acc, 0, 0, 0);
            if ((s & 3) == 3) __builtin_amdgcn_sched_barrier(0);
        }
        float sum = 0.f;
#pragma unroll
        for (int s = 0; s < 32; ++s)
#pragma unroll
            for (int k = 0; k < 4; ++k) sum += __uint_as_float(xr[s][k] << 16) + __uint_as_float(xr[s][k] & 0xffff0000u);
        const float mean = allred4(sum) * (1.f / D);
#pragma unroll
        for (int s = 0; s < 32; ++s) asm volatile("" : "+v"(xr[s]));
        float s2 = 0.f;
#pragma unroll
        for (int s = 0; s < 32; ++s)
#pragma unroll
            for (int k = 0; k < 4; ++k) { const float d0 = __uint_as_float(xr[s][k] << 16) - mean, d1 = __uint_as_float(xr[s][k] & 0xffff0000u) - mean; s2 = fmaf(d0, d0, s2); s2 = fmaf(d1, d1, s2); }
        const float rstd = 1.0f / sqrtf(allred4(s2) * (1.f / D) + LN_EPS);
        const int mrow = r0 + gi * 16 + fr; const bool valid = mrow < r1;
        u32x4* d_ = (u32x4*)(Hb + (size_t)(valid ? mrow : r1 - 1) * D) + fq;
#pragma unroll
        for (int s = 0; s < 32; ++s) asm volatile("" : "+v"(xr[s]));
#pragma unroll
        for (int s = 0; s < 32; ++s) {
            if ((s & 1) == 0) __builtin_amdgcn_sched_barrier(0);
            const f32x4 g0 = *(LAS f32x4*)(gbl + 128 * s), g1 = *(LAS f32x4*)(gbl + 128 * s + 16);
            const f32x4 b0 = *(LAS f32x4*)(gbl + 4096 + 128 * s), b1 = *(LAS f32x4*)(gbl + 4096 + 128 * s + 16);
            u32x4 o;
#pragma unroll
            for (int k = 0; k < 4; ++k) { const float gl = k < 2 ? g0[2 * k] : g1[2 * k - 4], gh = k < 2 ? g0[2 * k + 1] : g1[2 * k - 3], bl = k < 2 ? b0[2 * k] : b1[2 * k - 4], bh = k < 2 ? b0[2 * k + 1] : b1[2 * k - 3];
                const float y0 = (__uint_as_float(xr[s][k] << 16) - mean) * rstd * gl + bl, y1 = (__uint_as_float(xr[s][k] & 0xffff0000u) - mean) * rstd * gh + bh;
                o[k] = pk2(y0, y1); }
            d_[4 * s] = o;
        }
        float sc[4], se[4];
#pragma unroll
        for (int i = 0; i < 4; ++i) { const float lgt = rstd * (acc[i] - mean * Gv[i]) + Bv[i]; sc[i] = __builtin_amdgcn_rcpf(1.0f + __builtin_amdgcn_exp2f(-LOG2E * lgt)); se[i] = sc[i] + Rv[i]; }
        int i1 = 0; float v1 = se[0], c1 = sc[0];
#pragma unroll
        for (int i = 1; i < 4; ++i) if (se[i] > v1) { i1 = i; v1 = se[i]; c1 = sc[i]; }
        int i2 = -1; float v2 = -INFINITY, c2v = 0.f;
#pragma unroll
        for (int i = 0; i < 4; ++i) if (i != i1 && se[i] > v2) { i2 = i; v2 = se[i]; c2v = sc[i]; }
        *(LAS float*)(ldl + L_GS + ((c.wave * 16 + fr) * 4 + fq) * 4) = v1 + v2;
        const f32x4 g4 = *(LAS f32x4*)(ldl + L_GS + (c.wave * 16 + fr) * 16);
        int bg = 0; float bv = g4[0];
#pragma unroll
        for (int g = 1; g < 4; ++g) if (g4[g] > bv) { bv = g4[g]; bg = g; }
        if (valid && fq == bg) {
            const int be1 = 4 * fq + i1, be2 = 4 * fq + i2; const float inv = 1.0f / (c1 + c2v);
            const unsigned p1 = atomicAdd(lcnt + be1, 1u), p2 = atomicAdd(lcnt + be2, 1u);
            const int li = (gi * 16 + fr) * 2;
            *(LAS int*)(ldl + L_REC + li * 4) = be1; *(LAS int*)(ldl + L_REC + li * 4 + 4) = be2; *(LAS int*)(ldl + L_REC + 2048 + li * 4) = (int)p1; *(LAS int*)(ldl + L_REC + 2048 + li * 4 + 4) = (int)p2;
            *(LAS float*)(ldl + L_REC + 4096 + li * 4) = c1 * inv; *(LAS float*)(ldl + L_REC + 4096 + li * 4 + 4) = c2v * inv;
        }
        if (gi + NW < ng) M1_LOADX(gi + NW)
    }
#undef M1_LOADX
    __syncthreads();
    if (c.tid < 16) *(LAS int*)(ldl + L_BLK + c.tid * 4) = (int)atomicAdd(cnt + c.tid, lcnt[c.tid]);
    __syncthreads();
    for (int i = c.tid; i < 2 * (r1 - r0); i += NTHR) {
        const int e = *(LAS int*)(ldl + L_REC + i * 4), pe = e * ECAP + *(LAS int*)(ldl + L_BLK + e * 4) + *(LAS int*)(ldl + L_REC + 2048 + i * 4);
        P2TE[pe] = r0 + (i >> 1); ROWGE[pe] = *(LAS float*)(ldl + L_REC + 4096 + i * 4); TOKQ[(r0 + (i >> 1)) * 2 + (i & 1)] = pe; }
}
__device__ __forceinline__ void moe_tiles(const Ctx& c, const Params& p, int l) {
    const unsigned* cnt = (const unsigned*)(p.ws + WS_CTL) + CW_CNT + l * 64;
    LAS int* tab = (LAS int*)((LAS unsigned char*)c.lds + pg8::MOE_TAB);
    const int mt = c.tid; int tb = 0, e_ = 0, j_ = 0, nv_ = 0;
#pragma unroll
    for (int e = 0; e < 16; ++e) { const int ne = (int)__hip_atomic_load(cnt + e, __ATOMIC_RELAXED, __HIP_MEMORY_SCOPE_AGENT), nte = (ne + 255) >> 8;
        if (mt >= tb && mt < tb + nte) { e_ = e; j_ = mt - tb; nv_ = ne - 256 * j_ < 256 ? ne - 256 * j_ : 256; }
        tb += nte; }
    if (mt < 256) { tab[mt] = e_; tab[256 + mt] = j_; tab[512 + mt] = nv_; }
    if (mt == 0) tab[768] = tb;
    __syncthreads();
}
__device__ __forceinline__ void moe_combine(const Ctx& c, const Params& p, int l, float* outp, bool dry = false) {
    const bf16* Hbr = (const bf16*)(p.ws + WS_HB); bf16* Hb = (bf16*)(p.ws + (dry ? WS_ACT + 264 * MiB : WS_HB)); const bf16* Yd = (const bf16*)(p.ws + WS_YD); const int* TOKP = (const int*)(p.ws + WS_TOKQ);
    if (dry) outp = nullptr;
    LAS int* bs = (LAS int*)(LAS unsigned char*)c.lds;
    if (c.tid < 16) { const unsigned* cnt = (const unsigned*)(p.ws + WS_CTL) + CW_CNT + l * 64; int b_ = 0;
        for (int e = 0; e < c.tid; ++e) b_ += ((int)__hip_atomic_load(cnt + e, __ATOMIC_RELAXED, __HIP_MEMORY_SCOPE_AGENT) + 255) & ~255;
        bs[c.tid] = b_; }
    __syncthreads();
    int nq0 = 0, nq1 = 0, nq2 = 0, nq3 = 0;
    if (c.gw < T) { const int m1_ = (c.gw + c.ngw < T) ? c.gw + c.ngw : c.gw; nq0 = TOKP[c.gw * 2]; nq1 = TOKP[c.gw * 2 + 1]; nq2 = TOKP[m1_ * 2]; nq3 = TOKP[m1_ * 2 + 1]; }
    for (int m0 = c.gw; m0 < T; m0 += 2 * c.ngw) {
        const int m1 = (m0 + c.ngw < T) ? m0 + c.ngw : m0;
        const int qa0 = nq0, qa1 = nq1, qb0 = nq2, qb1 = nq3;
        { const int mn = m0 + 2 * c.ngw; if (mn < T) { const int mn1 = (mn + c.ngw < T) ? mn + c.ngw : mn; nq0 = TOKP[mn * 2]; nq1 = TOKP[mn * 2 + 1]; nq2 = TOKP[mn1 * 2]; nq3 = TOKP[mn1 * 2 + 1]; } }
        const int pa0 = bs[qa0 >> 14] + (qa0 & (ECAP - 1)), pa1 = bs[qa1 >> 14] + (qa1 & (ECAP - 1)), pb0 = bs[qb0 >> 14] + (qb0 & (ECAP - 1)), pb1 = bs[qb1 >> 14] + (qb1 & (ECAP - 1));
        Row xa = row_load_bf(Hbr + (size_t)m0 * D, c.lane), xb = row_load_bf(Hbr + (size_t)m1 * D, c.lane);
        unsigned long long ya0[4], ya1[4], yb0[4], yb1[4];
#pragma unroll
        for (int j = 0; j < 4; ++j) { ya0[j] = ((const unsigned long long*)(Yd + (size_t)pa0 * D) + c.lane)[64 * j]; ya1[j] = ((const unsigned long long*)(Yd + (size_t)pa1 * D) + c.lane)[64 * j];
                                      yb0[j] = ((const unsigned long long*)(Yd + (size_t)pb0 * D) + c.lane)[64 * j]; yb1[j] = ((const unsigned long long*)(Yd + (size_t)pb1 * D) + c.lane)[64 * j]; }
#define M5_ADD(RW, YA, YB) _Pragma("unroll") for (int j = 0; j < 4; ++j) { const unsigned long long a = YA[j], b = YB[j]; \
            RW.v[j][0] = ALPHA * RW.v[j][0] + bf2f((unsigned)a & 0xffffu) + bf2f((unsigned)b & 0xffffu); RW.v[j][1] = ALPHA * RW.v[j][1] + bf2f(((unsigned)a >> 16)) + bf2f(((unsigned)b >> 16)); \
            RW.v[j][2] = ALPHA * RW.v[j][2] + bf2f((unsigned)(a >> 32) & 0xffffu) + bf2f((unsigned)(b >> 32) & 0xffffu); RW.v[j][3] = ALPHA * RW.v[j][3] + bf2f((unsigned)(a >> 48)) + bf2f((unsigned)(b >> 48)); }
        M5_ADD(xa, ya0, ya1) M5_ADD(xb, yb0, yb1)
#undef M5_ADD
        const Row oa = row_ln(xa, p.in[I_LN2G] + l * D, p.in[I_LN2B] + l * D, c.lane), ob = row_ln(xb, p.in[I_LN2G] + l * D, p.in[I_LN2B] + l * D, c.lane);
        if (outp) { row_store(outp + (size_t)m0 * D, c.lane, oa); if (m1 != m0) row_store(outp + (size_t)m1 * D, c.lane, ob); }
        else { row_store_bf(Hb + (size_t)m0 * D, c.lane, oa); if (m1 != m0) row_store_bf(Hb + (size_t)m1 * D, c.lane, ob); }
    }
}

enum { PH_P0 = 0,
       PH_F1, PH_F3, PH_F4, PH_M1_0, PH_M3_0, PH_M4_0, PH_M5_0,
       PH_G1, PH_G2, PH_G3, PH_M1_1, PH_M3_1, PH_M4_1, PH_M5_1,
       PH_S1, PH_S2, PH_S3, PH_M1_2, PH_M3_2, PH_M4_2, PH_M5_2,
       PH_R0, PH_R1, PH_R2, PH_RC0, PH_RC1, PH_RC2, PH_RC3, PH_RC4, PH_RC5, PH_R4B, PH_R5, PH_M1_3, PH_M3_3, PH_M4_3, PH_M5_3, NPHASE };

#define RP_P0 RP1
#define RP_F1 RP1
#define RP_F3 RP1
#define RP_M34 RP1
#define RP_G2 RP1
#define RP_S2 RP1
#define RP_R4 RP1
#define RP0(...) {}
#define RP4B(...) { __VA_ARGS__; xcd_barrier(bar); __VA_ARGS__; xcd_barrier(bar); __VA_ARGS__; xcd_barrier(bar); __VA_ARGS__; xcd_barrier(bar); }
#define RP_M1D RP0
#define RP_M2 RP1
#define RP_M5D RP0
__global__ void __launch_bounds__(NTHR, 2) fwd_kernel(Params p) {
    extern __shared__ __attribute__((aligned(16))) unsigned char lds[];
    Ctx c; c.tid = threadIdx.x; c.lane = c.tid & 63; c.wave = __builtin_amdgcn_readfirstlane(c.tid >> 6); c.gw = blockIdx.x * NW + c.wave; c.ngw = gridDim.x * NW; c.lds = lds;
    volatile LAS unsigned* MISC = (volatile LAS unsigned*)((LAS unsigned char*)lds + MISC_OFF);
    if (c.tid < 32) MISC[c.tid] = 0u;
    __syncthreads();
    unsigned* ctl = (unsigned*)(p.ws + WS_CTL);
    XcdBarrier bar = xcd_barrier_post(ctl + CW_BAR + p.li * XCD_BAR_WORDS, MISC + 8);
    const int lo = p.ph_lo, hi = p.ph_hi;
    unsigned char* ws = p.ws;
#define PHASE(k, ...) if (lo <= (k) && (k) < hi) { Ctx c; { int t_ = threadIdx.x; asm volatile("" : "+v"(t_)); c.tid = t_; c.lane = t_ & 63; c.wave = __builtin_amdgcn_readfirstlane(t_ >> 6); c.gw = blockIdx.x * NW + c.wave; c.ngw = gridDim.x * NW; c.lds = lds; } \
        __VA_ARGS__; if ((k) + 1 < hi) xcd_barrier(bar); }
#define RP1(...) { __VA_ARGS__; }
#define RP5(...) { __VA_ARGS__; xcd_barrier(bar); __VA_ARGS__; xcd_barrier(bar); __VA_ARGS__; xcd_barrier(bar); __VA_ARGS__; xcd_barrier(bar); __VA_ARGS__; }

    PHASE(PH_P0, RP_P0(phase_p0(c, p)));
    LAS unsigned char* ldsr = (LAS unsigned char*)lds;
    const int G = gridDim.x, bid = blockIdx.x;
    const int vbid = (G % 8 == 0) ? (bid % 8) * (G / 8) + bid / 8 : bid;
#define GEMM_DENSE(Aoff, Boff, N, K, EPI_T, ...) { pg8::Gemm g{(const bf16*)(ws + (Aoff)), (const bf16*)(ws + (Boff)), T, (N), (K), nullptr}; pg8::StaticOrder S; S.init(T, (N), G, bid); \
        EPI_T E{__VA_ARGS__}; pg8::gemm_phase<EPI_T, pg8::StaticOrder, true, true>(ldsr, g, S, E); }
    PHASE(PH_F1, { fox_cumsum(c, p); __syncthreads();
        RP_F1(GEMM_DENSE(WS_HB, WS_FOX_IN, 4096, 1024, pg8::EpiBf16X<0>, (bf16*)(ws + WS_Q), 1024, nullptr, 1024, (size_t)T * 1024, C2)) });
    PHASE(PH_F3, RP_F3({ const attn_body::AttnTensors AT{(const attn_body::bf16*)(ws + WS_Q), (const attn_body::bf16*)(ws + WS_K), (const attn_body::bf16*)(ws + WS_V), (attn_body::bf16*)(ws + WS_O),
                                                  (const float*)(ws + WS_CB), (const attn_body::bf16*)(ws + WS_OG)};
        const attn_body::StaticOrder S(G, bid); attn_body::attn_phase<attn_body::StaticOrder>((char*)lds, AT, S); }));
    PHASE(PH_F4, GEMM_DENSE(WS_O, WS_FOX_OUT, 1024, 1024, pg8::EpiResid, (bf16*)(ws + WS_HB), ALPHA));
#define MOE_BLOCK(L, K1, K3, K4, K5, OUTP, NEXTCONV) \
    PHASE(K1, { RP_M1D(moe_ln_route(c, p, L, true)); moe_ln_route(c, p, L); }); \
    PHASE(K3, RP_M34({ moe_tiles(c, p, L); pg8::Gemm g{(const bf16*)(ws + WS_HB), (const bf16*)(ws + WS_GU + (size_t)((L) & 1) * WS_MOE_ALT), MPAD_MAX, 16 * 1024, 1024, (const int*)(ws + WS_P2TE)}; pg8::MoeOrder S{(const LAS int*)(ldsr + pg8::MOE_TAB), G, vbid}; \
        pg8::EpiSwiglu E{(bf16*)(ws + WS_H1)}; pg8::gemm_phase<pg8::EpiSwiglu, pg8::MoeOrder, true, true, true>(ldsr, g, S, E); \
        if (NEXTCONV) { int w_, nw_; if (tail_slot(c, 4 * __builtin_amdgcn_readfirstlane(*(const LAS int*)(ldsr + pg8::MOE_TAB + 768 * 4)), w_, nw_, vbid)) conv_moe_items(c, p, (L) + 1, 0, 32 * 256, w_, nw_); } })); \
    PHASE(K4, RP_M34({ moe_tiles(c, p, L); pg8::Gemm g{(const bf16*)(ws + WS_H1), (const bf16*)(ws + WS_DOWN + (size_t)((L) & 1) * WS_MOE_ALT), MPAD_MAX, 16 * 1024, 512, nullptr}; pg8::MoeOrder S{(const LAS int*)(ldsr + pg8::MOE_TAB), G, vbid}; \
        pg8::EpiDown E{(bf16*)(ws + WS_YD), (const float*)(ws + WS_ROWGE)}; pg8::gemm_phase<pg8::EpiDown, pg8::MoeOrder, true, true>(ldsr, g, S, E); \
        if (NEXTCONV) { int w_, nw_; if (tail_slot(c, 4 * __builtin_amdgcn_readfirstlane(*(const LAS int*)(ldsr + pg8::MOE_TAB + 768 * 4)), w_, nw_, vbid)) { conv_moe_items(c, p, (L) + 1, 32 * 256, 48 * 256, w_, nw_); \
             } } })); \
    PHASE(K5, { RP_M5D(moe_combine(c, p, L, OUTP, true)); moe_combine(c, p, L, OUTP); });
    MOE_BLOCK(0, PH_M1_0, PH_M3_0, PH_M4_0, PH_M5_0, nullptr, true)
    PHASE(PH_G1, GEMM_DENSE(WS_HB, WS_GM_IN, 2048, 1024, pg8::EpiBf16X<2>, (bf16*)(ws + WS_Z), 2048, p.in[I_GM_BIN], 0, 0, 1.f));
    PHASE(PH_G2, RP_G2(gmlp_spatial(c, p)));
    PHASE(PH_G3, GEMM_DENSE(WS_YG, WS_GM_OUT, 1024, 1024, pg8::EpiResid, (bf16*)(ws + WS_HB), ALPHA));
    MOE_BLOCK(1, PH_M1_1, PH_M3_1, PH_M4_1, PH_M5_1, nullptr, true)
    PHASE(PH_S1, GEMM_DENSE(WS_HB, WS_SB_IN, 3072, 1024, pg8::EpiBf16X<0>, (bf16*)(ws + WS_Q), 1024, nullptr, 1024, (size_t)T * 1024, C2));
    PHASE(PH_S2, RP_S2({ const attn_body::AttnTensors AT{(const attn_body::bf16*)(ws + WS_Q), (const attn_body::bf16*)(ws + WS_K), (const attn_body::bf16*)(ws + WS_V), (attn_body::bf16*)(ws + WS_O), nullptr, nullptr};
        const attn_body::SbOrder S(G, bid); attn_body::sb_phase<attn_body::SbOrder>((char*)lds, AT, S); }));
    PHASE(PH_S3, GEMM_DENSE(WS_O, WS_SB_OUT, 1024, 1024, pg8::EpiResid, (bf16*)(ws + WS_HB), ALPHA));
    MOE_BLOCK(2, PH_M1_2, PH_M3_2, PH_M4_2, PH_M5_2, nullptr, true)
    PHASE(PH_R0, rwkv_mix(c, p));
    PHASE(PH_R1, { pg8::Gemm g{(const bf16*)(ws + WS_HM), (const bf16*)(ws + WS_RKV), 6 * T, 15 * 256, 1024, nullptr}; pg8::Rw1Order S{G, vbid};
        pg8::EpiRw1 E{(bf16*)(ws + WS_RR), (bf16*)(ws + WS_L1), T}; pg8::gemm_phase<pg8::EpiRw1, pg8::Rw1Order, true, true>(ldsr, g, S, E); });
    PHASE(PH_R2, { pg8::Gemm g{(const bf16*)(ws + WS_L1), (const bf16*)(ws + WS_LORA2), 3 * T, 3 * 1024, 128, nullptr}; pg8::Rw2Order S{G, vbid};
        pg8::EpiRw2 E{(float*)(ws + WS_WDEC), (bf16*)(ws + WS_RA), (bf16*)(ws + WS_RG), p.in[I_RW_W0], p.in[I_RW_A0]}; pg8::gemm_phase<pg8::EpiRw2, pg8::Rw2Order, true, true>(ldsr, g, S, E); });
    const bool split_ok = G >= 128;
#define RW_STAGE(K, ST, C0, NCH, NC0, NNCH) PHASE(K, { if (split_ok) { if (bid < 64) rwc::rwc_scan(c, p, ST, C0, NCH); else rwc::rwc_prep(c, p, (ST) + 1, NC0, NNCH, 64, G - 64); } \
        else { rwc::rwc_scan(c, p, ST, C0, NCH); __syncthreads(); rwc::rwc_prep(c, p, (ST) + 1, NC0, NNCH, 0, G); } });
    PHASE(PH_RC0, rwc::rwc_prep(c, p, 0, 0, 32, 0, G));
    RW_STAGE(PH_RC1, 0, 0, 32, 32, 24)
    RW_STAGE(PH_RC2, 1, 32, 24, 56, 24)
    RW_STAGE(PH_RC3, 2, 56, 24, 80, 24)
    RW_STAGE(PH_RC4, 3, 80, 24, 104, 24)
#undef RW_STAGE
    PHASE(PH_RC5, { if (split_ok) { if (bid < 64) rwc::rwc_scan(c, p, 4, 104, 24); else rwkv_post(c, p, 0, 64, G - 64); } else { rwc::rwc_scan(c, p, 4, 104, 24); __syncthreads(); rwkv_post(c, p, 0, 0, G); } });
    PHASE(PH_R4B, rwkv_post(c, p, 1, 0, G));
    PHASE(PH_R5, GEMM_DENSE(WS_RYG, WS_RW_OUT, 1024, 1024, pg8::EpiResid, (bf16*)(ws + WS_HB), ALPHA));
    MOE_BLOCK(3, PH_M1_3, PH_M3_3, PH_M4_3, PH_M5_3, p.out, false)
#undef PHASE
}

#ifndef N_LAUNCH_MODE
#define N_LAUNCH_MODE 1
#endif
extern "C" void kernel_launch(void* const* d_in, const int* in_sizes, int n_in, void* d_out, int out_size, void* d_ws, size_t ws_size, hipStream_t stream) {
    static int grid = 0;
    if (grid == 0) {
        if (n_in != 38 || in_sizes[0] != T * D || out_size != T * D || ws_size < WS_END) { fprintf(stderr, "kernel_launch: unexpected shapes (n_in %d, ws %zu)\n", n_in, ws_size); grid = -1; return; }
        int dev = 0, cus = 0;
        if (hipGetDevice(&dev) != hipSuccess || hipDeviceGetAttribute(&cus, hipDeviceAttributeMultiprocessorCount, dev) != hipSuccess) { grid = -1; return; }
        if (hipFuncSetAttribute((const void*)fwd_kernel, hipFuncAttributeMaxDynamicSharedMemorySize, LDS_BYTES) != hipSuccess) { fprintf(stderr, "kernel_launch: hipFuncSetAttribute failed\n"); grid = -1; return; }
        int per_cu = 0; (void)hipOccupancyMaxActiveBlocksPerMultiprocessor(&per_cu, (const void*)fwd_kernel, NTHR, LDS_BYTES); (void)hipGetLastError();
        grid = cus > 0 ? cus : 256;
    }
    if (grid < 0) return;
    (void)hipMemsetAsync((char*)d_ws + WS_CTL, 0, CTL_BYTES, stream);
    Params a{};
    for (int i = 0; i < 38; ++i) a.in[i] = (const float*)d_in[i];
    a.out = (float*)d_out; a.ws = (unsigned char*)d_ws; a.pad = 0;
    if (N_LAUNCH_MODE == 1) { a.ph_lo = 0; a.ph_hi = NPHASE; a.li = 0; hipLaunchKernelGGL(fwd_kernel, dim3(grid), dim3(NTHR), LDS_BYTES, stream, a); }
    else for (int k = 0; k < NPHASE; ++k) { a.ph_lo = k; a.ph_hi = k + 1; a.li = k; hipLaunchKernelGGL(fwd_kernel, dim3(grid), dim3(NTHR), LDS_BYTES, stream, a); }
}
```

```cpp
#include <hip/hip_runtime.h>
#include <cstdio>
#include <cstdint>
#include <hip/hip_bf16.h>
#include <cmath>

#define LAS __attribute__((address_space(3)))
typedef unsigned short bf16;
typedef unsigned u32x4 __attribute__((ext_vector_type(4)));
typedef float f32x4 __attribute__((ext_vector_type(4)));

constexpr int D = 1024, BATCH = 4, SEQ = 4096, T = BATCH * SEQ, NH = 16, HD = 64;
constexpr int NEXP = 16, DEXP = 512;
constexpr float ALPHA = 1.6817928305074290f;
constexpr float LN_EPS = 1e-5f, GN_EPS = 64e-5f;
constexpr float LOG2E = 1.4426950408889634f;
constexpr float C2 = 0.125f * LOG2E;
constexpr int NW = 8, NTHR = 512;
constexpr int MPAD_MAX = 36864;

constexpr size_t MiB = 1u << 20;
constexpr size_t WS_CTL = 0, CTL_BYTES = 1 * MiB;
constexpr size_t WS_FOX_IN = 2 * MiB, WS_FOX_OUT = 10 * MiB, WS_GM_IN = 12 * MiB, WS_GM_OUT = 16 * MiB, WS_GM_WS = 18 * MiB;
constexpr size_t WS_SB_IN = 19 * MiB, WS_SB_OUT = 25 * MiB, WS_RKV = 27 * MiB, WS_LORA1 = 33 * MiB, WS_LORA2 = 35 * MiB, WS_RW_OUT = 134 * MiB;
constexpr size_t WS_GU = 38 * MiB, WS_DOWN = 70 * MiB, WS_MOE_ALT = 48 * MiB;
constexpr size_t WS_HF = 86 * MiB, WS_HB = 150 * MiB;
constexpr size_t WS_TOKE = 182 * MiB, WS_TOKG = WS_TOKE + 128 * 1024, WS_TOKP = WS_TOKG + 128 * 1024, WS_ROWG = WS_TOKP + 128 * 1024, WS_TILEE = WS_ROWG + 256 * 1024, WS_BLKB = WS_TILEE + 4096, WS_TOKQ = WS_BLKB + 32768, WS_P2T = WS_TOKQ + 128 * 1024;
constexpr size_t WS_FL = 184 * MiB, WS_CB = 185 * MiB;
constexpr int ECAP = 16384;
constexpr size_t WS_P2TE = 140 * MiB, WS_ROWGE = 141 * MiB;
constexpr size_t WS_ACT = 186 * MiB;
constexpr size_t WS_Q = WS_ACT, WS_K = WS_ACT + 32 * MiB, WS_V = WS_ACT + 64 * MiB, WS_OG = WS_ACT + 96 * MiB, WS_O = WS_ACT + 128 * MiB;
constexpr size_t WS_Z = WS_ACT, WS_YG = WS_ACT + 64 * MiB;
constexpr size_t WS_HM = WS_ACT, WS_RR = WS_ACT + 192 * MiB, WS_RK = WS_RR + 32 * MiB, WS_RV = WS_RK + 32 * MiB, WS_L1 = WS_RV + 32 * MiB;
constexpr size_t WS_WDEC = WS_ACT, WS_RA = WS_ACT + 64 * MiB, WS_RG = WS_ACT + 96 * MiB, WS_YSC = WS_ACT + 128 * MiB  , WS_RYG = WS_ACT  ;
constexpr size_t WS_XS = WS_ACT, WS_H1 = WS_ACT + 72 * MiB, WS_YD = WS_ACT + 108 * MiB;
constexpr size_t WS_CD0 = 2 * MiB, WS_CD1 = WS_ACT + 128 * MiB;
constexpr size_t WS_WLG = 136 * MiB;
constexpr size_t WS_SIG = 138 * MiB;
constexpr size_t WS_Y2 = WS_L1;
constexpr size_t WS_END = WS_Y2 + 32 * MiB;
constexpr int CW_BAR = 4096;
constexpr int CW_CNT = 200000;

constexpr int LDS_BYTES = 147456;
constexpr int MISC_OFF = LDS_BYTES - 256;

__device__ __forceinline__ float bf2f(unsigned b) { return __uint_as_float(b << 16); }
__device__ __forceinline__ unsigned f2bf(float f) { unsigned u = __float_as_uint(f); return (u + 0x7fffu + ((u >> 16) & 1u)) >> 16; }
typedef float f32x2_hw __attribute__((ext_vector_type(2))); typedef __bf16 bf16x2_hw __attribute__((ext_vector_type(2)));
__device__ __forceinline__ unsigned pk2(float lo, float hi) { f32x2_hw v = {lo, hi}; bf16x2_hw b = __builtin_convertvector(v, bf16x2_hw); return __builtin_bit_cast(unsigned, b); }
template <int CTRL> __device__ __forceinline__ float dppf(float v) { return __int_as_float(__builtin_amdgcn_update_dpp(0, __float_as_int(v), CTRL, 0xf, 0xf, true)); }
__device__ __forceinline__ float red16(float x) { x += dppf<0xB1>(x); x += dppf<0x4E>(x); x += dppf<0x141>(x); x += dppf<0x140>(x); return x; }
__device__ __forceinline__ float wave_sum(float v) {
    v = red16(v);
    return (__uint_as_float(__builtin_amdgcn_readlane(__float_as_uint(v), 0)) + __uint_as_float(__builtin_amdgcn_readlane(__float_as_uint(v), 16)))
         + (__uint_as_float(__builtin_amdgcn_readlane(__float_as_uint(v), 32)) + __uint_as_float(__builtin_amdgcn_readlane(__float_as_uint(v), 48)));
}
__device__ __forceinline__ float wave_max(float v) {
#pragma unroll
    for (int o = 1; o < 64; o <<= 1) v = fmaxf(v, __shfl_xor(v, o));
    return v;
}
__device__ __forceinline__ float wave_incl_scan(float v, int lane) {
#pragma unroll
    for (int o = 1; o < 64; o <<= 1) { float t = __shfl_up(v, o); if (lane >= o) v += t; }
    return v;
}
__device__ __forceinline__ float rdlane(float v, int l) { return __uint_as_float(__builtin_amdgcn_readlane(__float_as_uint(v), l)); }
__device__ __forceinline__ float sigmoidf_(float x) { return 1.0f / (1.0f + expf(-x)); }
__device__ __forceinline__ float softplusf_(float x) { return fmaxf(x, 0.f) + log1pf(expf(-fabsf(x))); }
#define LDS_WAIT() asm volatile("s_waitcnt lgkmcnt(0)" ::: "memory")

#define XB_TMO      128
#define XB_XCNT(j)  (256  + 64 * (j))
#define XB_XSUB(j)  (1280 + 64 * (j))
#define XB_XGEN(j)  (2304 + 64 * (j))
#define XB_TOP      3328
#define XB_TOPGEN   3392
#define XCD_BAR_WORDS 3456
#define XB_SPIN_CAP (1u << 24)
__device__ __forceinline__ unsigned xb_ld(unsigned* p)              { return __hip_atomic_load(p, __ATOMIC_RELAXED, __HIP_MEMORY_SCOPE_AGENT); }
__device__ __forceinline__ unsigned xb_add(unsigned* p, unsigned v) { return __hip_atomic_fetch_add(p, v, __ATOMIC_RELAXED, __HIP_MEMORY_SCOPE_AGENT); }
__device__ __forceinline__ unsigned xb_xcc_id() { return (unsigned)__builtin_amdgcn_s_getreg((3 << 11) | 20) & 0xFu; }
#define XB_SPIN(cond, bar) do { unsigned _sp = 0; while (cond) { __builtin_amdgcn_s_sleep(1); \
    if ((++_sp & 255u) == 0u) { if (xb_ld(&(bar)[XB_TMO])) break; if (_sp > XB_SPIN_CAP) { atomicAdd(&(bar)[XB_TMO], 1u); break; } } } } while (0)
struct XcdBarrier { unsigned* bar; unsigned x; volatile LAS unsigned* st; };
__device__ __forceinline__ XcdBarrier xcd_barrier_post(unsigned* bar, volatile LAS unsigned* st) {
    XcdBarrier b; b.bar = bar; b.x = xb_xcc_id(); b.st = st;
    if (threadIdx.x == 0) (void)xb_add(&bar[XB_XCNT(b.x)], 1u);
    return b;
}
__device__ __forceinline__ void xcd_barrier_complete(unsigned* bar, unsigned x, unsigned& nloc, unsigned& nx) {
    const unsigned G = gridDim.x * gridDim.y * gridDim.z;
    unsigned sum, cnt, mine, sp = 0u;
    for (;;) {
        sum = 0u; cnt = 0u; mine = 0u;
#pragma unroll
        for (unsigned j = 0; j < 16; ++j) { const unsigned c = xb_ld(&bar[XB_XCNT(j)]); sum += c; cnt += (c > 0u) ? 1u : 0u; mine = (j == x) ? c : mine; }
        if (sum == G) break;
        __builtin_amdgcn_s_sleep(1);
        if ((++sp & 255u) == 0u) { if (xb_ld(&bar[XB_TMO])) break; if (sp > XB_SPIN_CAP) { atomicAdd(&bar[XB_TMO], 1u); break; } }
    }
    nloc = mine > 0u ? mine : 1u; nx = cnt > 0u ? cnt : 1u;
}
__device__ __forceinline__ void xcd_barrier(const XcdBarrier& b) {
    asm volatile("s_waitcnt vmcnt(0)" ::: "memory");
    __syncthreads();
    if (threadIdx.x == 0) {
        unsigned* bar = b.bar;
        __builtin_amdgcn_s_waitcnt(0);
        unsigned nloc = b.st[0], nx = b.st[1];
        if (nloc == 0u) { xcd_barrier_complete(bar, b.x, nloc, nx); b.st[0] = nloc; b.st[1] = nx; }
        const unsigned old = xb_add(&bar[XB_XSUB(b.x)], 1u);
        const unsigned gen = old / nloc;
        if (old + 1u == (gen + 1u) * nloc) {
            __builtin_amdgcn_fence(__ATOMIC_RELEASE, "agent");
            asm volatile("s_waitcnt vmcnt(0)" ::: "memory");
            const unsigned og = xb_add(&bar[XB_TOP], 1u);
            const unsigned tg = og / nx;
            if (og + 1u == (tg + 1u) * nx) xb_add(&bar[XB_TOPGEN], 1u);
            else XB_SPIN(xb_ld(&bar[XB_TOPGEN]) == tg, bar);
            __builtin_amdgcn_fence(__ATOMIC_ACQUIRE, "agent");
            xb_add(&bar[XB_XGEN(b.x)], 1u);
            asm volatile("s_waitcnt vmcnt(0)" ::: "memory");
        } else {
            XB_SPIN(xb_ld(&bar[XB_XGEN(b.x)]) == gen, bar);
            __builtin_amdgcn_fence(__ATOMIC_ACQUIRE, "agent");
            asm volatile("s_waitcnt vmcnt(0)" ::: "memory");
        }
    }
    __syncthreads();
}

namespace pg8 {
#define PG8_LAS __attribute__((address_space(3)))
typedef unsigned short bf16_t;
typedef short bf16x8 __attribute__((ext_vector_type(8)));
typedef float f32x4 __attribute__((ext_vector_type(4)));
typedef unsigned u32x4 __attribute__((ext_vector_type(4)));
constexpr int BM = 256, BK = 64, HALF = 128, HTB = HALF * BK * 2  , STAGE_BYTES = 8 * HTB, NXCD = 8, WGM = 8;

__host__ __device__ __forceinline__ int lds_byte(int r, int c) { const int st = (r >> 4) * 2 + (c >> 5), rr = r & 15, cc = c & 31, ob = rr * 64 + cc * 2; return st * 1024 + (ob ^ (((ob >> 9) & 1) << 5)); }
__host__ __device__ __forceinline__ void stage_rc(int b, int& R, int& C) { const int st = b / 1024, sb = b % 1024, swz = sb ^ (((sb >> 9) & 1) << 5); R = (st >> 1) * 16 + swz / 64; C = (st & 1) * 32 + (swz % 64) / 2; }
__host__ __device__ __forceinline__ int perm32(int rho) { const int n = rho >> 4, i = rho & 15; return 8 * (i >> 2) + 4 * n + (i & 3); }

struct Unit { int pm, pn, rt, nv; };
struct Gemm { const bf16_t* A; const bf16_t* Bt; int M, N, K; const int* rowtok; };

struct StaticOrder {
    int nM, nN, nwg, G, c;
    __host__ __device__ void init(int M, int N, int G_, int c_) { nM = M / BM; nN = N / BM; nwg = nM * nN; G = G_; c = c_; }
    __host__ __device__ bool next(int i, Unit& u) const {
        const long L = (long)i * G + c; if (L >= nwg) return false;
        int wgid = (int)L; { const int q = nwg / NXCD, r = nwg % NXCD, xcd = wgid % NXCD, off = wgid / NXCD; wgid = (xcd < r ? xcd * (q + 1) : r * (q + 1) + (xcd - r) * q) + off; }
        const int nig = WGM * nN, gid = wgid / nig, fm = gid * WGM, gsz = (nM - fm) < WGM ? (nM - fm) : WGM;
        u.pm = fm + ((wgid % nig) % gsz); u.pn = (wgid % nig) / gsz; return true;
    }
    __device__ __forceinline__ void a_ready(const Unit&) const {}
    __device__ __forceinline__ void done(const Unit&) const {}
};

__device__ __forceinline__ unsigned cvt_pk_bf16(float lo, float hi) { unsigned r; asm volatile("v_cvt_pk_bf16_f32 %0, %1, %2" : "=v"(r) : "v"(lo), "v"(hi)); return r; }
typedef float f32x2 __attribute__((ext_vector_type(2)));
__device__ __forceinline__ f32x2 gelu_pk(f32x2 v) {
    const f32x2 av = __builtin_elementwise_abs(v), d = av * 0.2316418882f + 1.0f;
    f32x2 t; t.x = __builtin_amdgcn_rcpf(d.x); t.y = __builtin_amdgcn_rcpf(d.y);
    f32x2 q = t * 0.5307027145f + (-0.7265760135f); q = q * t + 0.7107068705f; q = q * t + (-0.142248368f); q = q * t + 0.127414796f; q = q * t;
    const f32x2 s = (v * v) * (-0.72134752044f);
    f32x2 e; e.x = __builtin_amdgcn_exp2f(s.x); e.y = __builtin_amdgcn_exp2f(s.y);
    const f32x2 m = v * (q * e), r = v - m;
    f32x2 o; o.x = v.x < 0.f ? m.x : r.x; o.y = v.y < 0.f ? m.y : r.y; return o;
}

template <int ACT  > struct EpiBf16 {
    static constexpr bool PERM = true, AFTER_DRAIN = false; static_assert(ACT == 0 || ACT == 1, "EpiBf16: ACT is 0 (none) or 1 (gelu_pk)");
    bf16_t* O; int ldc; const float* bias; int split_cols; size_t split_stride; float scale0;
    __device__ __forceinline__ void operator()(const f32x4 (&acc)[2][2][4][2], const Unit& u, int wr, int wc, int fr, int fq) const {
        const int row0 = u.pm * BM + wr * 64 + fr; int colt = u.pn * BM; bf16_t* base = O;
        float sc = 1.f; if (split_cols) { const int t = colt / split_cols; base += (size_t)t * split_stride; colt -= t * split_cols; if (t == 0) sc = scale0; }
        const int col0 = colt + wc * 32 + 8 * fq, bcol0 = u.pn * BM + wc * 32 + 8 * fq;
        f32x4 bv[2][2];
#pragma unroll
        for (int bj = 0; bj < 2; ++bj)
#pragma unroll
            for (int n = 0; n < 2; ++n) bv[bj][n] = bias ? *(const f32x4*)(bias + bcol0 + bj * HALF + 4 * n) : (f32x4){0.f, 0.f, 0.f, 0.f};
#pragma unroll
        for (int ai = 0; ai < 2; ++ai)
#pragma unroll
            for (int m = 0; m < 4; ++m) { bf16_t* rowp = base + (size_t)(row0 + ai * HALF + m * 16) * ldc + col0;
#pragma unroll
                for (int bj = 0; bj < 2; ++bj) { f32x4 v0 = acc[ai][bj][m][0] + bv[bj][0], v1 = acc[ai][bj][m][1] + bv[bj][1];
                    if (ACT == 1) { f32x2 a = gelu_pk((f32x2){v0[0], v0[1]}), b = gelu_pk((f32x2){v0[2], v0[3]}), c = gelu_pk((f32x2){v1[0], v1[1]}), d = gelu_pk((f32x2){v1[2], v1[3]});
                        v0 = (f32x4){a.x, a.y, b.x, b.y}; v1 = (f32x4){c.x, c.y, d.x, d.y}; }
                    v0 = v0 * sc; v1 = v1 * sc; u32x4 w; w.x = cvt_pk_bf16(v0[0], v0[1]); w.y = cvt_pk_bf16(v0[2], v0[3]); w.z = cvt_pk_bf16(v1[0], v1[1]); w.w = cvt_pk_bf16(v1[2], v1[3]);
                    *(u32x4*)(rowp + bj * HALF) = w; } }
    }
};


template <class Epi, class Sched, bool ALIGN_EPI = false, bool SP2 = false, bool GATH = false>
__device__ __forceinline__ void gemm_phase(PG8_LAS unsigned char* lds, const Gemm g, const Sched& S, const Epi& E) {
    const int tid = threadIdx.x, wid = __builtin_amdgcn_readfirstlane(tid >> 6), lane = tid & 63, wr = wid >> 2, wc = wid & 3, fr = lane & 15, fq = lane >> 4;
    const int K = g.K, nt = K / BK;
    unsigned voffA[2], voffB[2];
#pragma unroll
    for (int i = 0; i < 2; ++i) { int R, C; stage_rc(tid * 16 + i * 8192, R, C); const int Rb = Epi::PERM ? ((R & ~31) + perm32(R & 31)) : R;
        voffA[i] = (unsigned)(R * K + C) * 2u; voffB[i] = (unsigned)(Rb * K + C) * 2u; }
    static_assert(!GATH || SP2, "GATH is implemented for the SP2 loop only");
    int gR[2]; unsigned gC[2]; unsigned ogC[2][2], ogN[2][2];
    if constexpr (GATH) {
#pragma unroll
        for (int i = 0; i < 2; ++i) { int R, C; stage_rc(tid * 16 + i * 8192, R, C); gR[i] = R; gC[i] = (unsigned)C * 2u; }
    }
#define PG8_OG(og, U_) do { _Pragma("unroll") for (int h_ = 0; h_ < 2; ++h_) _Pragma("unroll") for (int i_ = 0; i_ < 2; ++i_) { const int rr_ = h_ * HALF + gR[i_]; \
        og[h_][i_] = (unsigned)(rr_ < (U_).nv ? g.rowtok[(U_).rt * BM + rr_] : 0) * (unsigned)(K * 2) + gC[i_]; } } while (0)
    const size_t kstep = (size_t)(BK * 2);
    const size_t hstep = (size_t)HALF * K * 2;
    const size_t tstep = 2 * hstep;
    const unsigned ldsw = (unsigned)wid * 1024u;
    const int aoff = lds_byte(wr * 64 + fr, fq * 8), boff = lds_byte(wc * 32 + fr, fq * 8);
#define PG8_SA(b, h) (((b) * 2 + (h)) * HTB)
#define PG8_SB(b, h) ((4 + (b) * 2 + (h)) * HTB)
#define PG8_STAGE(bufoff, gbase, voff) do { _Pragma("unroll") for (int _i = 0; _i < 2; ++_i) \
        __builtin_amdgcn_global_load_lds((const unsigned*)((const char*)(gbase) + (voff)[_i]), (PG8_LAS unsigned*)(lds + (bufoff) + ldsw + _i * 8192), 16, 0, 0); } while (0)
#define PG8_STAGE_G(bufoff, kptr, og) do { _Pragma("unroll") for (int _i = 0; _i < 2; ++_i) \
        __builtin_amdgcn_global_load_lds((const unsigned*)((const char*)(kptr) + (og)[_i]), (PG8_LAS unsigned*)(lds + (bufoff) + ldsw + _i * 8192), 16, 0, 0); } while (0)
#define PG8_STAGE_A(bufoff, tp, kp, h, sel) do { if constexpr (GATH) { unsigned og_[2] = {(sel) ? ogN[h][0] : ogC[h][0], (sel) ? ogN[h][1] : ogC[h][1]}; PG8_STAGE_G(bufoff, kp, og_); } \
        else { PG8_STAGE(bufoff, (tp) + (h) * hstep, voffA); } } while (0)
#define PG8_LDA(dst, b, h) do { _Pragma("unroll") for (int m = 0; m < 4; ++m) _Pragma("unroll") for (int k = 0; k < 2; ++k) dst[m][k] = *(const PG8_LAS bf16x8*)(lds + PG8_SA(b, h) + aoff + m * 2048 + k * 1024); } while (0)
#define PG8_LDB(dst, b, h) do { _Pragma("unroll") for (int n = 0; n < 2; ++n) _Pragma("unroll") for (int k = 0; k < 2; ++k) dst[n][k] = *(const PG8_LAS bf16x8*)(lds + PG8_SB(b, h) + boff + n * 2048 + k * 1024); } while (0)
#define PG8_MMA(ai, bj, At, Bt) do { __builtin_amdgcn_s_setprio(1); _Pragma("unroll") for (int m = 0; m < 4; ++m) _Pragma("unroll") for (int n = 0; n < 2; ++n) _Pragma("unroll") for (int k = 0; k < 2; ++k) \
        acc[ai][bj][m][n] = __builtin_amdgcn_mfma_f32_16x16x32_bf16(Bt[n][k], At[m][k], acc[ai][bj][m][n], 0, 0, 0); __builtin_amdgcn_s_setprio(0); } while (0)
#define PG8_WAIT_V(n) asm volatile("s_waitcnt vmcnt(" #n ")" ::: "memory")
#define PG8_WAIT_L(n) asm volatile("s_waitcnt lgkmcnt(" #n ")" ::: "memory")
#define PG8_BAR __builtin_amdgcn_s_barrier()
#define PG8_SCHED __builtin_amdgcn_sched_barrier(0)
    Unit cur, nxt; int ui = 0;
    if (!S.next(0, cur)) return;
    f32x4 acc[2][2][4][2];
#pragma unroll
    for (int a = 0; a < 2; ++a)
#pragma unroll
        for (int b = 0; b < 2; ++b)
#pragma unroll
            for (int m = 0; m < 4; ++m)
#pragma unroll
                for (int n = 0; n < 2; ++n) acc[a][b][m][n] = (f32x4){0.f, 0.f, 0.f, 0.f};
    bf16x8 At[4][2], B0[2][2], B1[2][2];
    const char* cA = (const char*)g.A + (size_t)cur.pm * tstep; const char* cB = (const char*)g.Bt + (size_t)cur.pn * tstep;
    const char* const gA = (const char*)g.A;
    if constexpr (GATH) { PG8_OG(ogC, cur); }
    S.a_ready(cur);
    if constexpr (SP2) {
        PG8_STAGE(PG8_SB(0, 0), cB, voffB); PG8_STAGE(PG8_SB(0, 1), cB + hstep, voffB); PG8_STAGE_A(PG8_SA(0, 0), cA, gA, 0, false); PG8_STAGE_A(PG8_SA(0, 1), cA, gA, 1, false);
        if (wr == 1) PG8_BAR;
        PG8_WAIT_V(2); PG8_BAR;
        PG8_STAGE(PG8_SB(1, 0), cB + kstep, voffB); PG8_STAGE_A(PG8_SA(1, 0), cA + kstep, gA + kstep, 0, false); PG8_STAGE(PG8_SB(1, 1), cB + hstep + kstep, voffB);
        PG8_WAIT_V(6); PG8_BAR;
    } else {
        PG8_STAGE(PG8_SB(0, 0), cB, voffB); PG8_STAGE(PG8_SA(0, 0), cA, voffA); PG8_STAGE(PG8_SB(0, 1), cB + hstep, voffB); PG8_STAGE(PG8_SA(0, 1), cA + hstep, voffA);
        if (wr == 1) PG8_BAR;
        PG8_WAIT_V(4); PG8_BAR;
        PG8_STAGE(PG8_SB(1, 0), cB + kstep, voffB); PG8_STAGE(PG8_SA(1, 0), cA + kstep, voffA); PG8_STAGE(PG8_SB(1, 1), cB + hstep + kstep, voffB);
        PG8_WAIT_V(6); PG8_BAR;
    }
    for (;;) {
        const bool has_next = S.next(ui + 1, nxt);
        if constexpr (GATH) { if (has_next) { PG8_OG(ogN, nxt); } }
        const char* nA = has_next ? (const char*)g.A + (size_t)nxt.pm * tstep : cA; const char* nB = has_next ? (const char*)g.Bt + (size_t)nxt.pn * tstep : cB;
        for (int t = 0; t < nt; t += 2) {
            const bool last = (t == nt - 2);
            const char* a1 = cA + (size_t)(t + 1) * kstep;
            const char* a2 = last ? nA : cA + (size_t)(t + 2) * kstep; const char* b2 = last ? nB : cB + (size_t)(t + 2) * kstep;
            const char* a3 = a2 + kstep; const char* b3 = b2 + kstep;
            const bool gsel = last && has_next; const char* ga1 = gA + (size_t)(t + 1) * kstep; const char* ga2 = last ? gA : gA + (size_t)(t + 2) * kstep; const char* ga3 = ga2 + kstep;
            if (last && has_next) S.a_ready(nxt);
            if constexpr (SP2) {
            PG8_LDB(B0, 0, 0); PG8_LDB(B1, 0, 1); PG8_SCHED; PG8_LDA(At, 0, 0); PG8_STAGE_A(PG8_SA(1, 1), a1, ga1, 1, false);
            PG8_WAIT_V(8); PG8_WAIT_L(0); PG8_BAR; PG8_MMA(0, 0, At, B0); PG8_MMA(0, 1, At, B1); PG8_BAR; PG8_SCHED;
            PG8_LDA(At, 0, 1); PG8_STAGE(PG8_SB(0, 0), b2, voffB); PG8_STAGE(PG8_SB(0, 1), b2 + hstep, voffB); PG8_STAGE_A(PG8_SA(0, 0), a2, ga2, 0, gsel);
            PG8_WAIT_V(8); PG8_WAIT_L(0); PG8_BAR; PG8_MMA(1, 0, At, B0); PG8_MMA(1, 1, At, B1); PG8_BAR; PG8_SCHED;
            PG8_LDB(B0, 1, 0); PG8_LDB(B1, 1, 1); PG8_SCHED; PG8_LDA(At, 1, 0); PG8_STAGE_A(PG8_SA(0, 1), a2, ga2, 1, gsel);
            PG8_WAIT_V(8); PG8_WAIT_L(0); PG8_BAR; PG8_MMA(0, 0, At, B0); PG8_MMA(0, 1, At, B1); PG8_BAR; PG8_SCHED;
            PG8_LDA(At, 1, 1); PG8_STAGE(PG8_SB(1, 0), b3, voffB); PG8_STAGE(PG8_SB(1, 1), b3 + hstep, voffB); PG8_STAGE_A(PG8_SA(1, 0), a3, ga3, 0, gsel);
            PG8_WAIT_V(8); PG8_WAIT_L(0); PG8_BAR; PG8_MMA(1, 0, At, B0); PG8_MMA(1, 1, At, B1); PG8_BAR; PG8_SCHED;
            } else {
            PG8_LDB(B0, 0, 0); PG8_SCHED; PG8_LDA(At, 0, 0); PG8_STAGE(PG8_SA(1, 1), a1 + hstep, voffA);
            PG8_WAIT_L(8); PG8_BAR; PG8_WAIT_L(0); PG8_MMA(0, 0, At, B0); PG8_BAR; PG8_SCHED;
            PG8_LDB(B1, 0, 1); PG8_STAGE(PG8_SB(0, 0), b2, voffB);
            PG8_BAR; PG8_WAIT_L(0); PG8_MMA(0, 1, At, B1); PG8_BAR;
            PG8_LDA(At, 0, 1); PG8_STAGE(PG8_SA(0, 0), a2, voffA);
            PG8_BAR; PG8_WAIT_L(0); PG8_MMA(1, 0, At, B0); PG8_BAR; PG8_SCHED;
            PG8_STAGE(PG8_SB(0, 1), b2 + hstep, voffB);
            PG8_WAIT_V(6); PG8_BAR; PG8_MMA(1, 1, At, B1); PG8_BAR;
            PG8_LDB(B0, 1, 0); PG8_SCHED; PG8_LDA(At, 1, 0); PG8_STAGE(PG8_SA(0, 1), a2 + hstep, voffA);
            PG8_WAIT_L(8); PG8_BAR; PG8_WAIT_L(0); PG8_MMA(0, 0, At, B0); PG8_BAR; PG8_SCHED;
            PG8_LDB(B1, 1, 1); PG8_STAGE(PG8_SB(1, 0), b3, voffB);
            PG8_BAR; PG8_WAIT_L(0); PG8_MMA(0, 1, At, B1); PG8_BAR;
            PG8_LDA(At, 1, 1); PG8_STAGE(PG8_SA(1, 0), a3, voffA);
            PG8_BAR; PG8_WAIT_L(0); PG8_MMA(1, 0, At, B0); PG8_BAR; PG8_SCHED;
            PG8_STAGE(PG8_SB(1, 1), b3 + hstep, voffB);
            PG8_WAIT_V(6); PG8_BAR; PG8_MMA(1, 1, At, B1); PG8_BAR;
            }
        }
        if constexpr (ALIGN_EPI) { if (wr == 0) PG8_BAR; }
        if constexpr (!Epi::AFTER_DRAIN) { E(acc, cur, wr, wc, fr, fq); S.done(cur); }
        if (!has_next) break;
#pragma unroll
        for (int a = 0; a < 2; ++a)
#pragma unroll
            for (int b = 0; b < 2; ++b)
#pragma unroll
                for (int m = 0; m < 4; ++m)
#pragma unroll
                    for (int n = 0; n < 2; ++n) acc[a][b][m][n] = (f32x4){0.f, 0.f, 0.f, 0.f};
        cur = nxt; cA = nA; cB = nB; ++ui;
        if constexpr (GATH) { ogC[0][0] = ogN[0][0]; ogC[0][1] = ogN[0][1]; ogC[1][0] = ogN[1][0]; ogC[1][1] = ogN[1][1]; }
        if constexpr (ALIGN_EPI) { if (wr == 1) PG8_BAR; }
    }
    PG8_WAIT_V(0);
    if constexpr (!ALIGN_EPI) { if (wr == 0) PG8_BAR; }
    PG8_BAR;
    if constexpr (Epi::AFTER_DRAIN) { E.fused(acc, cur, wr, wc, fr, fq, lds, wid, lane); S.done(cur); }
#undef PG8_SA
#undef PG8_SB
#undef PG8_STAGE
#undef PG8_LDA
#undef PG8_STAGE_G
#undef PG8_STAGE_A
#undef PG8_OG
#undef PG8_LDB
#undef PG8_MMA
#undef PG8_WAIT_V
#undef PG8_WAIT_L
#undef PG8_BAR
#undef PG8_SCHED
}

__device__ __forceinline__ float gelu_tanh_f(float x) { const float t = x + 0.044715f * x * x * x; return x * __builtin_amdgcn_rcpf(1.0f + __builtin_amdgcn_exp2f(-2.302208198f * t)); }
__device__ __forceinline__ float silu_f(float x) { return x * __builtin_amdgcn_rcpf(1.0f + __builtin_amdgcn_exp2f(-1.4426950408889634f * x)); }
__device__ __forceinline__ float sigm_f(float x) { return __builtin_amdgcn_rcpf(1.0f + __builtin_amdgcn_exp2f(-1.4426950408889634f * x)); }
template <int ACT  > struct EpiBf16X {
    static constexpr bool PERM = true, AFTER_DRAIN = false;
    bf16_t* O; int ldc; const float* bias; int split_cols; size_t split_stride; float scale0;
    __device__ __forceinline__ void operator()(const f32x4 (&acc)[2][2][4][2], const Unit& u, int wr, int wc, int fr, int fq) const {
        const int row0 = u.pm * BM + wr * 64 + fr; int colt = u.pn * BM; bf16_t* base = O;
        float sc = 1.f; if (split_cols) { const int t = colt / split_cols; base += (size_t)t * split_stride; colt -= t * split_cols; if (t == 0) sc = scale0; }
        const int col0 = colt + wc * 32 + 8 * fq, bcol0 = u.pn * BM + wc * 32 + 8 * fq;
        f32x4 bv[2][2];
#pragma unroll
        for (int bj = 0; bj < 2; ++bj)
#pragma unroll
            for (int n = 0; n < 2; ++n) bv[bj][n] = bias ? *(const f32x4*)(bias + bcol0 + bj * HALF + 4 * n) : (f32x4){0.f, 0.f, 0.f, 0.f};
#pragma unroll
        for (int ai = 0; ai < 2; ++ai)
#pragma unroll
            for (int m = 0; m < 4; ++m) { bf16_t* rowp = base + (size_t)(row0 + ai * HALF + m * 16) * ldc + col0;
#pragma unroll
                for (int bj = 0; bj < 2; ++bj) { f32x4 v0 = acc[ai][bj][m][0] + bv[bj][0], v1 = acc[ai][bj][m][1] + bv[bj][1];
                    if (ACT == 2) {
#pragma unroll
                        for (int i = 0; i < 4; ++i) { v0[i] = gelu_tanh_f(v0[i]); v1[i] = gelu_tanh_f(v1[i]); } }
                    v0 = v0 * sc; v1 = v1 * sc; u32x4 w; w.x = cvt_pk_bf16(v0[0], v0[1]); w.y = cvt_pk_bf16(v0[2], v0[3]); w.z = cvt_pk_bf16(v1[0], v1[1]); w.w = cvt_pk_bf16(v1[2], v1[3]);
                    *(u32x4*)(rowp + bj * HALF) = w; } }
    }
};
struct EpiResid {
    static constexpr bool PERM = true, AFTER_DRAIN = false;
    bf16_t* H; float alpha;
    __device__ __forceinline__ void operator()(const f32x4 (&acc)[2][2][4][2], const Unit& u, int wr, int wc, int fr, int fq) const {
        const int row0 = u.pm * BM + wr * 64 + fr, col0 = u.pn * BM + wc * 32 + 8 * fq;
#pragma unroll
        for (int ai = 0; ai < 2; ++ai) {
            u32x4 hres[4][2];
#pragma unroll
            for (int m = 0; m < 4; ++m)
#pragma unroll
                for (int bj = 0; bj < 2; ++bj) hres[m][bj] = *(const u32x4*)(H + (size_t)(row0 + ai * HALF + m * 16) * 1024 + col0 + bj * HALF);
#pragma unroll
            for (int m = 0; m < 4; ++m) { bf16_t* rowp = H + (size_t)(row0 + ai * HALF + m * 16) * 1024 + col0;
#pragma unroll
                for (int bj = 0; bj < 2; ++bj) { const u32x4 h = hres[m][bj]; const f32x4 a0 = acc[ai][bj][m][0], a1 = acc[ai][bj][m][1]; u32x4 w;
                    w.x = cvt_pk_bf16(alpha * __uint_as_float(h.x << 16) + a0[0], alpha * __uint_as_float(h.x & 0xffff0000u) + a0[1]);
                    w.y = cvt_pk_bf16(alpha * __uint_as_float(h.y << 16) + a0[2], alpha * __uint_as_float(h.y & 0xffff0000u) + a0[3]);
                    w.z = cvt_pk_bf16(alpha * __uint_as_float(h.z << 16) + a1[0], alpha * __uint_as_float(h.z & 0xffff0000u) + a1[1]);
                    w.w = cvt_pk_bf16(alpha * __uint_as_float(h.w << 16) + a1[2], alpha * __uint_as_float(h.w & 0xffff0000u) + a1[3]);
                    *(u32x4*)(rowp + bj * HALF) = w; } }
        }
    }
};
struct EpiSwiglu {
    static constexpr bool PERM = true, AFTER_DRAIN = false;
    bf16_t* H1;
    __device__ __forceinline__ void operator()(const f32x4 (&acc)[2][2][4][2], const Unit& u, int wr, int wc, int fr, int fq) const {
        const int row0 = u.pm * BM + wr * 64 + fr, col0 = (u.pn & 3) * 128 + wc * 32 + 8 * fq;
#pragma unroll
        for (int ai = 0; ai < 2; ++ai)
#pragma unroll
            for (int m = 0; m < 4; ++m) { bf16_t* rowp = H1 + (size_t)(row0 + ai * HALF + m * 16) * 512 + col0;
                f32x4 h0, h1;
#pragma unroll
                for (int i = 0; i < 4; ++i) { h0[i] = silu_f(acc[ai][0][m][0][i]) * acc[ai][1][m][0][i]; h1[i] = silu_f(acc[ai][0][m][1][i]) * acc[ai][1][m][1][i]; }
                u32x4 w; w.x = cvt_pk_bf16(h0[0], h0[1]); w.y = cvt_pk_bf16(h0[2], h0[3]); w.z = cvt_pk_bf16(h1[0], h1[1]); w.w = cvt_pk_bf16(h1[2], h1[3]);
                *(u32x4*)rowp = w; }
    }
};
struct EpiDown {
    static constexpr bool PERM = true, AFTER_DRAIN = false;
    bf16_t* Yd; const float* rowg;
    __device__ __forceinline__ void operator()(const f32x4 (&acc)[2][2][4][2], const Unit& u, int wr, int wc, int fr, int fq) const {
        const int row0 = u.pm * BM + wr * 64 + fr, col0 = (u.pn & 3) * BM + wc * 32 + 8 * fq;
        float scv[2][4];
#pragma unroll
        for (int ai = 0; ai < 2; ++ai)
#pragma unroll
            for (int m = 0; m < 4; ++m) scv[ai][m] = rowg[u.rt * BM + wr * 64 + fr + ai * HALF + m * 16];
#pragma unroll
        for (int ai = 0; ai < 2; ++ai)
#pragma unroll
            for (int m = 0; m < 4; ++m) { const int row = row0 + ai * HALF + m * 16; const float sc = scv[ai][m]; bf16_t* rowp = Yd + (size_t)row * 1024 + col0;
#pragma unroll
                for (int bj = 0; bj < 2; ++bj) { const f32x4 v0 = acc[ai][bj][m][0] * sc, v1 = acc[ai][bj][m][1] * sc;
                    u32x4 w; w.x = cvt_pk_bf16(v0[0], v0[1]); w.y = cvt_pk_bf16(v0[2], v0[3]); w.z = cvt_pk_bf16(v1[0], v1[1]); w.w = cvt_pk_bf16(v1[2], v1[3]);
                    *(u32x4*)(rowp + bj * HALF) = w; } }
    }
};
struct EpiRw1 {
    static constexpr bool PERM = true, AFTER_DRAIN = false;
    bf16_t* RKV; bf16_t* L1; int Trows;
    __device__ __forceinline__ void operator()(const f32x4 (&acc)[2][2][4][2], const Unit& u, int wr, int wc, int fr, int fq) const {
        const int t0 = (u.pm & 63) * BM + wr * 64 + fr;
        if (u.pn < 12) { const int cc = u.pn >> 2, col0 = (u.pn & 3) * BM + wc * 32 + 8 * fq;
#pragma unroll
            for (int ai = 0; ai < 2; ++ai)
#pragma unroll
                for (int m = 0; m < 4; ++m) { bf16_t* rowp = RKV + (size_t)cc * Trows * 1024 + (size_t)(t0 + ai * HALF + m * 16) * 1024 + col0;
#pragma unroll
                    for (int bj = 0; bj < 2; ++bj) { const f32x4 v0 = acc[ai][bj][m][0], v1 = acc[ai][bj][m][1];
                        u32x4 w; w.x = cvt_pk_bf16(v0[0], v0[1]); w.y = cvt_pk_bf16(v0[2], v0[3]); w.z = cvt_pk_bf16(v1[0], v1[1]); w.w = cvt_pk_bf16(v1[2], v1[3]);
                        *(u32x4*)(rowp + bj * HALF) = w; } }
        } else { const int j = u.pn - 12, col0 = wc * 32 + 8 * fq;
#pragma unroll
            for (int ai = 0; ai < 2; ++ai)
#pragma unroll
                for (int m = 0; m < 4; ++m) { bf16_t* rowp = L1 + (size_t)j * Trows * 128 + (size_t)(t0 + ai * HALF + m * 16) * 128 + col0;
                    f32x4 v0 = acc[ai][0][m][0], v1 = acc[ai][0][m][1];
#pragma unroll
                    for (int i = 0; i < 4; ++i) { if (j == 0) { v0[i] = 2.f * sigm_f(2.f * v0[i]) - 1.f; v1[i] = 2.f * sigm_f(2.f * v1[i]) - 1.f; } else if (j == 2) { v0[i] = sigm_f(v0[i]); v1[i] = sigm_f(v1[i]); } }
                    u32x4 w; w.x = cvt_pk_bf16(v0[0], v0[1]); w.y = cvt_pk_bf16(v0[2], v0[3]); w.z = cvt_pk_bf16(v1[0], v1[1]); w.w = cvt_pk_bf16(v1[2], v1[3]);
                    *(u32x4*)rowp = w; }
        }
    }
};
struct EpiRw2 {
    static constexpr bool PERM = true, AFTER_DRAIN = false;
    float* Wdec; bf16_t* A; bf16_t* G; const float* w0; const float* a0;
    __device__ __forceinline__ void operator()(const f32x4 (&acc)[2][2][4][2], const Unit& u, int wr, int wc, int fr, int fq) const {
        const int j = u.pn >> 2, t0 = (u.pm & 63) * BM + wr * 64 + fr, col0 = (u.pn & 3) * BM + wc * 32 + 8 * fq;
#pragma unroll
        for (int ai = 0; ai < 2; ++ai)
#pragma unroll
            for (int m = 0; m < 4; ++m) { const size_t ro = (size_t)(t0 + ai * HALF + m * 16) * 1024 + col0;
#pragma unroll
                for (int bj = 0; bj < 2; ++bj) { f32x4 v0 = acc[ai][bj][m][0], v1 = acc[ai][bj][m][1]; const size_t o = ro + bj * HALF;
                    if (j == 0) { const f32x4 b0 = __builtin_bit_cast(f32x4, *(const u32x4*)(w0 + col0 + bj * HALF)), b1 = __builtin_bit_cast(f32x4, *(const u32x4*)(w0 + col0 + bj * HALF + 4));
#pragma unroll
                        for (int i = 0; i < 4; ++i) { v0[i] = -0.8750387749f * sigm_f(v0[i] + b0[i]); v1[i] = -0.8750387749f * sigm_f(v1[i] + b1[i]); }
                        *(f32x4*)(Wdec + o) = v0; *(f32x4*)(Wdec + o + 4) = v1;
                    } else { if (j == 1) { const f32x4 b0 = __builtin_bit_cast(f32x4, *(const u32x4*)(a0 + col0 + bj * HALF)), b1 = __builtin_bit_cast(f32x4, *(const u32x4*)(a0 + col0 + bj * HALF + 4));
#pragma unroll
                            for (int i = 0; i < 4; ++i) { v0[i] = sigm_f(v0[i] + b0[i]); v1[i] = sigm_f(v1[i] + b1[i]); } }
                        u32x4 w; w.x = cvt_pk_bf16(v0[0], v0[1]); w.y = cvt_pk_bf16(v0[2], v0[3]); w.z = cvt_pk_bf16(v1[0], v1[1]); w.w = cvt_pk_bf16(v1[2], v1[3]);
                        if (j == 1) *(u32x4*)(A + o) = w; else *(u32x4*)(G + o) = w; } } }
    }
};
struct Rw1Order { int G, c;
    __device__ __forceinline__ bool next(int i, Unit& u) const { const int L = i * G + c; if (L >= 960) return false;
        if (L < 768) { const int cc = L >> 8, mt = (L & 255) >> 2, pn = L & 3; u.pm = cc * 64 + mt; u.pn = cc * 4 + pn; } else { const int L2 = L - 768, cc = 3 + (L2 >> 6), mt = L2 & 63; u.pm = cc * 64 + mt; u.pn = 9 + cc; }
        return true; }
    __device__ __forceinline__ void a_ready(const Unit&) const {}
    __device__ __forceinline__ void done(const Unit&) const {} };
struct Rw2Order { int G, c;
    __device__ __forceinline__ bool next(int i, Unit& u) const { const int L = i * G + c; if (L >= 768) return false; const int j = L >> 8, mt = (L & 255) >> 2, pn = L & 3; u.pm = j * 64 + mt; u.pn = j * 4 + pn; return true; }
    __device__ __forceinline__ void a_ready(const Unit&) const {}
    __device__ __forceinline__ void done(const Unit&) const {} };
constexpr int MOE_TAB = 131072;
struct MoeOrder { const PG8_LAS int* tab; int G, c;
    __device__ __forceinline__ bool next(int i, Unit& u) const {
        const int nt = __builtin_amdgcn_readfirstlane(tab[768]);
        const int L = i * G + c; if (L >= nt * 4) return false; const int mt = L >> 2;
        const int e = __builtin_amdgcn_readfirstlane(tab[mt]), j = __builtin_amdgcn_readfirstlane(tab[256 + mt]);
        u.pm = mt; u.pn = e * 4 + (L & 3); u.rt = e * (ECAP / BM) + j; u.nv = __builtin_amdgcn_readfirstlane(tab[512 + mt]); return true; }
    __device__ __forceinline__ void a_ready(const Unit&) const {}
    __device__ __forceinline__ void done(const Unit&) const {} };
}

namespace attn_body {
using bf16=__hip_bfloat16;
using bf16x8=__attribute__((ext_vector_type(8)))short;
using s16x4=__attribute__((ext_vector_type(4)))short;
using f32x16=__attribute__((ext_vector_type(16)))float;
using u32x4=__attribute__((ext_vector_type(4)))unsigned;
using f32x4_t=__attribute__((ext_vector_type(4)))float;
constexpr int BATCH=4,NHEAD=16,SEQ=4096,D=64,DM=NHEAD*D;
constexpr int NW=8,QBLK=32,QB=QBLK*NW,KVBLK=64,NQB=SEQ/QB;
constexpr int ATTN_PITCH=DM, ATTN_UNIT_ROWS=QB;
__device__ __forceinline__ int crow(int r,int hi){return (r&3)+8*(r>>2)+4*hi;}
#define SBAR() __builtin_amdgcn_sched_barrier(0)
__device__ __forceinline__ void cmask(f32x16&p0,f32x16&p1,int jb,int qrel,int hi){
  const float NEG=-INFINITY; int kb=64*jb+4*hi;
  #pragma unroll
  for(int r=0;r<16;++r){int kv=kb+(r&3)+8*(r>>2); if(kv>qrel)p0[r]=NEG; if(kv+32>qrel)p1[r]=NEG;}
}

constexpr int NSLOT=3, SLOTB=8192;
constexpr int LDS_K=0, LDS_V=NSLOT*SLOTB, LDS_WS=2*NSLOT*SLOTB, LDS_OST=LDS_WS+NW*64*4, LDS_CB=LDS_OST+NW*4096, LDS_BYTES=LDS_CB+SEQ*8;
constexpr float C2=0.125f*1.4426950408889634f;
__device__ __forceinline__ void glds16(const void*gsrc,unsigned lds_dst){unsigned keep;
  asm volatile("s_mov_b32 %0, m0\n\ts_mov_b32 m0, %2\n\ts_nop 0\n\tglobal_load_lds_dwordx4 %1, off\n\ts_mov_b32 m0, %0":"=&s"(keep):"v"(gsrc),"s"(lds_dst):"memory");}
__device__ __forceinline__ void glds16s(unsigned voff,const void*sbase,unsigned lds_dst){unsigned keep;
  asm volatile("s_mov_b32 %0, m0\n\ts_mov_b32 m0, %2\n\ts_nop 2\n\tglobal_load_lds_dwordx4 %1, %3\n\ts_mov_b32 m0, %0":"=&s"(keep):"v"(voff),"s"(lds_dst),"s"(sbase):"memory");}
__device__ __forceinline__ float max3f(float a,float b,float c){float r;asm("v_max3_f32 %0, %1, %2, %3":"=v"(r):"v"(a),"v"(b),"v"(c));return r;}
__device__ __forceinline__ float max2f(float a,float b){float r;asm("v_max_f32_e32 %0, %1, %2":"=v"(r):"v"(a),"v"(b));return r;}
__device__ __forceinline__ float fadd_s(float a,float b){float r;asm("v_add_f32_e32 %0, %1, %2":"=v"(r):"v"(a),"v"(b));return r;}
__device__ __forceinline__ float fsub_s(float a,float b){float r;asm("v_sub_f32_e32 %0, %1, %2":"=v"(r):"v"(a),"v"(b));return r;}
typedef float f32x2_t __attribute__((ext_vector_type(2))); typedef __bf16 bf16x2_t __attribute__((ext_vector_type(2)));
__device__ __forceinline__ unsigned cvtpk_s(float lo,float hi){f32x2_t v={lo,hi};bf16x2_t b=__builtin_convertvector(v,bf16x2_t);return __builtin_bit_cast(unsigned,b);}
#define WAIT_BAR(N) asm volatile("s_waitcnt vmcnt(" #N ") lgkmcnt(0)\n\ts_barrier":::"memory")
typedef unsigned u32x2_t __attribute__((ext_vector_type(2)));
__device__ __forceinline__ unsigned bfr_(float x){unsigned u=__float_as_uint(x);return (u+0x7fffu+((u>>16)&1u))>>16;}
__device__ __forceinline__ void split3(float v,unsigned&h1,unsigned&h2,unsigned&h3){h1=bfr_(v);const float r1=v-__uint_as_float(h1<<16);h2=bfr_(r1);const float r2=r1-__uint_as_float(h2<<16);h3=bfr_(r2);}

__device__ __forceinline__ void qkt(f32x16&p0,f32x16&p1,const char*Kslot,const bf16x8*qr,const f32x16&negm,int r32,int hi){
  const char*kb=Kslot+hi*1024+r32*16;
  #pragma unroll
  for(int d0=0;d0<4;++d0){
    const bf16x8 b0=*reinterpret_cast<const bf16x8*>(kb+d0*2048);
    const bf16x8 b1=*reinterpret_cast<const bf16x8*>(kb+d0*2048+512);
    if(d0==0){p0=__builtin_amdgcn_mfma_f32_32x32x16_bf16(b0,qr[0],negm,0,0,0);p1=__builtin_amdgcn_mfma_f32_32x32x16_bf16(b1,qr[0],negm,0,0,0);}
    else{p0=__builtin_amdgcn_mfma_f32_32x32x16_bf16(b0,qr[d0],p0,0,0,0);p1=__builtin_amdgcn_mfma_f32_32x32x16_bf16(b1,qr[d0],p1,0,0,0);}}
}
typedef __attribute__((address_space(3))) const char* lds_cptr;
typedef short v4i16_t __attribute__((ext_vector_type(4)));
__device__ __forceinline__ void kload8(bf16x8*kf,lds_cptr kp){
  kf[0]=*(const __attribute__((address_space(3))) bf16x8*)(kp);      kf[1]=*(const __attribute__((address_space(3))) bf16x8*)(kp+512);
  kf[2]=*(const __attribute__((address_space(3))) bf16x8*)(kp+2048); kf[3]=*(const __attribute__((address_space(3))) bf16x8*)(kp+2560);
  kf[4]=*(const __attribute__((address_space(3))) bf16x8*)(kp+4096); kf[5]=*(const __attribute__((address_space(3))) bf16x8*)(kp+4608);
  kf[6]=*(const __attribute__((address_space(3))) bf16x8*)(kp+6144); kf[7]=*(const __attribute__((address_space(3))) bf16x8*)(kp+6656);
}
__device__ __forceinline__ void kload2(bf16x8*kf,lds_cptr kp,int j){ kf[2*j]=*(const __attribute__((address_space(3))) bf16x8*)(kp+j*2048); kf[2*j+1]=*(const __attribute__((address_space(3))) bf16x8*)(kp+j*2048+512); }
__device__ __forceinline__ s16x4 vtr(lds_cptr p){ return __builtin_bit_cast(s16x4,__builtin_amdgcn_ds_read_tr16_b64_v4i16((__attribute__((address_space(3))) v4i16_t*)p)); }
__device__ __forceinline__ float rowmax(const f32x16&p0,const f32x16&p1){
  float a=max3f(p0[0],p0[1],p1[0]),b=max3f(p0[2],p0[3],p1[1]);a=max3f(a,p1[2],p1[3]);
  #pragma unroll
  for(int r=4;r<16;r+=4){a=max3f(a,p0[r],p0[r+1]);b=max3f(b,p0[r+2],p0[r+3]);a=max3f(a,p1[r],p1[r+1]);b=max3f(b,p1[r+2],p1[r+3]);}
  const float m=max2f(a,b);
  auto rr=__builtin_amdgcn_permlane32_swap(__float_as_uint(m),__float_as_uint(m),false,false);
  return max2f(__uint_as_float(rr[0]),__uint_as_float(rr[1]));
}
__device__ __forceinline__ void pv(f32x16*o,int vb,bf16x8 pa0,bf16x8 pa1,bf16x8 pa2,bf16x8 pa3){
  #pragma unroll
  for(int d0=0;d0<2;++d0){s16x4 lo[4],hi[4];
    #pragma unroll
    for(int ks=0;ks<4;++ks){
      asm volatile("ds_read_b64_tr_b16 %0,%1 offset:%c2":"=&v"(lo[ks]):"v"(vb),"i"(d0*4096+ks*1024):"memory");
      asm volatile("ds_read_b64_tr_b16 %0,%1 offset:%c2":"=&v"(hi[ks]):"v"(vb),"i"(d0*4096+ks*1024+512):"memory");}
    asm volatile("s_waitcnt lgkmcnt(0)":::"memory");SBAR();
    #define PK(k) (bf16x8){lo[k][0],lo[k][1],lo[k][2],lo[k][3],hi[k][0],hi[k][1],hi[k][2],hi[k][3]}
    o[d0]=__builtin_amdgcn_mfma_f32_32x32x16_bf16(pa0,PK(0),o[d0],0,0,0);
    o[d0]=__builtin_amdgcn_mfma_f32_32x32x16_bf16(pa1,PK(1),o[d0],0,0,0);
    o[d0]=__builtin_amdgcn_mfma_f32_32x32x16_bf16(pa2,PK(2),o[d0],0,0,0);
    o[d0]=__builtin_amdgcn_mfma_f32_32x32x16_bf16(pa3,PK(3),o[d0],0,0,0);
    #undef PK
  }
}

#ifndef ATTN_STORE16
#define ATTN_STORE16(p,v) (*(u32x4*)(p)=(v))
#endif
template<int THRL> __device__ __forceinline__ void attn_unit(int b,int h,int qb,const bf16*Q,const bf16*__restrict__ K,const bf16*__restrict__ V,bf16*O,const float*CBg,const bf16*OGg,bool loadcb,float bnd2,char*shm){
  const int tid=threadIdx.x,lane=tid&63,r32=lane&31,hi=lane>>5; const int wid=__builtin_amdgcn_readfirstlane(tid>>6);
  const long rowbase=(long)b*SEQ; const int q0=qb*QB;
  const bf16*Qw=Q+(rowbase+q0+wid*QBLK)*DM+h*D;
  const bf16*Kh=K+rowbase*DM+h*D,*Vh=V+rowbase*DM+h*D;
  const unsigned lds0=(unsigned)(uintptr_t)shm;
  float*wsf=(float*)(shm+LDS_WS)+wid*64;
  int ln2_=lane; asm volatile("":"+v"(ln2_));
  const unsigned koff=(unsigned)(ln2_*DM+wid*8)*2u;
  const unsigned voff=(unsigned)((16*(wid&3)+(ln2_>>2))*DM+(wid>>2)*32+(ln2_&3)*8)*2u;
  const unsigned kdst=lds0+LDS_K+wid*1024, vdst=lds0+LDS_V+wid*1024;
  #define DMA_K(t,slot) glds16s(koff,Kh+(long)(t)*KVBLK*DM,(unsigned)__builtin_amdgcn_readfirstlane(kdst+(slot)))
  #define DMA_V(t,slot) glds16s(voff,Vh+(long)(t)*KVBLK*DM,(unsigned)__builtin_amdgcn_readfirstlane(vdst+(slot)))
  const int vb0=(int)(lds0+LDS_V)+((lane>>4)&1)*32+(lane&3)*8+(4*hi+((lane&15)>>2))*64;
  const char*Kbase=shm+LDS_K; bf16x8 kf[8];
  const lds_cptr shm3=(lds_cptr)shm; const lds_cptr kp0=shm3+LDS_K+hi*1024+r32*16; const lds_cptr vp0=shm3+LDS_V+((lane>>4)&1)*32+(lane&3)*8+(4*hi+((lane&15)>>2))*64;
  int NT=(q0+QB)/KVBLK;
  typedef __attribute__((address_space(3))) const u32x2_t* lds_u2p; lds_u2p bt=(lds_u2p)(shm3+LDS_CB)+r32;
  if(loadcb){ const float*src=CBg+(long)(b*NHEAD+h)*SEQ; u32x2_t*dst=(u32x2_t*)(shm+LDS_CB);
    #pragma unroll
    for(int i=0;i<8;++i){ const int kv=tid+512*i; unsigned h1,h2,h3; split3(src[kv],h1,h2,h3); dst[kv]=(u32x2_t){h1|(h2<<16),h3|0x3F800000u}; }
    asm volatile("s_waitcnt vmcnt(0) lgkmcnt(0)\n\ts_barrier":::"memory"); }
  { const lds_u2p b0_=(lds_u2p)(shm3+LDS_CB);
    #define BTV(kv) ({ const u32x2_t e_=b0_[kv]; __uint_as_float(e_.x<<16)+__uint_as_float(e_.x&0xffff0000u)+__uint_as_float(e_.y<<16); })
    const float bq0_=BTV(q0); int cand_=NT-4;
    while(cand_>=2){ const float d_=bq0_-BTV(64*cand_-1); if(__builtin_amdgcn_readfirstlane(d_>=bnd2?1:0))break; cand_-=2; }
    #undef BTV
    const int T0_=cand_>=2?cand_:0; Kh+=(long)T0_*KVBLK*DM; Vh+=(long)T0_*KVBLK*DM; bt+=64*T0_; NT-=T0_; }
  u32x4 Bq; const unsigned hm_=hi?0u:0xffffffffu;
  #define SETBQ(mh) do{ unsigned h1_,h2_,h3_; split3(-(mh),h1_,h2_,h3_); Bq.x=0x3F803F80u&hm_; Bq.y=(0x3F80u|(h1_<<16))&hm_; Bq.z=(h2_|(h3_<<16))&hm_; Bq.w=0u; }while(0)
  #define BIASM(P0,P1,t) do{ const u32x2_t a0_=bt[64*(t)],a1_=bt[64*(t)+32]; \
      P0=__builtin_amdgcn_mfma_f32_32x32x16_bf16(__builtin_bit_cast(bf16x8,(u32x4){a0_.x,a0_.y,0x3F803F80u,0u}),__builtin_bit_cast(bf16x8,Bq),P0,0,0,0); \
      P1=__builtin_amdgcn_mfma_f32_32x32x16_bf16(__builtin_bit_cast(bf16x8,(u32x4){a1_.x,a1_.y,0x3F803F80u,0u}),__builtin_bit_cast(bf16x8,Bq),P1,0,0,0); }while(0)
  SETBQ(0.f);
  DMA_K(0,0);DMA_V(0,0);DMA_K(1,SLOTB);
  bf16x8 qr[4];
  #pragma unroll
  for(int d0=0;d0<4;++d0)qr[d0]=*reinterpret_cast<const bf16x8*>(&Qw[(long)r32*DM+d0*16+hi*8]);
  float mhat=0.f,l_reg=0.f;f32x16 o[2];o[0]=f32x16{};o[1]=f32x16{};const f32x16 zero16=f32x16{};
  const int qrel=wid*QBLK+r32;
  #define CMASK(P0,P1,t) do{int jb_=(t)-(NT-4); if(jb_>=0)cmask(P0,P1,jb_,qrel,hi);}while(0)
  bool resc=false;
  #define START(P0,P1) do{ const float rm=rowmax(P0,P1); resc=false; \
    { const float dl=rm; mhat=fadd_s(mhat,dl); \
      _Pragma("unroll") for(int r=0;r<16;++r){P0[r]=fsub_s(P0[r],dl);P1[r]=fsub_s(P1[r],dl);} \
      SETBQ(mhat); } \
    _Pragma("unroll") for(int r=0;r<16;++r)P0[r]=__builtin_amdgcn_exp2f(P0[r]); }while(0)
  #define RESC() do{ if(resc){ asm volatile("s_waitcnt lgkmcnt(0)":::"memory"); \
      _Pragma("unroll") for(int d_=0;d_<2;++d_) _Pragma("unroll") for(int r=0;r<16;++r)o[d_][r]*=wsf[crow(r,hi)]; } }while(0)
  f32x16 pA0,pA1,pB0,pB1;
  int sl_prev=0,sl_cur=0,sl_next=SLOTB;
  #define ROT() do{sl_prev=sl_cur;sl_cur=sl_next;sl_next=(sl_next==(NSLOT-1)*SLOTB)?0:sl_next+SLOTB;}while(0)
  DMA_K(2,2*SLOTB);
  WAIT_BAR(3);
  qkt(pA0,pA1,Kbase,qr,zero16,r32,hi);BIASM(pA0,pA1,0);asm volatile("s_nop 15\n\ts_nop 7":"+v"(pA0),"+v"(pA1));CMASK(pA0,pA1,0);
  START(pA0,pA1);
  _Pragma("unroll") for(int r=0;r<16;++r)pA1[r]=__builtin_amdgcn_exp2f(pA1[r]);
  WAIT_BAR(0);
  DMA_K(3,0);DMA_V(1,SLOTB);
  ROT();
  kload8(kf,kp0+sl_cur);
  WAIT_BAR(2);
  s16x4 vlo[8],vhi[8]; u32x4 pw0,pw1,pw2,pw3;
  #define PKW(P,B) cvtpk_s(P[B],P[B+1])
  #define PAF(k) __builtin_bit_cast(bf16x8,pw##k)
  #define VFR(i) (bf16x8){vlo[i][0],vlo[i][1],vlo[i][2],vlo[i][3],vhi[i][0],vhi[i][1],vhi[i][2],vhi[i][3]}
  #define PIN(x) asm volatile("":"+v"(x))
  #define MX3(a,b,c) __builtin_fmaxf(__builtin_fmaxf((a),(b)),(c))
  #define GAPA(MF,A0,A1,A2,A3,W0,W1,PW) do{ MF; sacc+=A0; sacc+=A1; sacc+=A2; sacc+=A3; PIN(sacc); W0; W1; PIN(PW); SBAR(); }while(0)
  #define EX(v) __builtin_amdgcn_exp2f(v)
  #define GAPB(MF,X,B) do{ MF; X[B]=EX(X[B]); X[B+1]=EX(X[B+1]); X[B+2]=EX(X[B+2]); X[B+3]=EX(X[B+3]); PIN(X); SBAR(); }while(0)
  #define VRD(i) do{ vlo[i]=vtr(vp_+(((i)>>2)*4096+((i)&3)*1024)); vhi[i]=vtr(vp_+(((i)>>2)*4096+((i)&3)*1024+512)); }while(0)
  #define KRD(G,j) do{ if(G){ kload2(kf,kp0+sl_next,j); SBAR(); } }while(0)
  #define STEP(C0,C1,P0,P1,t,GK,GV,GL) do{ SBAR(); \
    const lds_cptr vp_=vp0+sl_prev; \
    VRD(0); SBAR(); float sacc=(P0[0]+P0[1]); \
    GAPA(C0=__builtin_amdgcn_mfma_f32_32x32x16_bf16(kf[0],qr[0],zero16,0,0,0), P0[2],P0[3],P0[4],P0[5],     pw0[0]=PKW(P0,0), pw0[1]=PKW(P0,2), pw0); \
    VRD(4); SBAR(); GAPA(C1=__builtin_amdgcn_mfma_f32_32x32x16_bf16(kf[1],qr[0],zero16,0,0,0), P0[6],P0[7],P0[8],P0[9],     pw0[2]=PKW(P0,4), pw0[3]=PKW(P0,6), pw0); \
    VRD(1); SBAR(); GAPA(C0=__builtin_amdgcn_mfma_f32_32x32x16_bf16(kf[2],qr[1],C0,0,0,0),   P0[10],P0[11],P0[12],P0[13], pw1[0]=PKW(P0,8), pw1[1]=PKW(P0,10), pw1); \
    VRD(5); SBAR(); GAPA(C1=__builtin_amdgcn_mfma_f32_32x32x16_bf16(kf[3],qr[1],C1,0,0,0),   P0[14],P0[15],P1[0],P1[1],   pw1[2]=PKW(P0,12),pw1[3]=PKW(P0,14), pw1); \
    VRD(2); SBAR(); GAPA(C0=__builtin_amdgcn_mfma_f32_32x32x16_bf16(kf[4],qr[2],C0,0,0,0),   P1[2],P1[3],P1[4],P1[5],     pw2[0]=PKW(P1,0), pw2[1]=PKW(P1,2), pw2); \
    VRD(6); SBAR(); GAPA(C1=__builtin_amdgcn_mfma_f32_32x32x16_bf16(kf[5],qr[2],C1,0,0,0),   P1[6],P1[7],P1[8],P1[9],     pw2[2]=PKW(P1,4), pw2[3]=PKW(P1,6), pw2); \
    VRD(3); SBAR(); GAPA(C0=__builtin_amdgcn_mfma_f32_32x32x16_bf16(kf[6],qr[3],C0,0,0,0),   P1[10],P1[11],P1[12],P1[13], pw3[0]=PKW(P1,8), pw3[1]=PKW(P1,10), pw3); \
    VRD(7); SBAR(); GAPA(C1=__builtin_amdgcn_mfma_f32_32x32x16_bf16(kf[7],qr[3],C1,0,0,0),   P1[14],P1[15],0.f,0.f,       pw3[2]=PKW(P1,12),pw3[3]=PKW(P1,14), pw3); \
    l_reg+=sacc; \
    if(GK){DMA_K((t)+3,sl_cur);} if(GV){DMA_V((t)+1,sl_next);} \
    BIASM(C0,C1,t); CMASK(C0,C1,t); \
    { float a=MX3(C0[0],C0[1],C1[0]),b=MX3(C0[2],C0[3],C1[1]); a=MX3(a,C1[2],C1[3]); \
      _Pragma("unroll") for(int r=4;r<16;r+=4){a=MX3(a,C0[r],C0[r+1]);b=MX3(b,C0[r+2],C0[r+3]);a=MX3(a,C1[r],C1[r+1]);b=MX3(b,C1[r+2],C1[r+3]);} \
      float rm=__builtin_fmaxf(a,b); { auto rr=__builtin_amdgcn_permlane32_swap(__float_as_uint(rm),__float_as_uint(rm),false,false); rm=__builtin_fmaxf(__uint_as_float(rr[0]),__uint_as_float(rr[1])); } \
      resc=false; \
      if(__builtin_expect(__any(rm>(float)THRL),0)){ const float dl=__builtin_fmaxf(rm,0.f); mhat+=dl; \
        _Pragma("unroll") for(int r=0;r<16;++r){C0[r]-=dl;C1[r]-=dl;} \
        SETBQ(mhat); \
        const float f=__builtin_amdgcn_exp2f(-dl); l_reg*=f; if(hi==0)wsf[r32]=f; resc=true; } } \
    SBAR(); \
    GAPB(o[0]=__builtin_amdgcn_mfma_f32_32x32x16_bf16(PAF(0),VFR(0),o[0],0,0,0), C0,0); \
    GAPB(o[1]=__builtin_amdgcn_mfma_f32_32x32x16_bf16(PAF(0),VFR(4),o[1],0,0,0), C0,4); \
    KRD(GL,0); GAPB(o[0]=__builtin_amdgcn_mfma_f32_32x32x16_bf16(PAF(1),VFR(1),o[0],0,0,0), C0,8); \
    KRD(GL,1); GAPB(o[1]=__builtin_amdgcn_mfma_f32_32x32x16_bf16(PAF(1),VFR(5),o[1],0,0,0), C0,12); \
    KRD(GL,2); GAPB(o[0]=__builtin_amdgcn_mfma_f32_32x32x16_bf16(PAF(2),VFR(2),o[0],0,0,0), C1,0); \
    KRD(GL,3); GAPB(o[1]=__builtin_amdgcn_mfma_f32_32x32x16_bf16(PAF(2),VFR(6),o[1],0,0,0), C1,4); \
    GAPB(o[0]=__builtin_amdgcn_mfma_f32_32x32x16_bf16(PAF(3),VFR(3),o[0],0,0,0), C1,8); \
    GAPB(o[1]=__builtin_amdgcn_mfma_f32_32x32x16_bf16(PAF(3),VFR(7),o[1],0,0,0), C1,12); \
    }while(0)
  int t=1;
  #undef CMASK
  #define CMASK(P0,P1,t) do{}while(0)
  for(;t+5<NT;t+=2){
    STEP(pB0,pB1,pA0,pA1,t,true,true,true);     WAIT_BAR(2); RESC(); ROT();
    STEP(pA0,pA1,pB0,pB1,t+1,true,true,true);   WAIT_BAR(2); RESC(); ROT();
  }
  #undef CMASK
  #define CMASK(P0,P1,t) do{int jb_=(t)-(NT-4); if(jb_>=0)cmask(P0,P1,jb_,qrel,hi);}while(0)
  #define ENDW(tt) do{ if((tt)+3<NT){WAIT_BAR(2);} else if((tt)+2<NT){WAIT_BAR(1);} else {WAIT_BAR(0);} }while(0)
  for(;t+1<NT;t+=2){
    STEP(pB0,pB1,pA0,pA1,t,(t+3<NT),(t+1<NT),(t+1<NT));       ENDW(t);   RESC(); ROT();
    STEP(pA0,pA1,pB0,pB1,t+1,(t+4<NT),(t+2<NT),(t+2<NT));     ENDW(t+1); RESC(); ROT();
  }
  STEP(pB0,pB1,pA0,pA1,NT-1,false,false,false); RESC();
  { float sacc=pB0[0]+pB0[1]; _Pragma("unroll") for(int r=2;r<16;++r)sacc+=pB0[r]; _Pragma("unroll") for(int r=0;r<16;++r)sacc+=pB1[r]; l_reg+=sacc;
    pw0=(u32x4){PKW(pB0,0),PKW(pB0,2),PKW(pB0,4),PKW(pB0,6)};pw1=(u32x4){PKW(pB0,8),PKW(pB0,10),PKW(pB0,12),PKW(pB0,14)};pw2=(u32x4){PKW(pB1,0),PKW(pB1,2),PKW(pB1,4),PKW(pB1,6)};pw3=(u32x4){PKW(pB1,8),PKW(pB1,10),PKW(pB1,12),PKW(pB1,14)};
    SBAR(); pv(o,vb0+sl_cur,PAF(0),PAF(1),PAF(2),PAF(3)); }
  #undef PKW
  #undef PAF
  #undef VFR
  #undef PIN
  #undef MX3
  #undef GAPA
  #undef GAPB
  #undef EX
  #undef VRD
  #undef KRD
  #undef STEP
  #undef ENDW
  {auto rr=__builtin_amdgcn_permlane32_swap(__float_as_uint(l_reg),__float_as_uint(l_reg),false,false);l_reg=__uint_as_float(rr[0])+__uint_as_float(rr[1]);}
  if(hi==0)wsf[32+r32]=l_reg;asm volatile("s_waitcnt lgkmcnt(0)":::"memory");
  float rli[16];
  #pragma unroll
  for(int r=0;r<16;++r)rli[r]=__builtin_amdgcn_rcpf(wsf[32+crow(r,hi)]);
  bf16*Ow=O+(rowbase+q0+wid*QBLK)*DM+h*D;
  { bf16*stg=(bf16*)(shm+LDS_OST)+wid*2048;
    #pragma unroll
    for(int r=0;r<16;++r){const int orow=crow(r,hi);
      #pragma unroll
      for(int d0=0;d0<2;++d0)stg[orow*64+d0*32+r32]=__float2bfloat16(o[d0][r]*rli[r]);}
    asm volatile("s_waitcnt lgkmcnt(0)":::"memory");
    int ln_=lane; asm volatile("":"+v"(ln_));
    #pragma unroll
    for(int i=0;i<4;++i){const int row=i*8+(ln_>>3),ch=ln_&7; u32x4 v=*(const u32x4*)(stg+row*64+ch*8);
      if(OGg){ const u32x4 gt=*(const u32x4*)(OGg+(rowbase+q0+wid*QBLK+row)*DM+h*D+ch*8);
        _Pragma("unroll") for(int e=0;e<4;++e){ const float a0=__uint_as_float(v[e]<<16)*__builtin_amdgcn_rcpf(1.f+__builtin_amdgcn_exp2f(-1.4426950408889634f*__uint_as_float(gt[e]<<16)));
          const float a1=__uint_as_float(v[e]&0xffff0000u)*__builtin_amdgcn_rcpf(1.f+__builtin_amdgcn_exp2f(-1.4426950408889634f*__uint_as_float(gt[e]&0xffff0000u))); v[e]=cvtpk_s(a0,a1); } }
      ATTN_STORE16(Ow+(long)row*DM+ch*8,v);} }
  asm volatile("s_waitcnt lgkmcnt(0)\n\ts_barrier":::"memory");
  #undef BIASM
  #undef SETBQ
  #undef DMA_K
  #undef DMA_V
  #undef CMASK
  #undef START
  #undef RESC
  #undef ROT
}
constexpr int ATTN_LDS_BYTES=LDS_BYTES;
struct AttnTensors { const bf16* Q; const bf16* K; const bf16* V; bf16* O; const float* CB; const bf16* OG; };
struct AttnUnit { int bh; int qb; };
struct StaticOrder {
  int vcu,G;
  __device__ __forceinline__ explicit StaticOrder(int grid,int block):vcu((grid%8==0)?(block%8)*(grid/8)+block/8:block),G(grid){}
  __device__ __forceinline__ bool next(int i,AttnUnit&u)const{ const int vc=vcu+(i>>2)*G; if(vc>=256)return false; const int s=vc&3,k=i&3; u.bh=vc>>2; u.qb=(k==0)?s:(k==1)?7-s:(k==2)?8+s:15-s; return true; }
  __device__ __forceinline__ void a_ready(const AttnUnit&)const{}
  __device__ __forceinline__ void done(const AttnUnit&)const{}
};
template<class Sched,int THRL=60> __device__ __forceinline__ void attn_phase(char*lds,const AttnTensors&T,const Sched&S){
  AttnUnit u;
  int prev=-1; float bnd2=1e30f;
  for(int i=0;S.next(i,u);++i){ S.a_ready(u);
    if(u.bh!=prev){
      int tid=threadIdx.x; asm volatile("":"+v"(tid)); const int lane=tid&63,wid=tid>>6; const long rb=(long)(u.bh/NHEAD)*SEQ*DM+(u.bh%NHEAD)*D; float mq=0.f,mk=0.f;
      #pragma unroll 8
      for(int r=tid>>3;r<SEQ;r+=64){ const int cch=tid&7; const u32x4 a=*(const u32x4*)(T.Q+rb+(long)r*DM+cch*8), c=*(const u32x4*)(T.K+rb+(long)r*DM+cch*8); float sq=0.f,sk=0.f;
        #pragma unroll
        for(int e=0;e<4;++e){ const float a0=__uint_as_float(a[e]<<16),a1=__uint_as_float(a[e]&0xffff0000u),c0=__uint_as_float(c[e]<<16),c1=__uint_as_float(c[e]&0xffff0000u); sq+=a0*a0+a1*a1; sk+=c0*c0+c1*c1; }
        sq+=::dppf<0xB1>(sq); sk+=::dppf<0xB1>(sk); sq+=::dppf<0x4E>(sq); sk+=::dppf<0x4E>(sk); sq+=::dppf<0x141>(sq); sk+=::dppf<0x141>(sk);
        mq=fmaxf(mq,sq); mk=fmaxf(mk,sk); }
      #pragma unroll
      for(int o=1;o<64;o<<=1){ mq=fmaxf(mq,__shfl_xor(mq,o)); mk=fmaxf(mk,__shfl_xor(mk,o)); }
      float*red=(float*)(lds+LDS_WS);
      if(lane==0){ red[wid*2]=mq; red[wid*2+1]=mk; }
      asm volatile("s_waitcnt lgkmcnt(0)\n\ts_barrier":::"memory");
      float aq=0.f,ak=0.f;
      #pragma unroll
      for(int w=0;w<NW;++w){ aq=fmaxf(aq,red[w*2]); ak=fmaxf(ak,red[w*2+1]); }
      asm volatile("s_waitcnt lgkmcnt(0)\n\ts_barrier":::"memory");
      bnd2=__uint_as_float((unsigned)__builtin_amdgcn_readfirstlane((int)__float_as_uint(2.f*sqrtf(aq*ak)*1.01f+48.f))); }
    attn_unit<THRL>(u.bh/NHEAD,u.bh%NHEAD,u.qb,T.Q,T.K,T.V,T.O,T.CB,T.OG,u.bh!=prev,bnd2,lds); prev=u.bh; S.done(u); }
}

constexpr int SB_K=0, SB_V=2*SLOTB, SB_FLAG=4*SLOTB, SB_OST=SB_FLAG+256, SB_BYTES=SB_OST+NW*4096;
constexpr float SB_THR=48.0f;
__device__ __forceinline__ void sb_unit(int b,int h,int qb,const bf16*Q,const bf16*__restrict__ K,const bf16*__restrict__ V,bf16*O,char*shm){
  const int tid=threadIdx.x,lane=tid&63,r32=lane&31,hi=lane>>5; const int wid=__builtin_amdgcn_readfirstlane(tid>>6);
  const long rowbase=(long)b*SEQ; const int q0=qb*QB;
  const bf16*Qw=Q+(rowbase+q0+wid*QBLK)*DM+h*D;
  const bf16*Kh=K+rowbase*DM+h*D,*Vh=V+rowbase*DM+h*D;
  const unsigned lds0=(unsigned)(uintptr_t)shm;
  const unsigned koff=(unsigned)(lane*DM+wid*8)*2u;
  const unsigned voff=(unsigned)((16*(wid&3)+(lane>>2))*DM+(wid>>2)*32+(lane&3)*8)*2u;
  const unsigned kdst=lds0+SB_K+wid*1024, vdst=lds0+SB_V+wid*1024;
  #define SB_DMA_K(t,slot) glds16s(koff,Kh+(long)(t)*KVBLK*DM,(unsigned)__builtin_amdgcn_readfirstlane(kdst+(slot)))
  #define SB_DMA_V(t,slot) glds16s(voff,Vh+(long)(t)*KVBLK*DM,(unsigned)__builtin_amdgcn_readfirstlane(vdst+(slot)))
  const int vb0=(int)(lds0+SB_V)+((lane>>4)&1)*32+(lane&3)*8+(4*hi+((lane&15)>>2))*64;
  volatile unsigned*flag=(volatile unsigned*)(shm+SB_FLAG);
  int j=(q0+QB)/KVBLK-1;
  SB_DMA_K(j,0);SB_DMA_V(j,0);
  bf16x8 qr[4];
  #pragma unroll
  for(int d0=0;d0<4;++d0)qr[d0]=*reinterpret_cast<const bf16x8*>(&Qw[(long)r32*DM+d0*16+hi*8]);
  f32x16 o[2];o[0]=f32x16{};o[1]=f32x16{};
  const f32x16 zero16=f32x16{};
  float carry=0.f; bool mydone=false;
  const int qw0=q0+wid*QBLK, tq=qw0+r32;
  int slot=0;
  for(int it=0;j>=0;--j,++it){
    WAIT_BAR(0);
    if(it>0){ unsigned all=1u;
      #pragma unroll
      for(int w=0;w<NW;++w)all&=flag[((it-1)&1)*8+w];
      if(__builtin_amdgcn_readfirstlane(all))break; }
    if(j>0){SB_DMA_K(j-1,slot^SLOTB);SB_DMA_V(j-1,slot^SLOTB);}
    if(64*j<=qw0+30&&!mydone){
      f32x16 p0,p1;
      qkt(p0,p1,shm+SB_K+slot,qr,zero16,r32,hi);
      if(64*j+64>qw0){ const int kb=64*j+4*hi;
        #pragma unroll
        for(int r=0;r<16;++r){const int kv=kb+(r&3)+8*(r>>2); if(!(kv<tq))p0[r]=-INFINITY; if(!(kv+32<tq))p1[r]=-INFINITY;} }
      f32x16 s0,s1;
      #pragma unroll
      for(int r=0;r<16;++r){ s0[r]=__builtin_fmaxf(p0[r],0.f)+__builtin_amdgcn_logf(1.f+__builtin_amdgcn_exp2f(-__builtin_fabsf(p0[r])));
                             s1[r]=__builtin_fmaxf(p1[r],0.f)+__builtin_amdgcn_logf(1.f+__builtin_amdgcn_exp2f(-__builtin_fabsf(p1[r]))); }
      float w1[2][4],w0[2][4],gl[2][4],gh[2][4];
      #pragma unroll
      for(int g=0;g<4;++g){ w1[0][g]=s0[4*g+3]+s0[4*g+2]; w0[0][g]=w1[0][g]+s0[4*g+1]; const float gs0=w0[0][g]+s0[4*g];
                            w1[1][g]=s1[4*g+3]+s1[4*g+2]; w0[1][g]=w1[1][g]+s1[4*g+1]; const float gs1=w0[1][g]+s1[4*g];
        auto ra=__builtin_amdgcn_permlane32_swap(__float_as_uint(gs0),__float_as_uint(gs0),false,false); gl[0][g]=__uint_as_float(ra[0]); gh[0][g]=__uint_as_float(ra[1]);
        auto rb=__builtin_amdgcn_permlane32_swap(__float_as_uint(gs1),__float_as_uint(gs1),false,false); gl[1][g]=__uint_as_float(rb[0]); gh[1][g]=__uint_as_float(rb[1]); }
      float run=carry, base[2][4];
      #pragma unroll
      for(int blk=1;blk>=0;--blk)
        #pragma unroll
        for(int g=3;g>=0;--g){ const float eh=run; run+=gh[blk][g]; const float el=run; run+=gl[blk][g]; base[blk][g]=hi?eh:el; }
      carry=run;
      #pragma unroll
      for(int g=0;g<4;++g){
        p0[4*g+3]=__builtin_amdgcn_exp2f(p0[4*g+3]-s0[4*g+3]-base[0][g]);
        p0[4*g+2]=__builtin_amdgcn_exp2f(p0[4*g+2]-s0[4*g+2]-base[0][g]-s0[4*g+3]);
        p0[4*g+1]=__builtin_amdgcn_exp2f(p0[4*g+1]-s0[4*g+1]-base[0][g]-w1[0][g]);
        p0[4*g  ]=__builtin_amdgcn_exp2f(p0[4*g  ]-s0[4*g  ]-base[0][g]-w0[0][g]);
        p1[4*g+3]=__builtin_amdgcn_exp2f(p1[4*g+3]-s1[4*g+3]-base[1][g]);
        p1[4*g+2]=__builtin_amdgcn_exp2f(p1[4*g+2]-s1[4*g+2]-base[1][g]-s1[4*g+3]);
        p1[4*g+1]=__builtin_amdgcn_exp2f(p1[4*g+1]-s1[4*g+1]-base[1][g]-w1[1][g]);
        p1[4*g  ]=__builtin_amdgcn_exp2f(p1[4*g  ]-s1[4*g  ]-base[1][g]-w0[1][g]); }
      u32x4 pw0,pw1,pw2,pw3;
      pw0=(u32x4){cvtpk_s(p0[0],p0[1]),cvtpk_s(p0[2],p0[3]),cvtpk_s(p0[4],p0[5]),cvtpk_s(p0[6],p0[7])};
      pw1=(u32x4){cvtpk_s(p0[8],p0[9]),cvtpk_s(p0[10],p0[11]),cvtpk_s(p0[12],p0[13]),cvtpk_s(p0[14],p0[15])};
      pw2=(u32x4){cvtpk_s(p1[0],p1[1]),cvtpk_s(p1[2],p1[3]),cvtpk_s(p1[4],p1[5]),cvtpk_s(p1[6],p1[7])};
      pw3=(u32x4){cvtpk_s(p1[8],p1[9]),cvtpk_s(p1[10],p1[11]),cvtpk_s(p1[12],p1[13]),cvtpk_s(p1[14],p1[15])};
      SBAR(); pv(o,vb0+slot,__builtin_bit_cast(bf16x8,pw0),__builtin_bit_cast(bf16x8,pw1),__builtin_bit_cast(bf16x8,pw2),__builtin_bit_cast(bf16x8,pw3));
      mydone=__all(carry>SB_THR)!=0;
    }
    if(lane==0)flag[(it&1)*8+wid]=mydone?1u:0u;
    slot^=SLOTB;
  }
  bf16*Ow=O+(rowbase+q0+wid*QBLK)*DM+h*D;
  { bf16*stg=(bf16*)(shm+SB_OST)+wid*2048;
    #pragma unroll
    for(int r=0;r<16;++r){const int orow=crow(r,hi);
      #pragma unroll
      for(int d0=0;d0<2;++d0)stg[orow*64+d0*32+r32]=__float2bfloat16(o[d0][r]);}
    asm volatile("s_waitcnt lgkmcnt(0)":::"memory");
    #pragma unroll
    for(int i=0;i<4;++i){const int row=i*8+(lane>>3),ch=lane&7; const u32x4 v=*(const u32x4*)(stg+row*64+ch*8); *(u32x4*)(Ow+(long)row*DM+ch*8)=v;} }
  asm volatile("s_waitcnt vmcnt(0) lgkmcnt(0)\n\ts_barrier":::"memory");
  #undef SB_DMA_K
  #undef SB_DMA_V
}
struct SbOrder {
  int vcu,G;
  __device__ __forceinline__ explicit SbOrder(int grid,int block):vcu((grid%8==0)?(block%8)*(grid/8)+block/8:block),G(grid){}
  __device__ __forceinline__ bool next(int i,AttnUnit&u)const{ const int L=(vcu+(i>>2)*G)*4+(i&3); if(L>=BATCH*NHEAD*NQB)return false; u.bh=L/NQB; u.qb=L%NQB; return true; }
};
template<class Sched> __device__ __forceinline__ void sb_phase(char*lds,const AttnTensors&T,const Sched&S){
  AttnUnit u;
  for(int i=0;S.next(i,u);++i) sb_unit(u.bh/NHEAD,u.bh%NHEAD,u.qb,T.Q,T.K,T.V,T.O,lds);
}
#undef SBAR
#undef WAIT_BAR
}

struct Params {
    const float* in[38];
    float* out; unsigned char* ws;
    int ph_lo, ph_hi, li, pad;
};
enum { I_X = 0, I_LN1G, I_LN1B, I_LN2G, I_LN2B, I_FOX_WIN, I_FOX_BF, I_FOX_WOUT, I_GM_WIN, I_GM_BIN, I_GM_LNG, I_GM_LNB, I_GM_WS, I_GM_BS, I_GM_WOUT,
       I_SB_WIN, I_SB_WOUT, I_RW_MU, I_RW_WRKV, I_RW_W0, I_RW_W1, I_RW_W2, I_RW_A0, I_RW_A1, I_RW_A2, I_RW_G1, I_RW_G2, I_RW_KK, I_RW_KA, I_RW_RK,
       I_RW_GNG, I_RW_GNB, I_RW_WOUT, I_ROUTER_W, I_ROUTER_B, I_MOE_G, I_MOE_U, I_MOE_D };

struct Ctx { int tid, lane, wave, gw, ngw; unsigned char* lds; };

__device__ __forceinline__ void tr_tile(const float* src, int ld, bf16* dst, int ldt, float* scr, int lane) {
    float tv[32];
#pragma unroll
    for (int i = 0; i < 32; ++i) tv[i] = src[(size_t)(2 * i + (lane >> 5)) * ld + (lane & 31)];
#pragma unroll
    for (int i = 0; i < 32; ++i) scr[(2 * i + (lane >> 5)) * 33 + (lane & 31)] = tv[i];
    LDS_WAIT();
    const int c = lane & 7;
#pragma unroll
    for (int j = 0; j < 4; ++j) { const int n = (lane >> 3) + 8 * j; const float* s = scr + (8 * c) * 33 + n;
        u32x4 o; o.x = pk2(s[0 * 33], s[1 * 33]); o.y = pk2(s[2 * 33], s[3 * 33]); o.z = pk2(s[4 * 33], s[5 * 33]); o.w = pk2(s[6 * 33], s[7 * 33]);
        *(u32x4*)(dst + (size_t)n * ldt + 8 * c) = o; }
    LDS_WAIT();
}
__device__ __forceinline__ void conv_matrix(const Ctx& c, const float* W, int ld, int K, int ncols, bf16* WT, int ldt, int mode) {
    float* scr = (float*)(c.lds + c.wave * 16384);
    const int nblk = ncols / 32, nit = (K / 64) * nblk;
    for (int it = c.gw; it < nit; it += c.ngw) {
        const int kb = it / nblk, nb = it % nblk, n0 = nb * 32, k0 = kb * 64;
        int orow = n0; if (mode) orow = (n0 >> 7) * 256 + (n0 & 127) + (mode == 2 ? 128 : 0);
        tr_tile(W + (size_t)k0 * ld + n0, ld, WT + (size_t)orow * ldt + k0, ldt, scr, c.lane);
    }
}
__device__ __forceinline__ void conv_moe_items(const Ctx& c, const Params& p, int l, int it0, int it1, int w, int nw) {
    float* scr = (float*)(c.lds + c.wave * 16384);
    bf16* gu = (bf16*)(p.ws + WS_GU + (size_t)(l & 1) * WS_MOE_ALT); bf16* dn = (bf16*)(p.ws + WS_DOWN + (size_t)(l & 1) * WS_MOE_ALT);
    for (int it = it0 + w; it < it1; it += nw) {
        const int mtx = it >> 8, sub = it & 255, kind = mtx / 16, e = mtx % 16;
        if (kind < 2) {
            const float* W = p.in[kind == 0 ? I_MOE_G : I_MOE_U] + (size_t)(l * 16 + e) * 1024 * 512;
            const int kb = sub / 16, nb = sub % 16, n0 = nb * 32, k0 = kb * 64;
            const int orow = (n0 >> 7) * 256 + (n0 & 127) + (kind == 1 ? 128 : 0);
            tr_tile(W + (size_t)k0 * 512 + n0, 512, gu + (size_t)e * 1024 * 1024 + (size_t)orow * 1024 + k0, 1024, scr, c.lane);
        } else {
            const float* W = p.in[I_MOE_D] + (size_t)(l * 16 + e) * 512 * 1024;
            const int kb = sub / 32, nb = sub % 32, n0 = nb * 32, k0 = kb * 64;
            tr_tile(W + (size_t)k0 * 1024 + n0, 1024, dn + (size_t)e * 1024 * 512 + (size_t)n0 * 512 + k0, 512, scr, c.lane);
        }
    }
}
struct ConvDesc { int in_idx, src_off, ld, K, ncols; unsigned dst; int ldt; };
__device__ __forceinline__ void conv_list(const Ctx& c, const Params& p, const ConvDesc* tab, int n, int w, int nw) {
    float* scr = (float*)(c.lds + c.wave * 16384);
    int total = 0;
    for (int i = 0; i < n; ++i) total += (tab[i].K / 64) * (tab[i].ncols / 32);
    for (int it = w; it < total; it += nw) {
        int r = it, i = 0;
        for (; i < n - 1; ++i) { const int ni = (tab[i].K / 64) * (tab[i].ncols / 32); if (r < ni) break; r -= ni; }
        const ConvDesc d = tab[i]; const int nblk = d.ncols / 32, kb = r / nblk, nb = r % nblk;
        const float* src = p.in[I_FOX_WIN];
#define CSEL(ix) if (d.in_idx == ix) src = p.in[ix];
        CSEL(I_FOX_WOUT) CSEL(I_GM_WIN) CSEL(I_GM_WOUT) CSEL(I_SB_WIN) CSEL(I_SB_WOUT) CSEL(I_RW_WRKV) CSEL(I_RW_W1) CSEL(I_RW_A1) CSEL(I_RW_G1) CSEL(I_RW_W2) CSEL(I_RW_A2) CSEL(I_RW_G2) CSEL(I_RW_WOUT)
#undef CSEL
        tr_tile(src + d.src_off + (size_t)(kb * 64) * d.ld + nb * 32, d.ld, (bf16*)(p.ws + d.dst) + (size_t)(nb * 32) * d.ldt + kb * 64, d.ldt, scr, c.lane);
    }
}
__device__ const ConvDesc CONV_FOX[3] = { {I_FOX_WIN, 0, 4112, 1024, 3072, (unsigned)WS_FOX_IN, 1024}, {I_FOX_WIN, 3088, 4112, 1024, 1024, (unsigned)(WS_FOX_IN + 3072 * 1024 * 2), 1024}, {I_FOX_WOUT, 0, 1024, 1024, 1024, (unsigned)WS_FOX_OUT, 1024} };
__device__ const ConvDesc CONV_GM[2] = { {I_GM_WIN, 0, 2048, 1024, 2048, (unsigned)WS_GM_IN, 1024}, {I_GM_WOUT, 0, 1024, 1024, 1024, (unsigned)WS_GM_OUT, 1024} };
__device__ const ConvDesc CONV_SB[2] = { {I_SB_WIN, 0, 3072, 1024, 3072, (unsigned)WS_SB_IN, 1024}, {I_SB_WOUT, 0, 1024, 1024, 1024, (unsigned)WS_SB_OUT, 1024} };
__device__ const ConvDesc CONV_RW[10] = { {I_RW_WRKV, 0, 1024, 1024, 1024, (unsigned)WS_RKV, 1024}, {I_RW_WRKV, 1024 * 1024, 1024, 1024, 1024, (unsigned)(WS_RKV + 2 * MiB), 1024}, {I_RW_WRKV, 2 * 1024 * 1024, 1024, 1024, 1024, (unsigned)(WS_RKV + 4 * MiB), 1024},
    {I_RW_W1, 0, 64, 1024, 64, (unsigned)WS_LORA1, 1024}, {I_RW_A1, 0, 64, 1024, 64, (unsigned)(WS_LORA1 + 256 * 1024 * 2), 1024}, {I_RW_G1, 0, 128, 1024, 128, (unsigned)(WS_LORA1 + 512 * 1024 * 2), 1024},
    {I_RW_W2, 0, 1024, 64, 1024, (unsigned)WS_LORA2, 128}, {I_RW_A2, 0, 1024, 64, 1024, (unsigned)(WS_LORA2 + 1024 * 128 * 2), 128}, {I_RW_G2, 0, 1024, 128, 1024, (unsigned)(WS_LORA2 + 2048 * 128 * 2), 128},
    {I_RW_WOUT, 0, 1024, 1024, 1024, (unsigned)WS_RW_OUT, 1024} };
__device__ __forceinline__ bool tail_slot(const Ctx& c, int nunits, int& w, int& nw, int bid) {
    const int G = gridDim.x, rem = nunits % G;
    if (rem == 0 || (G - rem) * 2 < G) { w = bid * NW + c.wave; nw = G * NW; return true; }
    if (bid < rem) return false;
    w = (bid - rem) * NW + c.wave; nw = (G - rem) * NW; return true;
}

struct Row { f32x4 v[4]; };
__device__ __forceinline__ Row row_load(const float* r, int lane) { Row x; const f32x4* p = (const f32x4*)r + lane;
#pragma unroll
    for (int j = 0; j < 4; ++j) x.v[j] = p[64 * j]; return x; }
__device__ __forceinline__ Row row_load_bf(const bf16* r, int lane) { Row x; const unsigned long long* p = (const unsigned long long*)r + lane;
#pragma unroll
    for (int j = 0; j < 4; ++j) { const unsigned long long a = p[64 * j]; x.v[j][0] = bf2f((unsigned)a & 0xffffu); x.v[j][1] = bf2f((unsigned)a >> 16); x.v[j][2] = bf2f((unsigned)(a >> 32) & 0xffffu); x.v[j][3] = bf2f((unsigned)(a >> 48)); } return x; }
__device__ __forceinline__ void row_store(float* r, int lane, const Row& x) { f32x4* p = (f32x4*)r + lane;
#pragma unroll
    for (int j = 0; j < 4; ++j) p[64 * j] = x.v[j]; }
__device__ __forceinline__ void row_store_bf(bf16* r, int lane, const Row& x) { unsigned long long* p = (unsigned long long*)r + lane;
#pragma unroll
    for (int j = 0; j < 4; ++j) p[64 * j] = (unsigned long long)pk2(x.v[j].x, x.v[j].y) | ((unsigned long long)pk2(x.v[j].z, x.v[j].w) << 32); }
__device__ __forceinline__ Row row_ln(const Row& x, const float* g, const float* b, int lane) {
    float s = 0.f;
#pragma unroll
    for (int j = 0; j < 4; ++j) s += (x.v[j].x + x.v[j].y) + (x.v[j].z + x.v[j].w);
    const float mean = wave_sum(s) * (1.f / D); float s2 = 0.f; Row y;
#pragma unroll
    for (int j = 0; j < 4; ++j) { y.v[j] = x.v[j] - mean; s2 += (y.v[j].x * y.v[j].x + y.v[j].y * y.v[j].y) + (y.v[j].z * y.v[j].z + y.v[j].w * y.v[j].w); }
    const float rstd = 1.0f / sqrtf(wave_sum(s2) * (1.f / D) + LN_EPS);
    const f32x4* gp = (const f32x4*)g + lane; const f32x4* bp = (const f32x4*)b + lane;
#pragma unroll
    for (int j = 0; j < 4; ++j) y.v[j] = y.v[j] * rstd * gp[64 * j] + bp[64 * j];
    return y;
}
__device__ __forceinline__ void stage_w16(const Ctx& c, const float* W, int ld, float* tab) {
    for (int i = c.tid; i < 1024 * 4; i += NTHR) { const int col = i >> 2, e4 = i & 3; const f32x4 w = *(const f32x4*)(W + (size_t)col * ld + e4 * 4);
        tab[(e4 * 4 + 0) * 1024 + col] = w.x; tab[(e4 * 4 + 1) * 1024 + col] = w.y; tab[(e4 * 4 + 2) * 1024 + col] = w.z; tab[(e4 * 4 + 3) * 1024 + col] = w.w; }
}
__device__ __forceinline__ void row_dot16(const Row& x, const float* tab, int lane, float (&out)[16]) {
    const LAS f32x4* tp = (const LAS f32x4*)(LAS const float*)tab + lane;
#pragma unroll
    for (int e = 0; e < 16; ++e) {
        f32x4 a = x.v[0] * tp[e * 256]; a += x.v[1] * tp[e * 256 + 64]; a += x.v[2] * tp[e * 256 + 128]; a += x.v[3] * tp[e * 256 + 192];
        out[e] = (a.x + a.y) + (a.z + a.w);
        if ((e & 3) == 3) asm volatile("" ::: "memory");
    }
    float b8[8], c4[4];
#pragma unroll
    for (int k = 0; k < 8; ++k) { auto r = __builtin_amdgcn_permlane32_swap(__float_as_uint(out[k]), __float_as_uint(out[k + 8]), false, false); b8[k] = __uint_as_float(r[0]) + __uint_as_float(r[1]); }
#pragma unroll
    for (int k = 0; k < 4; ++k) { auto r = __builtin_amdgcn_permlane16_swap(__float_as_uint(b8[k]), __float_as_uint(b8[k + 4]), false, false); c4[k] = red16(__uint_as_float(r[0]) + __uint_as_float(r[1])); }
#pragma unroll
    for (int rho = 0; rho < 4; ++rho)
#pragma unroll
        for (int k = 0; k < 4; ++k) out[4 * rho + k] = rdlane(c4[k], 16 * rho);
}

__device__ __forceinline__ void phase_p0(const Ctx& c, const Params& p) {
    unsigned char* ws = p.ws;
    conv_list(c, p, CONV_FOX, 3, c.gw, c.ngw); conv_list(c, p, CONV_GM, 2, c.gw, c.ngw); conv_list(c, p, CONV_SB, 2, c.gw, c.ngw); conv_list(c, p, CONV_RW, 10, c.gw, c.ngw);
    {
        const int gt = c.gw * 64 + c.lane, ngt = c.ngw * 64;
        u32x4 z = {0u, 0u, 0u, 0u};
        u32x4* l1 = (u32x4*)(ws + WS_LORA1);
        for (int i = gt; i < 768 * 128; i += ngt) { const int row = i >> 7, blk = row >> 8, r = row & 255; if (r >= (blk == 2 ? 128 : 64)) l1[i] = z; }
        u32x4* l2 = (u32x4*)(ws + WS_LORA2);
        for (int i = gt; i < 2048 * 16; i += ngt) { if ((i & 15) >= 8) l2[i] = z; }
        const float* wsrc = p.in[I_GM_WS]; bf16* wd = (bf16*)(ws + WS_GM_WS);
        for (int i = gt; i < 8 * 128 * 128; i += ngt) { const int s = i & 127, t = (i >> 7) & 127; wd[i] = (bf16)f2bf(s <= t ? wsrc[i] : 0.f); }
    }
    conv_moe_items(c, p, 0, 0, 48 * 256, c.gw, c.ngw);
    bf16* Hb = (bf16*)(ws + WS_HB); float* FL = (float*)(ws + WS_FL);
    __syncthreads(); float* tab = (float*)c.lds; stage_w16(c, p.in[I_FOX_WIN] + 3072, 4112, tab); __syncthreads();
    for (int m = c.gw; m < T; m += c.ngw) {
        Row x = row_load(p.in[I_X] + (size_t)m * D, c.lane);
        row_store_bf(Hb + (size_t)m * D, c.lane, x);
        float fl[16]; row_dot16(x, tab, c.lane, fl);
        if (c.lane < 16) { float v = fl[0];
#pragma unroll
            for (int e = 1; e < 16; ++e) v = (c.lane == e) ? fl[e] : v;
            FL[(size_t)m * 16 + c.lane] = v; }
    }
}

struct GDesc { int arow0, brow0, pm, pn; };
template <class Sched, class Epi>
__device__ __forceinline__ void gemm_naive(const Ctx& c, const bf16* A, int lda, const bf16* Bt, int ldb, int K, const Sched& S, const Epi& E) {
    float* As = (float*)c.lds;
    float* Bs = As + 32 * 132;
    const int tid = c.tid, ty = tid >> 4, tx = tid & 15;
    for (int ui = blockIdx.x;; ui += gridDim.x) {
        GDesc d; if (!S.get(ui, d)) break;
        float acc[4][16];
#pragma unroll
        for (int i = 0; i < 4; ++i)
#pragma unroll
            for (int j = 0; j < 16; ++j) acc[i][j] = 0.f;
        for (int k0 = 0; k0 < K; k0 += 32) {
            { const int r = tid >> 2, kc = (tid & 3) * 8;
              const u32x4 v = *(const u32x4*)(A + (size_t)(d.arow0 + r) * lda + k0 + kc);
              As[(kc + 0) * 132 + r] = bf2f(v.x & 0xffffu); As[(kc + 1) * 132 + r] = bf2f(v.x >> 16);
              As[(kc + 2) * 132 + r] = bf2f(v.y & 0xffffu); As[(kc + 3) * 132 + r] = bf2f(v.y >> 16);
              As[(kc + 4) * 132 + r] = bf2f(v.z & 0xffffu); As[(kc + 5) * 132 + r] = bf2f(v.z >> 16);
              As[(kc + 6) * 132 + r] = bf2f(v.w & 0xffffu); As[(kc + 7) * 132 + r] = bf2f(v.w >> 16); }
#pragma unroll
            for (int jj = 0; jj < 2; ++jj) { const int idx = tid + 512 * jj, r = idx >> 2, kc = (idx & 3) * 8;
              const u32x4 v = *(const u32x4*)(Bt + (size_t)(d.brow0 + r) * ldb + k0 + kc);
              Bs[(kc + 0) * 260 + r] = bf2f(v.x & 0xffffu); Bs[(kc + 1) * 260 + r] = bf2f(v.x >> 16);
              Bs[(kc + 2) * 260 + r] = bf2f(v.y & 0xffffu); Bs[(kc + 3) * 260 + r] = bf2f(v.y >> 16);
              Bs[(kc + 4) * 260 + r] = bf2f(v.z & 0xffffu); Bs[(kc + 5) * 260 + r] = bf2f(v.z >> 16);
              Bs[(kc + 6) * 260 + r] = bf2f(v.w & 0xffffu); Bs[(kc + 7) * 260 + r] = bf2f(v.w >> 16); }
            __syncthreads();
#pragma unroll 4
            for (int k = 0; k < 32; ++k) {
                const f32x4 a = *(const f32x4*)&As[k * 132 + ty * 4];
#pragma unroll
                for (int q = 0; q < 4; ++q) { const f32x4 b = *(const f32x4*)&Bs[k * 260 + q * 64 + tx * 4];
#pragma unroll
                    for (int i = 0; i < 4; ++i) { acc[i][q * 4 + 0] += a[i] * b.x; acc[i][q * 4 + 1] += a[i] * b.y; acc[i][q * 4 + 2] += a[i] * b.z; acc[i][q * 4 + 3] += a[i] * b.w; } }
            }
            __syncthreads();
        }
#pragma unroll
        for (int i = 0; i < 4; ++i)
#pragma unroll
            for (int q = 0; q < 4; ++q)
#pragma unroll
                for (int j = 0; j < 4; ++j) E(d.pm * 128 + ty * 4 + i, d.pn * 256 + q * 64 + tx * 4 + j, acc[i][q * 4 + j], acc[i][(q ^ 2) * 4 + j]);
    }
}
struct DenseSched { int nM, nN;
    __device__ __forceinline__ bool get(int ui, GDesc& d) const { if (ui >= nM * nN) return false; d.pm = ui / nN; d.pn = ui % nN; d.arow0 = d.pm * 128; d.brow0 = d.pn * 256; return true; } };

struct EpiSplitBf16 {
    bf16* O0; size_t stride; float scale0;
    __device__ __forceinline__ void operator()(int row, int col, float v, float) const { const int t = col >> 10; if (t == 0) v *= scale0; O0[(size_t)t * stride + (size_t)row * 1024 + (col & 1023)] = (bf16)f2bf(v); } };
struct EpiResid {
    float* Hf;
    __device__ __forceinline__ void operator()(int row, int col, float v, float) const { float* q = Hf + (size_t)row * 1024 + col; *q = ALPHA * *q + v; } };
struct EpiGelu {
    bf16* Z; const float* bias;
    __device__ __forceinline__ void operator()(int row, int col, float v, float) const { const float x = v + bias[col];
        const float g = 0.5f * x * (1.f + tanhf(0.7978845608028654f * (x + 0.044715f * x * x * x))); Z[(size_t)row * 2048 + col] = (bf16)f2bf(g); } };
struct EpiRw1 {
    bf16* R; bf16* L1;
    __device__ __forceinline__ void operator()(int vrow, int col, float v, float) const { const int cc = vrow >> 14, t = vrow & (T - 1);
        if (cc < 3) R[(size_t)cc * T * 1024 + (size_t)t * 1024 + col] = (bf16)f2bf(v);
        else if (col < 128) { float o = v; if (cc == 3) o = tanhf(v); else if (cc == 5) o = sigmoidf_(v); L1[(size_t)(cc - 3) * T * 128 + (size_t)t * 128 + col] = (bf16)f2bf(o); } } };
struct Rw1Sched {
    __device__ __forceinline__ bool get(int ui, GDesc& d) const { if (ui >= 3 * 512 + 3 * 128) return false;
        int cc, mt, pn; if (ui < 1536) { cc = ui / 512; mt = (ui % 512) / 4; pn = ui % 4; d.brow0 = cc * 1024 + pn * 256; } else { const int u2 = ui - 1536; cc = 3 + u2 / 128; mt = u2 % 128; pn = 0; d.brow0 = 3072 + (cc - 3) * 256; }
        d.pm = cc * 128 + mt; d.pn = pn; d.arow0 = d.pm * 128; return true; } };
struct EpiRw2 {
    float* Wdec; bf16* A; bf16* G; const float* w0; const float* a0;
    __device__ __forceinline__ void operator()(int vrow, int col, float v, float) const { const int j = vrow >> 14, t = vrow & (T - 1); const size_t o = (size_t)t * 1024 + col;
        if (j == 0) Wdec[o] = expf(-0.6065306597126334f * sigmoidf_(w0[col] + v));
        else if (j == 1) A[o] = (bf16)f2bf(sigmoidf_(a0[col] + v)); else G[o] = (bf16)f2bf(v); } };
struct Rw2Sched { __device__ __forceinline__ bool get(int ui, GDesc& d) const { if (ui >= 3 * 512) return false; const int j = ui / 512, mt = (ui % 512) / 4, pn = ui % 4;
        d.pm = j * 128 + mt; d.pn = pn; d.arow0 = d.pm * 128; d.brow0 = j * 1024 + pn * 256; return true; } };
struct MoeSched {
    const int* tile_e; int nN, rowsB;
    __device__ __forceinline__ bool get(int ui, GDesc& d) const { const int ntile = tile_e[255] * 2; if (ui >= ntile * nN) return false;
        const int mt = ui / nN, pn = ui % nN, e = tile_e[mt >> 1]; d.pm = mt; d.pn = pn; d.arow0 = mt * 128; d.brow0 = e * rowsB + pn * 256; return true; } };
struct EpiSwiglu { bf16* H1;
    __device__ __forceinline__ void operator()(int row, int col, float v, float vp) const { const int x = col & 255; if (x < 128) { const float s = v / (1.f + expf(-v)); H1[(size_t)row * 512 + (col >> 8) * 128 + x] = (bf16)f2bf(s * vp); } } };
struct EpiDown { bf16* Yd; const float* rowg;
    __device__ __forceinline__ void operator()(int row, int col, float v, float) const { Yd[(size_t)row * 1024 + col] = (bf16)f2bf(v * rowg[row]); } };

__device__ __forceinline__ void fox_cumsum(const Ctx& c, const Params& p) {
    const float* FL = (const float*)(p.ws + WS_FL); float* CB = (float*)(p.ws + WS_CB); float* red = (float*)c.lds;
    for (int bh = blockIdx.x; bh < BATCH * NH; bh += gridDim.x) {
        const int b = bh / NH, h = bh % NH; const float bf = p.in[I_FOX_BF][h];
        float v[8], run = 0.f;
#pragma unroll
        for (int i = 0; i < 8; ++i) { const int s = c.tid * 8 + i; const float x = FL[(size_t)(b * SEQ + s) * 16 + h] + bf; run += -softplusf_(-x); v[i] = run; }
        const float incl = wave_incl_scan(run, c.lane);
        __syncthreads();
        if (c.lane == 63) red[c.wave] = incl;
        __syncthreads();
        float base = incl - run;
        for (int w = 0; w < c.wave; ++w) base += red[w];
#pragma unroll
        for (int i = 0; i < 8; ++i) CB[(size_t)bh * SEQ + c.tid * 8 + i] = -LOG2E * (base + v[i]);
    }
}
__device__ __forceinline__ void fox_attn_naive(const Ctx& c, const Params& p) {
    bf16* Q = (bf16*)(p.ws + WS_Q); const bf16* K = (const bf16*)(p.ws + WS_K); const bf16* V = (const bf16*)(p.ws + WS_V); const bf16* OG = (const bf16*)(p.ws + WS_OG);
    const float* CB = (const float*)(p.ws + WS_CB);
    float* qs = (float*)c.lds + c.wave * 64;
    for (int row = c.gw; row < BATCH * NH * SEQ; row += c.ngw) {
        const int bh = row / SEQ, t = row % SEQ, b = bh / NH, h = bh % NH;
        const size_t qoff = (size_t)(b * SEQ + t) * 1024 + h * 64 + c.lane;
        LDS_WAIT(); qs[c.lane] = bf2f(Q[qoff]); LDS_WAIT();
        float m = -INFINITY, l = 0.f, o = 0.f;
        for (int s0 = 0; s0 <= t; s0 += 64) {
            const int s = s0 + c.lane; const bool valid = s <= t;
            const u32x4* kp = (const u32x4*)(K + (size_t)(b * SEQ + s) * 1024 + h * 64);
            float z = 0.f;
#pragma unroll
            for (int cc = 0; cc < 8; ++cc) { const u32x4 kv = kp[cc];
                z += qs[cc * 8 + 0] * bf2f(kv.x & 0xffffu) + qs[cc * 8 + 1] * bf2f(kv.x >> 16) + qs[cc * 8 + 2] * bf2f(kv.y & 0xffffu) + qs[cc * 8 + 3] * bf2f(kv.y >> 16)
                   + qs[cc * 8 + 4] * bf2f(kv.z & 0xffffu) + qs[cc * 8 + 5] * bf2f(kv.z >> 16) + qs[cc * 8 + 6] * bf2f(kv.w & 0xffffu) + qs[cc * 8 + 7] * bf2f(kv.w >> 16); }
            z += CB[(size_t)bh * SEQ + s]; z = valid ? z : -INFINITY;
            const float mn = fmaxf(m, wave_max(z)); const float f = exp2f(m - mn); const float pe = valid ? exp2f(z - mn) : 0.f;
            l = l * f + pe; o *= f; m = mn;
#pragma unroll 8
            for (int k = 0; k < 64; ++k) { const float pk = rdlane(pe, k); o += pk * bf2f(V[(size_t)(b * SEQ + s0 + k) * 1024 + h * 64 + c.lane]); }
        }
        const float L = wave_sum(l);
        Q[qoff] = (bf16)f2bf(o / L * sigmoidf_(bf2f(OG[qoff])));
    }
}

__device__ __forceinline__ void sb_attn_naive(const Ctx& c, const Params& p) {
    bf16* Q = (bf16*)(p.ws + WS_Q); const bf16* K = (const bf16*)(p.ws + WS_K); const bf16* V = (const bf16*)(p.ws + WS_V);
    float* qs = (float*)c.lds + c.wave * 64;
    for (int row = c.gw; row < BATCH * NH * SEQ; row += c.ngw) {
        const int bh = row / SEQ, t = row % SEQ, b = bh / NH, h = bh % NH;
        const size_t qoff = (size_t)(b * SEQ + t) * 1024 + h * 64 + c.lane;
        LDS_WAIT(); qs[c.lane] = bf2f(Q[qoff]); LDS_WAIT();
        float carry = 0.f, o = 0.f;
        for (int c0 = 0; c0 < t; c0 += 64) {
            const int s = t - 1 - c0 - c.lane; const bool valid = s >= 0; const int sc = valid ? s : 0;
            const u32x4* kp = (const u32x4*)(K + (size_t)(b * SEQ + sc) * 1024 + h * 64);
            float z = 0.f;
#pragma unroll
            for (int cc = 0; cc < 8; ++cc) { const u32x4 kv = kp[cc];
                z += qs[cc * 8 + 0] * bf2f(kv.x & 0xffffu) + qs[cc * 8 + 1] * bf2f(kv.x >> 16) + qs[cc * 8 + 2] * bf2f(kv.y & 0xffffu) + qs[cc * 8 + 3] * bf2f(kv.y >> 16)
                   + qs[cc * 8 + 4] * bf2f(kv.z & 0xffffu) + qs[cc * 8 + 5] * bf2f(kv.z >> 16) + qs[cc * 8 + 6] * bf2f(kv.w & 0xffffu) + qs[cc * 8 + 7] * bf2f(kv.w >> 16); }
            const float sp = valid ? softplusf_(z) : 0.f;
            const float incl = wave_incl_scan(sp, c.lane);
            const float a = valid ? expf(z - incl - carry) : 0.f;
            carry += rdlane(incl, 63);
#pragma unroll 8
            for (int k = 0; k < 64; ++k) { const float ak = rdlane(a, k); int sk = t - 1 - c0 - k; sk = sk < 0 ? 0 : sk; o += ak * bf2f(V[(size_t)(b * SEQ + sk) * 1024 + h * 64 + c.lane]); }
        }
        Q[qoff] = (bf16)f2bf(o);
    }
}

__device__ __forceinline__ void gmlp_spatial_naive(const Ctx& c, const Params& p) {
    const bf16* Z = (const bf16*)(p.ws + WS_Z); bf16* Yg = (bf16*)(p.ws + WS_YG); const bf16* Wt = (const bf16*)(p.ws + WS_GM_WS);
    float* vn = (float*)c.lds;
    float* Ws = vn + 128 * 128;
    float* st = Ws + 128 * 129;
    for (int u = blockIdx.x; u < 128 * 8; u += gridDim.x) {
        const int n = u >> 3, g = u & 7;
        __syncthreads();
        for (int r = c.wave * 16; r < c.wave * 16 + 16; ++r) {
            const bf16* zr = Z + (size_t)(n * 128 + r) * 2048 + 1024;
            float x[16];
#pragma unroll
            for (int jj = 0; jj < 2; ++jj) { const u32x4 v = *(const u32x4*)(zr + c.lane * 8 + 512 * jj);
                x[jj * 8 + 0] = bf2f(v.x & 0xffffu); x[jj * 8 + 1] = bf2f(v.x >> 16); x[jj * 8 + 2] = bf2f(v.y & 0xffffu); x[jj * 8 + 3] = bf2f(v.y >> 16);
                x[jj * 8 + 4] = bf2f(v.z & 0xffffu); x[jj * 8 + 5] = bf2f(v.z >> 16); x[jj * 8 + 6] = bf2f(v.w & 0xffffu); x[jj * 8 + 7] = bf2f(v.w >> 16); }
            float s = 0.f;
#pragma unroll
            for (int i = 0; i < 16; ++i) s += x[i];
            const float mean = wave_sum(s) * (1.f / 1024.f); float s2 = 0.f;
#pragma unroll
            for (int i = 0; i < 16; ++i) { const float dd = x[i] - mean; s2 += dd * dd; }
            const float rstd = 1.0f / sqrtf(wave_sum(s2) * (1.f / 1024.f) + LN_EPS);
            if (c.lane == 0) { st[r * 2] = mean; st[r * 2 + 1] = rstd; }
        }
        __syncthreads();
        { const int s = c.tid >> 2, cb = (c.tid & 3) * 32; const float mean = st[s * 2], rstd = st[s * 2 + 1];
          const bf16* zr = Z + (size_t)(n * 128 + s) * 2048 + 1024 + g * 128 + cb;
          for (int i = 0; i < 32; ++i) { const int gc = g * 128 + cb + i; vn[s * 128 + cb + i] = (bf2f(zr[i]) - mean) * rstd * p.in[I_GM_LNG][gc] + p.in[I_GM_LNB][gc]; }
          for (int i = c.tid; i < 128 * 128; i += NTHR) Ws[(i >> 7) * 129 + (i & 127)] = bf2f(Wt[(size_t)g * 16384 + i]); }
        __syncthreads();
        { const int t = c.tid >> 2, cb = (c.tid & 3) * 32;
          float acc[32];
#pragma unroll
          for (int i = 0; i < 32; ++i) acc[i] = 0.f;
          for (int s = 0; s < 128; ++s) { const float w = Ws[t * 129 + s];
#pragma unroll
              for (int i = 0; i < 8; ++i) { const f32x4 x = *(const f32x4*)&vn[s * 128 + cb + 4 * i]; acc[4 * i] += w * x.x; acc[4 * i + 1] += w * x.y; acc[4 * i + 2] += w * x.z; acc[4 * i + 3] += w * x.w; } }
          const float bs = p.in[I_GM_BS][g * 128 + t];
          const bf16* ur = Z + (size_t)(n * 128 + t) * 2048 + g * 128 + cb; bf16* yr = Yg + (size_t)(n * 128 + t) * 1024 + g * 128 + cb;
#pragma unroll
          for (int i = 0; i < 32; ++i) yr[i] = (bf16)f2bf(bf2f(ur[i]) * (acc[i] + bs)); }
    }
}


constexpr int GM_SLD = 528;
constexpr int GM_LD = 272;
typedef float f32x16_t __attribute__((ext_vector_type(16)));
typedef short bf16x8_t __attribute__((ext_vector_type(8)));
__device__ __forceinline__ void gmlp_spatial(const Ctx& c, const Params& p) {
    const bf16* Z = (const bf16*)(p.ws + WS_Z); bf16* Yg = (bf16*)(p.ws + WS_YG); const bf16* Wt = (const bf16*)(p.ws + WS_GM_WS);
    unsigned char* Wl = c.lds; unsigned char* Vl = c.lds + 128 * GM_LD; float* st = (float*)(c.lds + 2 * 128 * GM_LD); unsigned char* Sl = c.lds + 2 * 128 * GM_LD + 1024;
    const int lane = c.lane, r32 = lane & 31, hi = lane >> 5, wid = c.wave;
    for (int u = blockIdx.x; u < 256; u += gridDim.x) {
        const int n = u >> 1, g0 = (u & 1) * 4;
        __syncthreads();
#pragma unroll
        for (int rb = 0; rb < 2; ++rb) {
            u32x4 zv[8][2];
#pragma unroll
            for (int i = 0; i < 8; ++i) { const bf16* zr = Z + (size_t)(n * 128 + wid * 16 + rb * 8 + i) * 2048 + 1024; zv[i][0] = *(const u32x4*)(zr + lane * 8); zv[i][1] = *(const u32x4*)(zr + lane * 8 + 512); }
#pragma unroll
            for (int i = 0; i < 8; ++i) { float s1 = 0.f, s2 = 0.f;
#pragma unroll
                for (int jj = 0; jj < 2; ++jj)
#pragma unroll
                    for (int e = 0; e < 4; ++e) { const float a = bf2f(zv[i][jj][e] & 0xffffu), b = bf2f(zv[i][jj][e] >> 16); s1 += a + b; s2 += a * a + b * b; }
                s1 = red16(s1); s2 = red16(s2);
                const float t1 = (rdlane(s1, 0) + rdlane(s1, 16)) + (rdlane(s1, 32) + rdlane(s1, 48)), t2 = (rdlane(s2, 0) + rdlane(s2, 16)) + (rdlane(s2, 32) + rdlane(s2, 48));
                const float mean = t1 * (1.f / 1024.f), var = fmaxf(t2 * (1.f / 1024.f) - mean * mean, 0.f);
                if (lane == 0) { const int r = wid * 16 + rb * 8 + i; st[r * 2] = mean; st[r * 2 + 1] = 1.0f / sqrtf(var + LN_EPS); } }
        }
        for (int gi = 0; gi < 4; ++gi) {
            const int g = g0 + gi;
            __syncthreads();
            { u32x4 wv[4];
#pragma unroll
              for (int k = 0; k < 4; ++k) wv[k] = *(const u32x4*)(Wt + (size_t)g * 16384 + (size_t)(c.tid + NTHR * k) * 8);
#pragma unroll
              for (int k = 0; k < 4; ++k) { const int i = c.tid + NTHR * k, t = i >> 4, ch = i & 15; *(LAS u32x4*)((LAS unsigned char*)Wl + t * GM_LD + ch * 16) = wv[k]; } }
            { const int sp = lane, cb = wid * 16;
              const float mean0 = st[4 * sp], rstd0 = st[4 * sp + 1], mean1 = st[4 * sp + 2], rstd1 = st[4 * sp + 3];
              const bf16* z0 = Z + (size_t)(n * 128 + 2 * sp) * 2048 + 1024 + g * 128 + cb;
              const u32x4 a0 = *(const u32x4*)z0, a1 = *(const u32x4*)(z0 + 8), b0 = *(const u32x4*)(z0 + 2048), b1 = *(const u32x4*)(z0 + 2048 + 8);
              const float* gp = p.in[I_GM_LNG] + g * 128 + cb; const float* bp = p.in[I_GM_LNB] + g * 128 + cb;
#pragma unroll
              for (int j = 0; j < 16; ++j) { const unsigned wa = j < 8 ? a0[(j & 7) >> 1] : a1[(j & 7) >> 1], wb = j < 8 ? b0[(j & 7) >> 1] : b1[(j & 7) >> 1];
                  const float xa = (j & 1) ? __uint_as_float(wa & 0xffff0000u) : __uint_as_float(wa << 16), xb = (j & 1) ? __uint_as_float(wb & 0xffff0000u) : __uint_as_float(wb << 16);
                  const float gn = gp[j], bs_ = bp[j];
                  *(unsigned*)(Vl + (cb + j) * GM_LD + sp * 4) = pk2((xa - mean0) * rstd0 * gn + bs_, (xb - mean1) * rstd1 * gn + bs_); } }
            __syncthreads();
            const int cb32 = wid >> 1, tb0 = 2 * (wid & 1);
            f32x16_t acc0 = {}, acc1 = {};
#pragma unroll
            for (int ks = 0; ks < 8; ++ks) {
                const bf16x8_t a = *(const bf16x8_t*)(Vl + (cb32 * 32 + r32) * GM_LD + (16 * ks + 8 * hi) * 2);
                const bf16x8_t b0 = *(const bf16x8_t*)(Wl + (tb0 * 32 + r32) * GM_LD + (16 * ks + 8 * hi) * 2);
                const bf16x8_t b1 = *(const bf16x8_t*)(Wl + ((tb0 + 1) * 32 + r32) * GM_LD + (16 * ks + 8 * hi) * 2);
                acc0 = __builtin_amdgcn_mfma_f32_32x32x16_bf16(a, b0, acc0, 0, 0, 0);
                acc1 = __builtin_amdgcn_mfma_f32_32x32x16_bf16(a, b1, acc1, 0, 0, 0);
            }
#pragma unroll
            for (int tt = 0; tt < 2; ++tt) { const f32x16_t& acc = tt ? acc1 : acc0; const int t = (tb0 + tt) * 32 + r32; const float bs = p.in[I_GM_BS][g * 128 + t];
#pragma unroll
                for (int q = 0; q < 4; ++q) *(f32x4*)(Sl + t * GM_SLD + (cb32 * 32 + 8 * q + 4 * hi) * 4) = (f32x4){acc[4 * q] + bs, acc[4 * q + 1] + bs, acc[4 * q + 2] + bs, acc[4 * q + 3] + bs}; }
            __syncthreads();
            u32x4 uvv[4];
#pragma unroll
            for (int k = 0; k < 4; ++k) { const int i = c.tid + NTHR * k, t = i >> 4, ch8 = (i & 15) * 8; uvv[k] = *(const u32x4*)(Z + (size_t)(n * 128 + t) * 2048 + g * 128 + ch8); }
#pragma unroll
            for (int k = 0; k < 4; ++k) { const int i = c.tid + NTHR * k, t = i >> 4, ch8 = (i & 15) * 8;
                const u32x4 uv = uvv[k];
                const f32x4 s0 = *(const f32x4*)(Sl + t * GM_SLD + ch8 * 4), s1 = *(const f32x4*)(Sl + t * GM_SLD + ch8 * 4 + 16);
                u32x4 o; o.x = pk2(__uint_as_float(uv.x << 16) * s0[0], __uint_as_float(uv.x & 0xffff0000u) * s0[1]); o.y = pk2(__uint_as_float(uv.y << 16) * s0[2], __uint_as_float(uv.y & 0xffff0000u) * s0[3]);
                o.z = pk2(__uint_as_float(uv.z << 16) * s1[0], __uint_as_float(uv.z & 0xffff0000u) * s1[1]); o.w = pk2(__uint_as_float(uv.w << 16) * s1[2], __uint_as_float(uv.w & 0xffff0000u) * s1[3]);
                *(u32x4*)(Yg + (size_t)(n * 128 + t) * 1024 + g * 128 + ch8) = o; }
        }
    }
}

__device__ __forceinline__ void rwkv_mix(const Ctx& c, const Params& p) {
    const bf16* Hb = (const bf16*)(p.ws + WS_HB); bf16* HM = (bf16*)(p.ws + WS_HM); const float* mu = p.in[I_RW_MU];
    f32x4 mv[6][2][2];
#pragma unroll
    for (int cc = 0; cc < 6; ++cc)
#pragma unroll
        for (int jj = 0; jj < 2; ++jj) { mv[cc][jj][0] = *(const f32x4*)(mu + cc * 1024 + 512 * jj + 8 * c.lane); mv[cc][jj][1] = *(const f32x4*)(mu + cc * 1024 + 512 * jj + 8 * c.lane + 4); }
    int m = c.gw; const u32x4 z4 = {0u, 0u, 0u, 0u};
    u32x4 h[2], hp[2];
#pragma unroll
    for (int jj = 0; jj < 2; ++jj) { h[jj] = (m < T) ? *(const u32x4*)(Hb + (size_t)m * D + 512 * jj + 8 * c.lane) : z4; hp[jj] = (m < T && (m & (SEQ - 1))) ? *(const u32x4*)(Hb + (size_t)(m - 1) * D + 512 * jj + 8 * c.lane) : z4; }
    for (; m < T; m += c.ngw) {
        u32x4 hc[2] = {h[0], h[1]}, hq[2] = {hp[0], hp[1]}; const int mn = m + c.ngw;
        if (mn < T) {
#pragma unroll
            for (int jj = 0; jj < 2; ++jj) { h[jj] = *(const u32x4*)(Hb + (size_t)mn * D + 512 * jj + 8 * c.lane); hp[jj] = (mn & (SEQ - 1)) ? *(const u32x4*)(Hb + (size_t)(mn - 1) * D + 512 * jj + 8 * c.lane) : z4; }
        }
#pragma unroll
        for (int jj = 0; jj < 2; ++jj) {
            f32x4 a0, a1, d0, d1;
#pragma unroll
            for (int e = 0; e < 2; ++e) { a0[2 * e] = bf2f(hc[jj][e] & 0xffffu); a0[2 * e + 1] = bf2f(hc[jj][e] >> 16); a1[2 * e] = bf2f(hc[jj][e + 2] & 0xffffu); a1[2 * e + 1] = bf2f(hc[jj][e + 2] >> 16);
                d0[2 * e] = bf2f(hq[jj][e] & 0xffffu) - a0[2 * e]; d0[2 * e + 1] = bf2f(hq[jj][e] >> 16) - a0[2 * e + 1]; d1[2 * e] = bf2f(hq[jj][e + 2] & 0xffffu) - a1[2 * e]; d1[2 * e + 1] = bf2f(hq[jj][e + 2] >> 16) - a1[2 * e + 1]; }
#pragma unroll
            for (int cc = 0; cc < 6; ++cc) { const f32x4 o0 = a0 + d0 * mv[cc][jj][0], o1 = a1 + d1 * mv[cc][jj][1];
                u32x4 w; w.x = pk2(o0[0], o0[1]); w.y = pk2(o0[2], o0[3]); w.z = pk2(o1[0], o1[1]); w.w = pk2(o1[2], o1[3]);
                *(u32x4*)(HM + (size_t)cc * T * 1024 + (size_t)m * 1024 + 512 * jj + 8 * c.lane) = w; }
        }
    }
}
struct RwIn { float r, k, v, w, a, g; };
__device__ __forceinline__ RwIn rw_load(const Params& p, size_t off) { RwIn x;
    x.r = bf2f(((const bf16*)(p.ws + WS_RR))[off]); x.k = bf2f(((const bf16*)(p.ws + WS_RK))[off]); x.v = bf2f(((const bf16*)(p.ws + WS_RV))[off]);
    x.w = ((const float*)(p.ws + WS_WDEC))[off]; x.a = bf2f(((const bf16*)(p.ws + WS_RA))[off]); x.g = bf2f(((const bf16*)(p.ws + WS_RG))[off]); return x; }
__device__ __forceinline__ void rwkv_scan_naive(const Ctx& c, const Params& p) {
    bf16* YG = (bf16*)(p.ws + WS_RYG);
    for (int bh = c.gw; bh < BATCH * NH; bh += c.ngw) {
        const int b = bh / NH, h = bh % NH, ch = h * 64 + c.lane;
        const float k_k = p.in[I_RW_KK][ch], k_a = p.in[I_RW_KA][ch], r_k = p.in[I_RW_RK][ch], gn_g = p.in[I_RW_GNG][ch], gn_b = p.in[I_RW_GNB][ch];
        float S[64];
#pragma unroll
        for (int j = 0; j < 64; ++j) S[j] = 0.f;
        RwIn nx = rw_load(p, (size_t)(b * SEQ) * 1024 + ch);
        for (int t = 0; t < SEQ; ++t) {
            const RwIn x = nx; const size_t off = (size_t)(b * SEQ + t) * 1024 + ch;
            if (t + 1 < SEQ) nx = rw_load(p, off + 1024);
            float kk = x.k * k_k; const float nrm = sqrtf(wave_sum(kk * kk)); kk = kk / fmaxf(nrm, 1e-12f);
            const float kt = x.k * (1.f + (x.a - 1.f) * k_a), bv = kk * x.a;
            float sa = 0.f;
#pragma unroll
            for (int j = 0; j < 64; ++j) sa -= S[j] * rdlane(kk, j);
            float y = 0.f;
#pragma unroll
            for (int j = 0; j < 64; ++j) { S[j] = S[j] * rdlane(x.w, j) + sa * rdlane(bv, j) + x.v * rdlane(kt, j); y += S[j] * rdlane(x.r, j); }
            const float mean = wave_sum(y) * (1.f / 64.f); const float dy = y - mean; const float var = wave_sum(dy * dy) * (1.f / 64.f);
            const float yn = dy * (1.0f / sqrtf(var + GN_EPS)) * gn_g + gn_b;
            const float bonus = wave_sum(x.r * kt * r_k) * x.v;
            YG[off] = (bf16)f2bf((yn + bonus) * x.g);
        }
    }
}


constexpr int RW_CH = 32, RW_RING = RW_CH * 6 * 64 * 4  , RW_YB = 2 * RW_RING, RW_YBB = RW_CH * 16 * 4;
#define RAW_BAR() asm volatile("s_waitcnt lgkmcnt(0)\n\ts_barrier" ::: "memory")
__device__ __forceinline__ void rwkv_scan(const Ctx& c, const Params& p) {
    const bf16* Rg = (const bf16*)(p.ws + WS_RR); const bf16* Kg = (const bf16*)(p.ws + WS_RK); const bf16* Vg = (const bf16*)(p.ws + WS_RV);
    const float* Wg = (const float*)(p.ws + WS_WDEC); const bf16* Ag = (const bf16*)(p.ws + WS_RA); float* Ysc = (float*)(p.ws + WS_YSC);
    float* ring = (float*)c.lds; float* ybuf = (float*)(c.lds + RW_YB);
    const int lane = c.lane, wid = c.wave;
    for (int u = blockIdx.x; u < BATCH * NH * 4; u += gridDim.x) {
        const int bh = u >> 2, qr = u & 3, b = bh / NH, h = bh % NH;
        const size_t gbase = (size_t)(b * SEQ) * 1024 + h * 64;
        if (wid >= 4) {
            const int pw = wid - 4; const int ch = h * 64 + lane;
            const float k_k = p.in[I_RW_KK][ch], k_a = p.in[I_RW_KA][ch];
            unsigned rr[8], rk[8], rv[8], ra[8]; float rw[8];
#define RW_LOAD(cc) _Pragma("unroll") for (int i = 0; i < 8; ++i) { const size_t o = gbase + (size_t)((cc) * RW_CH + pw + 4 * i) * 1024 + lane; rr[i] = Rg[o]; rk[i] = Kg[o]; rv[i] = Vg[o]; ra[i] = Ag[o]; rw[i] = Wg[o]; }
#define RW_PROC(cc) _Pragma("unroll") for (int i = 0; i < 8; ++i) { float* dst = ring + ((cc) & 1) * (RW_RING / 4) + (pw + 4 * i) * 384 + lane; \
                const float kf = bf2f(rk[i]), af = bf2f(ra[i]); float kk = kf * k_k; float n2 = red16(kk * kk); n2 = rdlane(n2, 0) + rdlane(n2, 16) + rdlane(n2, 32) + rdlane(n2, 48); \
                kk = kk * __builtin_amdgcn_rsqf(fmaxf(n2, 1e-24f)); dst[0] = bf2f(rr[i]); dst[64] = kf * (1.f + (af - 1.f) * k_a); dst[128] = __builtin_amdgcn_exp2f(rw[i]); dst[192] = kk * af; dst[256] = kk; dst[320] = bf2f(rv[i]); }
#define RW_FLUSH(cc) _Pragma("unroll") for (int i2 = 0; i2 < 2; ++i2) { const int st = pw + 4 * (i2 * 4 + (lane >> 4)); \
                Ysc[gbase + (size_t)((cc) * RW_CH + st) * 1024 + qr * 16 + (lane & 15)] = ybuf[((cc) & 1) * (RW_YBB / 4) + st * 16 + (lane & 15)]; }
            RW_LOAD(0); RW_PROC(0); RW_LOAD(1);
            RAW_BAR();
            for (int cc = 0; cc < SEQ / RW_CH; ++cc) {
                if (cc + 1 < SEQ / RW_CH) { RW_PROC(cc + 1); }
                if (cc + 2 < SEQ / RW_CH) { RW_LOAD(cc + 2); }
                if (cc > 0) { RW_FLUSH(cc - 1); }
                RAW_BAR();
            }
            RW_FLUSH(SEQ / RW_CH - 1);
#undef RW_LOAD
#undef RW_PROC
#undef RW_FLUSH
        } else {
            const int rg = lane >> 4, c4 = (lane & 15) * 4, row = wid * 4 + rg;
            float S0 = 0.f, S1 = 0.f, S2 = 0.f, S3 = 0.f;
            RAW_BAR();
            for (int cc = 0; cc < SEQ / RW_CH; ++cc) {
                const float* base = ring + (cc & 1) * (RW_RING / 4); float* yb = ybuf + (cc & 1) * (RW_YBB / 4);
                const float* sp0 = base + c4; const float* vp0 = base + 320 + qr * 16 + row;
                f32x4 r4 = *(const f32x4*)(sp0), kt4 = *(const f32x4*)(sp0 + 64), w4 = *(const f32x4*)(sp0 + 128), b4 = *(const f32x4*)(sp0 + 192), kk4 = *(const f32x4*)(sp0 + 256); float vi = vp0[0];
#pragma unroll 8
                for (int st = 0; st < RW_CH; ++st) {
                    const int sn = (st + 1 < RW_CH) ? st + 1 : st;
                    const f32x4 nr4 = *(const f32x4*)(sp0 + sn * 384), nkt4 = *(const f32x4*)(sp0 + sn * 384 + 64), nw4 = *(const f32x4*)(sp0 + sn * 384 + 128), nb4 = *(const f32x4*)(sp0 + sn * 384 + 192), nkk4 = *(const f32x4*)(sp0 + sn * 384 + 256);
                    const float nvi = vp0[sn * 384];
                    float pd = S0 * kk4.x; pd = fmaf(S1, kk4.y, pd); pd = fmaf(S2, kk4.z, pd); pd = fmaf(S3, kk4.w, pd);
                    pd = red16(pd);
                    S0 = fmaf(S0, w4.x, fmaf(-pd, b4.x, vi * kt4.x)); S1 = fmaf(S1, w4.y, fmaf(-pd, b4.y, vi * kt4.y));
                    S2 = fmaf(S2, w4.z, fmaf(-pd, b4.z, vi * kt4.z)); S3 = fmaf(S3, w4.w, fmaf(-pd, b4.w, vi * kt4.w));
                    float y = S0 * r4.x; y = fmaf(S1, r4.y, y); y = fmaf(S2, r4.z, y); y = fmaf(S3, r4.w, y);
                    y = red16(y);
                    yb[st * 16 + row] = y;
                    r4 = nr4; kt4 = nkt4; w4 = nw4; b4 = nb4; kk4 = nkk4; vi = nvi;
                }
                RAW_BAR();
            }
        }
        RAW_BAR();
    }
}

namespace rwc {
typedef float f32x16 __attribute__((ext_vector_type(16)));
typedef short bf16x8 __attribute__((ext_vector_type(8)));
__device__ __forceinline__ bf16 hbf(float x) { return (bf16)(pk2(x, 0.f) & 0xffffu); }
constexpr int L = 32, NCHH = 32  , NQ = 4, REC = 30720;
constexpr int O_P1T = 0, O_RBT = 4096, O_BBP = 8192, O_MBRT = 12288, O_VP2T = 14336, O_VMKRT = 18432, O_VKTP = 22528;
constexpr int A_ABT = 0, A_BBT = 4096, A_KBT = 8192, A_RBT = 12288, A_WAVE = 16384;
constexpr int A_MBB = A_BBT  , A_TT = A_KBT  , A_MKB = A_KBT + 2048, A_MKRT = A_RBT, A_P2T = A_RBT + 2048;
__device__ __forceinline__ int crow(int r, int hi) { return (r & 3) + 8 * (r >> 2) + 4 * hi; }
__device__ __forceinline__ int ppos(int k) { return (k & ~15) + 8 * ((k >> 2) & 1) + 4 * ((k >> 3) & 1) + (k & 3); }
__device__ __forceinline__ bf16x8 ldf(const unsigned char* base, int row, int rowbytes, int kb) { return *(const bf16x8*)(base + row * rowbytes + kb); }
__device__ __forceinline__ f32x16 mm(bf16x8 a, bf16x8 b, f32x16 c) { return __builtin_amdgcn_mfma_f32_32x32x16_bf16(a, b, c, 0, 0, 0); }
__device__ __forceinline__ unsigned char* rec_ptr(unsigned char* ws, int qr, int head, int cl) { return ws + ((qr & 1) ? WS_CD1 : WS_CD0) + (size_t)(head * NCHH + cl) * REC; }
#define RWC_FENCE() asm volatile("s_waitcnt lgkmcnt(0)" ::: "memory")

template <int TAU, int TP> struct TriDot { static __device__ __forceinline__ void run(const float (&x)[32], const f32x4 (&m)[8], float (&acc)[4]) { acc[TP & 3] = fmaf(m[TP >> 2][TP & 3], x[TP], acc[TP & 3]); TriDot<TAU, TP + 1>::run(x, m, acc); } };
template <int TAU> struct TriDot<TAU, 32> { static __device__ __forceinline__ void run(const float (&)[32], const f32x4 (&)[8], float (&)[4]) {} };
template <int TAU> struct TriSolve { static __device__ __forceinline__ void run(float (&x)[32], const unsigned char* mb, int col) {
    f32x4 m[8];
#pragma unroll
    for (int g = 0; g < 8; ++g) m[g] = *(const f32x4*)(mb + (TAU * 32 + 4 * g) * 4);
    float a4[4] = {0.f, 0.f, 0.f, 0.f};
    TriDot<TAU, TAU + 1>::run(x, m, a4);
    float acc = (a4[0] + a4[1]) + (a4[2] + a4[3]);
    asm volatile("" : "+v"(acc) :: "memory");
    x[TAU] = (TAU < col) ? acc : x[TAU];
    TriSolve<TAU - 1>::run(x, mb, col); } };
template <> struct TriSolve<-1> { static __device__ __forceinline__ void run(float (&)[32], const unsigned char*, int) {} };
__device__ __forceinline__ void rwc_prep(const Ctx& c, const Params& p, int half, int c0, int nch, int blk0, int nblk) {
    if ((int)blockIdx.x < blk0) return;
    unsigned char* wl = c.lds + c.wave * A_WAVE;
    const bf16* Rg = (const bf16*)(p.ws + WS_RR); const bf16* Kg = (const bf16*)(p.ws + WS_RK); const bf16* Vg = (const bf16*)(p.ws + WS_RV);
    const float* LWg = (const float*)(p.ws + WS_WDEC); const bf16* Ag = (const bf16*)(p.ws + WS_RA); float* WLg = (float*)(p.ws + WS_WLG);
    const int lane0 = c.lane;
    int lane = lane0;
    unsigned ra_[8], rb_[8], rd_[8]; float re_[8];
#define RWC_GB(q_) ((size_t)((((q_) & 63) / NH) * SEQ + (c0 + ((q_) >> 6)) * L) * 1024 + (((q_) & 63) % NH) * 64)
#define RWC_LD8(gb_, tb_) _Pragma("unroll") for (int i = 0; i < 8; ++i) { const int o = ((tb_) + i) * 1024 + lane; ra_[i] = (Rg + (gb_))[o]; rb_[i] = (Kg + (gb_))[o]; rd_[i] = (Ag + (gb_))[o]; re_[i] = (LWg + (gb_))[o]; }
    const int q0 = ((int)blockIdx.x - blk0) * NW + c.wave, qs = nblk * NW, qn = BATCH * NH * nch;
    if (q0 < qn) { const size_t g0 = RWC_GB(q0); RWC_LD8(g0, 0) }
    for (int q = q0; q < qn; q += qs) {
        lane = lane0; asm volatile("" : "+v"(lane)); const int r32 = lane & 31, hi = lane >> 5, pl = ppos(lane);
        const int head = q & 63, cl = q >> 6, b = head / NH, h = head % NH, ch = h * 64 + lane;
        const size_t gbase = (size_t)(b * SEQ + (c0 + cl) * L) * 1024 + h * 64;
        unsigned char* rec = rec_ptr(p.ws, half, head, cl);
        const float k_k = p.in[I_RW_KK][ch], k_a = p.in[I_RW_KA][ch];
        float run = 0.f, wprev = 1.f;
        RWC_FENCE();
#pragma unroll 1
        for (int tb = 0; tb < L; tb += 8) {
            unsigned rr[8], rk[8], ra[8]; float rl[8];
#pragma unroll
            for (int i = 0; i < 8; ++i) { rr[i] = ra_[i]; rk[i] = rb_[i]; ra[i] = rd_[i]; rl[i] = re_[i]; }
            if (tb + 8 < L) { RWC_LD8(gbase, tb + 8) }
#pragma unroll
            for (int i = 0; i < 8; ++i) { const int t = tb + i;
                const float kf = bf2f(rk[i]), af = bf2f(ra[i]); float kk = kf * k_k; kk = kk * __builtin_amdgcn_rsqf(fmaxf(wave_sum(kk * kk), 1e-24f));
                const float ktv = kf * (1.f + (af - 1.f) * k_a), bv = kk * af; run += rl[i];
                const float ep = __builtin_amdgcn_exp2f(run), em = __builtin_amdgcn_exp2f(-run);
                *(bf16*)(wl + A_ABT + t * 128 + pl * 2) = hbf(-kk * wprev);
                *(bf16*)(wl + A_BBT + t * 128 + pl * 2) = hbf(bv * em); *(bf16*)(wl + A_KBT + t * 128 + pl * 2) = hbf(ktv * em);
                *(bf16*)(wl + A_RBT + t * 128 + pl * 2) = hbf(bf2f(rr[i]) * ep);
                wprev = ep; }
        }
        RWC_FENCE();
        f32x16 mbb = {}, mkb = {}, mbr = {}, mkr = {};
#pragma unroll
        for (int s_ = 0; s_ < 4; ++s_) { const int kb = (16 * s_ + 8 * hi) * 2;
            const bf16x8 ab_ = ldf(wl + A_BBT, r32, 128, kb), ak_ = ldf(wl + A_KBT, r32, 128, kb), ba_ = ldf(wl + A_ABT, r32, 128, kb), br_ = ldf(wl + A_RBT, r32, 128, kb);
            mbb = mm(ab_, ba_, mbb); mkb = mm(ak_, ba_, mkb); mbr = mm(ab_, br_, mbr); mkr = mm(ak_, br_, mkr); }
        RWC_FENCE();
        unsigned abr[16], vr[16], kpr[16], bpr[16];
        { const float wlj = __builtin_amdgcn_exp2f(run);
          WLg[(size_t)(head * 128 + c0 + cl) * 64 + lane] = wlj;
#pragma unroll
          for (int t = 0; t < L; ++t) { const int pt = (t & ~15) + 8 * ((t >> 2) & 1) + 4 * ((t >> 3) & 1) + (t & 3);
              const unsigned ab = *(const bf16*)(wl + A_ABT + t * 128 + pl * 2), kp = hbf(bf2f(*(const bf16*)(wl + A_KBT + t * 128 + pl * 2)) * wlj), bp = hbf(bf2f(*(const bf16*)(wl + A_BBT + t * 128 + pl * 2)) * wlj);
              const unsigned vv = (Vg + gbase)[t * 1024 + lane];
              if (t & 1) { abr[t >> 1] |= ab << 16; vr[t >> 1] |= vv << 16; kpr[t >> 1] |= kp << 16; bpr[pt >> 1] |= bp << 16; }
              else { abr[t >> 1] = ab; vr[t >> 1] = vv; kpr[t >> 1] = kp; bpr[pt >> 1] = bp; } } }
#pragma unroll
        for (int i = 0; i < 4; ++i) *(u32x4*)(rec + O_BBP + lane * 64 + i * 16) = (u32x4){bpr[4 * i], bpr[4 * i + 1], bpr[4 * i + 2], bpr[4 * i + 3]};
#pragma unroll
        for (int i = 0; i < 4; ++i) *(u32x4*)(rec + O_RBT + i * 1024 + lane * 16) = *(const u32x4*)(wl + A_RBT + i * 1024 + lane * 16);
        RWC_FENCE();
        { int r32 = lane & 31, hi = lane >> 5; asm volatile("" : "+v"(r32), "+v"(hi));
#pragma unroll
        for (int r = 0; r < 16; ++r) { const int tau = crow(r, hi), t = r32; const bool s1 = tau < t, s2 = tau <= t;
            *(float*)(wl + A_MBB + (tau * 32 + t) * 4) = s1 ? mbb[r] : 0.f;
            *(bf16*)(wl + A_MKB + (tau * 32 + t) * 2) = hbf(s1 ? mkb[r] : 0.f);
            *(bf16*)(wl + A_MKRT + (t * 32 + tau) * 2) = hbf(s2 ? mkr[r] : 0.f);
            *(bf16*)(wl + A_ABT + (t * 32 + ppos(tau)) * 2) = hbf(s2 ? mbr[r] : 0.f); } }
        RWC_FENCE();
#pragma unroll
        for (int i = 0; i < 2; ++i) *(u32x4*)(rec + O_MBRT + i * 1024 + lane * 16) = *(const u32x4*)(wl + A_ABT + i * 1024 + lane * 16);
        RWC_FENCE();
        if (q + qs < qn) { const size_t gn = RWC_GB(q + qs); RWC_LD8(gn, 0) }
        { float x[L]; int r32 = lane & 31; asm volatile("" : "+v"(r32));
#pragma unroll
          for (int tau = 0; tau < L; ++tau) x[tau] = (tau == r32) ? 1.f : 0.f;
          TriSolve<L - 2>::run(x, wl + A_MBB, r32);
          RWC_FENCE();
          if (hi == 0) {
#pragma unroll
              for (int i = 0; i < 4; ++i) *(u32x4*)(wl + A_TT + r32 * 64 + i * 16) = (u32x4){pk2(x[8 * i], x[8 * i + 1]), pk2(x[8 * i + 2], x[8 * i + 3]), pk2(x[8 * i + 4], x[8 * i + 5]), pk2(x[8 * i + 6], x[8 * i + 7])}; } }
#pragma unroll
        for (int i = 0; i < 4; ++i) *(u32x4*)(wl + A_BBT + lane * 64 + i * 16) = (u32x4){abr[4 * i], abr[4 * i + 1], abr[4 * i + 2], abr[4 * i + 3]};
        RWC_FENCE();
        { f32x16 p1a = {}, p1b = {}, p2 = {};
#pragma unroll
          for (int s_ = 0; s_ < 2; ++s_) { const int kb = (16 * s_ + 8 * hi) * 2; const bf16x8 tt = ldf(wl + A_TT, r32, 64, kb);
              p1a = mm(tt, ldf(wl + A_BBT, r32, 64, kb), p1a); p1b = mm(tt, ldf(wl + A_BBT, 32 + r32, 64, kb), p1b); p2 = mm(tt, ldf(wl + A_MKB, r32, 64, kb), p2); }
          RWC_FENCE();
          int r32 = lane & 31, hi = lane >> 5; asm volatile("" : "+v"(r32), "+v"(hi));
#pragma unroll
          for (int r = 0; r < 16; ++r) { const int t = crow(r, hi);
              *(bf16*)(wl + A_ABT + (t * 64 + ppos(r32)) * 2) = hbf(p1a[r]); *(bf16*)(wl + A_ABT + (t * 64 + 32 + ppos(r32)) * 2) = hbf(p1b[r]);
              *(bf16*)(wl + A_P2T + (t * 32 + r32) * 2) = hbf(p2[r]); } }
#pragma unroll
        for (int i = 0; i < 4; ++i) { *(u32x4*)(wl + A_BBT + lane * 64 + i * 16) = (u32x4){vr[4 * i], vr[4 * i + 1], vr[4 * i + 2], vr[4 * i + 3]};
                                      *(u32x4*)(wl + A_KBT + lane * 64 + i * 16) = (u32x4){kpr[4 * i], kpr[4 * i + 1], kpr[4 * i + 2], kpr[4 * i + 3]}; }
        RWC_FENCE();
#pragma unroll
        for (int i = 0; i < 4; ++i) *(u32x4*)(rec + O_P1T + i * 1024 + lane * 16) = *(const u32x4*)(wl + A_ABT + i * 1024 + lane * 16);
        RWC_FENCE();
#pragma unroll
        for (int ib = 0; ib < 2; ++ib) { f32x16 vp = {}, vm = {}, vk0 = {}, vk1 = {};
#pragma unroll
            for (int s_ = 0; s_ < 2; ++s_) { const int kb = (16 * s_ + 8 * hi) * 2; const bf16x8 vv = ldf(wl + A_BBT, ib * 32 + r32, 64, kb);
                vp = mm(ldf(wl + A_P2T, r32, 64, kb), vv, vp); vm = mm(ldf(wl + A_MKRT, r32, 64, kb), vv, vm);
                vk0 = mm(ldf(wl + A_KBT, r32, 64, kb), vv, vk0); vk1 = mm(ldf(wl + A_KBT, 32 + r32, 64, kb), vv, vk1); }
            int ln_ = lane; asm volatile("" : "+v"(ln_));
#define RWC_ST(acc, off) do { _Pragma("unroll") for (int i_ = 0; i_ < 2; ++i_) *(u32x4*)(rec + (off) + ln_ * 32 + i_ * 16) = (u32x4){pk2(acc[8 * i_], acc[8 * i_ + 1]), pk2(acc[8 * i_ + 2], acc[8 * i_ + 3]), pk2(acc[8 * i_ + 4], acc[8 * i_ + 5]), pk2(acc[8 * i_ + 6], acc[8 * i_ + 7])}; } while (0)
            RWC_ST(vp, O_VP2T + ib * 2048); RWC_ST(vm, O_VMKRT + ib * 2048); RWC_ST(vk0, O_VKTP + (ib * 2 + 0) * 2048); RWC_ST(vk1, O_VKTP + (ib * 2 + 1) * 2048);
#undef RWC_ST
        }
        RWC_FENCE();
    }
}
#undef RWC_LD8
#undef RWC_GB
__device__ __forceinline__ void rwc_scan(const Ctx& c, const Params& p, int half, int c0, int nch) {
    bf16* Y2 = (bf16*)(p.ws + WS_Y2); const float* WLg = (const float*)(p.ws + WS_WLG); float* SIG = (float*)(p.ws + WS_SIG);
    const int lane = c.lane, r32 = lane & 31, hi = lane >> 5, wid = c.wave;
    const unsigned lds0 = (unsigned)(uintptr_t)c.lds;
    for (int head = blockIdx.x; head < BATCH * NH; head += gridDim.x) {
        const int b = head / NH, h = head % NH;
        const unsigned char* rec0 = rec_ptr(p.ws, half, head, 0);
        asm volatile("s_waitcnt vmcnt(0) lgkmcnt(0)\n\ts_barrier" ::: "memory");
        if (wid >= 2) {
            const int lw = wid - 2;
#define RWC_DMA(cl) do { _Pragma("unroll") for (int k_ = 0; k_ < 5; ++k_) attn_body::glds16s((unsigned)((lw * 5 + k_) * 1024 + lane * 16), rec0 + (size_t)(cl) * REC, \
                    (unsigned)__builtin_amdgcn_readfirstlane(lds0 + ((cl) & 3) * REC + (lw * 5 + k_) * 1024)); } while (0)
            RWC_DMA(0); RWC_DMA(1); RWC_DMA(2);
            asm volatile("s_waitcnt vmcnt(10)\n\ts_barrier" ::: "memory");
            for (int cl = 0; cl < nch; ++cl) {
                if (cl + 3 < nch) { RWC_DMA(cl + 3); asm volatile("s_waitcnt vmcnt(10)\n\ts_barrier" ::: "memory"); }
                else if (cl + 3 == nch) { asm volatile("s_waitcnt vmcnt(5)\n\ts_barrier" ::: "memory"); }
                else { asm volatile("s_waitcnt vmcnt(0)\n\ts_barrier" ::: "memory"); }
            }
#undef RWC_DMA
        } else {
            const int ib = wid; f32x16 S0, S1;
            float* sg = SIG + ((size_t)(head * 2 + ib) * 2) * 1024 + lane * 16;
            if (c0 == 0) { S0 = f32x16{}; S1 = f32x16{}; }
            else {
#pragma unroll
                for (int r = 0; r < 16; ++r) { S0[r] = sg[r]; S1[r] = sg[1024 + r]; } }
            f32x4 wn0[4], wn1[4];
#pragma unroll
            for (int g = 0; g < 4; ++g) { wn0[g] = *(const f32x4*)(WLg + (size_t)(head * 128 + c0) * 64 + 8 * g + 4 * hi); wn1[g] = *(const f32x4*)(WLg + (size_t)(head * 128 + c0) * 64 + 32 + 8 * g + 4 * hi); }
            asm volatile("s_waitcnt lgkmcnt(0)\n\ts_barrier" ::: "memory");
            for (int cl = 0; cl < nch; ++cl) {
                const unsigned char* rl = c.lds + (cl & 3) * REC;
                f32x4 w0[4], w1[4];
#pragma unroll
                for (int g = 0; g < 4; ++g) { w0[g] = wn0[g]; w1[g] = wn1[g]; }
                { const float* wlp = WLg + (size_t)(head * 128 + c0 + (cl + 1 < nch ? cl + 1 : cl)) * 64;
#pragma unroll
                  for (int g = 0; g < 4; ++g) { wn0[g] = *(const f32x4*)(wlp + 8 * g + 4 * hi); wn1[g] = *(const f32x4*)(wlp + 32 + 8 * g + 4 * hi); } }
                bf16x8 sb[4];
#define RWC_CV(X, o) __builtin_bit_cast(bf16x8, (u32x4){pk2(X[o], X[o + 1]), pk2(X[o + 2], X[o + 3]), pk2(X[o + 4], X[o + 5]), pk2(X[o + 6], X[o + 7])})
                sb[0] = RWC_CV(S0, 0); sb[1] = RWC_CV(S0, 8); sb[2] = RWC_CV(S1, 0); sb[3] = RWC_CV(S1, 8);
                f32x16 ut, yt;
                { const u32x4 a0 = *(const u32x4*)(rl + O_VP2T + ib * 2048 + lane * 32), a1 = *(const u32x4*)(rl + O_VP2T + ib * 2048 + lane * 32 + 16);
                  const u32x4 b0 = *(const u32x4*)(rl + O_VMKRT + ib * 2048 + lane * 32), b1 = *(const u32x4*)(rl + O_VMKRT + ib * 2048 + lane * 32 + 16);
#pragma unroll
                  for (int e = 0; e < 4; ++e) { ut[2 * e] = bf2f(a0[e] & 0xffffu); ut[2 * e + 1] = bf2f(a0[e] >> 16); ut[8 + 2 * e] = bf2f(a1[e] & 0xffffu); ut[8 + 2 * e + 1] = bf2f(a1[e] >> 16);
                                                yt[2 * e] = bf2f(b0[e] & 0xffffu); yt[2 * e + 1] = bf2f(b0[e] >> 16); yt[8 + 2 * e] = bf2f(b1[e] & 0xffffu); yt[8 + 2 * e + 1] = bf2f(b1[e] >> 16); } }
#pragma unroll
                for (int s_ = 0; s_ < 4; ++s_) { const int kb = (16 * s_ + 8 * hi) * 2; ut = mm(ldf(rl + O_P1T, r32, 128, kb), sb[s_], ut); yt = mm(ldf(rl + O_RBT, r32, 128, kb), sb[s_], yt); }
                { const u32x4 c0 = *(const u32x4*)(rl + O_VKTP + (ib * 2 + 0) * 2048 + lane * 32), c1 = *(const u32x4*)(rl + O_VKTP + (ib * 2 + 0) * 2048 + lane * 32 + 16);
                  const u32x4 d0 = *(const u32x4*)(rl + O_VKTP + (ib * 2 + 1) * 2048 + lane * 32), d1 = *(const u32x4*)(rl + O_VKTP + (ib * 2 + 1) * 2048 + lane * 32 + 16);
#pragma unroll
                  for (int e = 0; e < 4; ++e) {
                      S0[2 * e] = fmaf(S0[2 * e], w0[(2 * e) >> 2][(2 * e) & 3], bf2f(c0[e] & 0xffffu)); S0[2 * e + 1] = fmaf(S0[2 * e + 1], w0[(2 * e + 1) >> 2][(2 * e + 1) & 3], bf2f(c0[e] >> 16));
                      S0[8 + 2 * e] = fmaf(S0[8 + 2 * e], w0[(8 + 2 * e) >> 2][(8 + 2 * e) & 3], bf2f(c1[e] & 0xffffu)); S0[8 + 2 * e + 1] = fmaf(S0[8 + 2 * e + 1], w0[(9 + 2 * e) >> 2][(9 + 2 * e) & 3], bf2f(c1[e] >> 16));
                      S1[2 * e] = fmaf(S1[2 * e], w1[(2 * e) >> 2][(2 * e) & 3], bf2f(d0[e] & 0xffffu)); S1[2 * e + 1] = fmaf(S1[2 * e + 1], w1[(2 * e + 1) >> 2][(2 * e + 1) & 3], bf2f(d0[e] >> 16));
                      S1[8 + 2 * e] = fmaf(S1[8 + 2 * e], w1[(8 + 2 * e) >> 2][(8 + 2 * e) & 3], bf2f(d1[e] & 0xffffu)); S1[8 + 2 * e + 1] = fmaf(S1[8 + 2 * e + 1], w1[(9 + 2 * e) >> 2][(9 + 2 * e) & 3], bf2f(d1[e] >> 16)); } }
                bf16x8 ub[2]; ub[0] = RWC_CV(ut, 0); ub[1] = RWC_CV(ut, 8);
#pragma unroll
                for (int s_ = 0; s_ < 2; ++s_) { const int kb = (16 * s_ + 8 * hi) * 2;
                    S0 = mm(ldf(rl + O_BBP, r32, 64, kb), ub[s_], S0); S1 = mm(ldf(rl + O_BBP, 32 + r32, 64, kb), ub[s_], S1); yt = mm(ldf(rl + O_MBRT, r32, 64, kb), ub[s_], yt); }
#undef RWC_CV
                { bf16* yo = Y2 + (size_t)(b * SEQ + (c0 + cl) * L) * 1024 + h * 64 + ib * 32 + r32;
#pragma unroll
                  for (int r = 0; r < 16; ++r) yo[(size_t)crow(r, hi) * 1024] = hbf(yt[r]); }
                asm volatile("s_waitcnt lgkmcnt(0)\n\ts_barrier" ::: "memory");
            }
            if (c0 + nch < SEQ / L) {
#pragma unroll
                for (int r = 0; r < 16; ++r) { sg[r] = S0[r]; sg[1024 + r] = S1[r]; } }
        }
    }
}
}


constexpr int CW_CHK = 210000;
__device__ __forceinline__ void rwc_check(const Ctx& c, const Params& p) {
    const float* Ysc = (const float*)(p.ws + WS_YSC); const bf16* Y2 = (const bf16*)(p.ws + WS_Y2); float* acc = (float*)((unsigned*)(p.ws + WS_CTL) + CW_CHK);
    float num = 0.f, den = 0.f;
    for (size_t i = (size_t)blockIdx.x * NTHR + c.tid; i < (size_t)T * D; i += (size_t)gridDim.x * NTHR) { const float a = Ysc[i], b = bf2f(Y2[i]); num += (a - b) * (a - b); den += a * a; }
    num = wave_sum(num); den = wave_sum(den);
    if (c.lane == 0) { atomicAdd(acc, num); atomicAdd(acc + 1, den); }
}

constexpr int RW_SPLIT = 104 * 32;
__device__ __forceinline__ void rwkv_post(const Ctx& c, const Params& p, int part, int blk0, int nblk) {
    const bf16* Y2 = (const bf16*)(p.ws + WS_Y2); const bf16* Rg = (const bf16*)(p.ws + WS_RR); const bf16* Kg = (const bf16*)(p.ws + WS_RK); const bf16* Vg = (const bf16*)(p.ws + WS_RV);
    const bf16* Ag = (const bf16*)(p.ws + WS_RA); const bf16* Gg = (const bf16*)(p.ws + WS_RG); bf16* YG = (bf16*)(p.ws + WS_RYG);
    if ((int)blockIdx.x < blk0) return;
    const int per = part ? SEQ - RW_SPLIT : RW_SPLIT, cnt = BATCH * per, step = nblk * NW;
    typedef unsigned long long u64;
    u64 ny[4], nr[4], nk[4], nv[4], na[4], ng[4];
#define RWP_ROW(i_) (((i_) / per) * SEQ + (part ? RW_SPLIT : 0) + (i_) % per)
#define RWP_LOAD(i_) { const size_t o_ = (size_t)RWP_ROW(i_) * D + 4 * c.lane; _Pragma("unroll") for (int j = 0; j < 4; ++j) { ny[j] = *(const u64*)(Y2 + o_ + 256 * j); nr[j] = *(const u64*)(Rg + o_ + 256 * j); \
        nk[j] = *(const u64*)(Kg + o_ + 256 * j); nv[j] = *(const u64*)(Vg + o_ + 256 * j); na[j] = *(const u64*)(Ag + o_ + 256 * j); ng[j] = *(const u64*)(Gg + o_ + 256 * j); } }
    int idx = ((int)blockIdx.x - blk0) * NW + c.wave;
    if (idx < cnt) RWP_LOAD(idx)
    for (; idx < cnt; idx += step) {
        const int m = RWP_ROW(idx);
        u64 cy[4], cr[4], ck[4], cv[4], ca[4], cg[4];
#pragma unroll
        for (int j = 0; j < 4; ++j) { cy[j] = ny[j]; cr[j] = nr[j]; ck[j] = nk[j]; cv[j] = nv[j]; ca[j] = na[j]; cg[j] = ng[j]; }
        if (idx + step < cnt) RWP_LOAD(idx + step)
        Row o;
#pragma unroll
        for (int j = 0; j < 4; ++j) {
            const int col = 4 * (c.lane + 64 * j);
            const u64 y8 = cy[j], r8 = cr[j], k8 = ck[j], v8 = cv[j], a8 = ca[j], g8 = cg[j];
            const f32x4 ka = *(const f32x4*)(p.in[I_RW_KA] + col), rk = *(const f32x4*)(p.in[I_RW_RK] + col), gg = *(const f32x4*)(p.in[I_RW_GNG] + col), gb = *(const f32x4*)(p.in[I_RW_GNB] + col);
            f32x4 r4, k4, v4, a4, g4, yv;
#pragma unroll
            for (int q = 0; q < 4; ++q) { r4[q] = bf2f((unsigned)(r8 >> (16 * q)) & 0xffffu); k4[q] = bf2f((unsigned)(k8 >> (16 * q)) & 0xffffu); v4[q] = bf2f((unsigned)(v8 >> (16 * q)) & 0xffffu);
                a4[q] = bf2f((unsigned)(a8 >> (16 * q)) & 0xffffu); g4[q] = bf2f((unsigned)(g8 >> (16 * q)) & 0xffffu); yv[q] = bf2f((unsigned)(y8 >> (16 * q)) & 0xffffu); }
            const float mean = red16((yv.x + yv.y) + (yv.z + yv.w)) * (1.f / 64.f);
            const f32x4 dy = yv - mean;
            const float var = red16((dy.x * dy.x + dy.y * dy.y) + (dy.z * dy.z + dy.w * dy.w)) * (1.f / 64.f);
            const float rstd = 1.0f / sqrtf(var + GN_EPS);
            f32x4 kt; float bs = 0.f;
#pragma unroll
            for (int q = 0; q < 4; ++q) { kt[q] = k4[q] * (1.f + (a4[q] - 1.f) * ka[q]); bs += r4[q] * kt[q] * rk[q]; }
            const float bonus = red16(bs);
#pragma unroll
            for (int q = 0; q < 4; ++q) o.v[j][q] = (dy[q] * rstd * gg[q] + gb[q] + bonus * v4[q]) * g4[q];
        }
        row_store_bf(YG + (size_t)m * D, c.lane, o);
    }
#undef RWP_LOAD
#undef RWP_ROW
}

__device__ __forceinline__ float allred4(float x) {
    auto r = __builtin_amdgcn_permlane16_swap(__float_as_uint(x), __float_as_uint(x), false, false); x = __uint_as_float(r[0]) + __uint_as_float(r[1]);
    auto q = __builtin_amdgcn_permlane32_swap(__float_as_uint(x), __float_as_uint(x), false, false); return __uint_as_float(q[0]) + __uint_as_float(q[1]);
}
__device__ __forceinline__ void moe_ln_route(const Ctx& c, const Params& p, int l, bool = false) {
    const bf16* Hbr = (const bf16*)(p.ws + WS_HB); bf16* Hb = (bf16*)(p.ws + WS_HB);
    int* P2TE = (int*)(p.ws + WS_P2TE); float* ROWGE = (float*)(p.ws + WS_ROWGE); int* TOKQ = (int*)(p.ws + WS_TOKQ);
    unsigned* cnt = (unsigned*)(p.ws + WS_CTL) + CW_CNT + l * 64;
    constexpr int L_WT = 0  , L_GB = 98304  , L_RED = L_GB + 256  , L_CNT = L_RED + 1024, L_LNG = L_CNT + 64, L_LNB = L_LNG + 4096,
                  L_GS = L_LNB + 4096  , L_REC = L_GS + 2048  , L_BLK = L_REC + 6144  ;
    LAS unsigned char* ldl = (LAS unsigned char*)c.lds;
    unsigned* lcnt = (unsigned*)(c.lds + L_CNT);
    const int fr = c.lane & 15, fq = c.lane >> 4;
    if (c.tid < 16) lcnt[c.tid] = 0u;
    const int rpb = (T + (int)gridDim.x - 1) / (int)gridDim.x, r0 = (int)blockIdx.x * rpb, r1 = (r0 + rpb < T) ? r0 + rpb : T, ng = (r1 - r0 + 15) >> 4;
    u32x4 xr[32];
#define M1_LOADX(gi_) { int mr_ = r0 + (gi_) * 16 + fr; mr_ = mr_ < r1 ? mr_ : r1 - 1; const u32x4* s_ = (const u32x4*)(Hbr + (size_t)mr_ * D) + fq; _Pragma("unroll") for (int s = 0; s < 32; ++s) xr[s] = s_[4 * s]; }
    int gi = c.wave;
    if (gi < ng) M1_LOADX(gi)
    {
        const float* lg = p.in[I_LN1G] + l * D; const float* lb = p.in[I_LN1B] + l * D; const float* Wr = p.in[I_ROUTER_W];
        const int e = c.tid & 15, q = c.tid >> 4;
        float gsum = 0.f, bsum = 0.f;
#pragma unroll
        for (int m = 0; m < 4; ++m) {
            const int ch = q + 32 * m, col0 = 8 * ch;
            const f32x4 g0 = *(const f32x4*)(lg + col0), g1 = *(const f32x4*)(lg + col0 + 4), b0 = *(const f32x4*)(lb + col0), b1 = *(const f32x4*)(lb + col0 + 4);
            unsigned h1[8], h2[8], h3[8];
#pragma unroll
            for (int i = 0; i < 8; ++i) { const float w = Wr[(col0 + i) * 16 + e], gv = i < 4 ? g0[i & 3] : g1[i & 3], bv = i < 4 ? b0[i & 3] : b1[i & 3], pr = gv * w;
                gsum += pr; bsum = fmaf(bv, w, bsum); attn_body::split3(pr, h1[i], h2[i], h3[i]); }
            const int slot = ((ch >> 2) * 64 + (ch & 3) * 16 + e) * 16;
            *(LAS u32x4*)(ldl + L_WT + slot) = (u32x4){h1[0] | (h1[1] << 16), h1[2] | (h1[3] << 16), h1[4] | (h1[5] << 16), h1[6] | (h1[7] << 16)};
            *(LAS u32x4*)(ldl + L_WT + 32768 + slot) = (u32x4){h2[0] | (h2[1] << 16), h2[2] | (h2[3] << 16), h2[4] | (h2[5] << 16), h2[6] | (h2[7] << 16)};
            *(LAS u32x4*)(ldl + L_WT + 65536 + slot) = (u32x4){h3[0] | (h3[1] << 16), h3[2] | (h3[3] << 16), h3[4] | (h3[5] << 16), h3[6] | (h3[7] << 16)};
        }
        gsum = allred4(gsum); bsum = allred4(bsum);
        if (c.lane < 16) { *(LAS float*)(ldl + L_RED + (c.wave * 32 + e) * 4) = gsum; *(LAS float*)(ldl + L_RED + (c.wave * 32 + 16 + e) * 4) = bsum; }
        for (int i = c.tid; i < 1024; i += NTHR) { *(LAS float*)(ldl + L_LNG + i * 4) = lg[i]; *(LAS float*)(ldl + L_LNB + i * 4) = lb[i]; }
        __syncthreads();
        if (c.tid < 32) { float a = 0.f;
#pragma unroll
            for (int w = 0; w < NW; ++w) a += *(LAS float*)(ldl + L_RED + (w * 32 + c.tid) * 4);
            *(LAS float*)(ldl + L_GB + c.tid * 4) = a; }
        else if (c.tid < 48) *(LAS float*)(ldl + L_GB + c.tid * 4) = p.in[I_ROUTER_B][c.tid - 32];
        __syncthreads();
    }
    const f32x4 Gv = *(LAS f32x4*)(ldl + L_GB + fq * 16), Bv = *(LAS f32x4*)(ldl + L_GB + 64 + fq * 16), Rv = *(LAS f32x4*)(ldl + L_GB + 128 + fq * 16);
    for (; gi < ng; gi += NW) {
        f32x4 acc = {0.f, 0.f, 0.f, 0.f};
        unsigned wb_ = (unsigned)c.lane * 16u, gb_ = (unsigned)fq * 32u + (unsigned)L_LNG; asm volatile("" : "+v"(wb_), "+v"(gb_));
        LAS unsigned char* wtl = ldl + wb_; LAS unsigned char* gbl = ldl + gb_;
#pragma unroll
        for (int s = 0; s < 32; ++s) {
            const pg8::bf16x8 xf = __builtin_bit_cast(pg8::bf16x8, xr[s]);
#pragma unroll
            for (int part = 0; part < 3; ++part)
                acc = __builtin_amdgcn_mfma_f32_16x16x32_bf16(*(LAS pg8::bf16x8*)(wtl + L_WT + part * 32768 + s * 1024), xf, acc, 0, 0, 0);
            if ((s & 3) == 3) __builtin_amdgcn_sched_barrier(0);
        }
        float sum = 0.f;
#pragma unroll
        for (int s = 0; s < 32; ++s)
#pragma unroll
            for (int k = 0; k < 4; ++k) sum += __uint_as_float(xr[s][k] << 16) + __uint_as_float(xr[s][k] & 0xffff0000u);
        const float mean = allred4(sum) * (1.f / D);
#pragma unroll
        for (int s = 0; s < 32; ++s) asm volatile("" : "+v"(xr[s]));
        float s2 = 0.f;
#pragma unroll
        for (int s = 0; s < 32; ++s)
#pragma unroll
            for (int k = 0; k < 4; ++k) { const float d0 = __uint_as_float(xr[s][k] << 16) - mean, d1 = __uint_as_float(xr[s][k] & 0xffff0000u) - mean; s2 = fmaf(d0, d0, s2); s2 = fmaf(d1, d1, s2); }
        const float rstd = 1.0f / sqrtf(allred4(s2) * (1.f / D) + LN_EPS);
        const int mrow = r0 + gi * 16 + fr; const bool valid = mrow < r1;
        u32x4* d_ = (u32x4*)(Hb + (size_t)(valid ? mrow : r1 - 1) * D) + fq;
#pragma unroll
        for (int s = 0; s < 32; ++s) asm volatile("" : "+v"(xr[s]));
#pragma unroll
        for (int s = 0; s < 32; ++s) {
            if ((s & 1) == 0) __builtin_amdgcn_sched_barrier(0);
            const f32x4 g0 = *(LAS f32x4*)(gbl + 128 * s), g1 = *(LAS f32x4*)(gbl + 128 * s + 16);
            const f32x4 b0 = *(LAS f32x4*)(gbl + 4096 + 128 * s), b1 = *(LAS f32x4*)(gbl + 4096 + 128 * s + 16);
            u32x4 o;
#pragma unroll
            for (int k = 0; k < 4; ++k) { const float gl = k < 2 ? g0[2 * k] : g1[2 * k - 4], gh = k < 2 ? g0[2 * k + 1] : g1[2 * k - 3], bl = k < 2 ? b0[2 * k] : b1[2 * k - 4], bh = k < 2 ? b0[2 * k + 1] : b1[2 * k - 3];
                const float y0 = (__uint_as_float(xr[s][k] << 16) - mean) * rstd * gl + bl, y1 = (__uint_as_float(xr[s][k] & 0xffff0000u) - mean) * rstd * gh + bh;
                o[k] = pk2(y0, y1); }
            d_[4 * s] = o;
        }
        float sc[4], se[4];
#pragma unroll
        for (int i = 0; i < 4; ++i) { const float lgt = rstd * (acc[i] - mean * Gv[i]) + Bv[i]; sc[i] = __builtin_amdgcn_rcpf(1.0f + __builtin_amdgcn_exp2f(-LOG2E * lgt)); se[i] = sc[i] + Rv[i]; }
        int i1 = 0; float v1 = se[0], c1 = sc[0];
#pragma unroll
        for (int i = 1; i < 4; ++i) if (se[i] > v1) { i1 = i; v1 = se[i]; c1 = sc[i]; }
        int i2 = -1; float v2 = -INFINITY, c2v = 0.f;
#pragma unroll
        for (int i = 0; i < 4; ++i) if (i != i1 && se[i] > v2) { i2 = i; v2 = se[i]; c2v = sc[i]; }
        *(LAS float*)(ldl + L_GS + ((c.wave * 16 + fr) * 4 + fq) * 4) = v1 + v2;
        const f32x4 g4 = *(LAS f32x4*)(ldl + L_GS + (c.wave * 16 + fr) * 16);
        int bg = 0; float bv = g4[0];
#pragma unroll
        for (int g = 1; g < 4; ++g) if (g4[g] > bv) { bv = g4[g]; bg = g; }
        if (valid && fq == bg) {
            const int be1 = 4 * fq + i1, be2 = 4 * fq + i2; const float inv = 1.0f / (c1 + c2v);
            const unsigned p1 = atomicAdd(lcnt + be1, 1u), p2 = atomicAdd(lcnt + be2, 1u);
            const int li = (gi * 16 + fr) * 2;
            *(LAS int*)(ldl + L_REC + li * 4) = be1; *(LAS int*)(ldl + L_REC + li * 4 + 4) = be2; *(LAS int*)(ldl + L_REC + 2048 + li * 4) = (int)p1; *(LAS int*)(ldl + L_REC + 2048 + li * 4 + 4) = (int)p2;
            *(LAS float*)(ldl + L_REC + 4096 + li * 4) = c1 * inv; *(LAS float*)(ldl + L_REC + 4096 + li * 4 + 4) = c2v * inv;
        }
        if (gi + NW < ng) M1_LOADX(gi + NW)
    }
#undef M1_LOADX
    __syncthreads();
    if (c.tid < 16) *(LAS int*)(ldl + L_BLK + c.tid * 4) = (int)atomicAdd(cnt + c.tid, lcnt[c.tid]);
    __syncthreads();
    for (int i = c.tid; i < 2 * (r1 - r0); i += NTHR) {
        const int e = *(LAS int*)(ldl + L_REC + i * 4), pe = e * ECAP + *(LAS int*)(ldl + L_BLK + e * 4) + *(LAS int*)(ldl + L_REC + 2048 + i * 4);
        P2TE[pe] = r0 + (i >> 1); ROWGE[pe] = *(LAS float*)(ldl + L_REC + 4096 + i * 4); TOKQ[(r0 + (i >> 1)) * 2 + (i & 1)] = pe; }
}
__device__ __forceinline__ void moe_tiles(const Ctx& c, const Params& p, int l) {
    const unsigned* cnt = (const unsigned*)(p.ws + WS_CTL) + CW_CNT + l * 64;
    LAS int* tab = (LAS int*)((LAS unsigned char*)c.lds + pg8::MOE_TAB);
    const int mt = c.tid; int tb = 0, e_ = 0, j_ = 0, nv_ = 0;
#pragma unroll
    for (int e = 0; e < 16; ++e) { const int ne = (int)__hip_atomic_load(cnt + e, __ATOMIC_RELAXED, __HIP_MEMORY_SCOPE_AGENT), nte = (ne + 255) >> 8;
        if (mt >= tb && mt < tb + nte) { e_ = e; j_ = mt - tb; nv_ = ne - 256 * j_ < 256 ? ne - 256 * j_ : 256; }
        tb += nte; }
    if (mt < 256) { tab[mt] = e_; tab[256 + mt] = j_; tab[512 + mt] = nv_; }
    if (mt == 0) tab[768] = tb;
    __syncthreads();
}
__device__ __forceinline__ void moe_combine(const Ctx& c, const Params& p, int l, float* outp, bool dry = false) {
    const bf16* Hbr = (const bf16*)(p.ws + WS_HB); bf16* Hb = (bf16*)(p.ws + (dry ? WS_ACT + 264 * MiB : WS_HB)); const bf16* Yd = (const bf16*)(p.ws + WS_YD); const int* TOKP = (const int*)(p.ws + WS_TOKQ);
    if (dry) outp = nullptr;
    LAS int* bs = (LAS int*)(LAS unsigned char*)c.lds;
    if (c.tid < 16) { const unsigned* cnt = (const unsigned*)(p.ws + WS_CTL) + CW_CNT + l * 64; int b_ = 0;
        for (int e = 0; e < c.tid; ++e) b_ += ((int)__hip_atomic_load(cnt + e, __ATOMIC_RELAXED, __HIP_MEMORY_SCOPE_AGENT) + 255) & ~255;
        bs[c.tid] = b_; }
    __syncthreads();
    int nq0 = 0, nq1 = 0, nq2 = 0, nq3 = 0;
    if (c.gw < T) { const int m1_ = (c.gw + c.ngw < T) ? c.gw + c.ngw : c.gw; nq0 = TOKP[c.gw * 2]; nq1 = TOKP[c.gw * 2 + 1]; nq2 = TOKP[m1_ * 2]; nq3 = TOKP[m1_ * 2 + 1]; }
    for (int m0 = c.gw; m0 < T; m0 += 2 * c.ngw) {
        const int m1 = (m0 + c.ngw < T) ? m0 + c.ngw : m0;
        const int qa0 = nq0, qa1 = nq1, qb0 = nq2, qb1 = nq3;
        { const int mn = m0 + 2 * c.ngw; if (mn < T) { const int mn1 = (mn + c.ngw < T) ? mn + c.ngw : mn; nq0 = TOKP[mn * 2]; nq1 = TOKP[mn * 2 + 1]; nq2 = TOKP[mn1 * 2]; nq3 = TOKP[mn1 * 2 + 1]; } }
        const int pa0 = bs[qa0 >> 14] + (qa0 & (ECAP - 1)), pa1 = bs[qa1 >> 14] + (qa1 & (ECAP - 1)), pb0 = bs[qb0 >> 14] + (qb0 & (ECAP - 1)), pb1 = bs[qb1 >> 14] + (qb1 & (ECAP - 1));
        Row xa = row_load_bf(Hbr + (size_t)m0 * D, c.lane), xb = row_load_bf(Hbr + (size_t)m1 * D, c.lane);
        unsigned long long ya0[4], ya1[4], yb0[4], yb1[4];
#pragma unroll
        for (int j = 0; j < 4; ++j) { ya0[j] = ((const unsigned long long*)(Yd + (size_t)pa0 * D) + c.lane)[64 * j]; ya1[j] = ((const unsigned long long*)(Yd + (size_t)pa1 * D) + c.lane)[64 * j];
                                      yb0[j] = ((const unsigned long long*)(Yd + (size_t)pb0 * D) + c.lane)[64 * j]; yb1[j] = ((const unsigned long long*)(Yd + (size_t)pb1 * D) + c.lane)[64 * j]; }
#define M5_ADD(RW, YA, YB) _Pragma("unroll") for (int j = 0; j < 4; ++j) { const unsigned long long a = YA[j], b = YB[j]; \
            RW.v[j][0] = ALPHA * RW.v[j][0] + bf2f((unsigned)a & 0xffffu) + bf2f((unsigned)b & 0xffffu); RW.v[j][1] = ALPHA * RW.v[j][1] + bf2f(((unsigned)a >> 16)) + bf2f(((unsigned)b >> 16)); \
            RW.v[j][2] = ALPHA * RW.v[j][2] + bf2f((unsigned)(a >> 32) & 0xffffu) + bf2f((unsigned)(b >> 32) & 0xffffu); RW.v[j][3] = ALPHA * RW.v[j][3] + bf2f((unsigned)(a >> 48)) + bf2f((unsigned)(b >> 48)); }
        M5_ADD(xa, ya0, ya1) M5_ADD(xb, yb0, yb1)
#undef M5_ADD
        const Row oa = row_ln(xa, p.in[I_LN2G] + l * D, p.in[I_LN2B] + l * D, c.lane), ob = row_ln(xb, p.in[I_LN2G] + l * D, p.in[I_LN2B] + l * D, c.lane);
        if (outp) { row_store(outp + (size_t)m0 * D, c.lane, oa); if (m1 != m0) row_store(outp + (size_t)m1 * D, c.lane, ob); }
        else { row_store_bf(Hb + (size_t)m0 * D, c.lane, oa); if (m1 != m0) row_store_bf(Hb + (size_t)m1 * D, c.lane, ob); }
    }
}

enum { PH_P0 = 0,
       PH_F1, PH_F3, PH_F4, PH_M1_0, PH_M3_0, PH_M4_0, PH_M5_0,
       PH_G1, PH_G2, PH_G3, PH_M1_1, PH_M3_1, PH_M4_1, PH_M5_1,
       PH_S1, PH_S2, PH_S3, PH_M1_2, PH_M3_2, PH_M4_2, PH_M5_2,
       PH_R0, PH_R1, PH_R2, PH_RC0, PH_RC1, PH_RC2, PH_RC3, PH_RC4, PH_RC5, PH_R4B, PH_R5, PH_M1_3, PH_M3_3, PH_M4_3, PH_M5_3, NPHASE };

#define RP_P0 RP1
#define RP_F1 RP1
#define RP_F3 RP1
#define RP_M34 RP1
#define RP_G2 RP1
#define RP_S2 RP1
#define RP_R4 RP1
#define RP0(...) {}
#define RP4B(...) { __VA_ARGS__; xcd_barrier(bar); __VA_ARGS__; xcd_barrier(bar); __VA_ARGS__; xcd_barrier(bar); __VA_ARGS__; xcd_barrier(bar); }
#define RP_M1D RP0
#define RP_M2 RP1
#define RP_M5D RP0
__global__ void __launch_bounds__(NTHR, 2) fwd_kernel(Params p) {
    extern __shared__ __attribute__((aligned(16))) unsigned char lds[];
    Ctx c; c.tid = threadIdx.x; c.lane = c.tid & 63; c.wave = __builtin_amdgcn_readfirstlane(c.tid >> 6); c.gw = blockIdx.x * NW + c.wave; c.ngw = gridDim.x * NW; c.lds = lds;
    volatile LAS unsigned* MISC = (volatile LAS unsigned*)((LAS unsigned char*)lds + MISC_OFF);
    if (c.tid < 32) MISC[c.tid] = 0u;
    __syncthreads();
    unsigned* ctl = (unsigned*)(p.ws + WS_CTL);
    XcdBarrier bar = xcd_barrier_post(ctl + CW_BAR + p.li * XCD_BAR_WORDS, MISC + 8);
    const int lo = p.ph_lo, hi = p.ph_hi;
    unsigned char* ws = p.ws;
#define PHASE(k, ...) if (lo <= (k) && (k) < hi) { Ctx c; { int t_ = threadIdx.x; asm volatile("" : "+v"(t_)); c.tid = t_; c.lane = t_ & 63; c.wave = __builtin_amdgcn_readfirstlane(t_ >> 6); c.gw = blockIdx.x * NW + c.wave; c.ngw = gridDim.x * NW; c.lds = lds; } \
        __VA_ARGS__; if ((k) + 1 < hi) xcd_barrier(bar); }
#define RP1(...) { __VA_ARGS__; }
#define RP5(...) { __VA_ARGS__; xcd_barrier(bar); __VA_ARGS__; xcd_barrier(bar); __VA_ARGS__; xcd_barrier(bar); __VA_ARGS__; xcd_barrier(bar); __VA_ARGS__; }

    PHASE(PH_P0, RP_P0(phase_p0(c, p)));
    LAS unsigned char* ldsr = (LAS unsigned char*)lds;
    const int G = gridDim.x, bid = blockIdx.x;
    const int vbid = (G % 8 == 0) ? (bid % 8) * (G / 8) + bid / 8 : bid;
#define GEMM_DENSE(Aoff, Boff, N, K, EPI_T, ...) { pg8::Gemm g{(const bf16*)(ws + (Aoff)), (const bf16*)(ws + (Boff)), T, (N), (K), nullptr}; pg8::StaticOrder S; S.init(T, (N), G, bid); \
        EPI_T E{__VA_ARGS__}; pg8::gemm_phase<EPI_T, pg8::StaticOrder, true, true>(ldsr, g, S, E); }
    PHASE(PH_F1, { fox_cumsum(c, p); __syncthreads();
        RP_F1(GEMM_DENSE(WS_HB, WS_FOX_IN, 4096, 1024, pg8::EpiBf16X<0>, (bf16*)(ws + WS_Q), 1024, nullptr, 1024, (size_t)T * 1024, C2)) });
    PHASE(PH_F3, RP_F3({ const attn_body::AttnTensors AT{(const attn_body::bf16*)(ws + WS_Q), (const attn_body::bf16*)(ws + WS_K), (const attn_body::bf16*)(ws + WS_V), (attn_body::bf16*)(ws + WS_O),
                                                  (const float*)(ws + WS_CB), (const attn_body::bf16*)(ws + WS_OG)};
        const attn_body::StaticOrder S(G, bid); attn_body::attn_phase<attn_body::StaticOrder>((char*)lds, AT, S); }));
    PHASE(PH_F4, GEMM_DENSE(WS_O, WS_FOX_OUT, 1024, 1024, pg8::EpiResid, (bf16*)(ws + WS_HB), ALPHA));
#define MOE_BLOCK(L, K1, K3, K4, K5, OUTP, NEXTCONV) \
    PHASE(K1, { RP_M1D(moe_ln_route(c, p, L, true)); moe_ln_route(c, p, L); }); \
    PHASE(K3, RP_M34({ moe_tiles(c, p, L); pg8::Gemm g{(const bf16*)(ws + WS_HB), (const bf16*)(ws + WS_GU + (size_t)((L) & 1) * WS_MOE_ALT), MPAD_MAX, 16 * 1024, 1024, (const int*)(ws + WS_P2TE)}; pg8::MoeOrder S{(const LAS int*)(ldsr + pg8::MOE_TAB), G, vbid}; \
        pg8::EpiSwiglu E{(bf16*)(ws + WS_H1)}; pg8::gemm_phase<pg8::EpiSwiglu, pg8::MoeOrder, true, true, true>(ldsr, g, S, E); \
        if (NEXTCONV) { int w_, nw_; if (tail_slot(c, 4 * __builtin_amdgcn_readfirstlane(*(const LAS int*)(ldsr + pg8::MOE_TAB + 768 * 4)), w_, nw_, vbid)) conv_moe_items(c, p, (L) + 1, 0, 32 * 256, w_, nw_); } })); \
    PHASE(K4, RP_M34({ moe_tiles(c, p, L); pg8::Gemm g{(const bf16*)(ws + WS_H1), (const bf16*)(ws + WS_DOWN + (size_t)((L) & 1) * WS_MOE_ALT), MPAD_MAX, 16 * 1024, 512, nullptr}; pg8::MoeOrder S{(const LAS int*)(ldsr + pg8::MOE_TAB), G, vbid}; \
        pg8::EpiDown E{(bf16*)(ws + WS_YD), (const float*)(ws + WS_ROWGE)}; pg8::gemm_phase<pg8::EpiDown, pg8::MoeOrder, true, true>(ldsr, g, S, E); \
        if (NEXTCONV) { int w_, nw_; if (tail_slot(c, 4 * __builtin_amdgcn_readfirstlane(*(const LAS int*)(ldsr + pg8::MOE_TAB + 768 * 4)), w_, nw_, vbid)) { conv_moe_items(c, p, (L) + 1, 32 * 256, 48 * 256, w_, nw_); \
             } } })); \
    PHASE(K5, { RP_M5D(moe_combine(c, p, L, OUTP, true)); moe_combine(c, p, L, OUTP); });
    MOE_BLOCK(0, PH_M1_0, PH_M3_0, PH_M4_0, PH_M5_0, nullptr, true)
    PHASE(PH_G1, GEMM_DENSE(WS_HB, WS_GM_IN, 2048, 1024, pg8::EpiBf16X<2>, (bf16*)(ws + WS_Z), 2048, p.in[I_GM_BIN], 0, 0, 1.f));
    PHASE(PH_G2, RP_G2(gmlp_spatial(c, p)));
    PHASE(PH_G3, GEMM_DENSE(WS_YG, WS_GM_OUT, 1024, 1024, pg8::EpiResid, (bf16*)(ws + WS_HB), ALPHA));
    MOE_BLOCK(1, PH_M1_1, PH_M3_1, PH_M4_1, PH_M5_1, nullptr, true)
    PHASE(PH_S1, GEMM_DENSE(WS_HB, WS_SB_IN, 3072, 1024, pg8::EpiBf16X<0>, (bf16*)(ws + WS_Q), 1024, nullptr, 1024, (size_t)T * 1024, C2));
    PHASE(PH_S2, RP_S2({ const attn_body::AttnTensors AT{(const attn_body::bf16*)(ws + WS_Q), (const attn_body::bf16*)(ws + WS_K), (const attn_body::bf16*)(ws + WS_V), (attn_body::bf16*)(ws + WS_O), nullptr, nullptr};
        const attn_body::SbOrder S(G, bid); attn_body::sb_phase<attn_body::SbOrder>((char*)lds, AT, S); }));
    PHASE(PH_S3, GEMM_DENSE(WS_O, WS_SB_OUT, 1024, 1024, pg8::EpiResid, (bf16*)(ws + WS_HB), ALPHA));
    MOE_BLOCK(2, PH_M1_2, PH_M3_2, PH_M4_2, PH_M5_2, nullptr, true)
    PHASE(PH_R0, rwkv_mix(c, p));
    PHASE(PH_R1, { pg8::Gemm g{(const bf16*)(ws + WS_HM), (const bf16*)(ws + WS_RKV), 6 * T, 15 * 256, 1024, nullptr}; pg8::Rw1Order S{G, vbid};
        pg8::EpiRw1 E{(bf16*)(ws + WS_RR), (bf16*)(ws + WS_L1), T}; pg8::gemm_phase<pg8::EpiRw1, pg8::Rw1Order, true, true>(ldsr, g, S, E); });
    PHASE(PH_R2, { pg8::Gemm g{(const bf16*)(ws + WS_L1), (const bf16*)(ws + WS_LORA2), 3 * T, 3 * 1024, 128, nullptr}; pg8::Rw2Order S{G, vbid};
        pg8::EpiRw2 E{(float*)(ws + WS_WDEC), (bf16*)(ws + WS_RA), (bf16*)(ws + WS_RG), p.in[I_RW_W0], p.in[I_RW_A0]}; pg8::gemm_phase<pg8::EpiRw2, pg8::Rw2Order, true, true>(ldsr, g, S, E); });
    const bool split_ok = G >= 128;
#define RW_STAGE(K, ST, C0, NCH, NC0, NNCH) PHASE(K, { if (split_ok) { if (bid < 64) rwc::rwc_scan(c, p, ST, C0, NCH); else rwc::rwc_prep(c, p, (ST) + 1, NC0, NNCH, 64, G - 64); } \
        else { rwc::rwc_scan(c, p, ST, C0, NCH); __syncthreads(); rwc::rwc_prep(c, p, (ST) + 1, NC0, NNCH, 0, G); } });
    PHASE(PH_RC0, rwc::rwc_prep(c, p, 0, 0, 32, 0, G));
    RW_STAGE(PH_RC1, 0, 0, 32, 32, 24)
    RW_STAGE(PH_RC2, 1, 32, 24, 56, 24)
    RW_STAGE(PH_RC3, 2, 56, 24, 80, 24)
    RW_STAGE(PH_RC4, 3, 80, 24, 104, 24)
#undef RW_STAGE
    PHASE(PH_RC5, { if (split_ok) { if (bid < 64) rwc::rwc_scan(c, p, 4, 104, 24); else rwkv_post(c, p, 0, 64, G - 64); } else { rwc::rwc_scan(c, p, 4, 104, 24); __syncthreads(); rwkv_post(c, p, 0, 0, G); } });
    PHASE(PH_R4B, rwkv_post(c, p, 1, 0, G));
    PHASE(PH_R5, GEMM_DENSE(WS_RYG, WS_RW_OUT, 1024, 1024, pg8::EpiResid, (bf16*)(ws + WS_HB), ALPHA));
    MOE_BLOCK(3, PH_M1_3, PH_M3_3, PH_M4_3, PH_M5_3, p.out, false)
#undef PHASE
}

#ifndef N_LAUNCH_MODE
#define N_LAUNCH_MODE 1
#endif
extern "C" void kernel_launch(void* const* d_in, const int* in_sizes, int n_in, void* d_out, int out_size, void* d_ws, size_t ws_size, hipStream_t stream) {
    static int grid = 0;
    if (grid == 0) {
        if (n_in != 38 || in_sizes[0] != T * D || out_size != T * D || ws_size < WS_END) { fprintf(stderr, "kernel_launch: unexpected shapes (n_in %d, ws %zu)\n", n_in, ws_size); grid = -1; return; }
        int dev = 0, cus = 0;
        if (hipGetDevice(&dev) != hipSuccess || hipDeviceGetAttribute(&cus, hipDeviceAttributeMultiprocessorCount, dev) != hipSuccess) { grid = -1; return; }
        if (hipFuncSetAttribute((const void*)fwd_kernel, hipFuncAttributeMaxDynamicSharedMemorySize, LDS_BYTES) != hipSuccess) { fprintf(stderr, "kernel_launch: hipFuncSetAttribute failed\n"); grid = -1; return; }
        int per_cu = 0; (void)hipOccupancyMaxActiveBlocksPerMultiprocessor(&per_cu, (const void*)fwd_kernel, NTHR, LDS_BYTES); (void)hipGetLastError();
        grid = cus > 0 ? cus : 256;
    }
    if (grid < 0) return;
    (void)hipMemsetAsync((char*)d_ws + WS_CTL, 0, CTL_BYTES, stream);
    Params a{};
    for (int i = 0; i < 38; ++i) a.in[i] = (const float*)d_in[i];
    a.out = (float*)d_out; a.ws = (unsigned char*)d_ws; a.pad = 0;
    if (N_LAUNCH_MODE == 1) { a.ph_lo = 0; a.ph_hi = NPHASE; a.li = 0; hipLaunchKernelGGL(fwd_kernel, dim3(grid), dim3(NTHR), LDS_BYTES, stream, a); }
    else for (int k = 0; k < NPHASE; ++k) { a.ph_lo = k; a.ph_hi = k + 1; a.li = k; hipLaunchKernelGGL(fwd_kernel, dim3(grid), dim3(NTHR), LDS_BYTES, stream, a); }
}
```

```cpp
#include <hip/hip_runtime.h>
#include <cstdio>
#include <cstdint>
#include <hip/hip_bf16.h>
#include <cmath>

#define LAS __attribute__((address_space(3)))
typedef unsigned short bf16;
typedef unsigned u32x4 __attribute__((ext_vector_type(4)));
typedef float f32x4 __attribute__((ext_vector_type(4)));

constexpr int D = 1024, BATCH = 4, SEQ = 4096, T = BATCH * SEQ, NH = 16, HD = 64;
constexpr int NEXP = 16, DEXP = 512;
constexpr float ALPHA = 1.6817928305074290f;
constexpr float LN_EPS = 1e-5f, GN_EPS = 64e-5f;
constexpr float LOG2E = 1.4426950408889634f;
constexpr float C2 = 0.125f * LOG2E;
constexpr int NW = 8, NTHR = 512;
constexpr int MPAD_MAX = 36864;

constexpr size_t MiB = 1u << 20;
constexpr size_t WS_CTL = 0, CTL_BYTES = 1 * MiB;
constexpr size_t WS_FOX_IN = 2 * MiB, WS_FOX_OUT = 10 * MiB, WS_GM_IN = 12 * MiB, WS_GM_OUT = 16 * MiB, WS_GM_WS = 18 * MiB;
constexpr size_t WS_SB_IN = 19 * MiB, WS_SB_OUT = 25 * MiB, WS_RKV = 27 * MiB, WS_LORA1 = 33 * MiB, WS_LORA2 = 35 * MiB, WS_RW_OUT = 134 * MiB;
constexpr size_t WS_GU = 38 * MiB, WS_DOWN = 70 * MiB, WS_MOE_ALT = 48 * MiB;
constexpr size_t WS_HF = 86 * MiB, WS_HB = 150 * MiB;
constexpr size_t WS_TOKE = 182 * MiB, WS_TOKG = WS_TOKE + 128 * 1024, WS_TOKP = WS_TOKG + 128 * 1024, WS_ROWG = WS_TOKP + 128 * 1024, WS_TILEE = WS_ROWG + 256 * 1024, WS_BLKB = WS_TILEE + 4096, WS_TOKQ = WS_BLKB + 32768, WS_P2T = WS_TOKQ + 128 * 1024;
constexpr size_t WS_FL = 184 * MiB, WS_CB = 185 * MiB;
constexpr int ECAP = 16384;
constexpr size_t WS_P2TE = 140 * MiB, WS_ROWGE = 141 * MiB;
constexpr size_t WS_ACT = 186 * MiB;
constexpr size_t WS_Q = WS_ACT, WS_K = WS_ACT + 32 * MiB, WS_V = WS_ACT + 64 * MiB, WS_OG = WS_ACT + 96 * MiB, WS_O = WS_ACT + 128 * MiB;
constexpr size_t WS_Z = WS_ACT, WS_YG = WS_ACT + 64 * MiB;
constexpr size_t WS_HM = WS_ACT, WS_RR = WS_ACT + 192 * MiB, WS_RK = WS_RR + 32 * MiB, WS_RV = WS_RK + 32 * MiB, WS_L1 = WS_RV + 32 * MiB;
constexpr size_t WS_WDEC = WS_ACT, WS_RA = WS_ACT + 64 * MiB, WS_RG = WS_ACT + 96 * MiB, WS_YSC = WS_ACT + 128 * MiB  , WS_RYG = WS_ACT  ;
constexpr size_t WS_XS = WS_ACT, WS_H1 = WS_ACT + 72 * MiB, WS_YD = WS_ACT + 108 * MiB;
constexpr size_t WS_CD0 = 2 * MiB, WS_CD1 = WS_ACT + 128 * MiB;
constexpr size_t WS_WLG = 136 * MiB;
constexpr size_t WS_SIG = 138 * MiB;
constexpr size_t WS_Y2 = WS_L1;
constexpr size_t WS_END = WS_Y2 + 32 * MiB;
constexpr int CW_BAR = 4096;
#ifndef N_LAUNCH_MODE
#define N_LAUNCH_MODE 1
#endif
constexpr int CW_CNT = N_LAUNCH_MODE == 1 ? 8192 : 200000;
constexpr size_t CTL_ZERO_BYTES = N_LAUNCH_MODE == 1 ? 40960 : CTL_BYTES;

constexpr int LDS_BYTES = 147456;
constexpr int MISC_OFF = LDS_BYTES - 256;

__device__ __forceinline__ float bf2f(unsigned b) { return __uint_as_float(b << 16); }
__device__ __forceinline__ unsigned f2bf(float f) { unsigned u = __float_as_uint(f); return (u + 0x7fffu + ((u >> 16) & 1u)) >> 16; }
typedef float f32x2_hw __attribute__((ext_vector_type(2))); typedef __bf16 bf16x2_hw __attribute__((ext_vector_type(2)));
__device__ __forceinline__ unsigned pk2(float lo, float hi) { f32x2_hw v = {lo, hi}; bf16x2_hw b = __builtin_convertvector(v, bf16x2_hw); return __builtin_bit_cast(unsigned, b); }
template <int CTRL> __device__ __forceinline__ float dppf(float v) { return __int_as_float(__builtin_amdgcn_update_dpp(0, __float_as_int(v), CTRL, 0xf, 0xf, true)); }
__device__ __forceinline__ float red16(float x) { x += dppf<0xB1>(x); x += dppf<0x4E>(x); x += dppf<0x141>(x); x += dppf<0x140>(x); return x; }
__device__ __forceinline__ float wave_sum(float v) {
    v = red16(v);
    return (__uint_as_float(__builtin_amdgcn_readlane(__float_as_uint(v), 0)) + __uint_as_float(__builtin_amdgcn_readlane(__float_as_uint(v), 16)))
         + (__uint_as_float(__builtin_amdgcn_readlane(__float_as_uint(v), 32)) + __uint_as_float(__builtin_amdgcn_readlane(__float_as_uint(v), 48)));
}
__device__ __forceinline__ float wave_max(float v) {
#pragma unroll
    for (int o = 1; o < 64; o <<= 1) v = fmaxf(v, __shfl_xor(v, o));
    return v;
}
__device__ __forceinline__ float wave_incl_scan(float v, int lane) {
#pragma unroll
    for (int o = 1; o < 64; o <<= 1) { float t = __shfl_up(v, o); if (lane >= o) v += t; }
    return v;
}
__device__ __forceinline__ float rdlane(float v, int l) { return __uint_as_float(__builtin_amdgcn_readlane(__float_as_uint(v), l)); }
__device__ __forceinline__ float sigmoidf_(float x) { return 1.0f / (1.0f + expf(-x)); }
__device__ __forceinline__ float softplusf_(float x) { return fmaxf(x, 0.f) + log1pf(expf(-fabsf(x))); }
#define LDS_WAIT() asm volatile("s_waitcnt lgkmcnt(0)" ::: "memory")

#define XB_TMO      128
#define XB_XCNT(j)  (256  + 64 * (j))
#define XB_XSUB(j)  (1280 + 64 * (j))
#define XB_XGEN(j)  (2304 + 64 * (j))
#define XB_TOP      3328
#define XB_TOPGEN   3392
#define XCD_BAR_WORDS 3456
#define XB_SPIN_CAP (1u << 24)
__device__ __forceinline__ unsigned xb_ld(unsigned* p)              { return __hip_atomic_load(p, __ATOMIC_RELAXED, __HIP_MEMORY_SCOPE_AGENT); }
__device__ __forceinline__ unsigned xb_add(unsigned* p, unsigned v) { return __hip_atomic_fetch_add(p, v, __ATOMIC_RELAXED, __HIP_MEMORY_SCOPE_AGENT); }
__device__ __forceinline__ unsigned xb_xcc_id() { return (unsigned)__builtin_amdgcn_s_getreg((3 << 11) | 20) & 0xFu; }
#define XB_SPIN(cond, bar) do { unsigned _sp = 0; while (cond) { __builtin_amdgcn_s_sleep(1); \
    if ((++_sp & 255u) == 0u) { if (xb_ld(&(bar)[XB_TMO])) break; if (_sp > XB_SPIN_CAP) { atomicAdd(&(bar)[XB_TMO], 1u); break; } } } } while (0)
struct XcdBarrier { unsigned* bar; unsigned x; volatile LAS unsigned* st; };
__device__ __forceinline__ XcdBarrier xcd_barrier_post(unsigned* bar, volatile LAS unsigned* st) {
    XcdBarrier b; b.bar = bar; b.x = xb_xcc_id(); b.st = st;
    if (threadIdx.x == 0) (void)xb_add(&bar[XB_XCNT(b.x)], 1u);
    return b;
}
__device__ __forceinline__ void xcd_barrier_complete(unsigned* bar, unsigned x, unsigned& nloc, unsigned& nx) {
    const unsigned G = gridDim.x * gridDim.y * gridDim.z;
    unsigned sum, cnt, mine, sp = 0u;
    for (;;) {
        sum = 0u; cnt = 0u; mine = 0u;
#pragma unroll
        for (unsigned j = 0; j < 16; ++j) { const unsigned c = xb_ld(&bar[XB_XCNT(j)]); sum += c; cnt += (c > 0u) ? 1u : 0u; mine = (j == x) ? c : mine; }
        if (sum == G) break;
        __builtin_amdgcn_s_sleep(1);
        if ((++sp & 255u) == 0u) { if (xb_ld(&bar[XB_TMO])) break; if (sp > XB_SPIN_CAP) { atomicAdd(&bar[XB_TMO], 1u); break; } }
    }
    nloc = mine > 0u ? mine : 1u; nx = cnt > 0u ? cnt : 1u;
}
__device__ __forceinline__ void xcd_barrier(const XcdBarrier& b) {
    asm volatile("s_waitcnt vmcnt(0)" ::: "memory");
    __syncthreads();
    if (threadIdx.x == 0) {
        unsigned* bar = b.bar;
        __builtin_amdgcn_s_waitcnt(0);
        unsigned nloc = b.st[0], nx = b.st[1];
        if (nloc == 0u) { xcd_barrier_complete(bar, b.x, nloc, nx); b.st[0] = nloc; b.st[1] = nx; }
        const unsigned old = xb_add(&bar[XB_XSUB(b.x)], 1u);
        const unsigned gen = old / nloc;
        if (old + 1u == (gen + 1u) * nloc) {
            __builtin_amdgcn_fence(__ATOMIC_RELEASE, "agent");
            asm volatile("s_waitcnt vmcnt(0)" ::: "memory");
            const unsigned og = xb_add(&bar[XB_TOP], 1u);
            const unsigned tg = og / nx;
            if (og + 1u == (tg + 1u) * nx) xb_add(&bar[XB_TOPGEN], 1u);
            else XB_SPIN(xb_ld(&bar[XB_TOPGEN]) == tg, bar);
            __builtin_amdgcn_fence(__ATOMIC_ACQUIRE, "agent");
            xb_add(&bar[XB_XGEN(b.x)], 1u);
            asm volatile("s_waitcnt vmcnt(0)" ::: "memory");
        } else {
            XB_SPIN(xb_ld(&bar[XB_XGEN(b.x)]) == gen, bar);
            __builtin_amdgcn_fence(__ATOMIC_ACQUIRE, "agent");
            asm volatile("s_waitcnt vmcnt(0)" ::: "memory");
        }
    }
    __syncthreads();
}

namespace pg8 {
#define PG8_LAS __attribute__((address_space(3)))
typedef unsigned short bf16_t;
typedef short bf16x8 __attribute__((ext_vector_type(8)));
typedef float f32x4 __attribute__((ext_vector_type(4)));
typedef unsigned u32x4 __attribute__((ext_vector_type(4)));
constexpr int BM = 256, BK = 64, HALF = 128, HTB = HALF * BK * 2  , STAGE_BYTES = 8 * HTB, NXCD = 8, WGM = 8;

__host__ __device__ __forceinline__ int lds_byte(int r, int c) { const int st = (r >> 4) * 2 + (c >> 5), rr = r & 15, cc = c & 31, ob = rr * 64 + cc * 2; return st * 1024 + (ob ^ (((ob >> 9) & 1) << 5)); }
__host__ __device__ __forceinline__ void stage_rc(int b, int& R, int& C) { const int st = b / 1024, sb = b % 1024, swz = sb ^ (((sb >> 9) & 1) << 5); R = (st >> 1) * 16 + swz / 64; C = (st & 1) * 32 + (swz % 64) / 2; }
__host__ __device__ __forceinline__ int perm32(int rho) { const int n = rho >> 4, i = rho & 15; return 8 * (i >> 2) + 4 * n + (i & 3); }

struct Unit { int pm, pn, rt, nv; };
struct Gemm { const bf16_t* A; const bf16_t* Bt; int M, N, K; const int* rowtok; };

struct StaticOrder {
    int nM, nN, nwg, G, c;
    __host__ __device__ void init(int M, int N, int G_, int c_) { nM = M / BM; nN = N / BM; nwg = nM * nN; G = G_; c = c_; }
    __host__ __device__ bool next(int i, Unit& u) const {
        const long L = (long)i * G + c; if (L >= nwg) return false;
        int wgid = (int)L; { const int q = nwg / NXCD, r = nwg % NXCD, xcd = wgid % NXCD, off = wgid / NXCD; wgid = (xcd < r ? xcd * (q + 1) : r * (q + 1) + (xcd - r) * q) + off; }
        const int nig = WGM * nN, gid = wgid / nig, fm = gid * WGM, gsz = (nM - fm) < WGM ? (nM - fm) : WGM;
        u.pm = fm + ((wgid % nig) % gsz); u.pn = (wgid % nig) / gsz; return true;
    }
    __device__ __forceinline__ void a_ready(const Unit&) const {}
    __device__ __forceinline__ void done(const Unit&) const {}
};

__device__ __forceinline__ unsigned cvt_pk_bf16(float lo, float hi) { unsigned r; asm volatile("v_cvt_pk_bf16_f32 %0, %1, %2" : "=v"(r) : "v"(lo), "v"(hi)); return r; }
typedef float f32x2 __attribute__((ext_vector_type(2)));
__device__ __forceinline__ f32x2 gelu_pk(f32x2 v) {
    const f32x2 av = __builtin_elementwise_abs(v), d = av * 0.2316418882f + 1.0f;
    f32x2 t; t.x = __builtin_amdgcn_rcpf(d.x); t.y = __builtin_amdgcn_rcpf(d.y);
    f32x2 q = t * 0.5307027145f + (-0.7265760135f); q = q * t + 0.7107068705f; q = q * t + (-0.142248368f); q = q * t + 0.127414796f; q = q * t;
    const f32x2 s = (v * v) * (-0.72134752044f);
    f32x2 e; e.x = __builtin_amdgcn_exp2f(s.x); e.y = __builtin_amdgcn_exp2f(s.y);
    const f32x2 m = v * (q * e), r = v - m;
    f32x2 o; o.x = v.x < 0.f ? m.x : r.x; o.y = v.y < 0.f ? m.y : r.y; return o;
}

template <int ACT  > struct EpiBf16 {
    static constexpr bool PERM = true, AFTER_DRAIN = false; static_assert(ACT == 0 || ACT == 1, "EpiBf16: ACT is 0 (none) or 1 (gelu_pk)");
    bf16_t* O; int ldc; const float* bias; int split_cols; size_t split_stride; float scale0;
    __device__ __forceinline__ void operator()(const f32x4 (&acc)[2][2][4][2], const Unit& u, int wr, int wc, int fr, int fq) const {
        const int row0 = u.pm * BM + wr * 64 + fr; int colt = u.pn * BM; bf16_t* base = O;
        float sc = 1.f; if (split_cols) { const int t = colt / split_cols; base += (size_t)t * split_stride; colt -= t * split_cols; if (t == 0) sc = scale0; }
        const int col0 = colt + wc * 32 + 8 * fq, bcol0 = u.pn * BM + wc * 32 + 8 * fq;
        f32x4 bv[2][2];
#pragma unroll
        for (int bj = 0; bj < 2; ++bj)
#pragma unroll
            for (int n = 0; n < 2; ++n) bv[bj][n] = bias ? *(const f32x4*)(bias + bcol0 + bj * HALF + 4 * n) : (f32x4){0.f, 0.f, 0.f, 0.f};
#pragma unroll
        for (int ai = 0; ai < 2; ++ai)
#pragma unroll
            for (int m = 0; m < 4; ++m) { bf16_t* rowp = base + (size_t)(row0 + ai * HALF + m * 16) * ldc + col0;
#pragma unroll
                for (int bj = 0; bj < 2; ++bj) { f32x4 v0 = acc[ai][bj][m][0] + bv[bj][0], v1 = acc[ai][bj][m][1] + bv[bj][1];
                    if (ACT == 1) { f32x2 a = gelu_pk((f32x2){v0[0], v0[1]}), b = gelu_pk((f32x2){v0[2], v0[3]}), c = gelu_pk((f32x2){v1[0], v1[1]}), d = gelu_pk((f32x2){v1[2], v1[3]});
                        v0 = (f32x4){a.x, a.y, b.x, b.y}; v1 = (f32x4){c.x, c.y, d.x, d.y}; }
                    v0 = v0 * sc; v1 = v1 * sc; u32x4 w; w.x = cvt_pk_bf16(v0[0], v0[1]); w.y = cvt_pk_bf16(v0[2], v0[3]); w.z = cvt_pk_bf16(v1[0], v1[1]); w.w = cvt_pk_bf16(v1[2], v1[3]);
                    *(u32x4*)(rowp + bj * HALF) = w; } }
    }
};


template <class Epi, class Sched, bool ALIGN_EPI = false, bool SP2 = false, bool GATH = false>
__device__ __forceinline__ void gemm_phase(PG8_LAS unsigned char* lds, const Gemm g, const Sched& S, const Epi& E) {
    const int tid = threadIdx.x, wid = __builtin_amdgcn_readfirstlane(tid >> 6), lane = tid & 63, wr = wid >> 2, wc = wid & 3, fr = lane & 15, fq = lane >> 4;
    const int K = g.K, nt = K / BK;
    unsigned voffA[2], voffB[2];
#pragma unroll
    for (int i = 0; i < 2; ++i) { int R, C; stage_rc(tid * 16 + i * 8192, R, C); const int Rb = Epi::PERM ? ((R & ~31) + perm32(R & 31)) : R;
        voffA[i] = (unsigned)(R * K + C) * 2u; voffB[i] = (unsigned)(Rb * K + C) * 2u; }
    static_assert(!GATH || SP2, "GATH is implemented for the SP2 loop only");
    int gR[2]; unsigned gC[2]; unsigned ogC[2][2], ogN[2][2];
    if constexpr (GATH) {
#pragma unroll
        for (int i = 0; i < 2; ++i) { int R, C; stage_rc(tid * 16 + i * 8192, R, C); gR[i] = R; gC[i] = (unsigned)C * 2u; }
    }
#define PG8_OG(og, U_) do { _Pragma("unroll") for (int h_ = 0; h_ < 2; ++h_) _Pragma("unroll") for (int i_ = 0; i_ < 2; ++i_) { const int rr_ = h_ * HALF + gR[i_]; \
        og[h_][i_] = (unsigned)(rr_ < (U_).nv ? g.rowtok[(U_).rt * BM + rr_] : 0) * (unsigned)(K * 2) + gC[i_]; } } while (0)
    const size_t kstep = (size_t)(BK * 2);
    const size_t hstep = (size_t)HALF * K * 2;
    const size_t tstep = 2 * hstep;
    const unsigned ldsw = (unsigned)wid * 1024u;
    const int aoff = lds_byte(wr * 64 + fr, fq * 8), boff = lds_byte(wc * 32 + fr, fq * 8);
#define PG8_SA(b, h) (((b) * 2 + (h)) * HTB)
#define PG8_SB(b, h) ((4 + (b) * 2 + (h)) * HTB)
#define PG8_STAGE(bufoff, gbase, voff) do { _Pragma("unroll") for (int _i = 0; _i < 2; ++_i) \
        __builtin_amdgcn_global_load_lds((const unsigned*)((const char*)(gbase) + (voff)[_i]), (PG8_LAS unsigned*)(lds + (bufoff) + ldsw + _i * 8192), 16, 0, 0); } while (0)
#define PG8_STAGE_G(bufoff, kptr, og) do { _Pragma("unroll") for (int _i = 0; _i < 2; ++_i) \
        __builtin_amdgcn_global_load_lds((const unsigned*)((const char*)(kptr) + (og)[_i]), (PG8_LAS unsigned*)(lds + (bufoff) + ldsw + _i * 8192), 16, 0, 0); } while (0)
#define PG8_STAGE_A(bufoff, tp, kp, h, sel) do { if constexpr (GATH) { unsigned og_[2] = {(sel) ? ogN[h][0] : ogC[h][0], (sel) ? ogN[h][1] : ogC[h][1]}; PG8_STAGE_G(bufoff, kp, og_); } \
        else { PG8_STAGE(bufoff, (tp) + (h) * hstep, voffA); } } while (0)
#define PG8_LDA(dst, b, h) do { _Pragma("unroll") for (int m = 0; m < 4; ++m) _Pragma("unroll") for (int k = 0; k < 2; ++k) dst[m][k] = *(const PG8_LAS bf16x8*)(lds + PG8_SA(b, h) + aoff + m * 2048 + k * 1024); } while (0)
#define PG8_LDB(dst, b, h) do { _Pragma("unroll") for (int n = 0; n < 2; ++n) _Pragma("unroll") for (int k = 0; k < 2; ++k) dst[n][k] = *(const PG8_LAS bf16x8*)(lds + PG8_SB(b, h) + boff + n * 2048 + k * 1024); } while (0)
#define PG8_MMA(ai, bj, At, Bt) do { __builtin_amdgcn_s_setprio(1); _Pragma("unroll") for (int m = 0; m < 4; ++m) _Pragma("unroll") for (int n = 0; n < 2; ++n) _Pragma("unroll") for (int k = 0; k < 2; ++k) \
        acc[ai][bj][m][n] = __builtin_amdgcn_mfma_f32_16x16x32_bf16(Bt[n][k], At[m][k], acc[ai][bj][m][n], 0, 0, 0); __builtin_amdgcn_s_setprio(0); } while (0)
#define PG8_WAIT_V(n) asm volatile("s_waitcnt vmcnt(" #n ")" ::: "memory")
#define PG8_WAIT_L(n) asm volatile("s_waitcnt lgkmcnt(" #n ")" ::: "memory")
#define PG8_BAR __builtin_amdgcn_s_barrier()
#define PG8_SCHED __builtin_amdgcn_sched_barrier(0)
    Unit cur, nxt; int ui = 0;
    if (!S.next(0, cur)) return;
    f32x4 acc[2][2][4][2];
#pragma unroll
    for (int a = 0; a < 2; ++a)
#pragma unroll
        for (int b = 0; b < 2; ++b)
#pragma unroll
            for (int m = 0; m < 4; ++m)
#pragma unroll
                for (int n = 0; n < 2; ++n) acc[a][b][m][n] = (f32x4){0.f, 0.f, 0.f, 0.f};
    bf16x8 At[4][2], B0[2][2], B1[2][2];
    const char* cA = (const char*)g.A + (size_t)cur.pm * tstep; const char* cB = (const char*)g.Bt + (size_t)cur.pn * tstep;
    const char* const gA = (const char*)g.A;
    if constexpr (GATH) { PG8_OG(ogC, cur); }
    S.a_ready(cur);
    if constexpr (SP2) {
        PG8_STAGE(PG8_SB(0, 0), cB, voffB); PG8_STAGE(PG8_SB(0, 1), cB + hstep, voffB); PG8_STAGE_A(PG8_SA(0, 0), cA, gA, 0, false); PG8_STAGE_A(PG8_SA(0, 1), cA, gA, 1, false);
        if (wr == 1) PG8_BAR;
        PG8_WAIT_V(2); PG8_BAR;
        PG8_STAGE(PG8_SB(1, 0), cB + kstep, voffB); PG8_STAGE_A(PG8_SA(1, 0), cA + kstep, gA + kstep, 0, false); PG8_STAGE(PG8_SB(1, 1), cB + hstep + kstep, voffB);
        PG8_WAIT_V(6); PG8_BAR;
    } else {
        PG8_STAGE(PG8_SB(0, 0), cB, voffB); PG8_STAGE(PG8_SA(0, 0), cA, voffA); PG8_STAGE(PG8_SB(0, 1), cB + hstep, voffB); PG8_STAGE(PG8_SA(0, 1), cA + hstep, voffA);
        if (wr == 1) PG8_BAR;
        PG8_WAIT_V(4); PG8_BAR;
        PG8_STAGE(PG8_SB(1, 0), cB + kstep, voffB); PG8_STAGE(PG8_SA(1, 0), cA + kstep, voffA); PG8_STAGE(PG8_SB(1, 1), cB + hstep + kstep, voffB);
        PG8_WAIT_V(6); PG8_BAR;
    }
    for (;;) {
        const bool has_next = S.next(ui + 1, nxt);
        if constexpr (GATH) { if (has_next) { PG8_OG(ogN, nxt); } }
        const char* nA = has_next ? (const char*)g.A + (size_t)nxt.pm * tstep : cA; const char* nB = has_next ? (const char*)g.Bt + (size_t)nxt.pn * tstep : cB;
        for (int t = 0; t < nt; t += 2) {
            const bool last = (t == nt - 2);
            const char* a1 = cA + (size_t)(t + 1) * kstep;
            const char* a2 = last ? nA : cA + (size_t)(t + 2) * kstep; const char* b2 = last ? nB : cB + (size_t)(t + 2) * kstep;
            const char* a3 = a2 + kstep; const char* b3 = b2 + kstep;
            const bool gsel = last && has_next; const char* ga1 = gA + (size_t)(t + 1) * kstep; const char* ga2 = last ? gA : gA + (size_t)(t + 2) * kstep; const char* ga3 = ga2 + kstep;
            if (last && has_next) S.a_ready(nxt);
            if constexpr (SP2) {
            PG8_LDB(B0, 0, 0); PG8_LDB(B1, 0, 1); PG8_SCHED; PG8_LDA(At, 0, 0); PG8_STAGE_A(PG8_SA(1, 1), a1, ga1, 1, false);
            PG8_WAIT_V(8); PG8_WAIT_L(0); PG8_BAR; PG8_MMA(0, 0, At, B0); PG8_MMA(0, 1, At, B1); PG8_BAR; PG8_SCHED;
            PG8_LDA(At, 0, 1); PG8_STAGE(PG8_SB(0, 0), b2, voffB); PG8_STAGE(PG8_SB(0, 1), b2 + hstep, voffB); PG8_STAGE_A(PG8_SA(0, 0), a2, ga2, 0, gsel);
            PG8_WAIT_V(8); PG8_WAIT_L(0); PG8_BAR; PG8_MMA(1, 0, At, B0); PG8_MMA(1, 1, At, B1); PG8_BAR; PG8_SCHED;
            PG8_LDB(B0, 1, 0); PG8_LDB(B1, 1, 1); PG8_SCHED; PG8_LDA(At, 1, 0); PG8_STAGE_A(PG8_SA(0, 1), a2, ga2, 1, gsel);
            PG8_WAIT_V(8); PG8_WAIT_L(0); PG8_BAR; PG8_MMA(0, 0, At, B0); PG8_MMA(0, 1, At, B1); PG8_BAR; PG8_SCHED;
            PG8_LDA(At, 1, 1); PG8_STAGE(PG8_SB(1, 0), b3, voffB); PG8_STAGE(PG8_SB(1, 1), b3 + hstep, voffB); PG8_STAGE_A(PG8_SA(1, 0), a3, ga3, 0, gsel);
            PG8_WAIT_V(8); PG8_WAIT_L(0); PG8_BAR; PG8_MMA(1, 0, At, B0); PG8_MMA(1, 1, At, B1); PG8_BAR; PG8_SCHED;
            } else {
            PG8_LDB(B0, 0, 0); PG8_SCHED; PG8_LDA(At, 0, 0); PG8_STAGE(PG8_SA(1, 1), a1 + hstep, voffA);
            PG8_WAIT_L(8); PG8_BAR; PG8_WAIT_L(0); PG8_MMA(0, 0, At, B0); PG8_BAR; PG8_SCHED;
            PG8_LDB(B1, 0, 1); PG8_STAGE(PG8_SB(0, 0), b2, voffB);
            PG8_BAR; PG8_WAIT_L(0); PG8_MMA(0, 1, At, B1); PG8_BAR;
            PG8_LDA(At, 0, 1); PG8_STAGE(PG8_SA(0, 0), a2, voffA);
            PG8_BAR; PG8_WAIT_L(0); PG8_MMA(1, 0, At, B0); PG8_BAR; PG8_SCHED;
            PG8_STAGE(PG8_SB(0, 1), b2 + hstep, voffB);
            PG8_WAIT_V(6); PG8_BAR; PG8_MMA(1, 1, At, B1); PG8_BAR;
            PG8_LDB(B0, 1, 0); PG8_SCHED; PG8_LDA(At, 1, 0); PG8_STAGE(PG8_SA(0, 1), a2 + hstep, voffA);
            PG8_WAIT_L(8); PG8_BAR; PG8_WAIT_L(0); PG8_MMA(0, 0, At, B0); PG8_BAR; PG8_SCHED;
            PG8_LDB(B1, 1, 1); PG8_STAGE(PG8_SB(1, 0), b3, voffB);
            PG8_BAR; PG8_WAIT_L(0); PG8_MMA(0, 1, At, B1); PG8_BAR;
            PG8_LDA(At, 1, 1); PG8_STAGE(PG8_SA(1, 0), a3, voffA);
            PG8_BAR; PG8_WAIT_L(0); PG8_MMA(1, 0, At, B0); PG8_BAR; PG8_SCHED;
            PG8_STAGE(PG8_SB(1, 1), b3 + hstep, voffB);
            PG8_WAIT_V(6); PG8_BAR; PG8_MMA(1, 1, At, B1); PG8_BAR;
            }
        }
        if constexpr (ALIGN_EPI) { if (wr == 0) PG8_BAR; }
        if constexpr (!Epi::AFTER_DRAIN) { E(acc, cur, wr, wc, fr, fq); S.done(cur); }
        if (!has_next) break;
#pragma unroll
        for (int a = 0; a < 2; ++a)
#pragma unroll
            for (int b = 0; b < 2; ++b)
#pragma unroll
                for (int m = 0; m < 4; ++m)
#pragma unroll
                    for (int n = 0; n < 2; ++n) acc[a][b][m][n] = (f32x4){0.f, 0.f, 0.f, 0.f};
        cur = nxt; cA = nA; cB = nB; ++ui;
        if constexpr (GATH) { ogC[0][0] = ogN[0][0]; ogC[0][1] = ogN[0][1]; ogC[1][0] = ogN[1][0]; ogC[1][1] = ogN[1][1]; }
        if constexpr (ALIGN_EPI) { if (wr == 1) PG8_BAR; }
    }
    PG8_WAIT_V(0);
    if constexpr (!ALIGN_EPI) { if (wr == 0) PG8_BAR; }
    PG8_BAR;
    if constexpr (Epi::AFTER_DRAIN) { E.fused(acc, cur, wr, wc, fr, fq, lds, wid, lane); S.done(cur); }
#undef PG8_SA
#undef PG8_SB
#undef PG8_STAGE
#undef PG8_LDA
#undef PG8_STAGE_G
#undef PG8_STAGE_A
#undef PG8_OG
#undef PG8_LDB
#undef PG8_MMA
#undef PG8_WAIT_V
#undef PG8_WAIT_L
#undef PG8_BAR
#undef PG8_SCHED
}

__device__ __forceinline__ float gelu_tanh_f(float x) { const float t = x + 0.044715f * x * x * x; return x * __builtin_amdgcn_rcpf(1.0f + __builtin_amdgcn_exp2f(-2.302208198f * t)); }
__device__ __forceinline__ float silu_f(float x) { return x * __builtin_amdgcn_rcpf(1.0f + __builtin_amdgcn_exp2f(-1.4426950408889634f * x)); }
__device__ __forceinline__ float sigm_f(float x) { return __builtin_amdgcn_rcpf(1.0f + __builtin_amdgcn_exp2f(-1.4426950408889634f * x)); }
template <int ACT  > struct EpiBf16X {
    static constexpr bool PERM = true, AFTER_DRAIN = false;
    bf16_t* O; int ldc; const float* bias; int split_cols; size_t split_stride; float scale0;
    __device__ __forceinline__ void operator()(const f32x4 (&acc)[2][2][4][2], const Unit& u, int wr, int wc, int fr, int fq) const {
        const int row0 = u.pm * BM + wr * 64 + fr; int colt = u.pn * BM; bf16_t* base = O;
        float sc = 1.f; if (split_cols) { const int t = colt / split_cols; base += (size_t)t * split_stride; colt -= t * split_cols; if (t == 0) sc = scale0; }
        const int col0 = colt + wc * 32 + 8 * fq, bcol0 = u.pn * BM + wc * 32 + 8 * fq;
        f32x4 bv[2][2];
#pragma unroll
        for (int bj = 0; bj < 2; ++bj)
#pragma unroll
            for (int n = 0; n < 2; ++n) bv[bj][n] = bias ? *(const f32x4*)(bias + bcol0 + bj * HALF + 4 * n) : (f32x4){0.f, 0.f, 0.f, 0.f};
#pragma unroll
        for (int ai = 0; ai < 2; ++ai)
#pragma unroll
            for (int m = 0; m < 4; ++m) { bf16_t* rowp = base + (size_t)(row0 + ai * HALF + m * 16) * ldc + col0;
#pragma unroll
                for (int bj = 0; bj < 2; ++bj) { f32x4 v0 = acc[ai][bj][m][0] + bv[bj][0], v1 = acc[ai][bj][m][1] + bv[bj][1];
                    if (ACT == 2) {
#pragma unroll
                        for (int i = 0; i < 4; ++i) { v0[i] = gelu_tanh_f(v0[i]); v1[i] = gelu_tanh_f(v1[i]); } }
                    v0 = v0 * sc; v1 = v1 * sc; u32x4 w; w.x = cvt_pk_bf16(v0[0], v0[1]); w.y = cvt_pk_bf16(v0[2], v0[3]); w.z = cvt_pk_bf16(v1[0], v1[1]); w.w = cvt_pk_bf16(v1[2], v1[3]);
                    *(u32x4*)(rowp + bj * HALF) = w; } }
    }
};
struct EpiResid {
    static constexpr bool PERM = true, AFTER_DRAIN = false;
    bf16_t* H; float alpha;
    __device__ __forceinline__ void operator()(const f32x4 (&acc)[2][2][4][2], const Unit& u, int wr, int wc, int fr, int fq) const {
        const int row0 = u.pm * BM + wr * 64 + fr, col0 = u.pn * BM + wc * 32 + 8 * fq;
#pragma unroll
        for (int ai = 0; ai < 2; ++ai) {
            u32x4 hres[4][2];
#pragma unroll
            for (int m = 0; m < 4; ++m)
#pragma unroll
                for (int bj = 0; bj < 2; ++bj) hres[m][bj] = *(const u32x4*)(H + (size_t)(row0 + ai * HALF + m * 16) * 1024 + col0 + bj * HALF);
#pragma unroll
            for (int m = 0; m < 4; ++m) { bf16_t* rowp = H + (size_t)(row0 + ai * HALF + m * 16) * 1024 + col0;
#pragma unroll
                for (int bj = 0; bj < 2; ++bj) { const u32x4 h = hres[m][bj]; const f32x4 a0 = acc[ai][bj][m][0], a1 = acc[ai][bj][m][1]; u32x4 w;
                    w.x = cvt_pk_bf16(alpha * __uint_as_float(h.x << 16) + a0[0], alpha * __uint_as_float(h.x & 0xffff0000u) + a0[1]);
                    w.y = cvt_pk_bf16(alpha * __uint_as_float(h.y << 16) + a0[2], alpha * __uint_as_float(h.y & 0xffff0000u) + a0[3]);
                    w.z = cvt_pk_bf16(alpha * __uint_as_float(h.z << 16) + a1[0], alpha * __uint_as_float(h.z & 0xffff0000u) + a1[1]);
                    w.w = cvt_pk_bf16(alpha * __uint_as_float(h.w << 16) + a1[2], alpha * __uint_as_float(h.w & 0xffff0000u) + a1[3]);
                    *(u32x4*)(rowp + bj * HALF) = w; } }
        }
    }
};
struct EpiSwiglu {
    static constexpr bool PERM = true, AFTER_DRAIN = false;
    bf16_t* H1;
    __device__ __forceinline__ void operator()(const f32x4 (&acc)[2][2][4][2], const Unit& u, int wr, int wc, int fr, int fq) const {
        const int row0 = u.pm * BM + wr * 64 + fr, col0 = (u.pn & 3) * 128 + wc * 32 + 8 * fq;
#pragma unroll
        for (int ai = 0; ai < 2; ++ai)
#pragma unroll
            for (int m = 0; m < 4; ++m) { bf16_t* rowp = H1 + (size_t)(row0 + ai * HALF + m * 16) * 512 + col0;
                f32x4 h0, h1;
#pragma unroll
                for (int i = 0; i < 4; ++i) { h0[i] = silu_f(acc[ai][0][m][0][i]) * acc[ai][1][m][0][i]; h1[i] = silu_f(acc[ai][0][m][1][i]) * acc[ai][1][m][1][i]; }
                u32x4 w; w.x = cvt_pk_bf16(h0[0], h0[1]); w.y = cvt_pk_bf16(h0[2], h0[3]); w.z = cvt_pk_bf16(h1[0], h1[1]); w.w = cvt_pk_bf16(h1[2], h1[3]);
                *(u32x4*)rowp = w; }
    }
};
struct EpiDown {
    static constexpr bool PERM = true, AFTER_DRAIN = false;
    bf16_t* Yd; const float* rowg;
    __device__ __forceinline__ void operator()(const f32x4 (&acc)[2][2][4][2], const Unit& u, int wr, int wc, int fr, int fq) const {
        const int row0 = u.pm * BM + wr * 64 + fr, col0 = (u.pn & 3) * BM + wc * 32 + 8 * fq;
        float scv[2][4];
#pragma unroll
        for (int ai = 0; ai < 2; ++ai)
#pragma unroll
            for (int m = 0; m < 4; ++m) scv[ai][m] = rowg[u.rt * BM + wr * 64 + fr + ai * HALF + m * 16];
#pragma unroll
        for (int ai = 0; ai < 2; ++ai)
#pragma unroll
            for (int m = 0; m < 4; ++m) { const int row = row0 + ai * HALF + m * 16; const float sc = scv[ai][m]; bf16_t* rowp = Yd + (size_t)row * 1024 + col0;
#pragma unroll
                for (int bj = 0; bj < 2; ++bj) { const f32x4 v0 = acc[ai][bj][m][0] * sc, v1 = acc[ai][bj][m][1] * sc;
                    u32x4 w; w.x = cvt_pk_bf16(v0[0], v0[1]); w.y = cvt_pk_bf16(v0[2], v0[3]); w.z = cvt_pk_bf16(v1[0], v1[1]); w.w = cvt_pk_bf16(v1[2], v1[3]);
                    *(u32x4*)(rowp + bj * HALF) = w; } }
    }
};
struct EpiRw1 {
    static constexpr bool PERM = true, AFTER_DRAIN = false;
    bf16_t* RKV; bf16_t* L1; int Trows;
    __device__ __forceinline__ void operator()(const f32x4 (&acc)[2][2][4][2], const Unit& u, int wr, int wc, int fr, int fq) const {
        const int t0 = (u.pm & 63) * BM + wr * 64 + fr;
        if (u.pn < 12) { const int cc = u.pn >> 2, col0 = (u.pn & 3) * BM + wc * 32 + 8 * fq;
#pragma unroll
            for (int ai = 0; ai < 2; ++ai)
#pragma unroll
                for (int m = 0; m < 4; ++m) { bf16_t* rowp = RKV + (size_t)cc * Trows * 1024 + (size_t)(t0 + ai * HALF + m * 16) * 1024 + col0;
#pragma unroll
                    for (int bj = 0; bj < 2; ++bj) { const f32x4 v0 = acc[ai][bj][m][0], v1 = acc[ai][bj][m][1];
                        u32x4 w; w.x = cvt_pk_bf16(v0[0], v0[1]); w.y = cvt_pk_bf16(v0[2], v0[3]); w.z = cvt_pk_bf16(v1[0], v1[1]); w.w = cvt_pk_bf16(v1[2], v1[3]);
                        *(u32x4*)(rowp + bj * HALF) = w; } }
        } else { const int j = u.pn - 12, col0 = wc * 32 + 8 * fq;
#pragma unroll
            for (int ai = 0; ai < 2; ++ai)
#pragma unroll
                for (int m = 0; m < 4; ++m) { bf16_t* rowp = L1 + (size_t)j * Trows * 128 + (size_t)(t0 + ai * HALF + m * 16) * 128 + col0;
                    f32x4 v0 = acc[ai][0][m][0], v1 = acc[ai][0][m][1];
#pragma unroll
                    for (int i = 0; i < 4; ++i) { if (j == 0) { v0[i] = 2.f * sigm_f(2.f * v0[i]) - 1.f; v1[i] = 2.f * sigm_f(2.f * v1[i]) - 1.f; } else if (j == 2) { v0[i] = sigm_f(v0[i]); v1[i] = sigm_f(v1[i]); } }
                    u32x4 w; w.x = cvt_pk_bf16(v0[0], v0[1]); w.y = cvt_pk_bf16(v0[2], v0[3]); w.z = cvt_pk_bf16(v1[0], v1[1]); w.w = cvt_pk_bf16(v1[2], v1[3]);
                    *(u32x4*)rowp = w; }
        }
    }
};
struct EpiRw2 {
    static constexpr bool PERM = true, AFTER_DRAIN = false;
    float* Wdec; bf16_t* A; bf16_t* G; const float* w0; const float* a0;
    __device__ __forceinline__ void operator()(const f32x4 (&acc)[2][2][4][2], const Unit& u, int wr, int wc, int fr, int fq) const {
        const int j = u.pn >> 2, t0 = (u.pm & 63) * BM + wr * 64 + fr, col0 = (u.pn & 3) * BM + wc * 32 + 8 * fq;
#pragma unroll
        for (int ai = 0; ai < 2; ++ai)
#pragma unroll
            for (int m = 0; m < 4; ++m) { const size_t ro = (size_t)(t0 + ai * HALF + m * 16) * 1024 + col0;
#pragma unroll
                for (int bj = 0; bj < 2; ++bj) { f32x4 v0 = acc[ai][bj][m][0], v1 = acc[ai][bj][m][1]; const size_t o = ro + bj * HALF;
                    if (j == 0) { const f32x4 b0 = __builtin_bit_cast(f32x4, *(const u32x4*)(w0 + col0 + bj * HALF)), b1 = __builtin_bit_cast(f32x4, *(const u32x4*)(w0 + col0 + bj * HALF + 4));
#pragma unroll
                        for (int i = 0; i < 4; ++i) { v0[i] = -0.8750387749f * sigm_f(v0[i] + b0[i]); v1[i] = -0.8750387749f * sigm_f(v1[i] + b1[i]); }
                        *(f32x4*)(Wdec + o) = v0; *(f32x4*)(Wdec + o + 4) = v1;
                    } else { if (j == 1) { const f32x4 b0 = __builtin_bit_cast(f32x4, *(const u32x4*)(a0 + col0 + bj * HALF)), b1 = __builtin_bit_cast(f32x4, *(const u32x4*)(a0 + col0 + bj * HALF + 4));
#pragma unroll
                            for (int i = 0; i < 4; ++i) { v0[i] = sigm_f(v0[i] + b0[i]); v1[i] = sigm_f(v1[i] + b1[i]); } }
                        u32x4 w; w.x = cvt_pk_bf16(v0[0], v0[1]); w.y = cvt_pk_bf16(v0[2], v0[3]); w.z = cvt_pk_bf16(v1[0], v1[1]); w.w = cvt_pk_bf16(v1[2], v1[3]);
                        if (j == 1) *(u32x4*)(A + o) = w; else *(u32x4*)(G + o) = w; } } }
    }
};
struct Rw1Order { int G, c;
    __device__ __forceinline__ bool next(int i, Unit& u) const { const int L = i * G + c; if (L >= 960) return false;
        if (L < 768) { const int cc = L >> 8, mt = (L & 255) >> 2, pn = L & 3; u.pm = cc * 64 + mt; u.pn = cc * 4 + pn; } else { const int L2 = L - 768, cc = 3 + (L2 >> 6), mt = L2 & 63; u.pm = cc * 64 + mt; u.pn = 9 + cc; }
        return true; }
    __device__ __forceinline__ void a_ready(const Unit&) const {}
    __device__ __forceinline__ void done(const Unit&) const {} };
struct Rw2Order { int G, c;
    __device__ __forceinline__ bool next(int i, Unit& u) const { const int L = i * G + c; if (L >= 768) return false; const int j = L >> 8, mt = (L & 255) >> 2, pn = L & 3; u.pm = j * 64 + mt; u.pn = j * 4 + pn; return true; }
    __device__ __forceinline__ void a_ready(const Unit&) const {}
    __device__ __forceinline__ void done(const Unit&) const {} };
constexpr int MOE_TAB = 131072;
struct MoeOrder { const PG8_LAS int* tab; int G, c;
    __device__ __forceinline__ bool next(int i, Unit& u) const {
        const int nt = __builtin_amdgcn_readfirstlane(tab[768]);
        const int L = i * G + c; if (L >= nt * 4) return false; const int mt = L >> 2;
        const int e = __builtin_amdgcn_readfirstlane(tab[mt]), j = __builtin_amdgcn_readfirstlane(tab[256 + mt]);
        u.pm = mt; u.pn = e * 4 + (L & 3); u.rt = e * (ECAP / BM) + j; u.nv = __builtin_amdgcn_readfirstlane(tab[512 + mt]); return true; }
    __device__ __forceinline__ void a_ready(const Unit&) const {}
    __device__ __forceinline__ void done(const Unit&) const {} };
}

namespace attn_body {
using bf16=__hip_bfloat16;
using bf16x8=__attribute__((ext_vector_type(8)))short;
using s16x4=__attribute__((ext_vector_type(4)))short;
using f32x16=__attribute__((ext_vector_type(16)))float;
using u32x4=__attribute__((ext_vector_type(4)))unsigned;
using f32x4_t=__attribute__((ext_vector_type(4)))float;
constexpr int BATCH=4,NHEAD=16,SEQ=4096,D=64,DM=NHEAD*D;
constexpr int NW=8,QBLK=32,QB=QBLK*NW,KVBLK=64,NQB=SEQ/QB;
constexpr int ATTN_PITCH=DM, ATTN_UNIT_ROWS=QB;
__device__ __forceinline__ int crow(int r,int hi){return (r&3)+8*(r>>2)+4*hi;}
#define SBAR() __builtin_amdgcn_sched_barrier(0)
__device__ __forceinline__ void cmask(f32x16&p0,f32x16&p1,int jb,int qrel,int hi){
  const float NEG=-INFINITY; int kb=64*jb+4*hi;
  #pragma unroll
  for(int r=0;r<16;++r){int kv=kb+(r&3)+8*(r>>2); if(kv>qrel)p0[r]=NEG; if(kv+32>qrel)p1[r]=NEG;}
}

constexpr int NSLOT=3, SLOTB=8192;
constexpr int LDS_K=0, LDS_V=NSLOT*SLOTB, LDS_WS=2*NSLOT*SLOTB, LDS_OST=LDS_WS+NW*64*4, LDS_CB=LDS_OST+NW*4096, LDS_BYTES=LDS_CB+SEQ*8;
constexpr float C2=0.125f*1.4426950408889634f;
__device__ __forceinline__ void glds16(const void*gsrc,unsigned lds_dst){unsigned keep;
  asm volatile("s_mov_b32 %0, m0\n\ts_mov_b32 m0, %2\n\ts_nop 0\n\tglobal_load_lds_dwordx4 %1, off\n\ts_mov_b32 m0, %0":"=&s"(keep):"v"(gsrc),"s"(lds_dst):"memory");}
__device__ __forceinline__ void glds16s(unsigned voff,const void*sbase,unsigned lds_dst){unsigned keep;
  asm volatile("s_mov_b32 %0, m0\n\ts_mov_b32 m0, %2\n\ts_nop 2\n\tglobal_load_lds_dwordx4 %1, %3\n\ts_mov_b32 m0, %0":"=&s"(keep):"v"(voff),"s"(lds_dst),"s"(sbase):"memory");}
__device__ __forceinline__ float max3f(float a,float b,float c){float r;asm("v_max3_f32 %0, %1, %2, %3":"=v"(r):"v"(a),"v"(b),"v"(c));return r;}
__device__ __forceinline__ float max2f(float a,float b){float r;asm("v_max_f32_e32 %0, %1, %2":"=v"(r):"v"(a),"v"(b));return r;}
__device__ __forceinline__ float fadd_s(float a,float b){float r;asm("v_add_f32_e32 %0, %1, %2":"=v"(r):"v"(a),"v"(b));return r;}
__device__ __forceinline__ float fsub_s(float a,float b){float r;asm("v_sub_f32_e32 %0, %1, %2":"=v"(r):"v"(a),"v"(b));return r;}
typedef float f32x2_t __attribute__((ext_vector_type(2))); typedef __bf16 bf16x2_t __attribute__((ext_vector_type(2)));
__device__ __forceinline__ unsigned cvtpk_s(float lo,float hi){f32x2_t v={lo,hi};bf16x2_t b=__builtin_convertvector(v,bf16x2_t);return __builtin_bit_cast(unsigned,b);}
#define WAIT_BAR(N) asm volatile("s_waitcnt vmcnt(" #N ") lgkmcnt(0)\n\ts_barrier":::"memory")
typedef unsigned u32x2_t __attribute__((ext_vector_type(2)));
__device__ __forceinline__ unsigned bfr_(float x){unsigned u=__float_as_uint(x);return (u+0x7fffu+((u>>16)&1u))>>16;}
__device__ __forceinline__ void split3(float v,unsigned&h1,unsigned&h2,unsigned&h3){h1=bfr_(v);const float r1=v-__uint_as_float(h1<<16);h2=bfr_(r1);const float r2=r1-__uint_as_float(h2<<16);h3=bfr_(r2);}

__device__ __forceinline__ void qkt(f32x16&p0,f32x16&p1,const char*Kslot,const bf16x8*qr,const f32x16&negm,int r32,int hi){
  const char*kb=Kslot+hi*1024+r32*16;
  #pragma unroll
  for(int d0=0;d0<4;++d0){
    const bf16x8 b0=*reinterpret_cast<const bf16x8*>(kb+d0*2048);
    const bf16x8 b1=*reinterpret_cast<const bf16x8*>(kb+d0*2048+512);
    if(d0==0){p0=__builtin_amdgcn_mfma_f32_32x32x16_bf16(b0,qr[0],negm,0,0,0);p1=__builtin_amdgcn_mfma_f32_32x32x16_bf16(b1,qr[0],negm,0,0,0);}
    else{p0=__builtin_amdgcn_mfma_f32_32x32x16_bf16(b0,qr[d0],p0,0,0,0);p1=__builtin_amdgcn_mfma_f32_32x32x16_bf16(b1,qr[d0],p1,0,0,0);}}
}
typedef __attribute__((address_space(3))) const char* lds_cptr;
typedef short v4i16_t __attribute__((ext_vector_type(4)));
__device__ __forceinline__ void kload8(bf16x8*kf,lds_cptr kp){
  kf[0]=*(const __attribute__((address_space(3))) bf16x8*)(kp);      kf[1]=*(const __attribute__((address_space(3))) bf16x8*)(kp+512);
  kf[2]=*(const __attribute__((address_space(3))) bf16x8*)(kp+2048); kf[3]=*(const __attribute__((address_space(3))) bf16x8*)(kp+2560);
  kf[4]=*(const __attribute__((address_space(3))) bf16x8*)(kp+4096); kf[5]=*(const __attribute__((address_space(3))) bf16x8*)(kp+4608);
  kf[6]=*(const __attribute__((address_space(3))) bf16x8*)(kp+6144); kf[7]=*(const __attribute__((address_space(3))) bf16x8*)(kp+6656);
}
__device__ __forceinline__ void kload2(bf16x8*kf,lds_cptr kp,int j){ kf[2*j]=*(const __attribute__((address_space(3))) bf16x8*)(kp+j*2048); kf[2*j+1]=*(const __attribute__((address_space(3))) bf16x8*)(kp+j*2048+512); }
__device__ __forceinline__ s16x4 vtr(lds_cptr p){ return __builtin_bit_cast(s16x4,__builtin_amdgcn_ds_read_tr16_b64_v4i16((__attribute__((address_space(3))) v4i16_t*)p)); }
__device__ __forceinline__ float rowmax(const f32x16&p0,const f32x16&p1){
  float a=max3f(p0[0],p0[1],p1[0]),b=max3f(p0[2],p0[3],p1[1]);a=max3f(a,p1[2],p1[3]);
  #pragma unroll
  for(int r=4;r<16;r+=4){a=max3f(a,p0[r],p0[r+1]);b=max3f(b,p0[r+2],p0[r+3]);a=max3f(a,p1[r],p1[r+1]);b=max3f(b,p1[r+2],p1[r+3]);}
  const float m=max2f(a,b);
  auto rr=__builtin_amdgcn_permlane32_swap(__float_as_uint(m),__float_as_uint(m),false,false);
  return max2f(__uint_as_float(rr[0]),__uint_as_float(rr[1]));
}
__device__ __forceinline__ void pv(f32x16*o,int vb,bf16x8 pa0,bf16x8 pa1,bf16x8 pa2,bf16x8 pa3){
  #pragma unroll
  for(int d0=0;d0<2;++d0){s16x4 lo[4],hi[4];
    #pragma unroll
    for(int ks=0;ks<4;++ks){
      asm volatile("ds_read_b64_tr_b16 %0,%1 offset:%c2":"=&v"(lo[ks]):"v"(vb),"i"(d0*4096+ks*1024):"memory");
      asm volatile("ds_read_b64_tr_b16 %0,%1 offset:%c2":"=&v"(hi[ks]):"v"(vb),"i"(d0*4096+ks*1024+512):"memory");}
    asm volatile("s_waitcnt lgkmcnt(0)":::"memory");SBAR();
    #define PK(k) (bf16x8){lo[k][0],lo[k][1],lo[k][2],lo[k][3],hi[k][0],hi[k][1],hi[k][2],hi[k][3]}
    o[d0]=__builtin_amdgcn_mfma_f32_32x32x16_bf16(pa0,PK(0),o[d0],0,0,0);
    o[d0]=__builtin_amdgcn_mfma_f32_32x32x16_bf16(pa1,PK(1),o[d0],0,0,0);
    o[d0]=__builtin_amdgcn_mfma_f32_32x32x16_bf16(pa2,PK(2),o[d0],0,0,0);
    o[d0]=__builtin_amdgcn_mfma_f32_32x32x16_bf16(pa3,PK(3),o[d0],0,0,0);
    #undef PK
  }
}

#ifndef ATTN_STORE16
#define ATTN_STORE16(p,v) (*(u32x4*)(p)=(v))
#endif
template<int THRL> __device__ __forceinline__ void attn_unit(int b,int h,int qb,const bf16*Q,const bf16*__restrict__ K,const bf16*__restrict__ V,bf16*O,const float*CBg,const bf16*OGg,bool loadcb,float bnd2,char*shm){
  const int tid=threadIdx.x,lane=tid&63,r32=lane&31,hi=lane>>5; const int wid=__builtin_amdgcn_readfirstlane(tid>>6);
  const long rowbase=(long)b*SEQ; const int q0=qb*QB;
  const bf16*Qw=Q+(rowbase+q0+wid*QBLK)*DM+h*D;
  const bf16*Kh=K+rowbase*DM+h*D,*Vh=V+rowbase*DM+h*D;
  const unsigned lds0=(unsigned)(uintptr_t)shm;
  float*wsf=(float*)(shm+LDS_WS)+wid*64;
  int ln2_=lane; asm volatile("":"+v"(ln2_));
  const unsigned koff=(unsigned)(ln2_*DM+wid*8)*2u;
  const unsigned voff=(unsigned)((16*(wid&3)+(ln2_>>2))*DM+(wid>>2)*32+(ln2_&3)*8)*2u;
  const unsigned kdst=lds0+LDS_K+wid*1024, vdst=lds0+LDS_V+wid*1024;
  #define DMA_K(t,slot) glds16s(koff,Kh+(long)(t)*KVBLK*DM,(unsigned)__builtin_amdgcn_readfirstlane(kdst+(slot)))
  #define DMA_V(t,slot) glds16s(voff,Vh+(long)(t)*KVBLK*DM,(unsigned)__builtin_amdgcn_readfirstlane(vdst+(slot)))
  const int vb0=(int)(lds0+LDS_V)+((lane>>4)&1)*32+(lane&3)*8+(4*hi+((lane&15)>>2))*64;
  const char*Kbase=shm+LDS_K; bf16x8 kf[8];
  const lds_cptr shm3=(lds_cptr)shm; const lds_cptr kp0=shm3+LDS_K+hi*1024+r32*16; const lds_cptr vp0=shm3+LDS_V+((lane>>4)&1)*32+(lane&3)*8+(4*hi+((lane&15)>>2))*64;
  int NT=(q0+QB)/KVBLK;
  typedef __attribute__((address_space(3))) const u32x2_t* lds_u2p; lds_u2p bt=(lds_u2p)(shm3+LDS_CB)+r32;
  if(loadcb){ const float*src=CBg+(long)(b*NHEAD+h)*SEQ; u32x2_t*dst=(u32x2_t*)(shm+LDS_CB);
    #pragma unroll
    for(int i=0;i<8;++i){ const int kv=tid+512*i; unsigned h1,h2,h3; split3(src[kv],h1,h2,h3); dst[kv]=(u32x2_t){h1|(h2<<16),h3|0x3F800000u}; }
    asm volatile("s_waitcnt vmcnt(0) lgkmcnt(0)\n\ts_barrier":::"memory"); }
  { const lds_u2p b0_=(lds_u2p)(shm3+LDS_CB);
    #define BTV(kv) ({ const u32x2_t e_=b0_[kv]; __uint_as_float(e_.x<<16)+__uint_as_float(e_.x&0xffff0000u)+__uint_as_float(e_.y<<16); })
    const float bq0_=BTV(q0); int cand_=NT-4;
    while(cand_>=2){ const float d_=bq0_-BTV(64*cand_-1); if(__builtin_amdgcn_readfirstlane(d_>=bnd2?1:0))break; cand_-=2; }
    #undef BTV
    const int T0_=cand_>=2?cand_:0; Kh+=(long)T0_*KVBLK*DM; Vh+=(long)T0_*KVBLK*DM; bt+=64*T0_; NT-=T0_; }
  u32x4 Bq; const unsigned hm_=hi?0u:0xffffffffu;
  #define SETBQ(mh) do{ unsigned h1_,h2_,h3_; split3(-(mh),h1_,h2_,h3_); Bq.x=0x3F803F80u&hm_; Bq.y=(0x3F80u|(h1_<<16))&hm_; Bq.z=(h2_|(h3_<<16))&hm_; Bq.w=0u; }while(0)
  #define BIASM(P0,P1,t) do{ const u32x2_t a0_=bt[64*(t)],a1_=bt[64*(t)+32]; \
      P0=__builtin_amdgcn_mfma_f32_32x32x16_bf16(__builtin_bit_cast(bf16x8,(u32x4){a0_.x,a0_.y,0x3F803F80u,0u}),__builtin_bit_cast(bf16x8,Bq),P0,0,0,0); \
      P1=__builtin_amdgcn_mfma_f32_32x32x16_bf16(__builtin_bit_cast(bf16x8,(u32x4){a1_.x,a1_.y,0x3F803F80u,0u}),__builtin_bit_cast(bf16x8,Bq),P1,0,0,0); }while(0)
  SETBQ(0.f);
  DMA_K(0,0);DMA_V(0,0);DMA_K(1,SLOTB);
  bf16x8 qr[4];
  #pragma unroll
  for(int d0=0;d0<4;++d0)qr[d0]=*reinterpret_cast<const bf16x8*>(&Qw[(long)r32*DM+d0*16+hi*8]);
  float mhat=0.f,l_reg=0.f;f32x16 o[2];o[0]=f32x16{};o[1]=f32x16{};const f32x16 zero16=f32x16{};
  const int qrel=wid*QBLK+r32;
  #define CMASK(P0,P1,t) do{int jb_=(t)-(NT-4); if(jb_>=0)cmask(P0,P1,jb_,qrel,hi);}while(0)
  bool resc=false;
  #define START(P0,P1) do{ const float rm=rowmax(P0,P1); resc=false; \
    { const float dl=rm; mhat=fadd_s(mhat,dl); \
      _Pragma("unroll") for(int r=0;r<16;++r){P0[r]=fsub_s(P0[r],dl);P1[r]=fsub_s(P1[r],dl);} \
      SETBQ(mhat); } \
    _Pragma("unroll") for(int r=0;r<16;++r)P0[r]=__builtin_amdgcn_exp2f(P0[r]); }while(0)
  #define RESC() do{ if(resc){ asm volatile("s_waitcnt lgkmcnt(0)":::"memory"); \
      _Pragma("unroll") for(int d_=0;d_<2;++d_) _Pragma("unroll") for(int r=0;r<16;++r)o[d_][r]*=wsf[crow(r,hi)]; } }while(0)
  f32x16 pA0,pA1,pB0,pB1;
  int sl_prev=0,sl_cur=0,sl_next=SLOTB;
  #define ROT() do{sl_prev=sl_cur;sl_cur=sl_next;sl_next=(sl_next==(NSLOT-1)*SLOTB)?0:sl_next+SLOTB;}while(0)
  DMA_K(2,2*SLOTB);
  WAIT_BAR(3);
  qkt(pA0,pA1,Kbase,qr,zero16,r32,hi);BIASM(pA0,pA1,0);asm volatile("s_nop 15\n\ts_nop 7":"+v"(pA0),"+v"(pA1));CMASK(pA0,pA1,0);
  START(pA0,pA1);
  _Pragma("unroll") for(int r=0;r<16;++r)pA1[r]=__builtin_amdgcn_exp2f(pA1[r]);
  WAIT_BAR(0);
  DMA_K(3,0);DMA_V(1,SLOTB);
  ROT();
  kload8(kf,kp0+sl_cur);
  WAIT_BAR(2);
  s16x4 vlo[8],vhi[8]; u32x4 pw0,pw1,pw2,pw3;
  #define PKW(P,B) cvtpk_s(P[B],P[B+1])
  #define PAF(k) __builtin_bit_cast(bf16x8,pw##k)
  #define VFR(i) (bf16x8){vlo[i][0],vlo[i][1],vlo[i][2],vlo[i][3],vhi[i][0],vhi[i][1],vhi[i][2],vhi[i][3]}
  #define PIN(x) asm volatile("":"+v"(x))
  #define MX3(a,b,c) __builtin_fmaxf(__builtin_fmaxf((a),(b)),(c))
  #define GAPA(MF,A0,A1,A2,A3,W0,W1,PW) do{ MF; sacc+=A0; sacc+=A1; sacc+=A2; sacc+=A3; PIN(sacc); W0; W1; PIN(PW); SBAR(); }while(0)
  #define EX(v) __builtin_amdgcn_exp2f(v)
  #define GAPB(MF,X,B) do{ MF; X[B]=EX(X[B]); X[B+1]=EX(X[B+1]); X[B+2]=EX(X[B+2]); X[B+3]=EX(X[B+3]); PIN(X); SBAR(); }while(0)
  #define VRD(i) do{ vlo[i]=vtr(vp_+(((i)>>2)*4096+((i)&3)*1024)); vhi[i]=vtr(vp_+(((i)>>2)*4096+((i)&3)*1024+512)); }while(0)
  #define KRD(G,j) do{ if(G){ kload2(kf,kp0+sl_next,j); SBAR(); } }while(0)
  #define STEP(C0,C1,P0,P1,t,GK,GV,GL) do{ SBAR(); \
    const lds_cptr vp_=vp0+sl_prev; \
    VRD(0); SBAR(); float sacc=(P0[0]+P0[1]); \
    GAPA(C0=__builtin_amdgcn_mfma_f32_32x32x16_bf16(kf[0],qr[0],zero16,0,0,0), P0[2],P0[3],P0[4],P0[5],     pw0[0]=PKW(P0,0), pw0[1]=PKW(P0,2), pw0); \
    VRD(4); SBAR(); GAPA(C1=__builtin_amdgcn_mfma_f32_32x32x16_bf16(kf[1],qr[0],zero16,0,0,0), P0[6],P0[7],P0[8],P0[9],     pw0[2]=PKW(P0,4), pw0[3]=PKW(P0,6), pw0); \
    VRD(1); SBAR(); GAPA(C0=__builtin_amdgcn_mfma_f32_32x32x16_bf16(kf[2],qr[1],C0,0,0,0),   P0[10],P0[11],P0[12],P0[13], pw1[0]=PKW(P0,8), pw1[1]=PKW(P0,10), pw1); \
    VRD(5); SBAR(); GAPA(C1=__builtin_amdgcn_mfma_f32_32x32x16_bf16(kf[3],qr[1],C1,0,0,0),   P0[14],P0[15],P1[0],P1[1],   pw1[2]=PKW(P0,12),pw1[3]=PKW(P0,14), pw1); \
    VRD(2); SBAR(); GAPA(C0=__builtin_amdgcn_mfma_f32_32x32x16_bf16(kf[4],qr[2],C0,0,0,0),   P1[2],P1[3],P1[4],P1[5],     pw2[0]=PKW(P1,0), pw2[1]=PKW(P1,2), pw2); \
    VRD(6); SBAR(); GAPA(C1=__builtin_amdgcn_mfma_f32_32x32x16_bf16(kf[5],qr[2],C1,0,0,0),   P1[6],P1[7],P1[8],P1[9],     pw2[2]=PKW(P1,4), pw2[3]=PKW(P1,6), pw2); \
    VRD(3); SBAR(); GAPA(C0=__builtin_amdgcn_mfma_f32_32x32x16_bf16(kf[6],qr[3],C0,0,0,0),   P1[10],P1[11],P1[12],P1[13], pw3[0]=PKW(P1,8), pw3[1]=PKW(P1,10), pw3); \
    VRD(7); SBAR(); GAPA(C1=__builtin_amdgcn_mfma_f32_32x32x16_bf16(kf[7],qr[3],C1,0,0,0),   P1[14],P1[15],0.f,0.f,       pw3[2]=PKW(P1,12),pw3[3]=PKW(P1,14), pw3); \
    l_reg+=sacc; \
    if(GK){DMA_K((t)+3,sl_cur);} if(GV){DMA_V((t)+1,sl_next);} \
    BIASM(C0,C1,t); CMASK(C0,C1,t); \
    { float a=MX3(C0[0],C0[1],C1[0]),b=MX3(C0[2],C0[3],C1[1]); a=MX3(a,C1[2],C1[3]); \
      _Pragma("unroll") for(int r=4;r<16;r+=4){a=MX3(a,C0[r],C0[r+1]);b=MX3(b,C0[r+2],C0[r+3]);a=MX3(a,C1[r],C1[r+1]);b=MX3(b,C1[r+2],C1[r+3]);} \
      float rm=__builtin_fmaxf(a,b); { auto rr=__builtin_amdgcn_permlane32_swap(__float_as_uint(rm),__float_as_uint(rm),false,false); rm=__builtin_fmaxf(__uint_as_float(rr[0]),__uint_as_float(rr[1])); } \
      resc=false; \
      if(__builtin_expect(__any(rm>(float)THRL),0)){ const float dl=__builtin_fmaxf(rm,0.f); mhat+=dl; \
        _Pragma("unroll") for(int r=0;r<16;++r){C0[r]-=dl;C1[r]-=dl;} \
        SETBQ(mhat); \
        const float f=__builtin_amdgcn_exp2f(-dl); l_reg*=f; if(hi==0)wsf[r32]=f; resc=true; } } \
    SBAR(); \
    GAPB(o[0]=__builtin_amdgcn_mfma_f32_32x32x16_bf16(PAF(0),VFR(0),o[0],0,0,0), C0,0); \
    GAPB(o[1]=__builtin_amdgcn_mfma_f32_32x32x16_bf16(PAF(0),VFR(4),o[1],0,0,0), C0,4); \
    KRD(GL,0); GAPB(o[0]=__builtin_amdgcn_mfma_f32_32x32x16_bf16(PAF(1),VFR(1),o[0],0,0,0), C0,8); \
    KRD(GL,1); GAPB(o[1]=__builtin_amdgcn_mfma_f32_32x32x16_bf16(PAF(1),VFR(5),o[1],0,0,0), C0,12); \
    KRD(GL,2); GAPB(o[0]=__builtin_amdgcn_mfma_f32_32x32x16_bf16(PAF(2),VFR(2),o[0],0,0,0), C1,0); \
    KRD(GL,3); GAPB(o[1]=__builtin_amdgcn_mfma_f32_32x32x16_bf16(PAF(2),VFR(6),o[1],0,0,0), C1,4); \
    GAPB(o[0]=__builtin_amdgcn_mfma_f32_32x32x16_bf16(PAF(3),VFR(3),o[0],0,0,0), C1,8); \
    GAPB(o[1]=__builtin_amdgcn_mfma_f32_32x32x16_bf16(PAF(3),VFR(7),o[1],0,0,0), C1,12); \
    }while(0)
  int t=1;
  #undef CMASK
  #define CMASK(P0,P1,t) do{}while(0)
  for(;t+5<NT;t+=2){
    STEP(pB0,pB1,pA0,pA1,t,true,true,true);     WAIT_BAR(2); RESC(); ROT();
    STEP(pA0,pA1,pB0,pB1,t+1,true,true,true);   WAIT_BAR(2); RESC(); ROT();
  }
  #undef CMASK
  #define CMASK(P0,P1,t) do{int jb_=(t)-(NT-4); if(jb_>=0)cmask(P0,P1,jb_,qrel,hi);}while(0)
  #define ENDW(tt) do{ if((tt)+3<NT){WAIT_BAR(2);} else if((tt)+2<NT){WAIT_BAR(1);} else {WAIT_BAR(0);} }while(0)
  for(;t+1<NT;t+=2){
    STEP(pB0,pB1,pA0,pA1,t,(t+3<NT),(t+1<NT),(t+1<NT));       ENDW(t);   RESC(); ROT();
    STEP(pA0,pA1,pB0,pB1,t+1,(t+4<NT),(t+2<NT),(t+2<NT));     ENDW(t+1); RESC(); ROT();
  }
  STEP(pB0,pB1,pA0,pA1,NT-1,false,false,false); RESC();
  { float sacc=pB0[0]+pB0[1]; _Pragma("unroll") for(int r=2;r<16;++r)sacc+=pB0[r]; _Pragma("unroll") for(int r=0;r<16;++r)sacc+=pB1[r]; l_reg+=sacc;
    pw0=(u32x4){PKW(pB0,0),PKW(pB0,2),PKW(pB0,4),PKW(pB0,6)};pw1=(u32x4){PKW(pB0,8),PKW(pB0,10),PKW(pB0,12),PKW(pB0,14)};pw2=(u32x4){PKW(pB1,0),PKW(pB1,2),PKW(pB1,4),PKW(pB1,6)};pw3=(u32x4){PKW(pB1,8),PKW(pB1,10),PKW(pB1,12),PKW(pB1,14)};
    SBAR(); pv(o,vb0+sl_cur,PAF(0),PAF(1),PAF(2),PAF(3)); }
  #undef PKW
  #undef PAF
  #undef VFR
  #undef PIN
  #undef MX3
  #undef GAPA
  #undef GAPB
  #undef EX
  #undef VRD
  #undef KRD
  #undef STEP
  #undef ENDW
  {auto rr=__builtin_amdgcn_permlane32_swap(__float_as_uint(l_reg),__float_as_uint(l_reg),false,false);l_reg=__uint_as_float(rr[0])+__uint_as_float(rr[1]);}
  if(hi==0)wsf[32+r32]=l_reg;asm volatile("s_waitcnt lgkmcnt(0)":::"memory");
  float rli[16];
  #pragma unroll
  for(int r=0;r<16;++r)rli[r]=__builtin_amdgcn_rcpf(wsf[32+crow(r,hi)]);
  bf16*Ow=O+(rowbase+q0+wid*QBLK)*DM+h*D;
  { bf16*stg=(bf16*)(shm+LDS_OST)+wid*2048;
    #pragma unroll
    for(int r=0;r<16;++r){const int orow=crow(r,hi);
      #pragma unroll
      for(int d0=0;d0<2;++d0)stg[orow*64+d0*32+r32]=__float2bfloat16(o[d0][r]*rli[r]);}
    asm volatile("s_waitcnt lgkmcnt(0)":::"memory");
    int ln_=lane; asm volatile("":"+v"(ln_));
    #pragma unroll
    for(int i=0;i<4;++i){const int row=i*8+(ln_>>3),ch=ln_&7; u32x4 v=*(const u32x4*)(stg+row*64+ch*8);
      if(OGg){ const u32x4 gt=*(const u32x4*)(OGg+(rowbase+q0+wid*QBLK+row)*DM+h*D+ch*8);
        _Pragma("unroll") for(int e=0;e<4;++e){ const float a0=__uint_as_float(v[e]<<16)*__builtin_amdgcn_rcpf(1.f+__builtin_amdgcn_exp2f(-1.4426950408889634f*__uint_as_float(gt[e]<<16)));
          const float a1=__uint_as_float(v[e]&0xffff0000u)*__builtin_amdgcn_rcpf(1.f+__builtin_amdgcn_exp2f(-1.4426950408889634f*__uint_as_float(gt[e]&0xffff0000u))); v[e]=cvtpk_s(a0,a1); } }
      ATTN_STORE16(Ow+(long)row*DM+ch*8,v);} }
  asm volatile("s_waitcnt lgkmcnt(0)\n\ts_barrier":::"memory");
  #undef BIASM
  #undef SETBQ
  #undef DMA_K
  #undef DMA_V
  #undef CMASK
  #undef START
  #undef RESC
  #undef ROT
}
constexpr int ATTN_LDS_BYTES=LDS_BYTES;
struct AttnTensors { const bf16* Q; const bf16* K; const bf16* V; bf16* O; const float* CB; const bf16* OG; };
struct AttnUnit { int bh; int qb; };
struct StaticOrder {
  int vcu,G;
  __device__ __forceinline__ explicit StaticOrder(int grid,int block):vcu((grid%8==0)?(block%8)*(grid/8)+block/8:block),G(grid){}
  __device__ __forceinline__ bool next(int i,AttnUnit&u)const{ const int vc=vcu+(i>>2)*G; if(vc>=256)return false; const int s=vc&3,k=i&3; u.bh=vc>>2; u.qb=(k==0)?s:(k==1)?7-s:(k==2)?8+s:15-s; return true; }
  __device__ __forceinline__ void a_ready(const AttnUnit&)const{}
  __device__ __forceinline__ void done(const AttnUnit&)const{}
};
template<class Sched,int THRL=60> __device__ __forceinline__ void attn_phase(char*lds,const AttnTensors&T,const Sched&S){
  AttnUnit u;
  int prev=-1; float bnd2=1e30f;
  for(int i=0;S.next(i,u);++i){ S.a_ready(u);
    if(u.bh!=prev){
      int tid=threadIdx.x; asm volatile("":"+v"(tid)); const int lane=tid&63,wid=tid>>6; const long rb=(long)(u.bh/NHEAD)*SEQ*DM+(u.bh%NHEAD)*D; float mq=0.f,mk=0.f;
      #pragma unroll 8
      for(int r=tid>>3;r<SEQ;r+=64){ const int cch=tid&7; const u32x4 a=*(const u32x4*)(T.Q+rb+(long)r*DM+cch*8), c=*(const u32x4*)(T.K+rb+(long)r*DM+cch*8); float sq=0.f,sk=0.f;
        #pragma unroll
        for(int e=0;e<4;++e){ const float a0=__uint_as_float(a[e]<<16),a1=__uint_as_float(a[e]&0xffff0000u),c0=__uint_as_float(c[e]<<16),c1=__uint_as_float(c[e]&0xffff0000u); sq+=a0*a0+a1*a1; sk+=c0*c0+c1*c1; }
        sq+=::dppf<0xB1>(sq); sk+=::dppf<0xB1>(sk); sq+=::dppf<0x4E>(sq); sk+=::dppf<0x4E>(sk); sq+=::dppf<0x141>(sq); sk+=::dppf<0x141>(sk);
        mq=fmaxf(mq,sq); mk=fmaxf(mk,sk); }
      #pragma unroll
      for(int o=1;o<64;o<<=1){ mq=fmaxf(mq,__shfl_xor(mq,o)); mk=fmaxf(mk,__shfl_xor(mk,o)); }
      float*red=(float*)(lds+LDS_WS);
      if(lane==0){ red[wid*2]=mq; red[wid*2+1]=mk; }
      asm volatile("s_waitcnt lgkmcnt(0)\n\ts_barrier":::"memory");
      float aq=0.f,ak=0.f;
      #pragma unroll
      for(int w=0;w<NW;++w){ aq=fmaxf(aq,red[w*2]); ak=fmaxf(ak,red[w*2+1]); }
      asm volatile("s_waitcnt lgkmcnt(0)\n\ts_barrier":::"memory");
      bnd2=__uint_as_float((unsigned)__builtin_amdgcn_readfirstlane((int)__float_as_uint(2.f*sqrtf(aq*ak)*1.01f+48.f))); }
    attn_unit<THRL>(u.bh/NHEAD,u.bh%NHEAD,u.qb,T.Q,T.K,T.V,T.O,T.CB,T.OG,u.bh!=prev,bnd2,lds); prev=u.bh; S.done(u); }
}

constexpr int SB_K=0, SB_V=2*SLOTB, SB_FLAG=4*SLOTB, SB_OST=SB_FLAG+256, SB_BYTES=SB_OST+NW*4096;
constexpr float SB_THR=48.0f;
__device__ __forceinline__ void sb_unit(int b,int h,int qb,const bf16*Q,const bf16*__restrict__ K,const bf16*__restrict__ V,bf16*O,char*shm){
  const int tid=threadIdx.x,lane=tid&63,r32=lane&31,hi=lane>>5; const int wid=__builtin_amdgcn_readfirstlane(tid>>6);
  const long rowbase=(long)b*SEQ; const int q0=qb*QB;
  const bf16*Qw=Q+(rowbase+q0+wid*QBLK)*DM+h*D;
  const bf16*Kh=K+rowbase*DM+h*D,*Vh=V+rowbase*DM+h*D;
  const unsigned lds0=(unsigned)(uintptr_t)shm;
  const unsigned koff=(unsigned)(lane*DM+wid*8)*2u;
  const unsigned voff=(unsigned)((16*(wid&3)+(lane>>2))*DM+(wid>>2)*32+(lane&3)*8)*2u;
  const unsigned kdst=lds0+SB_K+wid*1024, vdst=lds0+SB_V+wid*1024;
  #define SB_DMA_K(t,slot) glds16s(koff,Kh+(long)(t)*KVBLK*DM,(unsigned)__builtin_amdgcn_readfirstlane(kdst+(slot)))
  #define SB_DMA_V(t,slot) glds16s(voff,Vh+(long)(t)*KVBLK*DM,(unsigned)__builtin_amdgcn_readfirstlane(vdst+(slot)))
  const int vb0=(int)(lds0+SB_V)+((lane>>4)&1)*32+(lane&3)*8+(4*hi+((lane&15)>>2))*64;
  volatile unsigned*flag=(volatile unsigned*)(shm+SB_FLAG);
  int j=(q0+QB)/KVBLK-1;
  SB_DMA_K(j,0);SB_DMA_V(j,0);
  bf16x8 qr[4];
  #pragma unroll
  for(int d0=0;d0<4;++d0)qr[d0]=*reinterpret_cast<const bf16x8*>(&Qw[(long)r32*DM+d0*16+hi*8]);
  f32x16 o[2];o[0]=f32x16{};o[1]=f32x16{};
  const f32x16 zero16=f32x16{};
  float carry=0.f; bool mydone=false;
  const int qw0=q0+wid*QBLK, tq=qw0+r32;
  int slot=0;
  for(int it=0;j>=0;--j,++it){
    WAIT_BAR(0);
    if(it>0){ unsigned all=1u;
      #pragma unroll
      for(int w=0;w<NW;++w)all&=flag[((it-1)&1)*8+w];
      if(__builtin_amdgcn_readfirstlane(all))break; }
    if(j>0){SB_DMA_K(j-1,slot^SLOTB);SB_DMA_V(j-1,slot^SLOTB);}
    if(64*j<=qw0+30&&!mydone){
      f32x16 p0,p1;
      qkt(p0,p1,shm+SB_K+slot,qr,zero16,r32,hi);
      if(64*j+64>qw0){ const int kb=64*j+4*hi;
        #pragma unroll
        for(int r=0;r<16;++r){const int kv=kb+(r&3)+8*(r>>2); if(!(kv<tq))p0[r]=-INFINITY; if(!(kv+32<tq))p1[r]=-INFINITY;} }
      f32x16 s0,s1;
      #pragma unroll
      for(int r=0;r<16;++r){ s0[r]=__builtin_fmaxf(p0[r],0.f)+__builtin_amdgcn_logf(1.f+__builtin_amdgcn_exp2f(-__builtin_fabsf(p0[r])));
                             s1[r]=__builtin_fmaxf(p1[r],0.f)+__builtin_amdgcn_logf(1.f+__builtin_amdgcn_exp2f(-__builtin_fabsf(p1[r]))); }
      float w1[2][4],w0[2][4],gl[2][4],gh[2][4];
      #pragma unroll
      for(int g=0;g<4;++g){ w1[0][g]=s0[4*g+3]+s0[4*g+2]; w0[0][g]=w1[0][g]+s0[4*g+1]; const float gs0=w0[0][g]+s0[4*g];
                            w1[1][g]=s1[4*g+3]+s1[4*g+2]; w0[1][g]=w1[1][g]+s1[4*g+1]; const float gs1=w0[1][g]+s1[4*g];
        auto ra=__builtin_amdgcn_permlane32_swap(__float_as_uint(gs0),__float_as_uint(gs0),false,false); gl[0][g]=__uint_as_float(ra[0]); gh[0][g]=__uint_as_float(ra[1]);
        auto rb=__builtin_amdgcn_permlane32_swap(__float_as_uint(gs1),__float_as_uint(gs1),false,false); gl[1][g]=__uint_as_float(rb[0]); gh[1][g]=__uint_as_float(rb[1]); }
      float run=carry, base[2][4];
      #pragma unroll
      for(int blk=1;blk>=0;--blk)
        #pragma unroll
        for(int g=3;g>=0;--g){ const float eh=run; run+=gh[blk][g]; const float el=run; run+=gl[blk][g]; base[blk][g]=hi?eh:el; }
      carry=run;
      #pragma unroll
      for(int g=0;g<4;++g){
        p0[4*g+3]=__builtin_amdgcn_exp2f(p0[4*g+3]-s0[4*g+3]-base[0][g]);
        p0[4*g+2]=__builtin_amdgcn_exp2f(p0[4*g+2]-s0[4*g+2]-base[0][g]-s0[4*g+3]);
        p0[4*g+1]=__builtin_amdgcn_exp2f(p0[4*g+1]-s0[4*g+1]-base[0][g]-w1[0][g]);
        p0[4*g  ]=__builtin_amdgcn_exp2f(p0[4*g  ]-s0[4*g  ]-base[0][g]-w0[0][g]);
        p1[4*g+3]=__builtin_amdgcn_exp2f(p1[4*g+3]-s1[4*g+3]-base[1][g]);
        p1[4*g+2]=__builtin_amdgcn_exp2f(p1[4*g+2]-s1[4*g+2]-base[1][g]-s1[4*g+3]);
        p1[4*g+1]=__builtin_amdgcn_exp2f(p1[4*g+1]-s1[4*g+1]-base[1][g]-w1[1][g]);
        p1[4*g  ]=__builtin_amdgcn_exp2f(p1[4*g  ]-s1[4*g  ]-base[1][g]-w0[1][g]); }
      u32x4 pw0,pw1,pw2,pw3;
      pw0=(u32x4){cvtpk_s(p0[0],p0[1]),cvtpk_s(p0[2],p0[3]),cvtpk_s(p0[4],p0[5]),cvtpk_s(p0[6],p0[7])};
      pw1=(u32x4){cvtpk_s(p0[8],p0[9]),cvtpk_s(p0[10],p0[11]),cvtpk_s(p0[12],p0[13]),cvtpk_s(p0[14],p0[15])};
      pw2=(u32x4){cvtpk_s(p1[0],p1[1]),cvtpk_s(p1[2],p1[3]),cvtpk_s(p1[4],p1[5]),cvtpk_s(p1[6],p1[7])};
      pw3=(u32x4){cvtpk_s(p1[8],p1[9]),cvtpk_s(p1[10],p1[11]),cvtpk_s(p1[12],p1[13]),cvtpk_s(p1[14],p1[15])};
      SBAR(); pv(o,vb0+slot,__builtin_bit_cast(bf16x8,pw0),__builtin_bit_cast(bf16x8,pw1),__builtin_bit_cast(bf16x8,pw2),__builtin_bit_cast(bf16x8,pw3));
      mydone=__all(carry>SB_THR)!=0;
    }
    if(lane==0)flag[(it&1)*8+wid]=mydone?1u:0u;
    slot^=SLOTB;
  }
  bf16*Ow=O+(rowbase+q0+wid*QBLK)*DM+h*D;
  { bf16*stg=(bf16*)(shm+SB_OST)+wid*2048;
    #pragma unroll
    for(int r=0;r<16;++r){const int orow=crow(r,hi);
      #pragma unroll
      for(int d0=0;d0<2;++d0)stg[orow*64+d0*32+r32]=__float2bfloat16(o[d0][r]);}
    asm volatile("s_waitcnt lgkmcnt(0)":::"memory");
    #pragma unroll
    for(int i=0;i<4;++i){const int row=i*8+(lane>>3),ch=lane&7; const u32x4 v=*(const u32x4*)(stg+row*64+ch*8); *(u32x4*)(Ow+(long)row*DM+ch*8)=v;} }
  asm volatile("s_waitcnt vmcnt(0) lgkmcnt(0)\n\ts_barrier":::"memory");
  #undef SB_DMA_K
  #undef SB_DMA_V
}
struct SbOrder {
  int vcu,G;
  __device__ __forceinline__ explicit SbOrder(int grid,int block):vcu((grid%8==0)?(block%8)*(grid/8)+block/8:block),G(grid){}
  __device__ __forceinline__ bool next(int i,AttnUnit&u)const{ const int L=(vcu+(i>>2)*G)*4+(i&3); if(L>=BATCH*NHEAD*NQB)return false; u.bh=L/NQB; u.qb=L%NQB; return true; }
};
template<class Sched> __device__ __forceinline__ void sb_phase(char*lds,const AttnTensors&T,const Sched&S){
  AttnUnit u;
  for(int i=0;S.next(i,u);++i) sb_unit(u.bh/NHEAD,u.bh%NHEAD,u.qb,T.Q,T.K,T.V,T.O,lds);
}
#undef SBAR
#undef WAIT_BAR
}

struct Params {
    const float* in[38];
    float* out; unsigned char* ws;
    int ph_lo, ph_hi, li, pad;
};
enum { I_X = 0, I_LN1G, I_LN1B, I_LN2G, I_LN2B, I_FOX_WIN, I_FOX_BF, I_FOX_WOUT, I_GM_WIN, I_GM_BIN, I_GM_LNG, I_GM_LNB, I_GM_WS, I_GM_BS, I_GM_WOUT,
       I_SB_WIN, I_SB_WOUT, I_RW_MU, I_RW_WRKV, I_RW_W0, I_RW_W1, I_RW_W2, I_RW_A0, I_RW_A1, I_RW_A2, I_RW_G1, I_RW_G2, I_RW_KK, I_RW_KA, I_RW_RK,
       I_RW_GNG, I_RW_GNB, I_RW_WOUT, I_ROUTER_W, I_ROUTER_B, I_MOE_G, I_MOE_U, I_MOE_D };

struct Ctx { int tid, lane, wave, gw, ngw; unsigned char* lds; };

__device__ __forceinline__ void tr_tile(const float* src, int ld, bf16* dst, int ldt, float* scr, int lane) {
    float tv[32];
#pragma unroll
    for (int i = 0; i < 32; ++i) tv[i] = __builtin_nontemporal_load(src + (size_t)(2 * i + (lane >> 5)) * ld + (lane & 31));
#pragma unroll
    for (int i = 0; i < 32; ++i) scr[(2 * i + (lane >> 5)) * 33 + (lane & 31)] = tv[i];
    LDS_WAIT();
    const int c = lane & 7;
#pragma unroll
    for (int j = 0; j < 4; ++j) { const int n = (lane >> 3) + 8 * j; const float* s = scr + (8 * c) * 33 + n;
        u32x4 o; o.x = pk2(s[0 * 33], s[1 * 33]); o.y = pk2(s[2 * 33], s[3 * 33]); o.z = pk2(s[4 * 33], s[5 * 33]); o.w = pk2(s[6 * 33], s[7 * 33]);
        *(u32x4*)(dst + (size_t)n * ldt + 8 * c) = o; }
    LDS_WAIT();
}
__device__ __forceinline__ void conv_matrix(const Ctx& c, const float* W, int ld, int K, int ncols, bf16* WT, int ldt, int mode) {
    float* scr = (float*)(c.lds + c.wave * 16384);
    const int nblk = ncols / 32, nit = (K / 64) * nblk;
    for (int it = c.gw; it < nit; it += c.ngw) {
        const int kb = it / nblk, nb = it % nblk, n0 = nb * 32, k0 = kb * 64;
        int orow = n0; if (mode) orow = (n0 >> 7) * 256 + (n0 & 127) + (mode == 2 ? 128 : 0);
        tr_tile(W + (size_t)k0 * ld + n0, ld, WT + (size_t)orow * ldt + k0, ldt, scr, c.lane);
    }
}
__device__ __forceinline__ void conv_moe_items(const Ctx& c, const Params& p, int l, int it0, int it1, int w, int nw) {
    float* scr = (float*)(c.lds + c.wave * 16384);
    bf16* gu = (bf16*)(p.ws + WS_GU + (size_t)(l & 1) * WS_MOE_ALT); bf16* dn = (bf16*)(p.ws + WS_DOWN + (size_t)(l & 1) * WS_MOE_ALT);
    for (int it = it0 + w; it < it1; it += nw) {
        const int mtx = it >> 8, sub = it & 255, kind = mtx / 16, e = mtx % 16;
        if (kind < 2) {
            const float* W = p.in[kind == 0 ? I_MOE_G : I_MOE_U] + (size_t)(l * 16 + e) * 1024 * 512;
            const int kb = sub / 16, nb = sub % 16, n0 = nb * 32, k0 = kb * 64;
            const int orow = (n0 >> 7) * 256 + (n0 & 127) + (kind == 1 ? 128 : 0);
            tr_tile(W + (size_t)k0 * 512 + n0, 512, gu + (size_t)e * 1024 * 1024 + (size_t)orow * 1024 + k0, 1024, scr, c.lane);
        } else {
            const float* W = p.in[I_MOE_D] + (size_t)(l * 16 + e) * 512 * 1024;
            const int kb = sub / 32, nb = sub % 32, n0 = nb * 32, k0 = kb * 64;
            tr_tile(W + (size_t)k0 * 1024 + n0, 1024, dn + (size_t)e * 1024 * 512 + (size_t)n0 * 512 + k0, 512, scr, c.lane);
        }
    }
}
struct ConvDesc { int in_idx, src_off, ld, K, ncols; unsigned dst; int ldt; };
__device__ __forceinline__ void conv_list(const Ctx& c, const Params& p, const ConvDesc* tab, int n, int w, int nw) {
    float* scr = (float*)(c.lds + c.wave * 16384);
    int total = 0;
    for (int i = 0; i < n; ++i) total += (tab[i].K / 64) * (tab[i].ncols / 32);
    for (int it = w; it < total; it += nw) {
        int r = it, i = 0;
        for (; i < n - 1; ++i) { const int ni = (tab[i].K / 64) * (tab[i].ncols / 32); if (r < ni) break; r -= ni; }
        const ConvDesc d = tab[i]; const int nblk = d.ncols / 32, kb = r / nblk, nb = r % nblk;
        const float* src = p.in[I_FOX_WIN];
#define CSEL(ix) if (d.in_idx == ix) src = p.in[ix];
        CSEL(I_FOX_WOUT) CSEL(I_GM_WIN) CSEL(I_GM_WOUT) CSEL(I_SB_WIN) CSEL(I_SB_WOUT) CSEL(I_RW_WRKV) CSEL(I_RW_W1) CSEL(I_RW_A1) CSEL(I_RW_G1) CSEL(I_RW_W2) CSEL(I_RW_A2) CSEL(I_RW_G2) CSEL(I_RW_WOUT)
#undef CSEL
        tr_tile(src + d.src_off + (size_t)(kb * 64) * d.ld + nb * 32, d.ld, (bf16*)(p.ws + d.dst) + (size_t)(nb * 32) * d.ldt + kb * 64, d.ldt, scr, c.lane);
    }
}
__device__ const ConvDesc CONV_FOX[3] = { {I_FOX_WIN, 0, 4112, 1024, 3072, (unsigned)WS_FOX_IN, 1024}, {I_FOX_WIN, 3088, 4112, 1024, 1024, (unsigned)(WS_FOX_IN + 3072 * 1024 * 2), 1024}, {I_FOX_WOUT, 0, 1024, 1024, 1024, (unsigned)WS_FOX_OUT, 1024} };
__device__ const ConvDesc CONV_GM[2] = { {I_GM_WIN, 0, 2048, 1024, 2048, (unsigned)WS_GM_IN, 1024}, {I_GM_WOUT, 0, 1024, 1024, 1024, (unsigned)WS_GM_OUT, 1024} };
__device__ const ConvDesc CONV_SB[2] = { {I_SB_WIN, 0, 3072, 1024, 3072, (unsigned)WS_SB_IN, 1024}, {I_SB_WOUT, 0, 1024, 1024, 1024, (unsigned)WS_SB_OUT, 1024} };
__device__ const ConvDesc CONV_RW[10] = { {I_RW_WRKV, 0, 1024, 1024, 1024, (unsigned)WS_RKV, 1024}, {I_RW_WRKV, 1024 * 1024, 1024, 1024, 1024, (unsigned)(WS_RKV + 2 * MiB), 1024}, {I_RW_WRKV, 2 * 1024 * 1024, 1024, 1024, 1024, (unsigned)(WS_RKV + 4 * MiB), 1024},
    {I_RW_W1, 0, 64, 1024, 64, (unsigned)WS_LORA1, 1024}, {I_RW_A1, 0, 64, 1024, 64, (unsigned)(WS_LORA1 + 256 * 1024 * 2), 1024}, {I_RW_G1, 0, 128, 1024, 128, (unsigned)(WS_LORA1 + 512 * 1024 * 2), 1024},
    {I_RW_W2, 0, 1024, 64, 1024, (unsigned)WS_LORA2, 128}, {I_RW_A2, 0, 1024, 64, 1024, (unsigned)(WS_LORA2 + 1024 * 128 * 2), 128}, {I_RW_G2, 0, 1024, 128, 1024, (unsigned)(WS_LORA2 + 2048 * 128 * 2), 128},
    {I_RW_WOUT, 0, 1024, 1024, 1024, (unsigned)WS_RW_OUT, 1024} };
__device__ const ConvDesc CONV_RWS[6] = { {I_RW_W1, 0, 64, 1024, 64, (unsigned)WS_LORA1, 1024}, {I_RW_A1, 0, 64, 1024, 64, (unsigned)(WS_LORA1 + 256 * 1024 * 2), 1024}, {I_RW_G1, 0, 128, 1024, 128, (unsigned)(WS_LORA1 + 512 * 1024 * 2), 1024}, {I_RW_W2, 0, 1024, 64, 1024, (unsigned)WS_LORA2, 128}, {I_RW_A2, 0, 1024, 64, 1024, (unsigned)(WS_LORA2 + 1024 * 128 * 2), 128}, {I_RW_G2, 0, 1024, 128, 1024, (unsigned)(WS_LORA2 + 2048 * 128 * 2), 128} };

template <int NA> __device__ __forceinline__ void conv_pair(const Ctx& c, const float* Win, const float* Wout, bf16* dA, bf16* dB, int w, int nw) {
    float* scr = (float*)(c.lds + c.wave * 16384);
    constexpr int nbA = NA / 32, nA = 16 * nbA, nB = 16 * 32;
    for (int it = w; it < nA + nB; it += nw) {
        if (it < nA) { const int kb = it / nbA, nb = it % nbA; tr_tile(Win + (size_t)(kb * 64) * NA + nb * 32, NA, dA + (size_t)(nb * 32) * 1024 + kb * 64, 1024, scr, c.lane); }
        else { const int r = it - nA, kb = r / 32, nb = r % 32; tr_tile(Wout + (size_t)(kb * 64) * 1024 + nb * 32, 1024, dB + (size_t)(nb * 32) * 1024 + kb * 64, 1024, scr, c.lane); }
    }
}
__device__ __forceinline__ void conv_rw_big(const Ctx& c, const float* Wrkv, const float* Wout, bf16* dRkv, bf16* dOut, int w, int nw) {
    float* scr = (float*)(c.lds + c.wave * 16384);
    for (int it = w; it < 4 * 512; it += nw) { const int m = it >> 9, r = it & 511, kb = r >> 5, nb = r & 31;
        const float* src = m < 3 ? Wrkv + (size_t)m * 1024 * 1024 : Wout; bf16* dst = m < 3 ? dRkv + (size_t)m * 1024 * 1024 : dOut;
        tr_tile(src + (size_t)(kb * 64) * 1024 + nb * 32, 1024, dst + (size_t)(nb * 32) * 1024 + kb * 64, 1024, scr, c.lane); }
}
constexpr int CW_PULL = 9216;
__device__ __forceinline__ void conv_up0_pull(const Ctx& c, const Params& p) {
    float* scr = (float*)(c.lds + c.wave * 16384);
    unsigned* ctr = (unsigned*)(p.ws + WS_CTL) + CW_PULL; bf16* gu = (bf16*)(p.ws + WS_GU);
    volatile LAS unsigned* slot = (volatile LAS unsigned*)((LAS unsigned char*)c.lds + 131072 + 4096);
    for (;;) {
        __syncthreads();
        if (c.tid == 0) *slot = atomicAdd(ctr, 16u);
        __syncthreads();
        const unsigned base = *slot; if (base >= 16u * 256u) break;
#pragma unroll 1
        for (int k = 0; k < 2; ++k) { const unsigned it = base + 2u * (unsigned)c.wave + (unsigned)k;
            const int e = (int)(it >> 8), sub = (int)(it & 255u), kb = sub / 16, nb = sub % 16, n0 = nb * 32, k0 = kb * 64, orow = (n0 >> 7) * 256 + (n0 & 127) + 128;
            tr_tile(p.in[I_MOE_U] + (size_t)e * 1024 * 512 + (size_t)k0 * 512 + n0, 512, gu + (size_t)e * 1024 * 1024 + (size_t)orow * 1024 + k0, 1024, scr, c.lane); }
    }
}
__device__ __forceinline__ bool tail_slot(const Ctx& c, int nunits, int& w, int& nw, int bid) {
    const int G = gridDim.x, rem = nunits % G;
    if (rem == 0 || (G - rem) * 2 < G) { w = bid * NW + c.wave; nw = G * NW; return true; }
    if (bid < rem) return false;
    w = (bid - rem) * NW + c.wave; nw = (G - rem) * NW; return true;
}

struct Row { f32x4 v[4]; };
__device__ __forceinline__ Row row_load(const float* r, int lane) { Row x; const f32x4* p = (const f32x4*)r + lane;
#pragma unroll
    for (int j = 0; j < 4; ++j) x.v[j] = __builtin_nontemporal_load(p + 64 * j); return x; }
__device__ __forceinline__ Row row_load_bf(const bf16* r, int lane) { Row x; const unsigned long long* p = (const unsigned long long*)r + lane;
#pragma unroll
    for (int j = 0; j < 4; ++j) { const unsigned long long a = p[64 * j]; x.v[j][0] = bf2f((unsigned)a & 0xffffu); x.v[j][1] = bf2f((unsigned)a >> 16); x.v[j][2] = bf2f((unsigned)(a >> 32) & 0xffffu); x.v[j][3] = bf2f((unsigned)(a >> 48)); } return x; }
__device__ __forceinline__ void row_store(float* r, int lane, const Row& x) { f32x4* p = (f32x4*)r + lane;
#pragma unroll
    for (int j = 0; j < 4; ++j) __builtin_nontemporal_store(x.v[j], p + 64 * j); }
__device__ __forceinline__ void row_store_bf(bf16* r, int lane, const Row& x) { unsigned long long* p = (unsigned long long*)r + lane;
#pragma unroll
    for (int j = 0; j < 4; ++j) p[64 * j] = (unsigned long long)pk2(x.v[j].x, x.v[j].y) | ((unsigned long long)pk2(x.v[j].z, x.v[j].w) << 32); }
__device__ __forceinline__ Row row_ln(const Row& x, const float* g, const float* b, int lane) {
    float s = 0.f;
#pragma unroll
    for (int j = 0; j < 4; ++j) s += (x.v[j].x + x.v[j].y) + (x.v[j].z + x.v[j].w);
    const float mean = wave_sum(s) * (1.f / D); float s2 = 0.f; Row y;
#pragma unroll
    for (int j = 0; j < 4; ++j) { y.v[j] = x.v[j] - mean; s2 += (y.v[j].x * y.v[j].x + y.v[j].y * y.v[j].y) + (y.v[j].z * y.v[j].z + y.v[j].w * y.v[j].w); }
    const float rstd = 1.0f / sqrtf(wave_sum(s2) * (1.f / D) + LN_EPS);
    const f32x4* gp = (const f32x4*)g + lane; const f32x4* bp = (const f32x4*)b + lane;
#pragma unroll
    for (int j = 0; j < 4; ++j) y.v[j] = y.v[j] * rstd * gp[64 * j] + bp[64 * j];
    return y;
}
__device__ __forceinline__ void stage_w16(const Ctx& c, const float* W, int ld, float* tab) {
    for (int i = c.tid; i < 1024 * 4; i += NTHR) { const int col = i >> 2, e4 = i & 3; const f32x4 w = *(const f32x4*)(W + (size_t)col * ld + e4 * 4);
        tab[(e4 * 4 + 0) * 1024 + col] = w.x; tab[(e4 * 4 + 1) * 1024 + col] = w.y; tab[(e4 * 4 + 2) * 1024 + col] = w.z; tab[(e4 * 4 + 3) * 1024 + col] = w.w; }
}
__device__ __forceinline__ void row_dot16(const Row& x, const float* tab, int lane, float (&out)[16]) {
    const LAS f32x4* tp = (const LAS f32x4*)(LAS const float*)tab + lane;
#pragma unroll
    for (int e = 0; e < 16; ++e) {
        f32x4 a = x.v[0] * tp[e * 256]; a += x.v[1] * tp[e * 256 + 64]; a += x.v[2] * tp[e * 256 + 128]; a += x.v[3] * tp[e * 256 + 192];
        out[e] = (a.x + a.y) + (a.z + a.w);
        if ((e & 3) == 3) asm volatile("" ::: "memory");
    }
    float b8[8], c4[4];
#pragma unroll
    for (int k = 0; k < 8; ++k) { auto r = __builtin_amdgcn_permlane32_swap(__float_as_uint(out[k]), __float_as_uint(out[k + 8]), false, false); b8[k] = __uint_as_float(r[0]) + __uint_as_float(r[1]); }
#pragma unroll
    for (int k = 0; k < 4; ++k) { auto r = __builtin_amdgcn_permlane16_swap(__float_as_uint(b8[k]), __float_as_uint(b8[k + 4]), false, false); c4[k] = red16(__uint_as_float(r[0]) + __uint_as_float(r[1])); }
#pragma unroll
    for (int rho = 0; rho < 4; ++rho)
#pragma unroll
        for (int k = 0; k < 4; ++k) out[4 * rho + k] = rdlane(c4[k], 16 * rho);
}

__device__ __forceinline__ void phase_p0(const Ctx& c, const Params& p) {
    unsigned char* ws = p.ws;
    conv_list(c, p, CONV_FOX, 3, c.gw, c.ngw); conv_list(c, p, CONV_RWS, 6, c.gw, c.ngw);
    {
        const int gt = c.gw * 64 + c.lane, ngt = c.ngw * 64;
        u32x4 z = {0u, 0u, 0u, 0u};
        u32x4* l1 = (u32x4*)(ws + WS_LORA1);
        for (int i = gt; i < 768 * 128; i += ngt) { const int row = i >> 7, blk = row >> 8, r = row & 255; if (r >= (blk == 2 ? 128 : 64)) l1[i] = z; }
        u32x4* l2 = (u32x4*)(ws + WS_LORA2);
        for (int i = gt; i < 2048 * 16; i += ngt) { if ((i & 15) >= 8) l2[i] = z; }
        const float* wsrc = p.in[I_GM_WS]; bf16* wd = (bf16*)(ws + WS_GM_WS);
        for (int i = gt; i < 8 * 128 * 128; i += ngt) { const int s = i & 127, t = (i >> 7) & 127; wd[i] = (bf16)f2bf(s <= t ? wsrc[i] : 0.f); }
    }
    conv_moe_items(c, p, 0, 0, 16 * 256, c.gw, c.ngw);
    bf16* Hb = (bf16*)(ws + WS_HB); float* FL = (float*)(ws + WS_FL);
    __syncthreads(); float* tab = (float*)c.lds; stage_w16(c, p.in[I_FOX_WIN] + 3072, 4112, tab); __syncthreads();
    for (int m = c.gw; m < T; m += c.ngw) {
        Row x = row_load(p.in[I_X] + (size_t)m * D, c.lane);
        row_store_bf(Hb + (size_t)m * D, c.lane, x);
        float fl[16]; row_dot16(x, tab, c.lane, fl);
        if (c.lane < 16) { float v = fl[0];
#pragma unroll
            for (int e = 1; e < 16; ++e) v = (c.lane == e) ? fl[e] : v;
            FL[(size_t)m * 16 + c.lane] = v; }
    }
}

struct GDesc { int arow0, brow0, pm, pn; };
template <class Sched, class Epi>
__device__ __forceinline__ void gemm_naive(const Ctx& c, const bf16* A, int lda, const bf16* Bt, int ldb, int K, const Sched& S, const Epi& E) {
    float* As = (float*)c.lds;
    float* Bs = As + 32 * 132;
    const int tid = c.tid, ty = tid >> 4, tx = tid & 15;
    for (int ui = blockIdx.x;; ui += gridDim.x) {
        GDesc d; if (!S.get(ui, d)) break;
        float acc[4][16];
#pragma unroll
        for (int i = 0; i < 4; ++i)
#pragma unroll
            for (int j = 0; j < 16; ++j) acc[i][j] = 0.f;
        for (int k0 = 0; k0 < K; k0 += 32) {
            { const int r = tid >> 2, kc = (tid & 3) * 8;
              const u32x4 v = *(const u32x4*)(A + (size_t)(d.arow0 + r) * lda + k0 + kc);
              As[(kc + 0) * 132 + r] = bf2f(v.x & 0xffffu); As[(kc + 1) * 132 + r] = bf2f(v.x >> 16);
              As[(kc + 2) * 132 + r] = bf2f(v.y & 0xffffu); As[(kc + 3) * 132 + r] = bf2f(v.y >> 16);
              As[(kc + 4) * 132 + r] = bf2f(v.z & 0xffffu); As[(kc + 5) * 132 + r] = bf2f(v.z >> 16);
              As[(kc + 6) * 132 + r] = bf2f(v.w & 0xffffu); As[(kc + 7) * 132 + r] = bf2f(v.w >> 16); }
#pragma unroll
            for (int jj = 0; jj < 2; ++jj) { const int idx = tid + 512 * jj, r = idx >> 2, kc = (idx & 3) * 8;
              const u32x4 v = *(const u32x4*)(Bt + (size_t)(d.brow0 + r) * ldb + k0 + kc);
              Bs[(kc + 0) * 260 + r] = bf2f(v.x & 0xffffu); Bs[(kc + 1) * 260 + r] = bf2f(v.x >> 16);
              Bs[(kc + 2) * 260 + r] = bf2f(v.y & 0xffffu); Bs[(kc + 3) * 260 + r] = bf2f(v.y >> 16);
              Bs[(kc + 4) * 260 + r] = bf2f(v.z & 0xffffu); Bs[(kc + 5) * 260 + r] = bf2f(v.z >> 16);
              Bs[(kc + 6) * 260 + r] = bf2f(v.w & 0xffffu); Bs[(kc + 7) * 260 + r] = bf2f(v.w >> 16); }
            __syncthreads();
#pragma unroll 4
            for (int k = 0; k < 32; ++k) {
                const f32x4 a = *(const f32x4*)&As[k * 132 + ty * 4];
#pragma unroll
                for (int q = 0; q < 4; ++q) { const f32x4 b = *(const f32x4*)&Bs[k * 260 + q * 64 + tx * 4];
#pragma unroll
                    for (int i = 0; i < 4; ++i) { acc[i][q * 4 + 0] += a[i] * b.x; acc[i][q * 4 + 1] += a[i] * b.y; acc[i][q * 4 + 2] += a[i] * b.z; acc[i][q * 4 + 3] += a[i] * b.w; } }
            }
            __syncthreads();
        }
#pragma unroll
        for (int i = 0; i < 4; ++i)
#pragma unroll
            for (int q = 0; q < 4; ++q)
#pragma unroll
                for (int j = 0; j < 4; ++j) E(d.pm * 128 + ty * 4 + i, d.pn * 256 + q * 64 + tx * 4 + j, acc[i][q * 4 + j], acc[i][(q ^ 2) * 4 + j]);
    }
}
struct DenseSched { int nM, nN;
    __device__ __forceinline__ bool get(int ui, GDesc& d) const { if (ui >= nM * nN) return false; d.pm = ui / nN; d.pn = ui % nN; d.arow0 = d.pm * 128; d.brow0 = d.pn * 256; return true; } };

struct EpiSplitBf16 {
    bf16* O0; size_t stride; float scale0;
    __device__ __forceinline__ void operator()(int row, int col, float v, float) const { const int t = col >> 10; if (t == 0) v *= scale0; O0[(size_t)t * stride + (size_t)row * 1024 + (col & 1023)] = (bf16)f2bf(v); } };
struct EpiResid {
    float* Hf;
    __device__ __forceinline__ void operator()(int row, int col, float v, float) const { float* q = Hf + (size_t)row * 1024 + col; *q = ALPHA * *q + v; } };
struct EpiGelu {
    bf16* Z; const float* bias;
    __device__ __forceinline__ void operator()(int row, int col, float v, float) const { const float x = v + bias[col];
        const float g = 0.5f * x * (1.f + tanhf(0.7978845608028654f * (x + 0.044715f * x * x * x))); Z[(size_t)row * 2048 + col] = (bf16)f2bf(g); } };
struct EpiRw1 {
    bf16* R; bf16* L1;
    __device__ __forceinline__ void operator()(int vrow, int col, float v, float) const { const int cc = vrow >> 14, t = vrow & (T - 1);
        if (cc < 3) R[(size_t)cc * T * 1024 + (size_t)t * 1024 + col] = (bf16)f2bf(v);
        else if (col < 128) { float o = v; if (cc == 3) o = tanhf(v); else if (cc == 5) o = sigmoidf_(v); L1[(size_t)(cc - 3) * T * 128 + (size_t)t * 128 + col] = (bf16)f2bf(o); } } };
struct Rw1Sched {
    __device__ __forceinline__ bool get(int ui, GDesc& d) const { if (ui >= 3 * 512 + 3 * 128) return false;
        int cc, mt, pn; if (ui < 1536) { cc = ui / 512; mt = (ui % 512) / 4; pn = ui % 4; d.brow0 = cc * 1024 + pn * 256; } else { const int u2 = ui - 1536; cc = 3 + u2 / 128; mt = u2 % 128; pn = 0; d.brow0 = 3072 + (cc - 3) * 256; }
        d.pm = cc * 128 + mt; d.pn = pn; d.arow0 = d.pm * 128; return true; } };
struct EpiRw2 {
    float* Wdec; bf16* A; bf16* G; const float* w0; const float* a0;
    __device__ __forceinline__ void operator()(int vrow, int col, float v, float) const { const int j = vrow >> 14, t = vrow & (T - 1); const size_t o = (size_t)t * 1024 + col;
        if (j == 0) Wdec[o] = expf(-0.6065306597126334f * sigmoidf_(w0[col] + v));
        else if (j == 1) A[o] = (bf16)f2bf(sigmoidf_(a0[col] + v)); else G[o] = (bf16)f2bf(v); } };
struct Rw2Sched { __device__ __forceinline__ bool get(int ui, GDesc& d) const { if (ui >= 3 * 512) return false; const int j = ui / 512, mt = (ui % 512) / 4, pn = ui % 4;
        d.pm = j * 128 + mt; d.pn = pn; d.arow0 = d.pm * 128; d.brow0 = j * 1024 + pn * 256; return true; } };
struct MoeSched {
    const int* tile_e; int nN, rowsB;
    __device__ __forceinline__ bool get(int ui, GDesc& d) const { const int ntile = tile_e[255] * 2; if (ui >= ntile * nN) return false;
        const int mt = ui / nN, pn = ui % nN, e = tile_e[mt >> 1]; d.pm = mt; d.pn = pn; d.arow0 = mt * 128; d.brow0 = e * rowsB + pn * 256; return true; } };
struct EpiSwiglu { bf16* H1;
    __device__ __forceinline__ void operator()(int row, int col, float v, float vp) const { const int x = col & 255; if (x < 128) { const float s = v / (1.f + expf(-v)); H1[(size_t)row * 512 + (col >> 8) * 128 + x] = (bf16)f2bf(s * vp); } } };
struct EpiDown { bf16* Yd; const float* rowg;
    __device__ __forceinline__ void operator()(int row, int col, float v, float) const { Yd[(size_t)row * 1024 + col] = (bf16)f2bf(v * rowg[row]); } };

__device__ __forceinline__ void fox_cumsum(const Ctx& c, const Params& p) {
    const float* FL = (const float*)(p.ws + WS_FL); float* CB = (float*)(p.ws + WS_CB); float* red = (float*)c.lds;
    for (int bh = blockIdx.x; bh < BATCH * NH; bh += gridDim.x) {
        const int b = bh / NH, h = bh % NH; const float bf = p.in[I_FOX_BF][h];
        float v[8], run = 0.f;
#pragma unroll
        for (int i = 0; i < 8; ++i) { const int s = c.tid * 8 + i; const float x = FL[(size_t)(b * SEQ + s) * 16 + h] + bf; run += -softplusf_(-x); v[i] = run; }
        const float incl = wave_incl_scan(run, c.lane);
        __syncthreads();
        if (c.lane == 63) red[c.wave] = incl;
        __syncthreads();
        float base = incl - run;
        for (int w = 0; w < c.wave; ++w) base += red[w];
#pragma unroll
        for (int i = 0; i < 8; ++i) CB[(size_t)bh * SEQ + c.tid * 8 + i] = -LOG2E * (base + v[i]);
    }
}
__device__ __forceinline__ void fox_attn_naive(const Ctx& c, const Params& p) {
    bf16* Q = (bf16*)(p.ws + WS_Q); const bf16* K = (const bf16*)(p.ws + WS_K); const bf16* V = (const bf16*)(p.ws + WS_V); const bf16* OG = (const bf16*)(p.ws + WS_OG);
    const float* CB = (const float*)(p.ws + WS_CB);
    float* qs = (float*)c.lds + c.wave * 64;
    for (int row = c.gw; row < BATCH * NH * SEQ; row += c.ngw) {
        const int bh = row / SEQ, t = row % SEQ, b = bh / NH, h = bh % NH;
        const size_t qoff = (size_t)(b * SEQ + t) * 1024 + h * 64 + c.lane;
        LDS_WAIT(); qs[c.lane] = bf2f(Q[qoff]); LDS_WAIT();
        float m = -INFINITY, l = 0.f, o = 0.f;
        for (int s0 = 0; s0 <= t; s0 += 64) {
            const int s = s0 + c.lane; const bool valid = s <= t;
            const u32x4* kp = (const u32x4*)(K + (size_t)(b * SEQ + s) * 1024 + h * 64);
            float z = 0.f;
#pragma unroll
            for (int cc = 0; cc < 8; ++cc) { const u32x4 kv = kp[cc];
                z += qs[cc * 8 + 0] * bf2f(kv.x & 0xffffu) + qs[cc * 8 + 1] * bf2f(kv.x >> 16) + qs[cc * 8 + 2] * bf2f(kv.y & 0xffffu) + qs[cc * 8 + 3] * bf2f(kv.y >> 16)
                   + qs[cc * 8 + 4] * bf2f(kv.z & 0xffffu) + qs[cc * 8 + 5] * bf2f(kv.z >> 16) + qs[cc * 8 + 6] * bf2f(kv.w & 0xffffu) + qs[cc * 8 + 7] * bf2f(kv.w >> 16); }
            z += CB[(size_t)bh * SEQ + s]; z = valid ? z : -INFINITY;
            const float mn = fmaxf(m, wave_max(z)); const float f = exp2f(m - mn); const float pe = valid ? exp2f(z - mn) : 0.f;
            l = l * f + pe; o *= f; m = mn;
#pragma unroll 8
            for (int k = 0; k < 64; ++k) { const float pk = rdlane(pe, k); o += pk * bf2f(V[(size_t)(b * SEQ + s0 + k) * 1024 + h * 64 + c.lane]); }
        }
        const float L = wave_sum(l);
        Q[qoff] = (bf16)f2bf(o / L * sigmoidf_(bf2f(OG[qoff])));
    }
}

__device__ __forceinline__ void sb_attn_naive(const Ctx& c, const Params& p) {
    bf16* Q = (bf16*)(p.ws + WS_Q); const bf16* K = (const bf16*)(p.ws + WS_K); const bf16* V = (const bf16*)(p.ws + WS_V);
    float* qs = (float*)c.lds + c.wave * 64;
    for (int row = c.gw; row < BATCH * NH * SEQ; row += c.ngw) {
        const int bh = row / SEQ, t = row % SEQ, b = bh / NH, h = bh % NH;
        const size_t qoff = (size_t)(b * SEQ + t) * 1024 + h * 64 + c.lane;
        LDS_WAIT(); qs[c.lane] = bf2f(Q[qoff]); LDS_WAIT();
        float carry = 0.f, o = 0.f;
        for (int c0 = 0; c0 < t; c0 += 64) {
            const int s = t - 1 - c0 - c.lane; const bool valid = s >= 0; const int sc = valid ? s : 0;
            const u32x4* kp = (const u32x4*)(K + (size_t)(b * SEQ + sc) * 1024 + h * 64);
            float z = 0.f;
#pragma unroll
            for (int cc = 0; cc < 8; ++cc) { const u32x4 kv = kp[cc];
                z += qs[cc * 8 + 0] * bf2f(kv.x & 0xffffu) + qs[cc * 8 + 1] * bf2f(kv.x >> 16) + qs[cc * 8 + 2] * bf2f(kv.y & 0xffffu) + qs[cc * 8 + 3] * bf2f(kv.y >> 16)
                   + qs[cc * 8 + 4] * bf2f(kv.z & 0xffffu) + qs[cc * 8 + 5] * bf2f(kv.z >> 16) + qs[cc * 8 + 6] * bf2f(kv.w & 0xffffu) + qs[cc * 8 + 7] * bf2f(kv.w >> 16); }
            const float sp = valid ? softplusf_(z) : 0.f;
            const float incl = wave_incl_scan(sp, c.lane);
            const float a = valid ? expf(z - incl - carry) : 0.f;
            carry += rdlane(incl, 63);
#pragma unroll 8
            for (int k = 0; k < 64; ++k) { const float ak = rdlane(a, k); int sk = t - 1 - c0 - k; sk = sk < 0 ? 0 : sk; o += ak * bf2f(V[(size_t)(b * SEQ + sk) * 1024 + h * 64 + c.lane]); }
        }
        Q[qoff] = (bf16)f2bf(o);
    }
}

__device__ __forceinline__ void gmlp_spatial_naive(const Ctx& c, const Params& p) {
    const bf16* Z = (const bf16*)(p.ws + WS_Z); bf16* Yg = (bf16*)(p.ws + WS_YG); const bf16* Wt = (const bf16*)(p.ws + WS_GM_WS);
    float* vn = (float*)c.lds;
    float* Ws = vn + 128 * 128;
    float* st = Ws + 128 * 129;
    for (int u = blockIdx.x; u < 128 * 8; u += gridDim.x) {
        const int n = u >> 3, g = u & 7;
        __syncthreads();
        for (int r = c.wave * 16; r < c.wave * 16 + 16; ++r) {
            const bf16* zr = Z + (size_t)(n * 128 + r) * 2048 + 1024;
            float x[16];
#pragma unroll
            for (int jj = 0; jj < 2; ++jj) { const u32x4 v = *(const u32x4*)(zr + c.lane * 8 + 512 * jj);
                x[jj * 8 + 0] = bf2f(v.x & 0xffffu); x[jj * 8 + 1] = bf2f(v.x >> 16); x[jj * 8 + 2] = bf2f(v.y & 0xffffu); x[jj * 8 + 3] = bf2f(v.y >> 16);
                x[jj * 8 + 4] = bf2f(v.z & 0xffffu); x[jj * 8 + 5] = bf2f(v.z >> 16); x[jj * 8 + 6] = bf2f(v.w & 0xffffu); x[jj * 8 + 7] = bf2f(v.w >> 16); }
            float s = 0.f;
#pragma unroll
            for (int i = 0; i < 16; ++i) s += x[i];
            const float mean = wave_sum(s) * (1.f / 1024.f); float s2 = 0.f;
#pragma unroll
            for (int i = 0; i < 16; ++i) { const float dd = x[i] - mean; s2 += dd * dd; }
            const float rstd = 1.0f / sqrtf(wave_sum(s2) * (1.f / 1024.f) + LN_EPS);
            if (c.lane == 0) { st[r * 2] = mean; st[r * 2 + 1] = rstd; }
        }
        __syncthreads();
        { const int s = c.tid >> 2, cb = (c.tid & 3) * 32; const float mean = st[s * 2], rstd = st[s * 2 + 1];
          const bf16* zr = Z + (size_t)(n * 128 + s) * 2048 + 1024 + g * 128 + cb;
          for (int i = 0; i < 32; ++i) { const int gc = g * 128 + cb + i; vn[s * 128 + cb + i] = (bf2f(zr[i]) - mean) * rstd * p.in[I_GM_LNG][gc] + p.in[I_GM_LNB][gc]; }
          for (int i = c.tid; i < 128 * 128; i += NTHR) Ws[(i >> 7) * 129 + (i & 127)] = bf2f(Wt[(size_t)g * 16384 + i]); }
        __syncthreads();
        { const int t = c.tid >> 2, cb = (c.tid & 3) * 32;
          float acc[32];
#pragma unroll
          for (int i = 0; i < 32; ++i) acc[i] = 0.f;
          for (int s = 0; s < 128; ++s) { const float w = Ws[t * 129 + s];
#pragma unroll
              for (int i = 0; i < 8; ++i) { const f32x4 x = *(const f32x4*)&vn[s * 128 + cb + 4 * i]; acc[4 * i] += w * x.x; acc[4 * i + 1] += w * x.y; acc[4 * i + 2] += w * x.z; acc[4 * i + 3] += w * x.w; } }
          const float bs = p.in[I_GM_BS][g * 128 + t];
          const bf16* ur = Z + (size_t)(n * 128 + t) * 2048 + g * 128 + cb; bf16* yr = Yg + (size_t)(n * 128 + t) * 1024 + g * 128 + cb;
#pragma unroll
          for (int i = 0; i < 32; ++i) yr[i] = (bf16)f2bf(bf2f(ur[i]) * (acc[i] + bs)); }
    }
}


constexpr int GM_SLD = 528;
constexpr int GM_LD = 272;
typedef float f32x16_t __attribute__((ext_vector_type(16)));
typedef short bf16x8_t __attribute__((ext_vector_type(8)));
__device__ __forceinline__ void gmlp_spatial(const Ctx& c, const Params& p) {
    const bf16* Z = (const bf16*)(p.ws + WS_Z); bf16* Yg = (bf16*)(p.ws + WS_YG); const bf16* Wt = (const bf16*)(p.ws + WS_GM_WS);
    unsigned char* Wl = c.lds; unsigned char* Vl = c.lds + 128 * GM_LD; float* st = (float*)(c.lds + 2 * 128 * GM_LD); unsigned char* Sl = c.lds + 2 * 128 * GM_LD + 1024;
    const int lane = c.lane, r32 = lane & 31, hi = lane >> 5, wid = c.wave;
    for (int u = blockIdx.x; u < 256; u += gridDim.x) {
        const int n = u >> 1, g0 = (u & 1) * 4;
        __syncthreads();
#pragma unroll
        for (int rb = 0; rb < 2; ++rb) {
            u32x4 zv[8][2];
#pragma unroll
            for (int i = 0; i < 8; ++i) { const bf16* zr = Z + (size_t)(n * 128 + wid * 16 + rb * 8 + i) * 2048 + 1024; zv[i][0] = *(const u32x4*)(zr + lane * 8); zv[i][1] = *(const u32x4*)(zr + lane * 8 + 512); }
#pragma unroll
            for (int i = 0; i < 8; ++i) { float s1 = 0.f, s2 = 0.f;
#pragma unroll
                for (int jj = 0; jj < 2; ++jj)
#pragma unroll
                    for (int e = 0; e < 4; ++e) { const float a = bf2f(zv[i][jj][e] & 0xffffu), b = bf2f(zv[i][jj][e] >> 16); s1 += a + b; s2 += a * a + b * b; }
                s1 = red16(s1); s2 = red16(s2);
                const float t1 = (rdlane(s1, 0) + rdlane(s1, 16)) + (rdlane(s1, 32) + rdlane(s1, 48)), t2 = (rdlane(s2, 0) + rdlane(s2, 16)) + (rdlane(s2, 32) + rdlane(s2, 48));
                const float mean = t1 * (1.f / 1024.f), var = fmaxf(t2 * (1.f / 1024.f) - mean * mean, 0.f);
                if (lane == 0) { const int r = wid * 16 + rb * 8 + i; st[r * 2] = mean; st[r * 2 + 1] = 1.0f / sqrtf(var + LN_EPS); } }
        }
        for (int gi = 0; gi < 4; ++gi) {
            const int g = g0 + gi;
            __syncthreads();
            { u32x4 wv[4];
#pragma unroll
              for (int k = 0; k < 4; ++k) wv[k] = *(const u32x4*)(Wt + (size_t)g * 16384 + (size_t)(c.tid + NTHR * k) * 8);
#pragma unroll
              for (int k = 0; k < 4; ++k) { const int i = c.tid + NTHR * k, t = i >> 4, ch = i & 15; *(LAS u32x4*)((LAS unsigned char*)Wl + t * GM_LD + ch * 16) = wv[k]; } }
            { const int sp = lane, cb = wid * 16;
              const float mean0 = st[4 * sp], rstd0 = st[4 * sp + 1], mean1 = st[4 * sp + 2], rstd1 = st[4 * sp + 3];
              const bf16* z0 = Z + (size_t)(n * 128 + 2 * sp) * 2048 + 1024 + g * 128 + cb;
              const u32x4 a0 = *(const u32x4*)z0, a1 = *(const u32x4*)(z0 + 8), b0 = *(const u32x4*)(z0 + 2048), b1 = *(const u32x4*)(z0 + 2048 + 8);
              const float* gp = p.in[I_GM_LNG] + g * 128 + cb; const float* bp = p.in[I_GM_LNB] + g * 128 + cb;
#pragma unroll
              for (int j = 0; j < 16; ++j) { const unsigned wa = j < 8 ? a0[(j & 7) >> 1] : a1[(j & 7) >> 1], wb = j < 8 ? b0[(j & 7) >> 1] : b1[(j & 7) >> 1];
                  const float xa = (j & 1) ? __uint_as_float(wa & 0xffff0000u) : __uint_as_float(wa << 16), xb = (j & 1) ? __uint_as_float(wb & 0xffff0000u) : __uint_as_float(wb << 16);
                  const float gn = gp[j], bs_ = bp[j];
                  *(unsigned*)(Vl + (cb + j) * GM_LD + sp * 4) = pk2((xa - mean0) * rstd0 * gn + bs_, (xb - mean1) * rstd1 * gn + bs_); } }
            __syncthreads();
            const int cb32 = wid >> 1, tb0 = 2 * (wid & 1);
            f32x16_t acc0 = {}, acc1 = {};
#pragma unroll
            for (int ks = 0; ks < 8; ++ks) {
                const bf16x8_t a = *(const bf16x8_t*)(Vl + (cb32 * 32 + r32) * GM_LD + (16 * ks + 8 * hi) * 2);
                const bf16x8_t b0 = *(const bf16x8_t*)(Wl + (tb0 * 32 + r32) * GM_LD + (16 * ks + 8 * hi) * 2);
                const bf16x8_t b1 = *(const bf16x8_t*)(Wl + ((tb0 + 1) * 32 + r32) * GM_LD + (16 * ks + 8 * hi) * 2);
                acc0 = __builtin_amdgcn_mfma_f32_32x32x16_bf16(a, b0, acc0, 0, 0, 0);
                acc1 = __builtin_amdgcn_mfma_f32_32x32x16_bf16(a, b1, acc1, 0, 0, 0);
            }
#pragma unroll
            for (int tt = 0; tt < 2; ++tt) { const f32x16_t& acc = tt ? acc1 : acc0; const int t = (tb0 + tt) * 32 + r32; const float bs = p.in[I_GM_BS][g * 128 + t];
#pragma unroll
                for (int q = 0; q < 4; ++q) *(f32x4*)(Sl + t * GM_SLD + (cb32 * 32 + 8 * q + 4 * hi) * 4) = (f32x4){acc[4 * q] + bs, acc[4 * q + 1] + bs, acc[4 * q + 2] + bs, acc[4 * q + 3] + bs}; }
            __syncthreads();
            u32x4 uvv[4];
#pragma unroll
            for (int k = 0; k < 4; ++k) { const int i = c.tid + NTHR * k, t = i >> 4, ch8 = (i & 15) * 8; uvv[k] = *(const u32x4*)(Z + (size_t)(n * 128 + t) * 2048 + g * 128 + ch8); }
#pragma unroll
            for (int k = 0; k < 4; ++k) { const int i = c.tid + NTHR * k, t = i >> 4, ch8 = (i & 15) * 8;
                const u32x4 uv = uvv[k];
                const f32x4 s0 = *(const f32x4*)(Sl + t * GM_SLD + ch8 * 4), s1 = *(const f32x4*)(Sl + t * GM_SLD + ch8 * 4 + 16);
                u32x4 o; o.x = pk2(__uint_as_float(uv.x << 16) * s0[0], __uint_as_float(uv.x & 0xffff0000u) * s0[1]); o.y = pk2(__uint_as_float(uv.y << 16) * s0[2], __uint_as_float(uv.y & 0xffff0000u) * s0[3]);
                o.z = pk2(__uint_as_float(uv.z << 16) * s1[0], __uint_as_float(uv.z & 0xffff0000u) * s1[1]); o.w = pk2(__uint_as_float(uv.w << 16) * s1[2], __uint_as_float(uv.w & 0xffff0000u) * s1[3]);
                *(u32x4*)(Yg + (size_t)(n * 128 + t) * 1024 + g * 128 + ch8) = o; }
        }
    }
}

__device__ __forceinline__ void rwkv_mix(const Ctx& c, const Params& p) {
    const bf16* Hb = (const bf16*)(p.ws + WS_HB); bf16* HM = (bf16*)(p.ws + WS_HM); const float* mu = p.in[I_RW_MU];
    f32x4 mv[6][2][2];
#pragma unroll
    for (int cc = 0; cc < 6; ++cc)
#pragma unroll
        for (int jj = 0; jj < 2; ++jj) { mv[cc][jj][0] = *(const f32x4*)(mu + cc * 1024 + 512 * jj + 8 * c.lane); mv[cc][jj][1] = *(const f32x4*)(mu + cc * 1024 + 512 * jj + 8 * c.lane + 4); }
    int m = c.gw; const u32x4 z4 = {0u, 0u, 0u, 0u};
    u32x4 h[2], hp[2];
#pragma unroll
    for (int jj = 0; jj < 2; ++jj) { h[jj] = (m < T) ? *(const u32x4*)(Hb + (size_t)m * D + 512 * jj + 8 * c.lane) : z4; hp[jj] = (m < T && (m & (SEQ - 1))) ? *(const u32x4*)(Hb + (size_t)(m - 1) * D + 512 * jj + 8 * c.lane) : z4; }
    for (; m < T; m += c.ngw) {
        u32x4 hc[2] = {h[0], h[1]}, hq[2] = {hp[0], hp[1]}; const int mn = m + c.ngw;
        if (mn < T) {
#pragma unroll
            for (int jj = 0; jj < 2; ++jj) { h[jj] = *(const u32x4*)(Hb + (size_t)mn * D + 512 * jj + 8 * c.lane); hp[jj] = (mn & (SEQ - 1)) ? *(const u32x4*)(Hb + (size_t)(mn - 1) * D + 512 * jj + 8 * c.lane) : z4; }
        }
#pragma unroll
        for (int jj = 0; jj < 2; ++jj) {
            f32x4 a0, a1, d0, d1;
#pragma unroll
            for (int e = 0; e < 2; ++e) { a0[2 * e] = bf2f(hc[jj][e] & 0xffffu); a0[2 * e + 1] = bf2f(hc[jj][e] >> 16); a1[2 * e] = bf2f(hc[jj][e + 2] & 0xffffu); a1[2 * e + 1] = bf2f(hc[jj][e + 2] >> 16);
                d0[2 * e] = bf2f(hq[jj][e] & 0xffffu) - a0[2 * e]; d0[2 * e + 1] = bf2f(hq[jj][e] >> 16) - a0[2 * e + 1]; d1[2 * e] = bf2f(hq[jj][e + 2] & 0xffffu) - a1[2 * e]; d1[2 * e + 1] = bf2f(hq[jj][e + 2] >> 16) - a1[2 * e + 1]; }
#pragma unroll
            for (int cc = 0; cc < 6; ++cc) { const f32x4 o0 = a0 + d0 * mv[cc][jj][0], o1 = a1 + d1 * mv[cc][jj][1];
                u32x4 w; w.x = pk2(o0[0], o0[1]); w.y = pk2(o0[2], o0[3]); w.z = pk2(o1[0], o1[1]); w.w = pk2(o1[2], o1[3]);
                __builtin_nontemporal_store(w, (u32x4*)(HM + (size_t)cc * T * 1024 + (size_t)m * 1024 + 512 * jj + 8 * c.lane)); }
        }
    }
}
struct RwIn { float r, k, v, w, a, g; };
__device__ __forceinline__ RwIn rw_load(const Params& p, size_t off) { RwIn x;
    x.r = bf2f(((const bf16*)(p.ws + WS_RR))[off]); x.k = bf2f(((const bf16*)(p.ws + WS_RK))[off]); x.v = bf2f(((const bf16*)(p.ws + WS_RV))[off]);
    x.w = ((const float*)(p.ws + WS_WDEC))[off]; x.a = bf2f(((const bf16*)(p.ws + WS_RA))[off]); x.g = bf2f(((const bf16*)(p.ws + WS_RG))[off]); return x; }
__device__ __forceinline__ void rwkv_scan_naive(const Ctx& c, const Params& p) {
    bf16* YG = (bf16*)(p.ws + WS_RYG);
    for (int bh = c.gw; bh < BATCH * NH; bh += c.ngw) {
        const int b = bh / NH, h = bh % NH, ch = h * 64 + c.lane;
        const float k_k = p.in[I_RW_KK][ch], k_a = p.in[I_RW_KA][ch], r_k = p.in[I_RW_RK][ch], gn_g = p.in[I_RW_GNG][ch], gn_b = p.in[I_RW_GNB][ch];
        float S[64];
#pragma unroll
        for (int j = 0; j < 64; ++j) S[j] = 0.f;
        RwIn nx = rw_load(p, (size_t)(b * SEQ) * 1024 + ch);
        for (int t = 0; t < SEQ; ++t) {
            const RwIn x = nx; const size_t off = (size_t)(b * SEQ + t) * 1024 + ch;
            if (t + 1 < SEQ) nx = rw_load(p, off + 1024);
            float kk = x.k * k_k; const float nrm = sqrtf(wave_sum(kk * kk)); kk = kk / fmaxf(nrm, 1e-12f);
            const float kt = x.k * (1.f + (x.a - 1.f) * k_a), bv = kk * x.a;
            float sa = 0.f;
#pragma unroll
            for (int j = 0; j < 64; ++j) sa -= S[j] * rdlane(kk, j);
            float y = 0.f;
#pragma unroll
            for (int j = 0; j < 64; ++j) { S[j] = S[j] * rdlane(x.w, j) + sa * rdlane(bv, j) + x.v * rdlane(kt, j); y += S[j] * rdlane(x.r, j); }
            const float mean = wave_sum(y) * (1.f / 64.f); const float dy = y - mean; const float var = wave_sum(dy * dy) * (1.f / 64.f);
            const float yn = dy * (1.0f / sqrtf(var + GN_EPS)) * gn_g + gn_b;
            const float bonus = wave_sum(x.r * kt * r_k) * x.v;
            YG[off] = (bf16)f2bf((yn + bonus) * x.g);
        }
    }
}


constexpr int RW_CH = 32, RW_RING = RW_CH * 6 * 64 * 4  , RW_YB = 2 * RW_RING, RW_YBB = RW_CH * 16 * 4;
#define RAW_BAR() asm volatile("s_waitcnt lgkmcnt(0)\n\ts_barrier" ::: "memory")
__device__ __forceinline__ void rwkv_scan(const Ctx& c, const Params& p) {
    const bf16* Rg = (const bf16*)(p.ws + WS_RR); const bf16* Kg = (const bf16*)(p.ws + WS_RK); const bf16* Vg = (const bf16*)(p.ws + WS_RV);
    const float* Wg = (const float*)(p.ws + WS_WDEC); const bf16* Ag = (const bf16*)(p.ws + WS_RA); float* Ysc = (float*)(p.ws + WS_YSC);
    float* ring = (float*)c.lds; float* ybuf = (float*)(c.lds + RW_YB);
    const int lane = c.lane, wid = c.wave;
    for (int u = blockIdx.x; u < BATCH * NH * 4; u += gridDim.x) {
        const int bh = u >> 2, qr = u & 3, b = bh / NH, h = bh % NH;
        const size_t gbase = (size_t)(b * SEQ) * 1024 + h * 64;
        if (wid >= 4) {
            const int pw = wid - 4; const int ch = h * 64 + lane;
            const float k_k = p.in[I_RW_KK][ch], k_a = p.in[I_RW_KA][ch];
            unsigned rr[8], rk[8], rv[8], ra[8]; float rw[8];
#define RW_LOAD(cc) _Pragma("unroll") for (int i = 0; i < 8; ++i) { const size_t o = gbase + (size_t)((cc) * RW_CH + pw + 4 * i) * 1024 + lane; rr[i] = Rg[o]; rk[i] = Kg[o]; rv[i] = Vg[o]; ra[i] = Ag[o]; rw[i] = Wg[o]; }
#define RW_PROC(cc) _Pragma("unroll") for (int i = 0; i < 8; ++i) { float* dst = ring + ((cc) & 1) * (RW_RING / 4) + (pw + 4 * i) * 384 + lane; \
                const float kf = bf2f(rk[i]), af = bf2f(ra[i]); float kk = kf * k_k; float n2 = red16(kk * kk); n2 = rdlane(n2, 0) + rdlane(n2, 16) + rdlane(n2, 32) + rdlane(n2, 48); \
                kk = kk * __builtin_amdgcn_rsqf(fmaxf(n2, 1e-24f)); dst[0] = bf2f(rr[i]); dst[64] = kf * (1.f + (af - 1.f) * k_a); dst[128] = __builtin_amdgcn_exp2f(rw[i]); dst[192] = kk * af; dst[256] = kk; dst[320] = bf2f(rv[i]); }
#define RW_FLUSH(cc) _Pragma("unroll") for (int i2 = 0; i2 < 2; ++i2) { const int st = pw + 4 * (i2 * 4 + (lane >> 4)); \
                Ysc[gbase + (size_t)((cc) * RW_CH + st) * 1024 + qr * 16 + (lane & 15)] = ybuf[((cc) & 1) * (RW_YBB / 4) + st * 16 + (lane & 15)]; }
            RW_LOAD(0); RW_PROC(0); RW_LOAD(1);
            RAW_BAR();
            for (int cc = 0; cc < SEQ / RW_CH; ++cc) {
                if (cc + 1 < SEQ / RW_CH) { RW_PROC(cc + 1); }
                if (cc + 2 < SEQ / RW_CH) { RW_LOAD(cc + 2); }
                if (cc > 0) { RW_FLUSH(cc - 1); }
                RAW_BAR();
            }
            RW_FLUSH(SEQ / RW_CH - 1);
#undef RW_LOAD
#undef RW_PROC
#undef RW_FLUSH
        } else {
            const int rg = lane >> 4, c4 = (lane & 15) * 4, row = wid * 4 + rg;
            float S0 = 0.f, S1 = 0.f, S2 = 0.f, S3 = 0.f;
            RAW_BAR();
            for (int cc = 0; cc < SEQ / RW_CH; ++cc) {
                const float* base = ring + (cc & 1) * (RW_RING / 4); float* yb = ybuf + (cc & 1) * (RW_YBB / 4);
                const float* sp0 = base + c4; const float* vp0 = base + 320 + qr * 16 + row;
                f32x4 r4 = *(const f32x4*)(sp0), kt4 = *(const f32x4*)(sp0 + 64), w4 = *(const f32x4*)(sp0 + 128), b4 = *(const f32x4*)(sp0 + 192), kk4 = *(const f32x4*)(sp0 + 256); float vi = vp0[0];
#pragma unroll 8
                for (int st = 0; st < RW_CH; ++st) {
                    const int sn = (st + 1 < RW_CH) ? st + 1 : st;
                    const f32x4 nr4 = *(const f32x4*)(sp0 + sn * 384), nkt4 = *(const f32x4*)(sp0 + sn * 384 + 64), nw4 = *(const f32x4*)(sp0 + sn * 384 + 128), nb4 = *(const f32x4*)(sp0 + sn * 384 + 192), nkk4 = *(const f32x4*)(sp0 + sn * 384 + 256);
                    const float nvi = vp0[sn * 384];
                    float pd = S0 * kk4.x; pd = fmaf(S1, kk4.y, pd); pd = fmaf(S2, kk4.z, pd); pd = fmaf(S3, kk4.w, pd);
                    pd = red16(pd);
                    S0 = fmaf(S0, w4.x, fmaf(-pd, b4.x, vi * kt4.x)); S1 = fmaf(S1, w4.y, fmaf(-pd, b4.y, vi * kt4.y));
                    S2 = fmaf(S2, w4.z, fmaf(-pd, b4.z, vi * kt4.z)); S3 = fmaf(S3, w4.w, fmaf(-pd, b4.w, vi * kt4.w));
                    float y = S0 * r4.x; y = fmaf(S1, r4.y, y); y = fmaf(S2, r4.z, y); y = fmaf(S3, r4.w, y);
                    y = red16(y);
                    yb[st * 16 + row] = y;
                    r4 = nr4; kt4 = nkt4; w4 = nw4; b4 = nb4; kk4 = nkk4; vi = nvi;
                }
                RAW_BAR();
            }
        }
        RAW_BAR();
    }
}

namespace rwc {
typedef float f32x16 __attribute__((ext_vector_type(16)));
typedef short bf16x8 __attribute__((ext_vector_type(8)));
__device__ __forceinline__ bf16 hbf(float x) { return (bf16)(pk2(x, 0.f) & 0xffffu); }
constexpr int L = 32, NCHH = 32  , NQ = 4, REC = 30720;
constexpr int O_P1T = 0, O_RBT = 4096, O_BBP = 8192, O_MBRT = 12288, O_VP2T = 14336, O_VMKRT = 18432, O_VKTP = 22528;
constexpr int A_ABT = 0, A_BBT = 4096, A_KBT = 8192, A_RBT = 12288, A_WAVE = 16384;
constexpr int A_MBB = A_BBT  , A_TT = A_KBT  , A_MKB = A_KBT + 2048, A_MKRT = A_RBT, A_P2T = A_RBT + 2048;
__device__ __forceinline__ int crow(int r, int hi) { return (r & 3) + 8 * (r >> 2) + 4 * hi; }
__device__ __forceinline__ int ppos(int k) { return (k & ~15) + 8 * ((k >> 2) & 1) + 4 * ((k >> 3) & 1) + (k & 3); }
__device__ __forceinline__ bf16x8 ldf(const unsigned char* base, int row, int rowbytes, int kb) { return *(const bf16x8*)(base + row * rowbytes + kb); }
__device__ __forceinline__ f32x16 mm(bf16x8 a, bf16x8 b, f32x16 c) { return __builtin_amdgcn_mfma_f32_32x32x16_bf16(a, b, c, 0, 0, 0); }
__device__ __forceinline__ unsigned char* rec_ptr(unsigned char* ws, int qr, int head, int cl) { return ws + ((qr & 1) ? WS_CD1 : WS_CD0) + (size_t)(head * NCHH + cl) * REC; }
#define RWC_FENCE() asm volatile("s_waitcnt lgkmcnt(0)" ::: "memory")

template <int TAU, int TP> struct TriDot { static __device__ __forceinline__ void run(const float (&x)[32], const f32x4 (&m)[8], float (&acc)[4]) { acc[TP & 3] = fmaf(m[TP >> 2][TP & 3], x[TP], acc[TP & 3]); TriDot<TAU, TP + 1>::run(x, m, acc); } };
template <int TAU> struct TriDot<TAU, 32> { static __device__ __forceinline__ void run(const float (&)[32], const f32x4 (&)[8], float (&)[4]) {} };
template <int TAU> struct TriSolve { static __device__ __forceinline__ void run(float (&x)[32], const unsigned char* mb, int col) {
    f32x4 m[8];
#pragma unroll
    for (int g = 0; g < 8; ++g) m[g] = *(const f32x4*)(mb + (TAU * 32 + 4 * g) * 4);
    float a4[4] = {0.f, 0.f, 0.f, 0.f};
    TriDot<TAU, TAU + 1>::run(x, m, a4);
    float acc = (a4[0] + a4[1]) + (a4[2] + a4[3]);
    asm volatile("" : "+v"(acc) :: "memory");
    x[TAU] = (TAU < col) ? acc : x[TAU];
    TriSolve<TAU - 1>::run(x, mb, col); } };
template <> struct TriSolve<-1> { static __device__ __forceinline__ void run(float (&)[32], const unsigned char*, int) {} };
__device__ __forceinline__ void rwc_prep(const Ctx& c, const Params& p, int half, int c0, int nch, int blk0, int nblk) {
    if ((int)blockIdx.x < blk0) return;
    unsigned char* wl = c.lds + c.wave * A_WAVE;
    const bf16* Rg = (const bf16*)(p.ws + WS_RR); const bf16* Kg = (const bf16*)(p.ws + WS_RK); const bf16* Vg = (const bf16*)(p.ws + WS_RV);
    const float* LWg = (const float*)(p.ws + WS_WDEC); const bf16* Ag = (const bf16*)(p.ws + WS_RA); float* WLg = (float*)(p.ws + WS_WLG);
    const int lane0 = c.lane;
    int lane = lane0;
    unsigned ra_[8], rb_[8], rd_[8]; float re_[8];
#define RWC_GB(q_) ((size_t)((((q_) & 63) / NH) * SEQ + (c0 + ((q_) >> 6)) * L) * 1024 + (((q_) & 63) % NH) * 64)
#define RWC_LD8(gb_, tb_) _Pragma("unroll") for (int i = 0; i < 8; ++i) { const int o = ((tb_) + i) * 1024 + lane; ra_[i] = (Rg + (gb_))[o]; rb_[i] = (Kg + (gb_))[o]; rd_[i] = (Ag + (gb_))[o]; re_[i] = (LWg + (gb_))[o]; }
    const int q0 = ((int)blockIdx.x - blk0) * NW + c.wave, qs = nblk * NW, qn = BATCH * NH * nch;
    if (q0 < qn) { const size_t g0 = RWC_GB(q0); RWC_LD8(g0, 0) }
    for (int q = q0; q < qn; q += qs) {
        lane = lane0; asm volatile("" : "+v"(lane)); const int r32 = lane & 31, hi = lane >> 5, pl = ppos(lane);
        const int head = q & 63, cl = q >> 6, b = head / NH, h = head % NH, ch = h * 64 + lane;
        const size_t gbase = (size_t)(b * SEQ + (c0 + cl) * L) * 1024 + h * 64;
        unsigned char* rec = rec_ptr(p.ws, half, head, cl);
        const float k_k = p.in[I_RW_KK][ch], k_a = p.in[I_RW_KA][ch];
        float run = 0.f, wprev = 1.f;
        RWC_FENCE();
#pragma unroll 1
        for (int tb = 0; tb < L; tb += 8) {
            unsigned rr[8], rk[8], ra[8]; float rl[8];
#pragma unroll
            for (int i = 0; i < 8; ++i) { rr[i] = ra_[i]; rk[i] = rb_[i]; ra[i] = rd_[i]; rl[i] = re_[i]; }
            if (tb + 8 < L) { RWC_LD8(gbase, tb + 8) }
#pragma unroll
            for (int i = 0; i < 8; ++i) { const int t = tb + i;
                const float kf = bf2f(rk[i]), af = bf2f(ra[i]); float kk = kf * k_k; kk = kk * __builtin_amdgcn_rsqf(fmaxf(wave_sum(kk * kk), 1e-24f));
                const float ktv = kf * (1.f + (af - 1.f) * k_a), bv = kk * af; run += rl[i];
                const float ep = __builtin_amdgcn_exp2f(run), em = __builtin_amdgcn_exp2f(-run);
                *(bf16*)(wl + A_ABT + t * 128 + pl * 2) = hbf(-kk * wprev);
                *(bf16*)(wl + A_BBT + t * 128 + pl * 2) = hbf(bv * em); *(bf16*)(wl + A_KBT + t * 128 + pl * 2) = hbf(ktv * em);
                *(bf16*)(wl + A_RBT + t * 128 + pl * 2) = hbf(bf2f(rr[i]) * ep);
                wprev = ep; }
        }
        RWC_FENCE();
        f32x16 mbb = {}, mkb = {}, mbr = {}, mkr = {};
#pragma unroll
        for (int s_ = 0; s_ < 4; ++s_) { const int kb = (16 * s_ + 8 * hi) * 2;
            const bf16x8 ab_ = ldf(wl + A_BBT, r32, 128, kb), ak_ = ldf(wl + A_KBT, r32, 128, kb), ba_ = ldf(wl + A_ABT, r32, 128, kb), br_ = ldf(wl + A_RBT, r32, 128, kb);
            mbb = mm(ab_, ba_, mbb); mkb = mm(ak_, ba_, mkb); mbr = mm(ab_, br_, mbr); mkr = mm(ak_, br_, mkr); }
        RWC_FENCE();
        unsigned abr[16], vr[16], kpr[16], bpr[16];
        { const float wlj = __builtin_amdgcn_exp2f(run);
          WLg[(size_t)(head * 128 + c0 + cl) * 64 + lane] = wlj;
#pragma unroll
          for (int t = 0; t < L; ++t) { const int pt = (t & ~15) + 8 * ((t >> 2) & 1) + 4 * ((t >> 3) & 1) + (t & 3);
              const unsigned ab = *(const bf16*)(wl + A_ABT + t * 128 + pl * 2), kp = hbf(bf2f(*(const bf16*)(wl + A_KBT + t * 128 + pl * 2)) * wlj), bp = hbf(bf2f(*(const bf16*)(wl + A_BBT + t * 128 + pl * 2)) * wlj);
              const unsigned vv = (Vg + gbase)[t * 1024 + lane];
              if (t & 1) { abr[t >> 1] |= ab << 16; vr[t >> 1] |= vv << 16; kpr[t >> 1] |= kp << 16; bpr[pt >> 1] |= bp << 16; }
              else { abr[t >> 1] = ab; vr[t >> 1] = vv; kpr[t >> 1] = kp; bpr[pt >> 1] = bp; } } }
#pragma unroll
        for (int i = 0; i < 4; ++i) *(u32x4*)(rec + O_BBP + lane * 64 + i * 16) = (u32x4){bpr[4 * i], bpr[4 * i + 1], bpr[4 * i + 2], bpr[4 * i + 3]};
#pragma unroll
        for (int i = 0; i < 4; ++i) *(u32x4*)(rec + O_RBT + i * 1024 + lane * 16) = *(const u32x4*)(wl + A_RBT + i * 1024 + lane * 16);
        RWC_FENCE();
        { int r32 = lane & 31, hi = lane >> 5; asm volatile("" : "+v"(r32), "+v"(hi));
#pragma unroll
        for (int r = 0; r < 16; ++r) { const int tau = crow(r, hi), t = r32; const bool s1 = tau < t, s2 = tau <= t;
            *(float*)(wl + A_MBB + (tau * 32 + t) * 4) = s1 ? mbb[r] : 0.f;
            *(bf16*)(wl + A_MKB + (tau * 32 + t) * 2) = hbf(s1 ? mkb[r] : 0.f);
            *(bf16*)(wl + A_MKRT + (t * 32 + tau) * 2) = hbf(s2 ? mkr[r] : 0.f);
            *(bf16*)(wl + A_ABT + (t * 32 + ppos(tau)) * 2) = hbf(s2 ? mbr[r] : 0.f); } }
        RWC_FENCE();
#pragma unroll
        for (int i = 0; i < 2; ++i) *(u32x4*)(rec + O_MBRT + i * 1024 + lane * 16) = *(const u32x4*)(wl + A_ABT + i * 1024 + lane * 16);
        RWC_FENCE();
        if (q + qs < qn) { const size_t gn = RWC_GB(q + qs); RWC_LD8(gn, 0) }
        { float x[L]; int r32 = lane & 31; asm volatile("" : "+v"(r32));
#pragma unroll
          for (int tau = 0; tau < L; ++tau) x[tau] = (tau == r32) ? 1.f : 0.f;
          TriSolve<L - 2>::run(x, wl + A_MBB, r32);
          RWC_FENCE();
          if (hi == 0) {
#pragma unroll
              for (int i = 0; i < 4; ++i) *(u32x4*)(wl + A_TT + r32 * 64 + i * 16) = (u32x4){pk2(x[8 * i], x[8 * i + 1]), pk2(x[8 * i + 2], x[8 * i + 3]), pk2(x[8 * i + 4], x[8 * i + 5]), pk2(x[8 * i + 6], x[8 * i + 7])}; } }
#pragma unroll
        for (int i = 0; i < 4; ++i) *(u32x4*)(wl + A_BBT + lane * 64 + i * 16) = (u32x4){abr[4 * i], abr[4 * i + 1], abr[4 * i + 2], abr[4 * i + 3]};
        RWC_FENCE();
        { f32x16 p1a = {}, p1b = {}, p2 = {};
#pragma unroll
          for (int s_ = 0; s_ < 2; ++s_) { const int kb = (16 * s_ + 8 * hi) * 2; const bf16x8 tt = ldf(wl + A_TT, r32, 64, kb);
              p1a = mm(tt, ldf(wl + A_BBT, r32, 64, kb), p1a); p1b = mm(tt, ldf(wl + A_BBT, 32 + r32, 64, kb), p1b); p2 = mm(tt, ldf(wl + A_MKB, r32, 64, kb), p2); }
          RWC_FENCE();
          int r32 = lane & 31, hi = lane >> 5; asm volatile("" : "+v"(r32), "+v"(hi));
#pragma unroll
          for (int r = 0; r < 16; ++r) { const int t = crow(r, hi);
              *(bf16*)(wl + A_ABT + (t * 64 + ppos(r32)) * 2) = hbf(p1a[r]); *(bf16*)(wl + A_ABT + (t * 64 + 32 + ppos(r32)) * 2) = hbf(p1b[r]);
              *(bf16*)(wl + A_P2T + (t * 32 + r32) * 2) = hbf(p2[r]); } }
#pragma unroll
        for (int i = 0; i < 4; ++i) { *(u32x4*)(wl + A_BBT + lane * 64 + i * 16) = (u32x4){vr[4 * i], vr[4 * i + 1], vr[4 * i + 2], vr[4 * i + 3]};
                                      *(u32x4*)(wl + A_KBT + lane * 64 + i * 16) = (u32x4){kpr[4 * i], kpr[4 * i + 1], kpr[4 * i + 2], kpr[4 * i + 3]}; }
        RWC_FENCE();
#pragma unroll
        for (int i = 0; i < 4; ++i) *(u32x4*)(rec + O_P1T + i * 1024 + lane * 16) = *(const u32x4*)(wl + A_ABT + i * 1024 + lane * 16);
        RWC_FENCE();
#pragma unroll
        for (int ib = 0; ib < 2; ++ib) { f32x16 vp = {}, vm = {}, vk0 = {}, vk1 = {};
#pragma unroll
            for (int s_ = 0; s_ < 2; ++s_) { const int kb = (16 * s_ + 8 * hi) * 2; const bf16x8 vv = ldf(wl + A_BBT, ib * 32 + r32, 64, kb);
                vp = mm(ldf(wl + A_P2T, r32, 64, kb), vv, vp); vm = mm(ldf(wl + A_MKRT, r32, 64, kb), vv, vm);
                vk0 = mm(ldf(wl + A_KBT, r32, 64, kb), vv, vk0); vk1 = mm(ldf(wl + A_KBT, 32 + r32, 64, kb), vv, vk1); }
            int ln_ = lane; asm volatile("" : "+v"(ln_));
#define RWC_ST(acc, off) do { _Pragma("unroll") for (int i_ = 0; i_ < 2; ++i_) *(u32x4*)(rec + (off) + ln_ * 32 + i_ * 16) = (u32x4){pk2(acc[8 * i_], acc[8 * i_ + 1]), pk2(acc[8 * i_ + 2], acc[8 * i_ + 3]), pk2(acc[8 * i_ + 4], acc[8 * i_ + 5]), pk2(acc[8 * i_ + 6], acc[8 * i_ + 7])}; } while (0)
            RWC_ST(vp, O_VP2T + ib * 2048); RWC_ST(vm, O_VMKRT + ib * 2048); RWC_ST(vk0, O_VKTP + (ib * 2 + 0) * 2048); RWC_ST(vk1, O_VKTP + (ib * 2 + 1) * 2048);
#undef RWC_ST
        }
        RWC_FENCE();
    }
}
#undef RWC_LD8
#undef RWC_GB
__device__ __forceinline__ void rwc_scan(const Ctx& c, const Params& p, int half, int c0, int nch) {
    bf16* Y2 = (bf16*)(p.ws + WS_Y2); const float* WLg = (const float*)(p.ws + WS_WLG); float* SIG = (float*)(p.ws + WS_SIG);
    const int lane = c.lane, r32 = lane & 31, hi = lane >> 5, wid = c.wave;
    const unsigned lds0 = (unsigned)(uintptr_t)c.lds;
    for (int head = blockIdx.x; head < BATCH * NH; head += gridDim.x) {
        const int b = head / NH, h = head % NH;
        const unsigned char* rec0 = rec_ptr(p.ws, half, head, 0);
        asm volatile("s_waitcnt vmcnt(0) lgkmcnt(0)\n\ts_barrier" ::: "memory");
        if (wid >= 2) {
            const int lw = wid - 2;
#define RWC_DMA(cl) do { _Pragma("unroll") for (int k_ = 0; k_ < 5; ++k_) attn_body::glds16s((unsigned)((lw * 5 + k_) * 1024 + lane * 16), rec0 + (size_t)(cl) * REC, \
                    (unsigned)__builtin_amdgcn_readfirstlane(lds0 + ((cl) & 3) * REC + (lw * 5 + k_) * 1024)); } while (0)
            RWC_DMA(0); RWC_DMA(1); RWC_DMA(2);
            asm volatile("s_waitcnt vmcnt(10)\n\ts_barrier" ::: "memory");
            for (int cl = 0; cl < nch; ++cl) {
                if (cl + 3 < nch) { RWC_DMA(cl + 3); asm volatile("s_waitcnt vmcnt(10)\n\ts_barrier" ::: "memory"); }
                else if (cl + 3 == nch) { asm volatile("s_waitcnt vmcnt(5)\n\ts_barrier" ::: "memory"); }
                else { asm volatile("s_waitcnt vmcnt(0)\n\ts_barrier" ::: "memory"); }
            }
#undef RWC_DMA
        } else {
            const int ib = wid; f32x16 S0, S1;
            float* sg = SIG + ((size_t)(head * 2 + ib) * 2) * 1024 + lane * 16;
            if (c0 == 0) { S0 = f32x16{}; S1 = f32x16{}; }
            else {
#pragma unroll
                for (int r = 0; r < 16; ++r) { S0[r] = sg[r]; S1[r] = sg[1024 + r]; } }
            f32x4 wn0[4], wn1[4];
#pragma unroll
            for (int g = 0; g < 4; ++g) { wn0[g] = *(const f32x4*)(WLg + (size_t)(head * 128 + c0) * 64 + 8 * g + 4 * hi); wn1[g] = *(const f32x4*)(WLg + (size_t)(head * 128 + c0) * 64 + 32 + 8 * g + 4 * hi); }
            asm volatile("s_waitcnt lgkmcnt(0)\n\ts_barrier" ::: "memory");
            for (int cl = 0; cl < nch; ++cl) {
                const unsigned char* rl = c.lds + (cl & 3) * REC;
                f32x4 w0[4], w1[4];
#pragma unroll
                for (int g = 0; g < 4; ++g) { w0[g] = wn0[g]; w1[g] = wn1[g]; }
                { const float* wlp = WLg + (size_t)(head * 128 + c0 + (cl + 1 < nch ? cl + 1 : cl)) * 64;
#pragma unroll
                  for (int g = 0; g < 4; ++g) { wn0[g] = *(const f32x4*)(wlp + 8 * g + 4 * hi); wn1[g] = *(const f32x4*)(wlp + 32 + 8 * g + 4 * hi); } }
                bf16x8 sb[4];
#define RWC_CV(X, o) __builtin_bit_cast(bf16x8, (u32x4){pk2(X[o], X[o + 1]), pk2(X[o + 2], X[o + 3]), pk2(X[o + 4], X[o + 5]), pk2(X[o + 6], X[o + 7])})
                sb[0] = RWC_CV(S0, 0); sb[1] = RWC_CV(S0, 8); sb[2] = RWC_CV(S1, 0); sb[3] = RWC_CV(S1, 8);
                f32x16 ut, yt;
                { const u32x4 a0 = *(const u32x4*)(rl + O_VP2T + ib * 2048 + lane * 32), a1 = *(const u32x4*)(rl + O_VP2T + ib * 2048 + lane * 32 + 16);
                  const u32x4 b0 = *(const u32x4*)(rl + O_VMKRT + ib * 2048 + lane * 32), b1 = *(const u32x4*)(rl + O_VMKRT + ib * 2048 + lane * 32 + 16);
#pragma unroll
                  for (int e = 0; e < 4; ++e) { ut[2 * e] = bf2f(a0[e] & 0xffffu); ut[2 * e + 1] = bf2f(a0[e] >> 16); ut[8 + 2 * e] = bf2f(a1[e] & 0xffffu); ut[8 + 2 * e + 1] = bf2f(a1[e] >> 16);
                                                yt[2 * e] = bf2f(b0[e] & 0xffffu); yt[2 * e + 1] = bf2f(b0[e] >> 16); yt[8 + 2 * e] = bf2f(b1[e] & 0xffffu); yt[8 + 2 * e + 1] = bf2f(b1[e] >> 16); } }
#pragma unroll
                for (int s_ = 0; s_ < 4; ++s_) { const int kb = (16 * s_ + 8 * hi) * 2; ut = mm(ldf(rl + O_P1T, r32, 128, kb), sb[s_], ut); yt = mm(ldf(rl + O_RBT, r32, 128, kb), sb[s_], yt); }
                { const u32x4 c0 = *(const u32x4*)(rl + O_VKTP + (ib * 2 + 0) * 2048 + lane * 32), c1 = *(const u32x4*)(rl + O_VKTP + (ib * 2 + 0) * 2048 + lane * 32 + 16);
                  const u32x4 d0 = *(const u32x4*)(rl + O_VKTP + (ib * 2 + 1) * 2048 + lane * 32), d1 = *(const u32x4*)(rl + O_VKTP + (ib * 2 + 1) * 2048 + lane * 32 + 16);
#pragma unroll
                  for (int e = 0; e < 4; ++e) {
                      S0[2 * e] = fmaf(S0[2 * e], w0[(2 * e) >> 2][(2 * e) & 3], bf2f(c0[e] & 0xffffu)); S0[2 * e + 1] = fmaf(S0[2 * e + 1], w0[(2 * e + 1) >> 2][(2 * e + 1) & 3], bf2f(c0[e] >> 16));
                      S0[8 + 2 * e] = fmaf(S0[8 + 2 * e], w0[(8 + 2 * e) >> 2][(8 + 2 * e) & 3], bf2f(c1[e] & 0xffffu)); S0[8 + 2 * e + 1] = fmaf(S0[8 + 2 * e + 1], w0[(9 + 2 * e) >> 2][(9 + 2 * e) & 3], bf2f(c1[e] >> 16));
                      S1[2 * e] = fmaf(S1[2 * e], w1[(2 * e) >> 2][(2 * e) & 3], bf2f(d0[e] & 0xffffu)); S1[2 * e + 1] = fmaf(S1[2 * e + 1], w1[(2 * e + 1) >> 2][(2 * e + 1) & 3], bf2f(d0[e] >> 16));
                      S1[8 + 2 * e] = fmaf(S1[8 + 2 * e], w1[(8 + 2 * e) >> 2][(8 + 2 * e) & 3], bf2f(d1[e] & 0xffffu)); S1[8 + 2 * e + 1] = fmaf(S1[8 + 2 * e + 1], w1[(9 + 2 * e) >> 2][(9 + 2 * e) & 3], bf2f(d1[e] >> 16)); } }
                bf16x8 ub[2]; ub[0] = RWC_CV(ut, 0); ub[1] = RWC_CV(ut, 8);
#pragma unroll
                for (int s_ = 0; s_ < 2; ++s_) { const int kb = (16 * s_ + 8 * hi) * 2;
                    S0 = mm(ldf(rl + O_BBP, r32, 64, kb), ub[s_], S0); S1 = mm(ldf(rl + O_BBP, 32 + r32, 64, kb), ub[s_], S1); yt = mm(ldf(rl + O_MBRT, r32, 64, kb), ub[s_], yt); }
#undef RWC_CV
                { bf16* yo = Y2 + (size_t)(b * SEQ + (c0 + cl) * L) * 1024 + h * 64 + ib * 32 + r32;
#pragma unroll
                  for (int r = 0; r < 16; ++r) yo[(size_t)crow(r, hi) * 1024] = hbf(yt[r]); }
                asm volatile("s_waitcnt lgkmcnt(0)\n\ts_barrier" ::: "memory");
            }
            if (c0 + nch < SEQ / L) {
#pragma unroll
                for (int r = 0; r < 16; ++r) { sg[r] = S0[r]; sg[1024 + r] = S1[r]; } }
        }
    }
}
}


constexpr int CW_CHK = 210000;
__device__ __forceinline__ void rwc_check(const Ctx& c, const Params& p) {
    const float* Ysc = (const float*)(p.ws + WS_YSC); const bf16* Y2 = (const bf16*)(p.ws + WS_Y2); float* acc = (float*)((unsigned*)(p.ws + WS_CTL) + CW_CHK);
    float num = 0.f, den = 0.f;
    for (size_t i = (size_t)blockIdx.x * NTHR + c.tid; i < (size_t)T * D; i += (size_t)gridDim.x * NTHR) { const float a = Ysc[i], b = bf2f(Y2[i]); num += (a - b) * (a - b); den += a * a; }
    num = wave_sum(num); den = wave_sum(den);
    if (c.lane == 0) { atomicAdd(acc, num); atomicAdd(acc + 1, den); }
}

constexpr int RW_SPLIT = 104 * 32;
__device__ __forceinline__ void rwkv_post(const Ctx& c, const Params& p, int part, int blk0, int nblk) {
    const bf16* Y2 = (const bf16*)(p.ws + WS_Y2); const bf16* Rg = (const bf16*)(p.ws + WS_RR); const bf16* Kg = (const bf16*)(p.ws + WS_RK); const bf16* Vg = (const bf16*)(p.ws + WS_RV);
    const bf16* Ag = (const bf16*)(p.ws + WS_RA); const bf16* Gg = (const bf16*)(p.ws + WS_RG); bf16* YG = (bf16*)(p.ws + WS_RYG);
    if ((int)blockIdx.x < blk0) return;
    const int per = part ? SEQ - RW_SPLIT : RW_SPLIT, cnt = BATCH * per, step = nblk * NW;
    typedef unsigned long long u64;
    u64 ny[4], nr[4], nk[4], nv[4], na[4], ng[4];
#define RWP_ROW(i_) (((i_) / per) * SEQ + (part ? RW_SPLIT : 0) + (i_) % per)
#define RWP_LOAD(i_) { const size_t o_ = (size_t)RWP_ROW(i_) * D + 4 * c.lane; _Pragma("unroll") for (int j = 0; j < 4; ++j) { ny[j] = *(const u64*)(Y2 + o_ + 256 * j); nr[j] = *(const u64*)(Rg + o_ + 256 * j); \
        nk[j] = *(const u64*)(Kg + o_ + 256 * j); nv[j] = *(const u64*)(Vg + o_ + 256 * j); na[j] = *(const u64*)(Ag + o_ + 256 * j); ng[j] = *(const u64*)(Gg + o_ + 256 * j); } }
    int idx = ((int)blockIdx.x - blk0) * NW + c.wave;
    if (idx < cnt) RWP_LOAD(idx)
    for (; idx < cnt; idx += step) {
        const int m = RWP_ROW(idx);
        u64 cy[4], cr[4], ck[4], cv[4], ca[4], cg[4];
#pragma unroll
        for (int j = 0; j < 4; ++j) { cy[j] = ny[j]; cr[j] = nr[j]; ck[j] = nk[j]; cv[j] = nv[j]; ca[j] = na[j]; cg[j] = ng[j]; }
        if (idx + step < cnt) RWP_LOAD(idx + step)
        Row o;
#pragma unroll
        for (int j = 0; j < 4; ++j) {
            const int col = 4 * (c.lane + 64 * j);
            const u64 y8 = cy[j], r8 = cr[j], k8 = ck[j], v8 = cv[j], a8 = ca[j], g8 = cg[j];
            const f32x4 ka = *(const f32x4*)(p.in[I_RW_KA] + col), rk = *(const f32x4*)(p.in[I_RW_RK] + col), gg = *(const f32x4*)(p.in[I_RW_GNG] + col), gb = *(const f32x4*)(p.in[I_RW_GNB] + col);
            f32x4 r4, k4, v4, a4, g4, yv;
#pragma unroll
            for (int q = 0; q < 4; ++q) { r4[q] = bf2f((unsigned)(r8 >> (16 * q)) & 0xffffu); k4[q] = bf2f((unsigned)(k8 >> (16 * q)) & 0xffffu); v4[q] = bf2f((unsigned)(v8 >> (16 * q)) & 0xffffu);
                a4[q] = bf2f((unsigned)(a8 >> (16 * q)) & 0xffffu); g4[q] = bf2f((unsigned)(g8 >> (16 * q)) & 0xffffu); yv[q] = bf2f((unsigned)(y8 >> (16 * q)) & 0xffffu); }
            const float mean = red16((yv.x + yv.y) + (yv.z + yv.w)) * (1.f / 64.f);
            const f32x4 dy = yv - mean;
            const float var = red16((dy.x * dy.x + dy.y * dy.y) + (dy.z * dy.z + dy.w * dy.w)) * (1.f / 64.f);
            const float rstd = 1.0f / sqrtf(var + GN_EPS);
            f32x4 kt; float bs = 0.f;
#pragma unroll
            for (int q = 0; q < 4; ++q) { kt[q] = k4[q] * (1.f + (a4[q] - 1.f) * ka[q]); bs += r4[q] * kt[q] * rk[q]; }
            const float bonus = red16(bs);
#pragma unroll
            for (int q = 0; q < 4; ++q) o.v[j][q] = (dy[q] * rstd * gg[q] + gb[q] + bonus * v4[q]) * g4[q];
        }
        row_store_bf(YG + (size_t)m * D, c.lane, o);
    }
#undef RWP_LOAD
#undef RWP_ROW
}

__device__ __forceinline__ float allred4(float x) {
    auto r = __builtin_amdgcn_permlane16_swap(__float_as_uint(x), __float_as_uint(x), false, false); x = __uint_as_float(r[0]) + __uint_as_float(r[1]);
    auto q = __builtin_amdgcn_permlane32_swap(__float_as_uint(x), __float_as_uint(x), false, false); return __uint_as_float(q[0]) + __uint_as_float(q[1]);
}
__device__ __forceinline__ void moe_ln_route(const Ctx& c, const Params& p, int l, bool = false) {
    const bf16* Hbr = (const bf16*)(p.ws + WS_HB); bf16* Hb = (bf16*)(p.ws + WS_HB);
    int* P2TE = (int*)(p.ws + WS_P2TE); float* ROWGE = (float*)(p.ws + WS_ROWGE); int* TOKQ = (int*)(p.ws + WS_TOKQ);
    unsigned* cnt = (unsigned*)(p.ws + WS_CTL) + CW_CNT + l * 64;
    constexpr int L_WT = 0  , L_GB = 98304  , L_RED = L_GB + 256  , L_CNT = L_RED + 1024, L_LNG = L_CNT + 64, L_LNB = L_LNG + 4096,
                  L_GS = L_LNB + 4096  , L_REC = L_GS + 2048  , L_BLK = L_REC + 6144  ;
    LAS unsigned char* ldl = (LAS unsigned char*)c.lds;
    unsigned* lcnt = (unsigned*)(c.lds + L_CNT);
    const int fr = c.lane & 15, fq = c.lane >> 4;
    if (c.tid < 16) lcnt[c.tid] = 0u;
    const int rpb = (T + (int)gridDim.x - 1) / (int)gridDim.x, r0 = (int)blockIdx.x * rpb, r1 = (r0 + rpb < T) ? r0 + rpb : T, ng = (r1 - r0 + 15) >> 4;
    constexpr int L_EX = L_BLK + 64  , L_EXA = L_EX + 1024  ;
    const int kh = c.wave >> 2, gq = c.wave & 3;
    u32x4 xr[16];
#define M1_LOADX(gi_) { int mr_ = r0 + (gi_) * 16 + fr; mr_ = mr_ < r1 ? mr_ : r1 - 1; const u32x4* s_ = (const u32x4*)(Hbr + (size_t)mr_ * D) + fq + 64 * kh; _Pragma("unroll") for (int s = 0; s < 16; ++s) xr[s] = s_[4 * s]; }
    M1_LOADX(gq)
    {
        const float* lg = p.in[I_LN1G] + l * D; const float* lb = p.in[I_LN1B] + l * D; const float* Wr = p.in[I_ROUTER_W];
        const int e = c.tid & 15, q = c.tid >> 4;
        float gsum = 0.f, bsum = 0.f;
#pragma unroll
        for (int m = 0; m < 4; ++m) {
            const int ch = q + 32 * m, col0 = 8 * ch;
            const f32x4 g0 = *(const f32x4*)(lg + col0), g1 = *(const f32x4*)(lg + col0 + 4), b0 = *(const f32x4*)(lb + col0), b1 = *(const f32x4*)(lb + col0 + 4);
            unsigned h1[8], h2[8], h3[8];
#pragma unroll
            for (int i = 0; i < 8; ++i) { const float w = Wr[(col0 + i) * 16 + e], gv = i < 4 ? g0[i & 3] : g1[i & 3], bv = i < 4 ? b0[i & 3] : b1[i & 3], pr = gv * w;
                gsum += pr; bsum = fmaf(bv, w, bsum); attn_body::split3(pr, h1[i], h2[i], h3[i]); }
            const int slot = ((ch >> 2) * 64 + (ch & 3) * 16 + e) * 16;
            *(LAS u32x4*)(ldl + L_WT + slot) = (u32x4){h1[0] | (h1[1] << 16), h1[2] | (h1[3] << 16), h1[4] | (h1[5] << 16), h1[6] | (h1[7] << 16)};
            *(LAS u32x4*)(ldl + L_WT + 32768 + slot) = (u32x4){h2[0] | (h2[1] << 16), h2[2] | (h2[3] << 16), h2[4] | (h2[5] << 16), h2[6] | (h2[7] << 16)};
            *(LAS u32x4*)(ldl + L_WT + 65536 + slot) = (u32x4){h3[0] | (h3[1] << 16), h3[2] | (h3[3] << 16), h3[4] | (h3[5] << 16), h3[6] | (h3[7] << 16)};
        }
        gsum = allred4(gsum); bsum = allred4(bsum);
        if (c.lane < 16) { *(LAS float*)(ldl + L_RED + (c.wave * 32 + e) * 4) = gsum; *(LAS float*)(ldl + L_RED + (c.wave * 32 + 16 + e) * 4) = bsum; }
        for (int i = c.tid; i < 1024; i += NTHR) { *(LAS float*)(ldl + L_LNG + i * 4) = lg[i]; *(LAS float*)(ldl + L_LNB + i * 4) = lb[i]; }
        __syncthreads();
        if (c.tid < 32) { float a = 0.f;
#pragma unroll
            for (int w = 0; w < NW; ++w) a += *(LAS float*)(ldl + L_RED + (w * 32 + c.tid) * 4);
            *(LAS float*)(ldl + L_GB + c.tid * 4) = a; }
        else if (c.tid < 48) *(LAS float*)(ldl + L_GB + c.tid * 4) = p.in[I_ROUTER_B][c.tid - 32];
        __syncthreads();
    }
    const f32x4 Gv = *(LAS f32x4*)(ldl + L_GB + fq * 16), Bv = *(LAS f32x4*)(ldl + L_GB + 64 + fq * 16), Rv = *(LAS f32x4*)(ldl + L_GB + 128 + fq * 16);
    for (int g0 = 0; g0 < ng; g0 += 4) {
        const int gi = g0 + gq;
        f32x4 acc = {0.f, 0.f, 0.f, 0.f};
        unsigned wb_ = (unsigned)c.lane * 16u + (unsigned)kh * 16384u, gb_ = (unsigned)fq * 32u + (unsigned)L_LNG + (unsigned)kh * 2048u; asm volatile("" : "+v"(wb_), "+v"(gb_));
        LAS unsigned char* wtl = ldl + wb_; LAS unsigned char* gbl = ldl + gb_;
#pragma unroll
        for (int s = 0; s < 16; ++s) {
            const pg8::bf16x8 xf = __builtin_bit_cast(pg8::bf16x8, xr[s]);
#pragma unroll
            for (int part = 0; part < 3; ++part)
                acc = __builtin_amdgcn_mfma_f32_16x16x32_bf16(*(LAS pg8::bf16x8*)(wtl + L_WT + part * 32768 + s * 1024), xf, acc, 0, 0, 0);
            if ((s & 3) == 3) __builtin_amdgcn_sched_barrier(0);
        }
        float sum = 0.f;
#pragma unroll
        for (int s = 0; s < 16; ++s)
#pragma unroll
            for (int k = 0; k < 4; ++k) sum += __uint_as_float(xr[s][k] << 16) + __uint_as_float(xr[s][k] & 0xffff0000u);
        sum = allred4(sum);
        if (fq == 0) *(LAS float*)(ldl + L_EX + ((gq * 2 + kh) * 16 + fr) * 4) = sum;
        if (kh == 1) *(LAS f32x4*)(ldl + L_EXA + (gq * 64 + c.lane) * 16) = acc;
        __syncthreads();
        const float mean = (*(LAS float*)(ldl + L_EX + ((gq * 2) * 16 + fr) * 4) + *(LAS float*)(ldl + L_EX + ((gq * 2 + 1) * 16 + fr) * 4)) * (1.f / D);
#pragma unroll
        for (int s = 0; s < 16; ++s) asm volatile("" : "+v"(xr[s]));
        float s2 = 0.f;
#pragma unroll
        for (int s = 0; s < 16; ++s)
#pragma unroll
            for (int k = 0; k < 4; ++k) { const float d0 = __uint_as_float(xr[s][k] << 16) - mean, d1 = __uint_as_float(xr[s][k] & 0xffff0000u) - mean; s2 = fmaf(d0, d0, s2); s2 = fmaf(d1, d1, s2); }
        s2 = allred4(s2);
        if (fq == 0) *(LAS float*)(ldl + L_EX + 512 + ((gq * 2 + kh) * 16 + fr) * 4) = s2;
        __syncthreads();
        const float rstd = 1.0f / sqrtf((*(LAS float*)(ldl + L_EX + 512 + ((gq * 2) * 16 + fr) * 4) + *(LAS float*)(ldl + L_EX + 512 + ((gq * 2 + 1) * 16 + fr) * 4)) * (1.f / D) + LN_EPS);
        const int mrow = r0 + gi * 16 + fr; const bool valid = mrow < r1;
        u32x4* d_ = (u32x4*)(Hb + (size_t)(valid ? mrow : r1 - 1) * D) + fq + 64 * kh;
#pragma unroll
        for (int s = 0; s < 16; ++s) asm volatile("" : "+v"(xr[s]));
#pragma unroll
        for (int s = 0; s < 16; ++s) {
            if ((s & 1) == 0) __builtin_amdgcn_sched_barrier(0);
            const f32x4 g0 = *(LAS f32x4*)(gbl + 128 * s), g1 = *(LAS f32x4*)(gbl + 128 * s + 16);
            const f32x4 b0 = *(LAS f32x4*)(gbl + 4096 + 128 * s), b1 = *(LAS f32x4*)(gbl + 4096 + 128 * s + 16);
            u32x4 o;
#pragma unroll
            for (int k = 0; k < 4; ++k) { const float gl = k < 2 ? g0[2 * k] : g1[2 * k - 4], gh = k < 2 ? g0[2 * k + 1] : g1[2 * k - 3], bl = k < 2 ? b0[2 * k] : b1[2 * k - 4], bh = k < 2 ? b0[2 * k + 1] : b1[2 * k - 3];
                const float y0 = (__uint_as_float(xr[s][k] << 16) - mean) * rstd * gl + bl, y1 = (__uint_as_float(xr[s][k] & 0xffff0000u) - mean) * rstd * gh + bh;
                o[k] = pk2(y0, y1); }
            d_[4 * s] = o;
        }
        if (g0 + 4 < ng) M1_LOADX(g0 + 4 + gq)
        if (kh == 0) {
        const f32x4 accu = *(LAS f32x4*)(ldl + L_EXA + (gq * 64 + c.lane) * 16);
        float sc[4], se[4];
#pragma unroll
        for (int i = 0; i < 4; ++i) { const float lgt = rstd * ((acc[i] + accu[i]) - mean * Gv[i]) + Bv[i]; sc[i] = __builtin_amdgcn_rcpf(1.0f + __builtin_amdgcn_exp2f(-LOG2E * lgt)); se[i] = sc[i] + Rv[i]; }
        int i1 = 0; float v1 = se[0], c1 = sc[0];
#pragma unroll
        for (int i = 1; i < 4; ++i) if (se[i] > v1) { i1 = i; v1 = se[i]; c1 = sc[i]; }
        int i2 = -1; float v2 = -INFINITY, c2v = 0.f;
#pragma unroll
        for (int i = 0; i < 4; ++i) if (i != i1 && se[i] > v2) { i2 = i; v2 = se[i]; c2v = sc[i]; }
        *(LAS float*)(ldl + L_GS + ((c.wave * 16 + fr) * 4 + fq) * 4) = v1 + v2;
        const f32x4 g4 = *(LAS f32x4*)(ldl + L_GS + (c.wave * 16 + fr) * 16);
        int bg = 0; float bv = g4[0];
#pragma unroll
        for (int g = 1; g < 4; ++g) if (g4[g] > bv) { bv = g4[g]; bg = g; }
        if (valid && gi < ng && fq == bg) {
            const int be1 = 4 * fq + i1, be2 = 4 * fq + i2; const float inv = 1.0f / (c1 + c2v);
            const unsigned p1 = atomicAdd(lcnt + be1, 1u), p2 = atomicAdd(lcnt + be2, 1u);
            const int li = (gi * 16 + fr) * 2;
            *(LAS int*)(ldl + L_REC + li * 4) = be1; *(LAS int*)(ldl + L_REC + li * 4 + 4) = be2; *(LAS int*)(ldl + L_REC + 2048 + li * 4) = (int)p1; *(LAS int*)(ldl + L_REC + 2048 + li * 4 + 4) = (int)p2;
            *(LAS float*)(ldl + L_REC + 4096 + li * 4) = c1 * inv; *(LAS float*)(ldl + L_REC + 4096 + li * 4 + 4) = c2v * inv;
        }
        }
        __syncthreads();
    }
#undef M1_LOADX
    __syncthreads();
    if (c.tid < 16) *(LAS int*)(ldl + L_BLK + c.tid * 4) = (int)atomicAdd(cnt + c.tid, lcnt[c.tid]);
    __syncthreads();
    for (int i = c.tid; i < 2 * (r1 - r0); i += NTHR) {
        const int e = *(LAS int*)(ldl + L_REC + i * 4), pe = e * ECAP + *(LAS int*)(ldl + L_BLK + e * 4) + *(LAS int*)(ldl + L_REC + 2048 + i * 4);
        P2TE[pe] = r0 + (i >> 1); ROWGE[pe] = *(LAS float*)(ldl + L_REC + 4096 + i * 4); TOKQ[(r0 + (i >> 1)) * 2 + (i & 1)] = pe; }
}
__device__ __forceinline__ void moe_tiles(const Ctx& c, const Params& p, int l) {
    const unsigned* cnt = (const unsigned*)(p.ws + WS_CTL) + CW_CNT + l * 64;
    LAS int* tab = (LAS int*)((LAS unsigned char*)c.lds + pg8::MOE_TAB);
    const int mt = c.tid; int tb = 0, e_ = 0, j_ = 0, nv_ = 0;
#pragma unroll
    for (int e = 0; e < 16; ++e) { const int ne = (int)__hip_atomic_load(cnt + e, __ATOMIC_RELAXED, __HIP_MEMORY_SCOPE_AGENT), nte = (ne + 255) >> 8;
        if (mt >= tb && mt < tb + nte) { e_ = e; j_ = mt - tb; nv_ = ne - 256 * j_ < 256 ? ne - 256 * j_ : 256; }
        tb += nte; }
    if (mt < 256) { tab[mt] = e_; tab[256 + mt] = j_; tab[512 + mt] = nv_; }
    if (mt == 0) tab[768] = tb;
    __syncthreads();
}
__device__ __forceinline__ void moe_combine(const Ctx& c, const Params& p, int l, float* outp, bool dry = false) {
    const bf16* Hbr = (const bf16*)(p.ws + WS_HB); bf16* Hb = (bf16*)(p.ws + (dry ? WS_ACT + 264 * MiB : WS_HB)); const bf16* Yd = (const bf16*)(p.ws + WS_YD); const int* TOKP = (const int*)(p.ws + WS_TOKQ);
    if (dry) outp = nullptr;
    LAS int* bs = (LAS int*)(LAS unsigned char*)c.lds;
    if (c.tid < 16) { const unsigned* cnt = (const unsigned*)(p.ws + WS_CTL) + CW_CNT + l * 64; int b_ = 0;
        for (int e = 0; e < c.tid; ++e) b_ += ((int)__hip_atomic_load(cnt + e, __ATOMIC_RELAXED, __HIP_MEMORY_SCOPE_AGENT) + 255) & ~255;
        bs[c.tid] = b_; }
    __syncthreads();
    int nq0 = 0, nq1 = 0, nq2 = 0, nq3 = 0;
    if (c.gw < T) { const int m1_ = (c.gw + c.ngw < T) ? c.gw + c.ngw : c.gw; nq0 = TOKP[c.gw * 2]; nq1 = TOKP[c.gw * 2 + 1]; nq2 = TOKP[m1_ * 2]; nq3 = TOKP[m1_ * 2 + 1]; }
    for (int m0 = c.gw; m0 < T; m0 += 2 * c.ngw) {
        const int m1 = (m0 + c.ngw < T) ? m0 + c.ngw : m0;
        const int qa0 = nq0, qa1 = nq1, qb0 = nq2, qb1 = nq3;
        { const int mn = m0 + 2 * c.ngw; if (mn < T) { const int mn1 = (mn + c.ngw < T) ? mn + c.ngw : mn; nq0 = TOKP[mn * 2]; nq1 = TOKP[mn * 2 + 1]; nq2 = TOKP[mn1 * 2]; nq3 = TOKP[mn1 * 2 + 1]; } }
        const int pa0 = bs[qa0 >> 14] + (qa0 & (ECAP - 1)), pa1 = bs[qa1 >> 14] + (qa1 & (ECAP - 1)), pb0 = bs[qb0 >> 14] + (qb0 & (ECAP - 1)), pb1 = bs[qb1 >> 14] + (qb1 & (ECAP - 1));
        Row xa = row_load_bf(Hbr + (size_t)m0 * D, c.lane), xb = row_load_bf(Hbr + (size_t)m1 * D, c.lane);
        unsigned long long ya0[4], ya1[4], yb0[4], yb1[4];
#pragma unroll
        for (int j = 0; j < 4; ++j) { ya0[j] = ((const unsigned long long*)(Yd + (size_t)pa0 * D) + c.lane)[64 * j]; ya1[j] = ((const unsigned long long*)(Yd + (size_t)pa1 * D) + c.lane)[64 * j];
                                      yb0[j] = ((const unsigned long long*)(Yd + (size_t)pb0 * D) + c.lane)[64 * j]; yb1[j] = ((const unsigned long long*)(Yd + (size_t)pb1 * D) + c.lane)[64 * j]; }
#define M5_ADD(RW, YA, YB) _Pragma("unroll") for (int j = 0; j < 4; ++j) { const unsigned long long a = YA[j], b = YB[j]; \
            RW.v[j][0] = ALPHA * RW.v[j][0] + bf2f((unsigned)a & 0xffffu) + bf2f((unsigned)b & 0xffffu); RW.v[j][1] = ALPHA * RW.v[j][1] + bf2f(((unsigned)a >> 16)) + bf2f(((unsigned)b >> 16)); \
            RW.v[j][2] = ALPHA * RW.v[j][2] + bf2f((unsigned)(a >> 32) & 0xffffu) + bf2f((unsigned)(b >> 32) & 0xffffu); RW.v[j][3] = ALPHA * RW.v[j][3] + bf2f((unsigned)(a >> 48)) + bf2f((unsigned)(b >> 48)); }
        M5_ADD(xa, ya0, ya1) M5_ADD(xb, yb0, yb1)
#undef M5_ADD
        const Row oa = row_ln(xa, p.in[I_LN2G] + l * D, p.in[I_LN2B] + l * D, c.lane), ob = row_ln(xb, p.in[I_LN2G] + l * D, p.in[I_LN2B] + l * D, c.lane);
        if (outp) { row_store(outp + (size_t)m0 * D, c.lane, oa); if (m1 != m0) row_store(outp + (size_t)m1 * D, c.lane, ob); }
        else { row_store_bf(Hb + (size_t)m0 * D, c.lane, oa); if (m1 != m0) row_store_bf(Hb + (size_t)m1 * D, c.lane, ob); }
    }
}

enum { PH_P0 = 0,
       PH_F1, PH_F3, PH_F4, PH_M1_0, PH_M3_0, PH_M4_0, PH_M5_0,
       PH_G1, PH_G2, PH_G3, PH_M1_1, PH_M3_1, PH_M4_1, PH_M5_1,
       PH_S1, PH_S2, PH_S3, PH_M1_2, PH_M3_2, PH_M4_2, PH_M5_2,
       PH_R0, PH_R1, PH_R2, PH_RC0, PH_RC1, PH_RC2, PH_RC3, PH_RC4, PH_RC5, PH_R4B, PH_R5, PH_M1_3, PH_M3_3, PH_M4_3, PH_M5_3, NPHASE };

#define RP_P0 RP1
#define RP_F1 RP1
#define RP_F3 RP1
#define RP_M34 RP1
#define RP_G2 RP1
#define RP_S2 RP1
#define RP_R4 RP1
#define RP0(...) {}
#define RP4B(...) { __VA_ARGS__; xcd_barrier(bar); __VA_ARGS__; xcd_barrier(bar); __VA_ARGS__; xcd_barrier(bar); __VA_ARGS__; xcd_barrier(bar); }
#define RP_M1D RP0
#define RP_M2 RP1
#define RP_M5D RP0
__global__ void __launch_bounds__(NTHR, 2) fwd_kernel(Params p) {
    extern __shared__ __attribute__((aligned(16))) unsigned char lds[];
    Ctx c; c.tid = threadIdx.x; c.lane = c.tid & 63; c.wave = __builtin_amdgcn_readfirstlane(c.tid >> 6); c.gw = blockIdx.x * NW + c.wave; c.ngw = gridDim.x * NW; c.lds = lds;
    volatile LAS unsigned* MISC = (volatile LAS unsigned*)((LAS unsigned char*)lds + MISC_OFF);
    if (c.tid < 32) MISC[c.tid] = 0u;
    __syncthreads();
    unsigned* ctl = (unsigned*)(p.ws + WS_CTL);
    XcdBarrier bar = xcd_barrier_post(ctl + CW_BAR + p.li * XCD_BAR_WORDS, MISC + 8);
    const int lo = p.ph_lo, hi = p.ph_hi;
    unsigned char* ws = p.ws;
#define PHASE(k, ...) if (lo <= (k) && (k) < hi) { Ctx c; { int t_ = threadIdx.x; asm volatile("" : "+v"(t_)); c.tid = t_; c.lane = t_ & 63; c.wave = __builtin_amdgcn_readfirstlane(t_ >> 6); c.gw = blockIdx.x * NW + c.wave; c.ngw = gridDim.x * NW; c.lds = lds; } \
        __VA_ARGS__; if ((k) + 1 < hi) xcd_barrier(bar); }
#define RP1(...) { __VA_ARGS__; }
#define RP5(...) { __VA_ARGS__; xcd_barrier(bar); __VA_ARGS__; xcd_barrier(bar); __VA_ARGS__; xcd_barrier(bar); __VA_ARGS__; xcd_barrier(bar); __VA_ARGS__; }

    PHASE(PH_P0, RP_P0(phase_p0(c, p)));
    LAS unsigned char* ldsr = (LAS unsigned char*)lds;
    const int G = gridDim.x, bid = blockIdx.x;
    const int vbid = (G % 8 == 0) ? (bid % 8) * (G / 8) + bid / 8 : bid;
#define GEMM_DENSE(Aoff, Boff, N, K, EPI_T, ...) { pg8::Gemm g{(const bf16*)(ws + (Aoff)), (const bf16*)(ws + (Boff)), T, (N), (K), nullptr}; pg8::StaticOrder S; S.init(T, (N), G, bid); \
        EPI_T E{__VA_ARGS__}; pg8::gemm_phase<EPI_T, pg8::StaticOrder, true, true>(ldsr, g, S, E); }
    PHASE(PH_F1, { fox_cumsum(c, p); __syncthreads();
        RP_F1(GEMM_DENSE(WS_HB, WS_FOX_IN, 4096, 1024, pg8::EpiBf16X<0>, (bf16*)(ws + WS_Q), 1024, nullptr, 1024, (size_t)T * 1024, C2)) });
    PHASE(PH_F3, RP_F3({ const attn_body::AttnTensors AT{(const attn_body::bf16*)(ws + WS_Q), (const attn_body::bf16*)(ws + WS_K), (const attn_body::bf16*)(ws + WS_V), (attn_body::bf16*)(ws + WS_O),
                                                  (const float*)(ws + WS_CB), (const attn_body::bf16*)(ws + WS_OG)};
        const attn_body::StaticOrder S(G, bid); attn_body::attn_phase<attn_body::StaticOrder>((char*)lds, AT, S); conv_up0_pull(c, p); }));
    PHASE(PH_F4, { GEMM_DENSE(WS_O, WS_FOX_OUT, 1024, 1024, pg8::EpiResid, (bf16*)(ws + WS_HB), ALPHA); conv_up0_pull(c, p); });
#define MOE_BLOCK(L, K1, K3, K4, K5, OUTP, NEXTCONV) \
    PHASE(K1, { RP_M1D(moe_ln_route(c, p, L, true)); moe_ln_route(c, p, L); }); \
    PHASE(K3, RP_M34({ moe_tiles(c, p, L); pg8::Gemm g{(const bf16*)(ws + WS_HB), (const bf16*)(ws + WS_GU + (size_t)((L) & 1) * WS_MOE_ALT), MPAD_MAX, 16 * 1024, 1024, (const int*)(ws + WS_P2TE)}; pg8::MoeOrder S{(const LAS int*)(ldsr + pg8::MOE_TAB), G, vbid}; \
        pg8::EpiSwiglu E{(bf16*)(ws + WS_H1)}; pg8::gemm_phase<pg8::EpiSwiglu, pg8::MoeOrder, true, true, true>(ldsr, g, S, E); \
        { int w_, nw_; if (tail_slot(c, 4 * __builtin_amdgcn_readfirstlane(*(const LAS int*)(ldsr + pg8::MOE_TAB + 768 * 4)), w_, nw_, vbid)) { conv_moe_items(c, p, (L), 32 * 256, 48 * 256, w_, nw_); if (NEXTCONV) conv_moe_items(c, p, (L) + 1, 0, 16 * 256, w_, nw_); } } })); \
    PHASE(K4, RP_M34({ moe_tiles(c, p, L); pg8::Gemm g{(const bf16*)(ws + WS_H1), (const bf16*)(ws + WS_DOWN + (size_t)((L) & 1) * WS_MOE_ALT), MPAD_MAX, 16 * 1024, 512, nullptr}; pg8::MoeOrder S{(const LAS int*)(ldsr + pg8::MOE_TAB), G, vbid}; \
        pg8::EpiDown E{(bf16*)(ws + WS_YD), (const float*)(ws + WS_ROWGE)}; pg8::gemm_phase<pg8::EpiDown, pg8::MoeOrder, true, true>(ldsr, g, S, E); \
        if (NEXTCONV) { int w_, nw_; if (tail_slot(c, 4 * __builtin_amdgcn_readfirstlane(*(const LAS int*)(ldsr + pg8::MOE_TAB + 768 * 4)), w_, nw_, vbid)) { conv_moe_items(c, p, (L) + 1, 16 * 256, 32 * 256, w_, nw_); \
             if ((L) == 0) conv_pair<2048>(c, p.in[I_GM_WIN], p.in[I_GM_WOUT], (bf16*)(ws + WS_GM_IN), (bf16*)(ws + WS_GM_OUT), w_, nw_); \
             if ((L) == 1) conv_pair<3072>(c, p.in[I_SB_WIN], p.in[I_SB_WOUT], (bf16*)(ws + WS_SB_IN), (bf16*)(ws + WS_SB_OUT), w_, nw_); \
             if ((L) == 2) conv_rw_big(c, p.in[I_RW_WRKV], p.in[I_RW_WOUT], (bf16*)(ws + WS_RKV), (bf16*)(ws + WS_RW_OUT), w_, nw_); } } })); \
    PHASE(K5, { RP_M5D(moe_combine(c, p, L, OUTP, true)); moe_combine(c, p, L, OUTP); });
    MOE_BLOCK(0, PH_M1_0, PH_M3_0, PH_M4_0, PH_M5_0, nullptr, true)
    PHASE(PH_G1, GEMM_DENSE(WS_HB, WS_GM_IN, 2048, 1024, pg8::EpiBf16X<2>, (bf16*)(ws + WS_Z), 2048, p.in[I_GM_BIN], 0, 0, 1.f));
    PHASE(PH_G2, RP_G2(gmlp_spatial(c, p)));
    PHASE(PH_G3, GEMM_DENSE(WS_YG, WS_GM_OUT, 1024, 1024, pg8::EpiResid, (bf16*)(ws + WS_HB), ALPHA));
    MOE_BLOCK(1, PH_M1_1, PH_M3_1, PH_M4_1, PH_M5_1, nullptr, true)
    PHASE(PH_S1, GEMM_DENSE(WS_HB, WS_SB_IN, 3072, 1024, pg8::EpiBf16X<0>, (bf16*)(ws + WS_Q), 1024, nullptr, 1024, (size_t)T * 1024, C2));
    PHASE(PH_S2, RP_S2({ const attn_body::AttnTensors AT{(const attn_body::bf16*)(ws + WS_Q), (const attn_body::bf16*)(ws + WS_K), (const attn_body::bf16*)(ws + WS_V), (attn_body::bf16*)(ws + WS_O), nullptr, nullptr};
        const attn_body::SbOrder S(G, bid); attn_body::sb_phase<attn_body::SbOrder>((char*)lds, AT, S); }));
    PHASE(PH_S3, GEMM_DENSE(WS_O, WS_SB_OUT, 1024, 1024, pg8::EpiResid, (bf16*)(ws + WS_HB), ALPHA));
    MOE_BLOCK(2, PH_M1_2, PH_M3_2, PH_M4_2, PH_M5_2, nullptr, true)
    PHASE(PH_R0, rwkv_mix(c, p));
    PHASE(PH_R1, { pg8::Gemm g{(const bf16*)(ws + WS_HM), (const bf16*)(ws + WS_RKV), 6 * T, 15 * 256, 1024, nullptr}; pg8::Rw1Order S{G, vbid};
        pg8::EpiRw1 E{(bf16*)(ws + WS_RR), (bf16*)(ws + WS_L1), T}; pg8::gemm_phase<pg8::EpiRw1, pg8::Rw1Order, true, true>(ldsr, g, S, E); });
    PHASE(PH_R2, { pg8::Gemm g{(const bf16*)(ws + WS_L1), (const bf16*)(ws + WS_LORA2), 3 * T, 3 * 1024, 128, nullptr}; pg8::Rw2Order S{G, vbid};
        pg8::EpiRw2 E{(float*)(ws + WS_WDEC), (bf16*)(ws + WS_RA), (bf16*)(ws + WS_RG), p.in[I_RW_W0], p.in[I_RW_A0]}; pg8::gemm_phase<pg8::EpiRw2, pg8::Rw2Order, true, true>(ldsr, g, S, E); });
    const bool split_ok = G >= 128;
#define RW_STAGE(K, ST, C0, NCH, NC0, NNCH) PHASE(K, { if (split_ok) { if (bid < 64) rwc::rwc_scan(c, p, ST, C0, NCH); else rwc::rwc_prep(c, p, (ST) + 1, NC0, NNCH, 64, G - 64); } \
        else { rwc::rwc_scan(c, p, ST, C0, NCH); __syncthreads(); rwc::rwc_prep(c, p, (ST) + 1, NC0, NNCH, 0, G); } });
    PHASE(PH_RC0, rwc::rwc_prep(c, p, 0, 0, 32, 0, G));
    RW_STAGE(PH_RC1, 0, 0, 32, 32, 24)
    RW_STAGE(PH_RC2, 1, 32, 24, 56, 24)
    RW_STAGE(PH_RC3, 2, 56, 24, 80, 24)
    RW_STAGE(PH_RC4, 3, 80, 24, 104, 24)
#undef RW_STAGE
    PHASE(PH_RC5, { if (split_ok) { if (bid < 64) rwc::rwc_scan(c, p, 4, 104, 24); else rwkv_post(c, p, 0, 64, G - 64); } else { rwc::rwc_scan(c, p, 4, 104, 24); __syncthreads(); rwkv_post(c, p, 0, 0, G); } });
    PHASE(PH_R4B, rwkv_post(c, p, 1, 0, G));
    PHASE(PH_R5, GEMM_DENSE(WS_RYG, WS_RW_OUT, 1024, 1024, pg8::EpiResid, (bf16*)(ws + WS_HB), ALPHA));
    MOE_BLOCK(3, PH_M1_3, PH_M3_3, PH_M4_3, PH_M5_3, p.out, false)
#undef PHASE
}

extern "C" void kernel_launch(void* const* d_in, const int* in_sizes, int n_in, void* d_out, int out_size, void* d_ws, size_t ws_size, hipStream_t stream) {
    static int grid = 0;
    if (grid == 0) {
        if (n_in != 38 || in_sizes[0] != T * D || out_size != T * D || ws_size < WS_END) { fprintf(stderr, "kernel_launch: unexpected shapes (n_in %d, ws %zu)\n", n_in, ws_size); grid = -1; return; }
        int dev = 0, cus = 0;
        if (hipGetDevice(&dev) != hipSuccess || hipDeviceGetAttribute(&cus, hipDeviceAttributeMultiprocessorCount, dev) != hipSuccess) { grid = -1; return; }
        if (hipFuncSetAttribute((const void*)fwd_kernel, hipFuncAttributeMaxDynamicSharedMemorySize, LDS_BYTES) != hipSuccess) { fprintf(stderr, "kernel_launch: hipFuncSetAttribute failed\n"); grid = -1; return; }
        int per_cu = 0; (void)hipOccupancyMaxActiveBlocksPerMultiprocessor(&per_cu, (const void*)fwd_kernel, NTHR, LDS_BYTES); (void)hipGetLastError();
        grid = cus > 0 ? cus : 256;
    }
    if (grid < 0) return;
    (void)hipMemsetAsync((char*)d_ws + WS_CTL, 0, CTL_ZERO_BYTES, stream);
    Params a{};
    for (int i = 0; i < 38; ++i) a.in[i] = (const float*)d_in[i];
    a.out = (float*)d_out; a.ws = (unsigned char*)d_ws; a.pad = 0;
    if (N_LAUNCH_MODE == 1) { a.ph_lo = 0; a.ph_hi = NPHASE; a.li = 0; hipLaunchKernelGGL(fwd_kernel, dim3(grid), dim3(NTHR), LDS_BYTES, stream, a); }
    else for (int k = 0; k < NPHASE; ++k) { a.ph_lo = k; a.ph_hi = k + 1; a.li = k; hipLaunchKernelGGL(fwd_kernel, dim3(grid), dim3(NTHR), LDS_BYTES, stream, a); }
}
```
